# Optimizing an MI355X kernel written in HIP

```python
import math
import jax, jax.numpy as jnp
from jax import lax
import numpy as np

D_MODEL = 1024
BATCH = 16
SEQ = 2048
DEPTH = 1

D_RNN = 1344
LRU_BLOCKS = 4
LRU_BLOCK_W = D_RNN // LRU_BLOCKS
CONV_W = 4
LRU_C = 8.0
N_HEADS = 16
HEAD_DIM = 64
N_KV_GROUPS = 4
HEADS_PER_GROUP = N_HEADS // N_KV_GROUPS
CMP_BLOCK = 32
CMP_STRIDE = 16
SEL_BLOCK = 64
N_SELECT = 16
WINDOW = 512
PHI_HIDDEN = 256
Q_BLOCK = 32
SEL_FORCED = 1e4
NEG_INF = -1e30
REL_BUCKETS = 32
REL_MAX_DIST = 128
D_FF = 4 * D_MODEL
NORM_EPS = 1e-6

Q_W = N_HEADS * HEAD_DIM
KV_W = N_KV_GROUPS * HEAD_DIM
SPLIT_SIZES = (D_RNN, D_RNN, Q_W, KV_W, KV_W, KV_W, KV_W, KV_W, KV_W, 3 * N_HEADS, D_MODEL, D_MODEL)
D_IN = 2 * D_RNN + Q_W + 6 * KV_W + 3 * N_HEADS + 2 * D_MODEL

kernel_name = "hybrid_rglru_nsa_sqrelu"


def rmsnorm(x, g):
    xf = x.astype(jnp.float32)
    y = xf * lax.rsqrt(jnp.mean(xf * xf, axis=-1, keepdims=True) + NORM_EPS)
    return y.astype(x.dtype) * g


def t5_bucket(dist):
    max_exact = REL_BUCKETS // 2
    d = jnp.maximum(dist, 0)
    df = jnp.maximum(d.astype(jnp.float32), 1.0)
    large = max_exact + (jnp.log(df / max_exact) / math.log(REL_MAX_DIST / max_exact)
                         * (REL_BUCKETS - max_exact)).astype(jnp.int32)
    large = jnp.minimum(large, REL_BUCKETS - 1)
    return jnp.where(d < max_exact, d, large)


def masked_softmax(s, mask):
    p = jax.nn.softmax(jnp.where(mask, s.astype(jnp.float32), NEG_INF), axis=-1)
    return jnp.where(mask, p, 0.0)


def causal_depthwise_conv(x, w, b):
    y = lax.conv_general_dilated(x, w[:, None, :], window_strides=(1,), padding=[(CONV_W - 1, 0)],
                                 dimension_numbers=("NWC", "WIO", "NWC"),
                                 feature_group_count=x.shape[-1])
    return y + b


def block_diag_linear(x, w, b):
    xb = x.reshape(x.shape[0], x.shape[1], LRU_BLOCKS, LRU_BLOCK_W)
    y = jnp.einsum("btni,nij->btnj", xb, w) + b
    return y.reshape(x.shape)


def rg_lru(x, w_a, b_a, w_x, b_x, lam):
    r = jax.nn.sigmoid(block_diag_linear(x, w_a, b_a)).astype(jnp.float32)
    i = jax.nn.sigmoid(block_diag_linear(x, w_x, b_x))
    log_a = -LRU_C * r * jax.nn.softplus(-lam.astype(jnp.float32))
    a = jnp.exp(log_a)
    mult = jnp.sqrt(-jnp.expm1(2.0 * log_a))
    first = (jnp.arange(x.shape[1]) == 0)[None, :, None]
    mult = jnp.where(first, 1.0, mult)
    u = mult * (i * x).astype(jnp.float32)

    def combine(c1, c2):
        a1, b1 = c1
        a2, b2 = c2
        return a1 * a2, a2 * b1 + b2

    _, h = lax.associative_scan(combine, (a, u), axis=1)
    return h.astype(x.dtype)


def compress_blocks(z, pe, w1, w2):
    b, t = z.shape[0], z.shape[1]
    n_c = (t - CMP_BLOCK) // CMP_STRIDE + 1
    idx = jnp.arange(n_c)[:, None] * CMP_STRIDE + jnp.arange(CMP_BLOCK)[None, :]
    blk = z[:, idx] + pe[None, None, :, None, :]
    flat = blk.transpose(0, 3, 1, 2, 4).reshape(b, N_KV_GROUPS, n_c, CMP_BLOCK * HEAD_DIM)
    return jax.nn.gelu(flat @ w1, approximate=True) @ w2


def nsa_mixer(q, k_c, v_c, k_s, v_s, k_w, v_w, g_nsa, rel_bias,
              phi_k_pe, phi_k_w1, phi_k_w2, phi_v_pe, phi_v_w1, phi_v_w2,
              q_norm, kc_norm, ks_norm, kw_norm):
    B, T, _ = q.shape
    G, R, hd = N_KV_GROUPS, HEADS_PER_GROUP, HEAD_DIM
    qh = rmsnorm(q.reshape(B, T, N_HEADS, hd), q_norm) * (hd ** -0.5)
    qh = qh.reshape(B, T, G, R, hd).transpose(0, 2, 3, 1, 4)
    kv = lambda z: z.reshape(B, T, G, hd)
    kc = rmsnorm(compress_blocks(kv(k_c), phi_k_pe, phi_k_w1, phi_k_w2), kc_norm)
    vc = compress_blocks(kv(v_c), phi_v_pe, phi_v_w1, phi_v_w2)
    n_c = kc.shape[2]
    n_sblk = T // SEL_BLOCK
    ks = rmsnorm(kv(k_s), ks_norm).transpose(0, 2, 1, 3).reshape(B, G, n_sblk, SEL_BLOCK, hd)
    vs = kv(v_s).transpose(0, 2, 1, 3).reshape(B, G, n_sblk, SEL_BLOCK, hd)
    pad = ((0, 0), (0, 0), (WINDOW, 0), (0, 0))
    kw = jnp.pad(rmsnorm(kv(k_w), kw_norm).transpose(0, 2, 1, 3), pad)
    vw = jnp.pad(kv(v_w).transpose(0, 2, 1, 3), pad)
    gates = jax.nn.sigmoid(g_nsa.reshape(B, T, G, R, 3).transpose(0, 2, 3, 1, 4))
    bias_gr = rel_bias.T.reshape(G, R, REL_BUCKETS)

    cstart = jnp.arange(n_c) * CMP_STRIDE
    cend = cstart + CMP_BLOCK - 1
    sj = jnp.arange(n_sblk)
    cover = ((cstart[:, None] < (sj[None, :] + 1) * SEL_BLOCK)
             & (cend[:, None] >= sj[None, :] * SEL_BLOCK)).astype(jnp.float32)
    n_top = min(N_SELECT, n_sblk)
    L = n_top * SEL_BLOCK
    bi = jnp.arange(B)[:, None, None, None]
    gi = jnp.arange(G)[None, :, None, None]
    gi5 = jnp.arange(G)[None, :, None, None, None]
    ri5 = jnp.arange(R)[None, None, :, None, None]

    def attend_block(blk):
        t0 = blk * Q_BLOCK
        tq = t0 + jnp.arange(Q_BLOCK)
        qb = lax.dynamic_slice_in_dim(qh, t0, Q_BLOCK, axis=3)
        gb = lax.dynamic_slice_in_dim(gates, t0, Q_BLOCK, axis=3)
        s_c = (jnp.einsum("bgrqd,bgcd->bgrqc", qb, kc).astype(jnp.float32)
               + bias_gr[:, :, t5_bucket(tq[:, None] - cend[None, :])])
        p_c = masked_softmax(s_c, cend[None, :] <= tq[:, None])
        o_c = jnp.einsum("bgrqc,bgcd->bgrqd", p_c.astype(vc.dtype), vc)
        imp = jnp.einsum("bgrqc,cj->bgqj", p_c, cover)
        qblk = tq // SEL_BLOCK
        causal_j = sj[None, :] <= qblk[:, None]
        forced = causal_j & ((sj[None, :] == 0) | (sj[None, :] >= qblk[:, None] - 1))
        score = jnp.where(forced, SEL_FORCED, jnp.where(causal_j, imp, -1.0))
        top_v, top_i = lax.top_k(score, n_top)
        k_sel = ks[bi, gi, top_i].reshape(B, G, Q_BLOCK, L, hd)
        v_sel = vs[bi, gi, top_i].reshape(B, G, Q_BLOCK, L, hd)
        pos = top_i[..., None] * SEL_BLOCK + jnp.arange(SEL_BLOCK)
        mask_s = ((top_v >= 0.0)[..., None] & (pos <= tq[:, None, None])).reshape(B, G, Q_BLOCK, L)
        dist_s = tq[:, None] - pos.reshape(B, G, Q_BLOCK, L)
        s_s = (jnp.einsum("bgrqd,bgqld->bgrql", qb, k_sel).astype(jnp.float32)
               + bias_gr[gi5, ri5, t5_bucket(dist_s)[:, :, None]])
        p_s = masked_softmax(s_s, mask_s[:, :, None])
        o_s = jnp.einsum("bgrql,bgqld->bgrqd", p_s.astype(v_sel.dtype), v_sel)
        kwb = lax.dynamic_slice_in_dim(kw, t0, WINDOW + Q_BLOCK, axis=2)
        vwb = lax.dynamic_slice_in_dim(vw, t0, WINDOW + Q_BLOCK, axis=2)
        sk = t0 - WINDOW + jnp.arange(WINDOW + Q_BLOCK)
        dist_w = tq[:, None] - sk[None, :]
        mask_w = (dist_w >= 0) & (dist_w < WINDOW) & (sk[None, :] >= 0)
        s_w = (jnp.einsum("bgrqd,bgsd->bgrqs", qb, kwb).astype(jnp.float32)
               + bias_gr[:, :, t5_bucket(dist_w)])
        p_w = masked_softmax(s_w, mask_w)
        o_w = jnp.einsum("bgrqs,bgsd->bgrqd", p_w.astype(vwb.dtype), vwb)
        return gb[..., 0:1] * o_c + gb[..., 1:2] * o_s + gb[..., 2:3] * o_w

    o = lax.map(attend_block, jnp.arange(T // Q_BLOCK))
    return o.transpose(1, 0, 4, 2, 3, 5).reshape(B, T, Q_W)


def hybrid_layer(x, rel_bias, norm_mix, w_in, conv_w, conv_b, gate_a_w, gate_a_b, gate_x_w, gate_x_b,
                 lru_lambda, phi_k_pe, phi_k_w1, phi_k_w2, phi_v_pe, phi_v_w1, phi_v_w2,
                 q_norm, kc_norm, ks_norm, kw_norm, proj_a, proj_b, w_out,
                 norm_mlp, w_mlp_in, w_mlp_out):
    xn = rmsnorm(x, norm_mix)
    cuts = [int(c) for c in np.cumsum(SPLIT_SIZES)[:-1]]
    (u_rnn, u_gate, q, k_c, v_c, k_s, v_s, k_w, v_w, g_nsa, g_a, g_b) = jnp.split(xn @ w_in, cuts, axis=-1)
    h_a = rg_lru(causal_depthwise_conv(u_rnn, conv_w, conv_b), gate_a_w, gate_a_b, gate_x_w, gate_x_b, lru_lambda)
    y_a = h_a * jax.nn.gelu(u_gate, approximate=True)
    y_b = nsa_mixer(q, k_c, v_c, k_s, v_s, k_w, v_w, g_nsa, rel_bias,
                    phi_k_pe, phi_k_w1, phi_k_w2, phi_v_pe, phi_v_w1, phi_v_w2,
                    q_norm, kc_norm, ks_norm, kw_norm)
    merged = jax.nn.sigmoid(g_a) * (y_a @ proj_a) + jax.nn.sigmoid(g_b) * (y_b @ proj_b)
    h = x + merged @ w_out
    z = rmsnorm(h, norm_mlp) @ w_mlp_in
    return h + jnp.square(jax.nn.relu(z)) @ w_mlp_out


def setup_inputs(seed: int = 0) -> dict:
    key = jax.random.key(seed)
    ks = jax.random.split(key, 32)
    nrm = lambda k, shape, scale: jax.random.normal(k, shape, jnp.float32) * scale
    gain = lambda k, shape: 1.0 + 0.05 * jax.random.normal(k, shape, jnp.float32)
    a0 = jax.random.uniform(ks[9], (DEPTH, D_RNN), jnp.float32, minval=0.9, maxval=0.999)
    s = a0 ** (1.0 / LRU_C)
    lam = jnp.log(s) - jnp.log1p(-s)
    cw = CMP_BLOCK * HEAD_DIM
    return {
        "x": nrm(ks[0], (BATCH, SEQ, D_MODEL), 1.0),
        "norm_mix": gain(ks[1], (DEPTH, D_MODEL)),
        "w_in": nrm(ks[2], (DEPTH, D_MODEL, D_IN), D_MODEL ** -0.5),
        "conv_w": nrm(ks[3], (DEPTH, CONV_W, D_RNN), CONV_W ** -0.5),
        "conv_b": nrm(ks[4], (DEPTH, D_RNN), 0.1),
        "gate_a_w": nrm(ks[5], (DEPTH, LRU_BLOCKS, LRU_BLOCK_W, LRU_BLOCK_W), LRU_BLOCK_W ** -0.5),
        "gate_a_b": nrm(ks[6], (DEPTH, LRU_BLOCKS, LRU_BLOCK_W), 0.1),
        "gate_x_w": nrm(ks[7], (DEPTH, LRU_BLOCKS, LRU_BLOCK_W, LRU_BLOCK_W), LRU_BLOCK_W ** -0.5),
        "gate_x_b": nrm(ks[8], (DEPTH, LRU_BLOCKS, LRU_BLOCK_W), 0.1),
        "lru_lambda": lam,
        "phi_k_pe": nrm(ks[10], (DEPTH, CMP_BLOCK, HEAD_DIM), 0.1),
        "phi_k_w1": nrm(ks[11], (DEPTH, cw, PHI_HIDDEN), cw ** -0.5),
        "phi_k_w2": nrm(ks[12], (DEPTH, PHI_HIDDEN, HEAD_DIM), PHI_HIDDEN ** -0.5),
        "phi_v_pe": nrm(ks[13], (DEPTH, CMP_BLOCK, HEAD_DIM), 0.1),
        "phi_v_w1": nrm(ks[14], (DEPTH, cw, PHI_HIDDEN), cw ** -0.5),
        "phi_v_w2": nrm(ks[15], (DEPTH, PHI_HIDDEN, HEAD_DIM), PHI_HIDDEN ** -0.5),
        "q_norm": gain(ks[16], (DEPTH, HEAD_DIM)),
        "kc_norm": gain(ks[17], (DEPTH, HEAD_DIM)),
        "ks_norm": gain(ks[18], (DEPTH, HEAD_DIM)),
        "kw_norm": gain(ks[19], (DEPTH, HEAD_DIM)),
        "rel_bias": nrm(ks[20], (REL_BUCKETS, N_HEADS), 0.5),
        "proj_a": nrm(ks[21], (DEPTH, D_RNN, D_MODEL), D_RNN ** -0.5),
        "proj_b": nrm(ks[22], (DEPTH, Q_W, D_MODEL), Q_W ** -0.5),
        "w_out": nrm(ks[23], (DEPTH, D_MODEL, D_MODEL), D_MODEL ** -0.5),
        "norm_mlp": gain(ks[24], (DEPTH, D_MODEL)),
        "w_mlp_in": nrm(ks[25], (DEPTH, D_MODEL, D_FF), D_MODEL ** -0.5),
        "w_mlp_out": nrm(ks[26], (DEPTH, D_FF, D_MODEL), D_FF ** -0.5),
    }


def reference(x, norm_mix, w_in, conv_w, conv_b, gate_a_w, gate_a_b, gate_x_w, gate_x_b, lru_lambda,
              phi_k_pe, phi_k_w1, phi_k_w2, phi_v_pe, phi_v_w1, phi_v_w2,
              q_norm, kc_norm, ks_norm, kw_norm, rel_bias, proj_a, proj_b, w_out,
              norm_mlp, w_mlp_in, w_mlp_out):
    h = x
    for l in range(DEPTH):
        h = hybrid_layer(h, rel_bias, norm_mix[l], w_in[l], conv_w[l], conv_b[l],
                         gate_a_w[l], gate_a_b[l], gate_x_w[l], gate_x_b[l], lru_lambda[l],
                         phi_k_pe[l], phi_k_w1[l], phi_k_w2[l], phi_v_pe[l], phi_v_w1[l], phi_v_w2[l],
                         q_norm[l], kc_norm[l], ks_norm[l], kw_norm[l],
                         proj_a[l], proj_b[l], w_out[l], norm_mlp[l], w_mlp_in[l], w_mlp_out[l])
    return h
```

```cpp
#include <hip/hip_runtime.h>
#include <hip/hip_cooperative_groups.h>
#include <cstdio>
#include <cstdint>
#ifndef FASTMASK
#define FASTMASK 0xFFFFFFFFu
#endif
#define FAST(p) ((FASTMASK >> (p)) & 1u)
namespace cg = cooperative_groups;

typedef unsigned short bf16_t;
constexpr int NTHREADS = 512;
constexpr int LDS_BYTES = 163840;
constexpr size_t MiB = 1u << 20;

constexpr int NB = 16, T = 2048, D = 1024, M = NB * T;
constexpr int DRNN = 1344, BW = 336, QW = 1024, KVW = 256, NH = 16, HD = 64, NG = 4;
constexpr int DIN = 7344, DFF = 4096, NC = 127, NSB = 32, CROWS = NB * NG * NC;
constexpr int C_URNN = 0, C_UGATE = 1344, C_Q = 2688, C_KV = 3712, C_GN = 5248, C_GA = 5296, C_GB = 6320;
constexpr float EPS = 1e-6f, LOG2E = 1.4426950408889634f;
constexpr int YA_LD = 1408, XC_LD = 384;

constexpr size_t WS_RSTD = 1 * MiB, WS_RSTD2 = 1 * MiB + 512 * 1024, WS_KCC = 2 * MiB, WS_VCC = 4 * MiB, WS_SEL = 6 * MiB;
constexpr size_t WS_URNN = 52 * MiB, WS_UGATE = 136 * MiB, WS_Q = 220 * MiB, WS_KV = 284 * MiB  , WS_GN = 380 * MiB, WS_GA = 384 * MiB, WS_GB = 448 * MiB, WS_END = 512 * MiB;
constexpr size_t WS_PES = 1 * MiB + 448 * 1024  , WS_NORMS = 1 * MiB + 384 * 1024, WS_LAMC = 1 * MiB + 256 * 1024, WS_SSQ = 6 * MiB + 512 * 1024  ;
constexpr size_t WS_WIN = 9 * MiB  , WS_WG = 24 * MiB  , WS_W1 = 27 * MiB  , WS_PA = 29 * MiB  , WS_PB = 32 * MiB, WS_WO = 34 * MiB, WS_WMI = 36 * MiB  , WS_WMO = 44 * MiB  ;
constexpr size_t DO_KCB = 104 * MiB  , DO_VCT = 105 * MiB  ;
constexpr size_t DO_VST = 72 * MiB, DO_VWT = 88 * MiB;
constexpr size_t DO_CAR = 112 * MiB, DO_CBR = 120 * MiB;
constexpr size_t DO_XB = 0;
constexpr size_t WS_LA = WS_URNN, WS_UP = WS_KV, WS_T1 = WS_URNN, WS_MERGED = WS_UGATE, WS_HB = WS_GA, WS_ZACT = 52 * MiB;
constexpr size_t DO_FLATK = 64 * MiB, DO_FLATV = 96 * MiB, DO_HIDK = 0, DO_HIDV = 4 * MiB, DO_XC = 0, DO_YA = 0;

__device__ __constant__ unsigned char BUCKET[128] = {0, 1, 2, 3, 4, 5, 6, 7, 8, 9, 10, 11, 12, 13, 14, 15, 16, 16, 16, 17, 17, 18, 18, 18, 19, 19, 19, 20, 20, 20, 20, 21, 21, 21, 21, 22, 22, 22, 22, 22, 23, 23, 23, 23, 23, 23, 24, 24, 24, 24, 24, 24, 25, 25, 25, 25, 25, 25, 25, 26, 26, 26, 26, 26, 26, 26, 26, 27, 27, 27, 27, 27, 27, 27, 27, 27, 27, 28, 28, 28, 28, 28, 28, 28, 28, 28, 28, 29, 29, 29, 29, 29, 29, 29, 29, 29, 29, 29, 29, 30, 30, 30, 30, 30, 30, 30, 30, 30, 30, 30, 30, 30, 30, 31, 31, 31, 31, 31, 31, 31, 31, 31, 31, 31, 31, 31, 31, 31};

__device__ __forceinline__ float bf2f(bf16_t v) { return __uint_as_float((unsigned)v << 16); }
__device__ __forceinline__ bf16_t f2bf(float f) { unsigned u = __float_as_uint(f); return (bf16_t)((u + 0x7fffu + ((u >> 16) & 1u)) >> 16); }
__device__ __forceinline__ float sigmoidf_(float x) { return 1.f / (1.f + __expf(-x)); }
__device__ __forceinline__ float gelu_tanh(float x) { const float u = 0.7978845608028654f * (x + 0.044715f * x * x * x); return 0.5f * x * (1.f + tanhf(u)); }
__device__ __forceinline__ float wave_sum(float v) {
#pragma unroll
    for (int o = 1; o < 64; o <<= 1) v += __shfl_xor(v, o);
    return v;
}

struct Args { const float* in[27]; float* out; unsigned char* ws; int ph_lo, ph_hi; };

template <class AL, class BL, class EP>
__device__ __forceinline__ void ngemm(float* lds, int Mm, int Nn, int Kk, const AL& A, const BL& Bf, const EP& E) {
    float* As = lds;
    float* Bs = lds + 16 * 132;
    const int tid = threadIdx.x, tx = tid & 31, ty = tid >> 5;
    const int tm = (Mm + 127) / 128, tn = (Nn + 127) / 128, ntiles = tm * tn;
    for (int tile = blockIdx.x; tile < ntiles; tile += gridDim.x) {
        const int m0 = (tile / tn) * 128, n0 = (tile % tn) * 128;
        float acc[8][4];
#pragma unroll
        for (int i = 0; i < 8; ++i)
#pragma unroll
            for (int j = 0; j < 4; ++j) acc[i][j] = 0.f;
        for (int k0 = 0; k0 < Kk; k0 += 16) {
            {
                const int m = m0 + (tid >> 2), kb = k0 + (tid & 3) * 4;
#pragma unroll
                for (int i = 0; i < 4; ++i) As[((tid & 3) * 4 + i) * 132 + (tid >> 2)] = (m < Mm && kb + i < Kk) ? A(m, kb + i) : 0.f;
                const int k = k0 + (tid >> 5), nb = n0 + (tid & 31) * 4;
#pragma unroll
                for (int i = 0; i < 4; ++i) Bs[(tid >> 5) * 132 + (tid & 31) * 4 + i] = (k < Kk && nb + i < Nn) ? Bf(k, nb + i) : 0.f;
            }
            __syncthreads();
#pragma unroll 2
            for (int kk = 0; kk < 16; ++kk) {
                float a[8], b[4];
#pragma unroll
                for (int i = 0; i < 8; ++i) a[i] = As[kk * 132 + ty * 8 + i];
#pragma unroll
                for (int j = 0; j < 4; ++j) b[j] = Bs[kk * 132 + tx * 4 + j];
#pragma unroll
                for (int i = 0; i < 8; ++i)
#pragma unroll
                    for (int j = 0; j < 4; ++j) acc[i][j] += a[i] * b[j];
            }
            __syncthreads();
        }
#pragma unroll
        for (int i = 0; i < 8; ++i)
#pragma unroll
            for (int j = 0; j < 4; ++j) { const int m = m0 + ty * 8 + i, n = n0 + tx * 4 + j; if (m < Mm && n < Nn) E(m, n, acc[i][j]); }
    }
}

struct ALbf { const bf16_t* p; int ld; __device__ __forceinline__ float operator()(int m, int k) const { return bf2f(p[(size_t)m * ld + k]); } };
struct ALbfScale { const bf16_t* p; int ld; const float* g; __device__ __forceinline__ float operator()(int m, int k) const { return bf2f(p[(size_t)m * ld + k]) * g[k]; } };
struct ALf32Scale { const float* p; int ld; const float* g; __device__ __forceinline__ float operator()(int m, int k) const { return p[(size_t)m * ld + k] * g[k]; } };
struct BLf32 { const float* p; int ld; __device__ __forceinline__ float operator()(int k, int n) const { return p[(size_t)k * ld + n]; } };
struct BLgate { const float* wa; const float* wx; __device__ __forceinline__ float operator()(int k, int n) const { return n < BW ? wa[k * BW + n] : wx[k * BW + n - BW]; } };

struct Ep1 {
    const float* rstd; bf16_t *urnn, *ugate, *q, *kv, *gn, *ga, *gb;
    __device__ __forceinline__ void operator()(int m, int n, float v) const {
        v *= rstd[m];
        if (n < C_UGATE) urnn[(size_t)m * DRNN + n] = f2bf(v);
        else if (n < C_Q) ugate[(size_t)m * DRNN + n - C_UGATE] = f2bf(gelu_tanh(v));
        else if (n < C_KV) q[(size_t)m * QW + n - C_Q] = f2bf(v);
        else if (n < C_GN) { const int c = n - C_KV; kv[(size_t)(c >> 8) * ((size_t)M * KVW) + (size_t)m * KVW + (c & 255)] = f2bf(v); }
        else if (n < C_GA) gn[(size_t)m * 48 + n - C_GN] = f2bf(sigmoidf_(v));
        else if (n < C_GB) ga[(size_t)m * D + n - C_GA] = f2bf(sigmoidf_(v));
        else gb[(size_t)m * D + n - C_GB] = f2bf(sigmoidf_(v));
    }
};
struct EpGelu { bf16_t* o; int ld; __device__ __forceinline__ void operator()(int m, int n, float v) const { o[(size_t)m * ld + n] = f2bf(gelu_tanh(v)); } };
struct EpGate {
    int nb; const float *ba, *bx, *lam; const bf16_t* xc; bf16_t *la, *up;
    __device__ __forceinline__ void operator()(int m, int n, float v) const {
        if (n < BW) { const int c = nb * BW + n; const float r = sigmoidf_(v + ba[c]); const float sp = log1pf(__expf(-lam[c])); la[(size_t)m * DRNN + c] = f2bf(-8.f * r * sp * LOG2E); }
        else { const int j = n - BW, c = nb * BW + j; const float i = sigmoidf_(v + bx[c]); up[(size_t)m * DRNN + c] = f2bf(i * bf2f(xc[(size_t)m * XC_LD + j])); }
    }
};
struct EpT1 { const bf16_t* g; bf16_t* o; __device__ __forceinline__ void operator()(int m, int n, float v) const { o[(size_t)m * D + n] = f2bf(bf2f(g[(size_t)m * D + n]) * v); } };
struct EpMerged { const bf16_t* g; const bf16_t* t1; bf16_t* o; __device__ __forceinline__ void operator()(int m, int n, float v) const { o[(size_t)m * D + n] = f2bf(bf2f(t1[(size_t)m * D + n]) + bf2f(g[(size_t)m * D + n]) * v); } };
struct EpH { const float* x; float* h; bf16_t* hb; __device__ __forceinline__ void operator()(int m, int n, float v) const { const float r = x[(size_t)m * D + n] + v; h[(size_t)m * D + n] = r; hb[(size_t)m * D + n] = f2bf(r); } };
struct EpZ { const float* ssq; bf16_t* z; __device__ __forceinline__ void operator()(int m, int n, float v) const { float s_ = 0.f; for (int i = 0; i < 16; ++i) s_ += ssq[(size_t)m * 16 + i]; v *= rsqrtf(s_ * (1.f / D) + EPS); v = v > 0.f ? v * v : 0.f; z[(size_t)m * DFF + n] = f2bf(v); } };
struct EpOut { float* o; __device__ __forceinline__ void operator()(int m, int n, float v) const { o[(size_t)m * D + n] += v; } };

namespace pg8 {
#define PG8_LAS __attribute__((address_space(3)))
typedef unsigned short bf16_t;
typedef short bf16x8 __attribute__((ext_vector_type(8)));
typedef float f32x4 __attribute__((ext_vector_type(4)));
typedef unsigned u32x4 __attribute__((ext_vector_type(4)));
constexpr int BM = 256, BK = 64, HALF = 128, HTB = HALF * BK * 2  , STAGE_BYTES = 8 * HTB, NXCD = 8, WGM = 4;

__host__ __device__ __forceinline__ int lds_byte(int r, int c) { const int st = (r >> 4) * 2 + (c >> 5), rr = r & 15, cc = c & 31, ob = rr * 64 + cc * 2; return st * 1024 + (ob ^ (((ob >> 9) & 1) << 5)); }
__host__ __device__ __forceinline__ void stage_rc(int b, int& R, int& C) { const int st = b / 1024, sb = b % 1024, swz = sb ^ (((sb >> 9) & 1) << 5); R = (st >> 1) * 16 + swz / 64; C = (st & 1) * 32 + (swz % 64) / 2; }
__host__ __device__ __forceinline__ int perm32(int rho) { const int n = rho >> 4, i = rho & 15; return 8 * (i >> 2) + 4 * n + (i & 3); }

struct Unit { int pm, pn, ord; };
struct Gemm { const bf16_t* A; const bf16_t* Bt; int M, N, K; };

struct StaticOrder {
    int nM, nN, nwg, G, c;
    __host__ __device__ void init(int M, int N, int G_, int c_) { nM = M / BM; nN = N / BM; nwg = nM * nN; G = G_; c = c_; }
    __host__ __device__ __forceinline__ bool next(int i, Unit& u) const {
        const long L = (long)i * G + c; if (L >= nwg) return false;
        int wgid = (int)L; { const int q = nwg / NXCD, r = nwg % NXCD, xcd = wgid % NXCD, off = wgid / NXCD; wgid = (xcd < r ? xcd * (q + 1) : r * (q + 1) + (xcd - r) * q) + off; }
        const int nig = WGM * nN, gid = wgid / nig, fm = gid * WGM, gsz = (nM - fm) < WGM ? (nM - fm) : WGM;
        u.pm = fm + ((wgid % nig) % gsz); u.pn = (wgid % nig) / gsz; u.ord = i; return true;
    }
    __device__ __forceinline__ void a_ready(const Unit&) const {}
    __device__ __forceinline__ void done(const Unit&) const {}
};

__device__ __forceinline__ unsigned cvt_pk_bf16(float lo, float hi) { unsigned r; asm volatile("v_cvt_pk_bf16_f32 %0, %1, %2" : "=v"(r) : "v"(lo), "v"(hi)); return r; }
typedef float f32x2 __attribute__((ext_vector_type(2)));
template <class Epi, class Sched, bool ALIGN_EPI = false, bool SP2 = false>
__device__ __forceinline__ void gemm_phase(PG8_LAS unsigned char* lds, const Gemm g, const Sched& S, const Epi& E) {
    const int tid = threadIdx.x, wid = __builtin_amdgcn_readfirstlane(tid >> 6), lane = tid & 63, wr = wid >> 2, wc = wid & 3, fr = lane & 15, fq = lane >> 4;
    const int K = g.K, nt = K / BK;
    unsigned voffA[2], voffB[2];
#pragma unroll
    for (int i = 0; i < 2; ++i) { int R, C; stage_rc(tid * 16 + i * 8192, R, C); const int Rb = Epi::PERM ? ((R & ~31) + perm32(R & 31)) : R;
        voffA[i] = (unsigned)(R * K + C) * 2u; voffB[i] = (unsigned)(Rb * K + C) * 2u; }
    const size_t kstep = (size_t)(BK * 2);
    const size_t hstep = (size_t)HALF * K * 2;
    const size_t tstep = 2 * hstep;
    const unsigned ldsw = (unsigned)wid * 1024u;
    const int aoff = lds_byte(wr * 64 + fr, fq * 8), boff = lds_byte(wc * 32 + fr, fq * 8);
#define PG8_SA(b, h) (((b) * 2 + (h)) * HTB)
#define PG8_SB(b, h) ((4 + (b) * 2 + (h)) * HTB)
#define PG8_STAGE(bufoff, gbase, voff) do { _Pragma("unroll") for (int _i = 0; _i < 2; ++_i) \
        __builtin_amdgcn_global_load_lds((const unsigned*)((const char*)(gbase) + (voff)[_i]), (PG8_LAS unsigned*)(lds + (bufoff) + ldsw + _i * 8192), 16, 0, 0); } while (0)
#define PG8_LDA(dst, b, h) do { _Pragma("unroll") for (int m = 0; m < 4; ++m) _Pragma("unroll") for (int k = 0; k < 2; ++k) dst[m][k] = *(const PG8_LAS bf16x8*)(lds + PG8_SA(b, h) + aoff + m * 2048 + k * 1024); } while (0)
#define PG8_LDB(dst, b, h) do { _Pragma("unroll") for (int n = 0; n < 2; ++n) _Pragma("unroll") for (int k = 0; k < 2; ++k) dst[n][k] = *(const PG8_LAS bf16x8*)(lds + PG8_SB(b, h) + boff + n * 2048 + k * 1024); } while (0)
#define PG8_MMA(ai, bj, At, Bt) do { __builtin_amdgcn_s_setprio(1); _Pragma("unroll") for (int m = 0; m < 4; ++m) _Pragma("unroll") for (int n = 0; n < 2; ++n) _Pragma("unroll") for (int k = 0; k < 2; ++k) \
        acc[ai][bj][m][n] = __builtin_amdgcn_mfma_f32_16x16x32_bf16(Bt[n][k], At[m][k], acc[ai][bj][m][n], 0, 0, 0); __builtin_amdgcn_s_setprio(0); } while (0)
#define PG8_WAIT_V(n) asm volatile("s_waitcnt vmcnt(" #n ")" ::: "memory")
#define PG8_WAIT_L(n) asm volatile("s_waitcnt lgkmcnt(" #n ")" ::: "memory")
#define PG8_BAR __builtin_amdgcn_s_barrier()
#define PG8_SCHED __builtin_amdgcn_sched_barrier(0)
    Unit cur, nxt; int ui = 0;
    if (!S.next(0, cur)) return;
    f32x4 acc[2][2][4][2];
#pragma unroll
    for (int a = 0; a < 2; ++a)
#pragma unroll
        for (int b = 0; b < 2; ++b)
#pragma unroll
            for (int m = 0; m < 4; ++m)
#pragma unroll
                for (int n = 0; n < 2; ++n) acc[a][b][m][n] = (f32x4){0.f, 0.f, 0.f, 0.f};
    bf16x8 At[4][2], B0[2][2], B1[2][2];
    const char* cA = (const char*)g.A + (size_t)cur.pm * tstep; const char* cB = (const char*)g.Bt + (size_t)cur.pn * tstep;
    S.a_ready(cur);
    if constexpr (SP2) {
        PG8_STAGE(PG8_SB(0, 0), cB, voffB); PG8_STAGE(PG8_SB(0, 1), cB + hstep, voffB); PG8_STAGE(PG8_SA(0, 0), cA, voffA); PG8_STAGE(PG8_SA(0, 1), cA + hstep, voffA);
        if (wr == 1) PG8_BAR;
        PG8_WAIT_V(2); PG8_BAR;
        PG8_STAGE(PG8_SB(1, 0), cB + kstep, voffB); PG8_STAGE(PG8_SA(1, 0), cA + kstep, voffA); PG8_STAGE(PG8_SB(1, 1), cB + hstep + kstep, voffB);
        PG8_WAIT_V(6); PG8_BAR;
    } else {
        PG8_STAGE(PG8_SB(0, 0), cB, voffB); PG8_STAGE(PG8_SA(0, 0), cA, voffA); PG8_STAGE(PG8_SB(0, 1), cB + hstep, voffB); PG8_STAGE(PG8_SA(0, 1), cA + hstep, voffA);
        if (wr == 1) PG8_BAR;
        PG8_WAIT_V(4); PG8_BAR;
        PG8_STAGE(PG8_SB(1, 0), cB + kstep, voffB); PG8_STAGE(PG8_SA(1, 0), cA + kstep, voffA); PG8_STAGE(PG8_SB(1, 1), cB + hstep + kstep, voffB);
        PG8_WAIT_V(6); PG8_BAR;
    }
    for (;;) {
        const bool has_next = S.next(ui + 1, nxt);
        const char* nA = has_next ? (const char*)g.A + (size_t)nxt.pm * tstep : cA; const char* nB = has_next ? (const char*)g.Bt + (size_t)nxt.pn * tstep : cB;
        for (int t = 0; t < nt; t += 2) {
            const bool last = (t == nt - 2);
            const char* a1 = cA + (size_t)(t + 1) * kstep;
            const char* a2 = last ? nA : cA + (size_t)(t + 2) * kstep; const char* b2 = last ? nB : cB + (size_t)(t + 2) * kstep;
            const char* a3 = a2 + kstep; const char* b3 = b2 + kstep;
            if (last && has_next) S.a_ready(nxt);
            if constexpr (SP2) {
            PG8_LDB(B0, 0, 0); PG8_LDB(B1, 0, 1); PG8_SCHED; PG8_LDA(At, 0, 0); PG8_STAGE(PG8_SA(1, 1), a1 + hstep, voffA);
            PG8_WAIT_V(8); PG8_WAIT_L(0); PG8_BAR; PG8_MMA(0, 0, At, B0); PG8_MMA(0, 1, At, B1); PG8_BAR; PG8_SCHED;
            PG8_LDA(At, 0, 1); PG8_STAGE(PG8_SB(0, 0), b2, voffB); PG8_STAGE(PG8_SB(0, 1), b2 + hstep, voffB); PG8_STAGE(PG8_SA(0, 0), a2, voffA);
            PG8_WAIT_V(8); PG8_WAIT_L(0); PG8_BAR; PG8_MMA(1, 0, At, B0); PG8_MMA(1, 1, At, B1); PG8_BAR; PG8_SCHED;
            PG8_LDB(B0, 1, 0); PG8_LDB(B1, 1, 1); PG8_SCHED; PG8_LDA(At, 1, 0); PG8_STAGE(PG8_SA(0, 1), a2 + hstep, voffA);
            PG8_WAIT_V(8); PG8_WAIT_L(0); PG8_BAR; PG8_MMA(0, 0, At, B0); PG8_MMA(0, 1, At, B1); PG8_BAR; PG8_SCHED;
            PG8_LDA(At, 1, 1); PG8_STAGE(PG8_SB(1, 0), b3, voffB); PG8_STAGE(PG8_SB(1, 1), b3 + hstep, voffB); PG8_STAGE(PG8_SA(1, 0), a3, voffA);
            PG8_WAIT_V(8); PG8_WAIT_L(0); PG8_BAR; PG8_MMA(1, 0, At, B0); PG8_MMA(1, 1, At, B1); PG8_BAR; PG8_SCHED;
            } else {
            PG8_LDB(B0, 0, 0); PG8_SCHED; PG8_LDA(At, 0, 0); PG8_STAGE(PG8_SA(1, 1), a1 + hstep, voffA);
            PG8_WAIT_L(8); PG8_BAR; PG8_WAIT_L(0); PG8_MMA(0, 0, At, B0); PG8_BAR; PG8_SCHED;
            PG8_LDB(B1, 0, 1); PG8_STAGE(PG8_SB(0, 0), b2, voffB);
            PG8_BAR; PG8_WAIT_L(0); PG8_MMA(0, 1, At, B1); PG8_BAR;
            PG8_LDA(At, 0, 1); PG8_STAGE(PG8_SA(0, 0), a2, voffA);
            PG8_BAR; PG8_WAIT_L(0); PG8_MMA(1, 0, At, B0); PG8_BAR; PG8_SCHED;
            PG8_STAGE(PG8_SB(0, 1), b2 + hstep, voffB);
            PG8_WAIT_V(6); PG8_BAR; PG8_MMA(1, 1, At, B1); PG8_BAR;
            PG8_LDB(B0, 1, 0); PG8_SCHED; PG8_LDA(At, 1, 0); PG8_STAGE(PG8_SA(0, 1), a2 + hstep, voffA);
            PG8_WAIT_L(8); PG8_BAR; PG8_WAIT_L(0); PG8_MMA(0, 0, At, B0); PG8_BAR; PG8_SCHED;
            PG8_LDB(B1, 1, 1); PG8_STAGE(PG8_SB(1, 0), b3, voffB);
            PG8_BAR; PG8_WAIT_L(0); PG8_MMA(0, 1, At, B1); PG8_BAR;
            PG8_LDA(At, 1, 1); PG8_STAGE(PG8_SA(1, 0), a3, voffA);
            PG8_BAR; PG8_WAIT_L(0); PG8_MMA(1, 0, At, B0); PG8_BAR; PG8_SCHED;
            PG8_STAGE(PG8_SB(1, 1), b3 + hstep, voffB);
            PG8_WAIT_V(6); PG8_BAR; PG8_MMA(1, 1, At, B1); PG8_BAR;
            }
        }
        if constexpr (ALIGN_EPI) { if (wr == 0) PG8_BAR; }
        if constexpr (!Epi::AFTER_DRAIN) { E(acc, cur, wr, wc, fr, fq); S.done(cur); }
        if (!has_next) break;
#pragma unroll
        for (int a = 0; a < 2; ++a)
#pragma unroll
            for (int b = 0; b < 2; ++b)
#pragma unroll
                for (int m = 0; m < 4; ++m)
#pragma unroll
                    for (int n = 0; n < 2; ++n) acc[a][b][m][n] = (f32x4){0.f, 0.f, 0.f, 0.f};
        cur = nxt; cA = nA; cB = nB; ++ui;
        if constexpr (ALIGN_EPI) { if (wr == 1) PG8_BAR; }
    }
    PG8_WAIT_V(0);
    if constexpr (!ALIGN_EPI) { if (wr == 0) PG8_BAR; }
    PG8_BAR;
    if constexpr (Epi::AFTER_DRAIN) { E.fused(acc, cur, wr, wc, fr, fq, lds, wid, lane); S.done(cur); }
#undef PG8_SA
#undef PG8_SB
#undef PG8_STAGE
#undef PG8_LDA
#undef PG8_LDB
#undef PG8_MMA
#undef PG8_WAIT_V
#undef PG8_WAIT_L
#undef PG8_BAR
#undef PG8_SCHED
}
}

namespace pg8 {
__device__ __forceinline__ float sigm(float x) { return __builtin_amdgcn_rcpf(1.f + __expf(-x)); }
__device__ __forceinline__ float gelu_t(float x) { const float u = 1.5957691216057308f * (x + 0.044715f * x * x * x); return x * __builtin_amdgcn_rcpf(1.f + __expf(-u)); }
__device__ __forceinline__ u32x4 pack8(const f32x4& a, const f32x4& b) { u32x4 w; w.x = cvt_pk_bf16(a[0], a[1]); w.y = cvt_pk_bf16(a[2], a[3]); w.z = cvt_pk_bf16(b[0], b[1]); w.w = cvt_pk_bf16(b[2], b[3]); return w; }
__device__ __forceinline__ void unpack8(const u32x4& w, f32x4& a, f32x4& b) {
    a[0] = __uint_as_float(w.x << 16); a[1] = __uint_as_float(w.x & 0xffff0000u); a[2] = __uint_as_float(w.y << 16); a[3] = __uint_as_float(w.y & 0xffff0000u);
    b[0] = __uint_as_float(w.z << 16); b[1] = __uint_as_float(w.z & 0xffff0000u); b[2] = __uint_as_float(w.w << 16); b[3] = __uint_as_float(w.w & 0xffff0000u); }

struct Ep1F {
    static constexpr bool PERM = true, AFTER_DRAIN = false;
    bf16_t *urnn, *ugate, *q, *kv, *gn, *ga; const PG8_LAS float* norms; bf16_t* flat; const PG8_LAS float* pes;
    __device__ __forceinline__ void operator()(const f32x4 (&acc)[2][2][4][2], const Unit& u, int wr, int wc, int fr, int fq) const {
        const int row0 = u.pm * BM + wr * 64 + fr, pn = u.pn;
        if (pn == 4 || pn == 5) {
            const PG8_LAS float* pe = pes + (pn - 4) * 2048; bf16_t* fl = flat + (size_t)(pn - 4) * 8192 * 2048;
#pragma unroll
            for (int ai = 0; ai < 2; ++ai)
#pragma unroll
                for (int m = 0; m < 4; ++m) { const int mt = row0 + ai * HALF + m * 16, b = mt >> 11, t = mt & (T - 1), c1 = t >> 4, l1 = t & 15; const size_t rb = (size_t)((b * 4 + wc) * NC + c1) * 2048;
#pragma unroll
                    for (int bj = 0; bj < 2; ++bj) { const int d0 = 32 * bj + 8 * fq; const f32x4 v0 = acc[ai][bj][m][0], v1 = acc[ai][bj][m][1];
                        if (c1 < NC) { const PG8_LAS float* p = pe + l1 * 64 + d0; *(u32x4*)(fl + rb + l1 * 64 + d0) = pack8(v0 + *(const PG8_LAS f32x4*)p, v1 + *(const PG8_LAS f32x4*)(p + 4)); }
                        if (c1 > 0) { const PG8_LAS float* p = pe + (l1 + 16) * 64 + d0; *(u32x4*)(fl + rb - 2048 + (l1 + 16) * 64 + d0) = pack8(v0 + *(const PG8_LAS f32x4*)p, v1 + *(const PG8_LAS f32x4*)(p + 4)); } } }
            return;
        }
        if (pn < 10) {
            const bool donorm = pn < 4 || pn == 6 || pn == 8; const PG8_LAS float* g = norms + (pn < 4 ? 0 : (pn == 6 ? 64 : 128)); const float sc = pn < 4 ? 0.125f * LOG2E : 1.f;
            bf16_t* base; int ld;
            if (pn < 4) { base = q + 256 * pn + 64 * wc + 8 * fq; ld = QW; } else { base = kv + (size_t)(pn - 4) * ((size_t)M * KVW) + 64 * wc + 8 * fq; ld = KVW; }
            f32x4 gv[2][2];
#pragma unroll
            for (int bj = 0; bj < 2; ++bj)
#pragma unroll
                for (int n = 0; n < 2; ++n) gv[bj][n] = donorm ? *(const PG8_LAS f32x4*)(g + 32 * bj + 8 * fq + 4 * n) : (f32x4){1.f, 1.f, 1.f, 1.f};
#pragma unroll
            for (int ai = 0; ai < 2; ++ai)
#pragma unroll
                for (int m = 0; m < 4; ++m) {
                    float ss = 0.f;
#pragma unroll
                    for (int bj = 0; bj < 2; ++bj)
#pragma unroll
                        for (int n = 0; n < 2; ++n) { const f32x4 v = acc[ai][bj][m][n]; ss += (v[0] * v[0] + v[1] * v[1]) + (v[2] * v[2] + v[3] * v[3]); }
                    ss += __shfl_xor(ss, 16); ss += __shfl_xor(ss, 32);
                    const float r = donorm ? rsqrtf(ss * (1.f / 64.f) + EPS) * sc : 1.f;
                    bf16_t* rowp = base + (size_t)(row0 + ai * HALF + m * 16) * ld;
#pragma unroll
                    for (int bj = 0; bj < 2; ++bj) *(u32x4*)(rowp + 32 * bj) = pack8(acc[ai][bj][m][0] * r * gv[bj][0], acc[ai][bj][m][1] * r * gv[bj][1]);
                }
        } else if (pn < 18) {
            bf16_t* base = ga + (pn < 14 ? (size_t)0 : (size_t)M * D) + 256 * ((pn - 10) & 3) + 32 * wc + 8 * fq;
#pragma unroll
            for (int ai = 0; ai < 2; ++ai)
#pragma unroll
                for (int m = 0; m < 4; ++m) { bf16_t* rowp = base + (size_t)(row0 + ai * HALF + m * 16) * D;
#pragma unroll
                    for (int bj = 0; bj < 2; ++bj) { f32x4 v0 = acc[ai][bj][m][0], v1 = acc[ai][bj][m][1];
#pragma unroll
                        for (int e = 0; e < 4; ++e) { v0[e] = sigm(v0[e]); v1[e] = sigm(v1[e]); }
                        *(u32x4*)(rowp + bj * HALF) = pack8(v0, v1); } }
        } else { seg3<0>(acc, pn, row0, wc, fq); seg3<1>(acc, pn, row0, wc, fq); }
    }
    template <int BJ> __device__ __forceinline__ void seg3(const f32x4 (&acc)[2][2][4][2], int pn, int row0, int wc, int fq) const {
        const int c = 256 * (pn - 18) + 128 * BJ + 32 * wc;
        if (c < 1344) { bf16_t* base = urnn + c + 8 * fq;
#pragma unroll
            for (int ai = 0; ai < 2; ++ai)
#pragma unroll
                for (int m = 0; m < 4; ++m) *(u32x4*)(base + (size_t)(row0 + ai * HALF + m * 16) * DRNN) = pack8(acc[ai][BJ][m][0], acc[ai][BJ][m][1]);
        } else if (c < 2688) { bf16_t* base = ugate + (c - 1344) + 8 * fq;
#pragma unroll
            for (int ai = 0; ai < 2; ++ai)
#pragma unroll
                for (int m = 0; m < 4; ++m) { f32x4 v0 = acc[ai][BJ][m][0], v1 = acc[ai][BJ][m][1];
#pragma unroll
                    for (int e = 0; e < 4; ++e) { v0[e] = gelu_t(v0[e]); v1[e] = gelu_t(v1[e]); }
                    *(u32x4*)(base + (size_t)(row0 + ai * HALF + m * 16) * DRNN) = pack8(v0, v1); }
        } else if (c + 8 * fq < 2736) { bf16_t* base = gn + (c - 2688) + 8 * fq;
#pragma unroll
            for (int ai = 0; ai < 2; ++ai)
#pragma unroll
                for (int m = 0; m < 4; ++m) { f32x4 v0 = acc[ai][BJ][m][0], v1 = acc[ai][BJ][m][1];
#pragma unroll
                    for (int e = 0; e < 4; ++e) { v0[e] = sigm(v0[e]); v1[e] = sigm(v1[e]); }
                    *(u32x4*)(base + (size_t)(row0 + ai * HALF + m * 16) * 48) = pack8(v0, v1); }
        }
    }
};
__device__ __forceinline__ void win_src(int ch, int& c0, int& cvalid) {
    const int tile = ch >> 3, l0 = (ch & 7) * 32, bj = l0 >> 7, wc = (l0 >> 5) & 3; cvalid = 32;
    if (tile < 4) c0 = C_Q + 256 * tile + 64 * wc + 32 * bj;
    else if (tile < 10) c0 = C_KV + 256 * (tile - 4) + 64 * wc + 32 * bj;
    else if (tile < 14) c0 = C_GA + 256 * (tile - 10) + l0;
    else if (tile < 18) c0 = C_GB + 256 * (tile - 14) + l0;
    else { const int c = 256 * (tile - 18) + l0; if (c < 2688) c0 = c; else if (c < 2736) { c0 = C_GN + c - 2688; cvalid = 2736 - c < 32 ? 2736 - c : 32; } else { c0 = 0; cvalid = 0; } }
}
constexpr int N1PAD = 29 * 256;

struct EpGeluF {
    static constexpr bool PERM = true, AFTER_DRAIN = false;
    bf16_t* O; int ldc;
    __device__ __forceinline__ void operator()(const f32x4 (&acc)[2][2][4][2], const Unit& u, int wr, int wc, int fr, int fq) const {
        const int row0 = u.pm * BM + wr * 64 + fr; bf16_t* base = O + wc * 32 + 8 * fq;
#pragma unroll
        for (int ai = 0; ai < 2; ++ai)
#pragma unroll
            for (int m = 0; m < 4; ++m) { bf16_t* rowp = base + (size_t)(row0 + ai * HALF + m * 16) * ldc;
#pragma unroll
                for (int bj = 0; bj < 2; ++bj) { f32x4 v0 = acc[ai][bj][m][0], v1 = acc[ai][bj][m][1];
#pragma unroll
                    for (int e = 0; e < 4; ++e) { v0[e] = gelu_t(v0[e]); v1[e] = gelu_t(v1[e]); }
                    *(u32x4*)(rowp + bj * HALF) = pack8(v0, v1); } }
    }
};
struct OrderC1 {
    int G, c;
    __device__ __forceinline__ bool next(int i, Unit& u) const { const int L = i * G + c; if (L >= 64) return false; u.pm = L; u.pn = L >> 5; u.ord = i; return true; }
    __device__ __forceinline__ void a_ready(const Unit&) const {}
    __device__ __forceinline__ void done(const Unit&) const {}
};
struct OrderGate {
    int G, c;
    __device__ __forceinline__ bool next(int i, Unit& u) const { const int L = i * G + c; if (L >= 4 * 128 * 3) return false; const int nb = L / 384, r = L % 384; u.pm = nb * 128 + r / 3; u.pn = nb * 3 + r % 3; u.ord = i; return true; }
    __device__ __forceinline__ void a_ready(const Unit&) const {}
    __device__ __forceinline__ void done(const Unit&) const {}
};
struct EpGateF {
    static constexpr bool PERM = true, AFTER_DRAIN = false;
    const float *ba, *bx, *lamc; const bf16_t* xc; bf16_t *la, *up;
    __device__ __forceinline__ void operator()(const f32x4 (&acc)[2][2][4][2], const Unit& u, int wr, int wc, int fr, int fq) const {
        const int nb = u.pn / 3, pn3 = u.pn % 3, ch0 = 128 * pn3 + 32 * wc + 8 * fq; if (ch0 >= BW) return;
        const int c0 = nb * BW + ch0, row0 = (u.pm & 127) * BM + wr * 64 + fr;
        const bf16_t* xcb = xc + (size_t)nb * ((size_t)M * XC_LD) + ch0; bf16_t* lab = la + c0; bf16_t* upb = up + c0;
        const f32x4 bav0 = *(const f32x4*)(ba + c0), bav1 = *(const f32x4*)(ba + c0 + 4), bxv0 = *(const f32x4*)(bx + c0), bxv1 = *(const f32x4*)(bx + c0 + 4), lcv0 = *(const f32x4*)(lamc + c0), lcv1 = *(const f32x4*)(lamc + c0 + 4);
        u32x4 xcv[2][4];
#pragma unroll
        for (int ai = 0; ai < 2; ++ai)
#pragma unroll
            for (int m = 0; m < 4; ++m) xcv[ai][m] = *(const u32x4*)(xcb + (unsigned)(row0 + ai * HALF + m * 16) * (unsigned)XC_LD);
#pragma unroll
        for (int ai = 0; ai < 2; ++ai)
#pragma unroll
            for (int m = 0; m < 4; ++m) { const unsigned row = (unsigned)(row0 + ai * HALF + m * 16);
                f32x4 x0, x1; unpack8(xcv[ai][m], x0, x1);
                f32x4 l0, l1, u0, u1;
#pragma unroll
                for (int e = 0; e < 4; ++e) {
                    l0[e] = sigm(acc[ai][0][m][0][e] + bav0[e]) * lcv0[e]; l1[e] = sigm(acc[ai][0][m][1][e] + bav1[e]) * lcv1[e];
                    u0[e] = sigm(acc[ai][1][m][0][e] + bxv0[e]) * x0[e];   u1[e] = sigm(acc[ai][1][m][1][e] + bxv1[e]) * x1[e]; }
                *(u32x4*)(lab + row * (unsigned)DRNN) = pack8(l0, l1); *(u32x4*)(upb + row * (unsigned)DRNN) = pack8(u0, u1);
                asm volatile("" ::: "memory"); }
    }
};
struct EpT1F {
    static constexpr bool PERM = true, AFTER_DRAIN = false;
    const bf16_t* g; bf16_t* o;
    __device__ __forceinline__ void operator()(const f32x4 (&acc)[2][2][4][2], const Unit& u, int wr, int wc, int fr, int fq) const {
        const int row0 = u.pm * BM + wr * 64 + fr, col0 = u.pn * BM + wc * 32 + 8 * fq;
        u32x4 gv[2][4][2];
#pragma unroll
        for (int ai = 0; ai < 2; ++ai)
#pragma unroll
            for (int m = 0; m < 4; ++m) { const size_t off = (size_t)(row0 + ai * HALF + m * 16) * D + col0;
#pragma unroll
                for (int bj = 0; bj < 2; ++bj) gv[ai][m][bj] = *(const u32x4*)(g + off + bj * HALF); }
#pragma unroll
        for (int ai = 0; ai < 2; ++ai)
#pragma unroll
            for (int m = 0; m < 4; ++m) { const size_t off = (size_t)(row0 + ai * HALF + m * 16) * D + col0;
#pragma unroll
                for (int bj = 0; bj < 2; ++bj) { f32x4 g0, g1; unpack8(gv[ai][m][bj], g0, g1);
                    *(u32x4*)(o + off + bj * HALF) = pack8(acc[ai][bj][m][0] * g0, acc[ai][bj][m][1] * g1); } }
    }
};
struct EpMergedF {
    static constexpr bool PERM = true, AFTER_DRAIN = false;
    const bf16_t* g; const bf16_t* t1; bf16_t* o;
    __device__ __forceinline__ void operator()(const f32x4 (&acc)[2][2][4][2], const Unit& u, int wr, int wc, int fr, int fq) const {
        const int row0 = u.pm * BM + wr * 64 + fr, col0 = u.pn * BM + wc * 32 + 8 * fq;
#pragma unroll
        for (int ai = 0; ai < 2; ++ai) {
            u32x4 gv[4][2], tv[4][2];
#pragma unroll
            for (int m = 0; m < 4; ++m) { const size_t off = (size_t)(row0 + ai * HALF + m * 16) * D + col0;
#pragma unroll
                for (int bj = 0; bj < 2; ++bj) { gv[m][bj] = *(const u32x4*)(g + off + bj * HALF); tv[m][bj] = *(const u32x4*)(t1 + off + bj * HALF); } }
#pragma unroll
            for (int m = 0; m < 4; ++m) { const size_t off = (size_t)(row0 + ai * HALF + m * 16) * D + col0;
#pragma unroll
                for (int bj = 0; bj < 2; ++bj) { f32x4 g0, g1, t0, t1v; unpack8(gv[m][bj], g0, g1); unpack8(tv[m][bj], t0, t1v);
                    *(u32x4*)(o + off + bj * HALF) = pack8(t0 + acc[ai][bj][m][0] * g0, t1v + acc[ai][bj][m][1] * g1); } }
            asm volatile("" ::: "memory");
        }
    }
};
struct EpHF {
    static constexpr bool PERM = true, AFTER_DRAIN = false;
    const float* x; float* h; bf16_t* hb; float* ssq;
    __device__ __forceinline__ void operator()(const f32x4 (&acc)[2][2][4][2], const Unit& u, int wr, int wc, int fr, int fq) const {
        const int row0 = u.pm * BM + wr * 64 + fr, col0 = u.pn * BM + wc * 32 + 8 * fq;
#pragma unroll
        for (int ai = 0; ai < 2; ++ai) {
            f32x4 xv[4][2][2];
#pragma unroll
            for (int m = 0; m < 4; ++m) { const size_t off = (size_t)(row0 + ai * HALF + m * 16) * D + col0;
#pragma unroll
                for (int bj = 0; bj < 2; ++bj) { xv[m][bj][0] = *(const f32x4*)(x + off + bj * HALF); xv[m][bj][1] = *(const f32x4*)(x + off + bj * HALF + 4); } }
#pragma unroll
            for (int m = 0; m < 4; ++m) { const size_t row = (size_t)(row0 + ai * HALF + m * 16), off = row * D + col0; float ss = 0.f;
#pragma unroll
                for (int bj = 0; bj < 2; ++bj) {
                    const f32x4 h0 = xv[m][bj][0] + acc[ai][bj][m][0], h1 = xv[m][bj][1] + acc[ai][bj][m][1];
                    *(u32x4*)(hb + off + bj * HALF) = pack8(h0, h1);
                    ss += (h0[0] * h0[0] + h0[1] * h0[1]) + (h0[2] * h0[2] + h0[3] * h0[3]) + (h1[0] * h1[0] + h1[1] * h1[1]) + (h1[2] * h1[2] + h1[3] * h1[3]); }
                ss += __shfl_xor(ss, 16); ss += __shfl_xor(ss, 32);
                if (fq == 0) ssq[row * 16 + 4 * u.pn + wc] = ss; }
            asm volatile("" ::: "memory");
        }
    }
};
struct EpZF {
    static constexpr bool PERM = true, AFTER_DRAIN = false;
    const PG8_LAS float* rtab; const float* ssq; bf16_t* z;
    __device__ __forceinline__ void operator()(const f32x4 (&acc)[2][2][4][2], const Unit& u, int wr, int wc, int fr, int fq) const {
        const int rl0 = wr * 64 + fr, row0 = u.pm * BM + rl0, col0 = u.pn * BM + wc * 32 + 8 * fq;
#pragma unroll
        for (int ai = 0; ai < 2; ++ai)
#pragma unroll
            for (int m = 0; m < 4; ++m) { const size_t row = (size_t)(row0 + ai * HALF + m * 16);
                float r;
                if (rtab) r = rtab[u.ord * 256 + rl0 + ai * HALF + m * 16];
                else { const f32x4 s0 = *(const f32x4*)(ssq + row * 16), s1 = *(const f32x4*)(ssq + row * 16 + 4), s2 = *(const f32x4*)(ssq + row * 16 + 8), s3 = *(const f32x4*)(ssq + row * 16 + 12);
                    const f32x4 st = (s0 + s1) + (s2 + s3); r = rsqrtf(((st[0] + st[1]) + (st[2] + st[3])) * (1.f / D) + EPS); }
#pragma unroll
                for (int bj = 0; bj < 2; ++bj) { f32x4 v0 = acc[ai][bj][m][0] * r, v1 = acc[ai][bj][m][1] * r;
#pragma unroll
                    for (int e = 0; e < 4; ++e) { v0[e] = v0[e] > 0.f ? v0[e] * v0[e] : 0.f; v1[e] = v1[e] > 0.f ? v1[e] * v1[e] : 0.f; }
                    *(u32x4*)(z + row * DFF + col0 + bj * HALF) = pack8(v0, v1); } }
    }
};
struct EpOutF {
    static constexpr bool PERM = true, AFTER_DRAIN = false;
    const bf16_t* hb; float* o;
    __device__ __forceinline__ void operator()(const f32x4 (&acc)[2][2][4][2], const Unit& u, int wr, int wc, int fr, int fq) const {
        const int row0 = u.pm * BM + wr * 64 + fr, col0 = u.pn * BM + wc * 32 + 8 * fq;
        u32x4 hv[2][4][2];
#pragma unroll
        for (int ai = 0; ai < 2; ++ai)
#pragma unroll
            for (int m = 0; m < 4; ++m) { const size_t off = (size_t)(row0 + ai * HALF + m * 16) * D + col0;
#pragma unroll
                for (int bj = 0; bj < 2; ++bj) hv[ai][m][bj] = *(const u32x4*)(hb + off + bj * HALF); }
#pragma unroll
        for (int ai = 0; ai < 2; ++ai)
#pragma unroll
            for (int m = 0; m < 4; ++m) { float* p = o + (size_t)(row0 + ai * HALF + m * 16) * D + col0;
#pragma unroll
                for (int bj = 0; bj < 2; ++bj) { f32x4 h0, h1; unpack8(hv[ai][m][bj], h0, h1); *(f32x4*)(p + bj * HALF) = h0 + acc[ai][bj][m][0]; *(f32x4*)(p + bj * HALF + 4) = h1 + acc[ai][bj][m][1]; } }
    }
};
}

namespace att {
using pg8::bf16x8; using pg8::f32x4; using pg8::u32x4;
typedef float f32x16 __attribute__((ext_vector_type(16)));
typedef short s16x4 __attribute__((ext_vector_type(4)));
typedef float f32x2_t __attribute__((ext_vector_type(2))); typedef __bf16 bf16x2_t __attribute__((ext_vector_type(2)));
constexpr int KROW = 144, VROW = 144, KT = 64 * KROW, VT = 64 * VROW;
__device__ __forceinline__ int vperm(int kv) { return (kv & ~12) | ((kv & 4) << 1) | ((kv & 8) >> 1); }
constexpr int L_K0 = 0, L_K1 = KT, L_V0 = 2 * KT, L_V1 = 2 * KT + VT, L_BT = 2 * KT + 2 * VT  , L_IMPG = L_BT + 4096 + 64, L_IMPL = L_IMPG + 33792, L_IMP = L_IMPL + 33792, L_SELM = L_IMP + 64 * 33 * 4, L_KC = L_SELM + 512  , VCROW = 272, L_VC = L_KC + 128 * KROW  , L_END = L_VC + 64 * VCROW;
static_assert(L_END <= 163840 - 512, "attention LDS map");
__device__ __forceinline__ int crow(int r, int hi) { return (r & 3) + 8 * (r >> 2) + 4 * hi; }
__device__ __forceinline__ float max3f(float a, float b, float c) { float r; asm("v_max3_f32 %0, %1, %2, %3" : "=v"(r) : "v"(a), "v"(b), "v"(c)); return r; }
__device__ __forceinline__ unsigned cvtpk(float lo, float hi) { f32x2_t v = {lo, hi}; bf16x2_t b = __builtin_convertvector(v, bf16x2_t); return __builtin_bit_cast(unsigned, b); }
__device__ __forceinline__ bf16x8 packp(const f32x16& p, int s) {
    u32x4 w; w.x = cvtpk(p[8 * s + 0], p[8 * s + 1]); w.y = cvtpk(p[8 * s + 2], p[8 * s + 3]); w.z = cvtpk(p[8 * s + 4], p[8 * s + 5]); w.w = cvtpk(p[8 * s + 6], p[8 * s + 7]);
    return __builtin_bit_cast(bf16x8, w); }
__device__ __forceinline__ bf16x8 kfrag(const unsigned char* kbuf, int st, int sp, int q32, int hi) { return *(const bf16x8*)(kbuf + (32 * st + q32) * KROW + (16 * sp + 8 * hi) * 2); }
__device__ __forceinline__ bf16x8 vfrag(const unsigned char* vbuf, int st, int s, int dt, int q32, int hi) { return *(const bf16x8*)(vbuf + (32 * dt + q32) * VROW + (32 * st + 16 * s + 8 * hi) * 2); }
__device__ __forceinline__ f32x16 qk_tile(const unsigned char* kbuf, int st, const bf16x8 (&qf)[4], int q32, int hi) {
    f32x16 s = {};
#pragma unroll
    for (int sp = 0; sp < 4; ++sp) s = __builtin_amdgcn_mfma_f32_32x32x16_bf16(kfrag(kbuf, st, sp, q32, hi), qf[sp], s, 0, 0, 0);
    return s; }
__device__ __forceinline__ void pv_tile(f32x16 (&o)[2], const unsigned char* vbuf, int st, const f32x16& p, int q32, int hi) {
#pragma unroll
    for (int s = 0; s < 2; ++s) { const bf16x8 pb = packp(p, s);
#pragma unroll
        for (int dt = 0; dt < 2; ++dt) o[dt] = __builtin_amdgcn_mfma_f32_32x32x16_bf16(vfrag(vbuf, st, s, dt, q32, hi), pb, o[dt], 0, 0, 0); }
}
struct Stage { u32x4 k, v; };
__device__ __forceinline__ void stage_load(Stage& s, const bf16_t* Kblk  , int ldk, const bf16_t* Vblk  , int ldv, int tid) {
    const int row = tid >> 3, ch = tid & 7;
    s.k = *(const u32x4*)(Kblk + (size_t)row * ldk + ch * 8); s.v = *(const u32x4*)(Vblk + (size_t)row * ldv + ch * 8); }
__device__ __forceinline__ void stage_store(const Stage& s, unsigned char* kbuf, unsigned char* vbuf, int tid) {
    const int row = tid >> 3, ch = tid & 7;
    *(u32x4*)(kbuf + row * KROW + ch * 16) = s.k;
    *(u32x4*)(vbuf + row * VROW + ch * 16) = s.v; }

struct SoftState { float mhat, l; f32x16 cneg; };
constexpr float ATT_THR = 8.0f;
template <int BR, int ABL>
__device__ __forceinline__ void block64(f32x16 (&o)[2], SoftState& ss, const unsigned char* kbuf, const unsigned char* vbuf, int dj, bool selbit, bool anyunsel, const bf16x8 (&qf)[4], const float* bt2,
                                        int q32, int hi, int tl) {
    f32x16 s0 = ss.cneg, s1 = ss.cneg;
#pragma unroll
    for (int sp = 0; sp < 4; ++sp) { s0 = __builtin_amdgcn_mfma_f32_32x32x16_bf16(kfrag(kbuf, 0, sp, q32, hi), qf[sp], s0, 0, 0, 0); s1 = __builtin_amdgcn_mfma_f32_32x32x16_bf16(kfrag(kbuf, 1, sp, q32, hi), qf[sp], s1, 0, 0, 0); }
    __builtin_amdgcn_sched_barrier(0);
    bf16x8 vf0[2][2], vf1[2][2];
#pragma unroll
    for (int s = 0; s < 2; ++s)
#pragma unroll
        for (int dt = 0; dt < 2; ++dt) vf0[s][dt] = vfrag(vbuf, 0, s, dt, q32, hi);
    __builtin_amdgcn_sched_barrier(0);
    if (dj <= 2) {
        const int basei = 64 * dj + tl + 64 - 4 * hi - 27; const float* bt0 = bt2 + basei; const float* bt1 = bt0 - 32;
#pragma unroll
        for (int r = 0; r < 16; ++r) { const int cr = (r & 3) + 8 * (r >> 2); s0[r] += bt0[27 - cr]; s1[r] += bt1[27 - cr]; }
    } else if (BR == 1 && dj == 8) {
        const int basei = tl - 4 * hi;
#pragma unroll
        for (int r = 0; r < 16; ++r) { const int cr = (r & 3) + 8 * (r >> 2);
            s0[r] += __int_as_float(((cr - basei - 1) >> 31) & 0xf149f2cau); s1[r] += __int_as_float(((cr + 32 - basei - 1) >> 31) & 0xf149f2cau); }
    }
    float rm = max3f(s0[0], s0[1], s1[0]), rm2 = max3f(s0[2], s0[3], s1[1]);
    rm = max3f(rm, s1[2], s1[3]);
#pragma unroll
    for (int r = 4; r < 16; r += 4) { rm = max3f(rm, s0[r], s0[r + 1]); rm2 = max3f(rm2, s0[r + 2], s0[r + 3]); rm = max3f(rm, s1[r], s1[r + 1]); rm2 = max3f(rm2, s1[r + 2], s1[r + 3]); }
    rm = max3f(rm, rm2, rm2);
    if (BR == 0) rm = selbit ? rm : -1e30f;
    if (__any(rm > ATT_THR)) {
        const float rmc = fmaxf(rm, __shfl_xor(rm, 32)), dl = fmaxf(rmc, 0.f), f = __builtin_amdgcn_exp2f(-dl);
        ss.mhat += dl; ss.l *= f;
#pragma unroll
        for (int r = 0; r < 16; ++r) { s0[r] -= dl; s1[r] -= dl; ss.cneg[r] -= dl; o[0][r] *= f; o[1][r] *= f; }
    }
    float ps = 0.f, ps1 = 0.f, ps2 = 0.f, ps3 = 0.f;
#pragma unroll
    for (int r = 0; r < 16; r += 2) { s0[r] = __builtin_amdgcn_exp2f(s0[r]); s0[r + 1] = __builtin_amdgcn_exp2f(s0[r + 1]); ps += s0[r]; ps2 += s0[r + 1]; }
    const unsigned pm = (BR == 0 && !selbit) ? 0u : 0xffffffffu;
    bf16x8 pb0[2];
#pragma unroll
    for (int s = 0; s < 2; ++s) { pb0[s] = packp(s0, s);
        if (BR == 0 && anyunsel) { u32x4 w = __builtin_bit_cast(u32x4, pb0[s]); w.x &= pm; w.y &= pm; w.z &= pm; w.w &= pm; pb0[s] = __builtin_bit_cast(bf16x8, w); } }
    __builtin_amdgcn_sched_barrier(0);
#pragma unroll
    for (int i = 0; i < 4; ++i) { const int s = i >> 1, dt = i & 1;
        o[dt] = __builtin_amdgcn_mfma_f32_32x32x16_bf16(vf0[s][dt], pb0[s], o[dt], 0, 0, 0);
#pragma unroll
        for (int e = 0; e < 4; ++e) s1[4 * i + e] = __builtin_amdgcn_exp2f(s1[4 * i + e]);
        __builtin_amdgcn_sched_barrier(0); }
#pragma unroll
    for (int s = 0; s < 2; ++s)
#pragma unroll
        for (int dt = 0; dt < 2; ++dt) vf1[s][dt] = vfrag(vbuf, 1, s, dt, q32, hi);
#pragma unroll
    for (int r = 0; r < 16; r += 2) { ps1 += s1[r]; ps3 += s1[r + 1]; }
    ps = (ps + ps1) + (ps2 + ps3);
    if (BR == 0) ps = selbit ? ps : 0.f;
    ss.l += ps;
#pragma unroll
    for (int s = 0; s < 2; ++s) { bf16x8 pb = packp(s1, s);
        if (BR == 0 && anyunsel) { u32x4 w = __builtin_bit_cast(u32x4, pb); w.x &= pm; w.y &= pm; w.z &= pm; w.w &= pm; pb = __builtin_bit_cast(bf16x8, w); }
#pragma unroll
        for (int dt = 0; dt < 2; ++dt) o[dt] = __builtin_amdgcn_mfma_f32_32x32x16_bf16(vf1[s][dt], pb, o[dt], 0, 0, 0); }
}
__device__ __forceinline__ void stage_load_t(Stage& s, const bf16_t* Kblk, const bf16_t* Vblk, int tid) {
    s.k = *(const u32x4*)(Kblk + (size_t)(tid >> 3) * KVW + (tid & 7) * 8); s.v = *(const u32x4*)(Vblk + (size_t)(tid & 63) * KVW + (tid >> 6) * 8); }
__device__ __forceinline__ void stage_store_t(const Stage& s, unsigned char* kbuf, unsigned char* vbuf, int tid) {
    const int row = tid >> 3, ch = tid & 7;
    *(u32x4*)(kbuf + row * KROW + ch * 16) = s.k;
    unsigned short* vp = (unsigned short*)(vbuf + ((tid >> 6) * 8) * VROW + vperm(tid & 63) * 2);
    vp[0 * (VROW / 2)] = (unsigned short)s.v.x; vp[1 * (VROW / 2)] = (unsigned short)(s.v.x >> 16); vp[2 * (VROW / 2)] = (unsigned short)s.v.y; vp[3 * (VROW / 2)] = (unsigned short)(s.v.y >> 16);
    vp[4 * (VROW / 2)] = (unsigned short)s.v.z; vp[5 * (VROW / 2)] = (unsigned short)(s.v.z >> 16); vp[6 * (VROW / 2)] = (unsigned short)s.v.w; vp[7 * (VROW / 2)] = (unsigned short)(s.v.w >> 16); }
template <int BR, int ABL>
__device__ __forceinline__ void branch(float* outl  , const Stage* first  , float gate, const bf16_t* Kg  , const bf16_t* Vg  ,
                                       int qblk, unsigned unionmask, unsigned mysel, const bf16x8 (&qf)[4], const float* bt2  , float cb  ,
                                       unsigned char* lds, int tid, int q32, int hi, int tl) {
    const int jlo = BR == 0 ? 0 : (qblk - 8 < 0 ? 0 : qblk - 8);
    f32x16 o[2]; o[0] = f32x16{}; o[1] = f32x16{};
    SoftState ss; ss.mhat = 0.f; ss.l = 0.f;
#pragma unroll
    for (int r = 0; r < 16; ++r) ss.cneg[r] = cb;
#define ATT_NEXT(jv) do { --(jv); if (BR == 0) { while ((jv) >= jlo && !((unionmask >> (jv)) & 1u)) --(jv); } } while (0)
#define ATT_LOAD(sg, jv) do { const int jl_ = (jv) < jlo ? jlo : (jv); if (!(ABL & 8)) stage_load_t(sg, Kg + (size_t)jl_ * 64 * KVW, Vg + (size_t)jl_ * 64 * KVW, tid); else { sg.k = (u32x4){(unsigned)jl_, 0u, 0u, 0u}; sg.v = sg.k; } } while (0)
#define ATT_SEL(jv) (BR == 0 ? (((mysel >> (jv)) & 1u) != 0u) : true)
    int jA = qblk, jB = qblk, jC;
    Stage sA, sB;
    if (first) sA = *first; else ATT_LOAD(sA, jA);
    ATT_NEXT(jB); ATT_LOAD(sB, jB);
    stage_store_t(sA, lds + L_K0, lds + L_V0, tid);
    __syncthreads();
    for (;;) {
        jC = jB; if (jB >= jlo) ATT_NEXT(jC);
        ATT_LOAD(sA, jC);
        { const bool sel = ATT_SEL(jA); if (BR == 1 || __any(sel)) block64<BR, ABL>(o, ss, lds + L_K0, lds + L_V0, qblk - jA, sel, BR == 0 && __any(!sel), qf, bt2, q32, hi, tl); }
        if (jB < jlo) break;
        if (!(ABL & 16)) stage_store_t(sB, lds + L_K1, lds + L_V1, tid);
        if (!(ABL & 4)) __syncthreads();
        jA = jC; if (jC >= jlo) ATT_NEXT(jA);
        ATT_LOAD(sB, jA);
        { const bool sel = ATT_SEL(jB); if (BR == 1 || __any(sel)) block64<BR, ABL>(o, ss, lds + L_K1, lds + L_V1, qblk - jB, sel, BR == 0 && __any(!sel), qf, bt2, q32, hi, tl); }
        if (jC < jlo) break;
        if (!(ABL & 16)) stage_store_t(sA, lds + L_K0, lds + L_V0, tid);
        if (!(ABL & 4)) __syncthreads();
        jB = jA; jA = jC;
    }
#undef ATT_NEXT
#undef ATT_LOAD
#undef ATT_SEL
    float lrun = ss.l; lrun += __shfl_xor(lrun, 32);
    const float f = gate / lrun;
#pragma unroll
    for (int r = 0; r < 16; ++r) { outl[r * 64] += o[0][r] * f; outl[(16 + r) * 64] += o[1][r] * f; }
    __syncthreads();
}

__device__ __forceinline__ void attn_bias_table(int g, const float* rel_bias, unsigned char* lds) {
    float* bt = (float*)(lds + L_BT); const int tid = threadIdx.x;
#pragma unroll
    for (int i = 0; i < 2; ++i) { const int e = tid + 512 * i, hh = e >> 8, ix = (e & 255) - 64; const float cbh = rel_bias[31 * NH + g * 4 + hh] * LOG2E; bt[e] = ix < 0 ? -1e30f : rel_bias[BUCKET[ix > 127 ? 127 : ix] * NH + g * 4 + hh] * LOG2E - cbh; }
    if (tid < 4) bt[1024 + tid] = rel_bias[31 * NH + g * 4 + tid] * LOG2E;
    __syncthreads();
}
__device__ __forceinline__ void attn_compress_l2(int bg, const bf16_t* HIDK, const bf16_t* HIDV, const float* w2k, const float* w2v, const float* kc_norm, unsigned char* lds) {
    const int tid = threadIdx.x, lane = tid & 63, wave = tid >> 6, q32 = lane & 31, hi = lane >> 5, which = wave >> 2, c = 32 * (wave & 3) + q32; const bool okc = c < NC;
    const bf16_t* hrow = (which ? HIDV : HIDK) + (size_t)(bg * NC + (okc ? c : 0)) * 256; const float* w2 = which ? w2v : w2k;
    f32x16 acc[2]; acc[0] = f32x16{}; acc[1] = f32x16{};
    for (int s = 0; s < 16; ++s) {
        const bf16x8 bfrag = *(const bf16x8*)(hrow + 16 * s + 8 * hi);
#pragma unroll
        for (int nt = 0; nt < 2; ++nt) { const float* wp = w2 + (size_t)(16 * s + 8 * hi) * HD + 32 * nt + q32;
            u32x4 aw; aw.x = cvtpk(wp[0], wp[HD]); aw.y = cvtpk(wp[2 * HD], wp[3 * HD]); aw.z = cvtpk(wp[4 * HD], wp[5 * HD]); aw.w = cvtpk(wp[6 * HD], wp[7 * HD]);
            acc[nt] = __builtin_amdgcn_mfma_f32_32x32x16_bf16(__builtin_bit_cast(bf16x8, aw), bfrag, acc[nt], 0, 0, 0); }
    }
    if (which) {
        unsigned short* vp = (unsigned short*)(lds + L_VC) + vperm(c);
#pragma unroll
        for (int nt = 0; nt < 2; ++nt)
#pragma unroll
            for (int q = 0; q < 16; ++q) vp[(32 * nt + crow(q, hi)) * (VCROW / 2)] = okc ? (unsigned short)(cvtpk(acc[nt][q], 0.f) & 0xffffu) : (unsigned short)0;
    } else {
        float ss = 0.f;
#pragma unroll
        for (int nt = 0; nt < 2; ++nt)
#pragma unroll
            for (int q = 0; q < 16; ++q) ss += acc[nt][q] * acc[nt][q];
        ss += __shfl_xor(ss, 32); const float rn = okc ? rsqrtf(ss * (1.f / HD) + EPS) : 0.f;
#pragma unroll
        for (int nt = 0; nt < 2; ++nt)
#pragma unroll
            for (int rg = 0; rg < 4; ++rg) { const int n0 = 32 * nt + 8 * rg + 4 * hi; const f32x4 gk = *(const f32x4*)(kc_norm + n0);
                *(unsigned long long*)(lds + L_KC + c * KROW + n0 * 2) = (unsigned long long)cvtpk(acc[nt][4 * rg] * rn * gk[0], acc[nt][4 * rg + 1] * rn * gk[1]) | ((unsigned long long)cvtpk(acc[nt][4 * rg + 2] * rn * gk[2], acc[nt][4 * rg + 3] * rn * gk[3]) << 32); }
    }
    __syncthreads();
}
__device__ __forceinline__ bf16x8 vfragc(const unsigned char* vcbuf, int tile, int s, int dt, int q32, int hi) { return *(const bf16x8*)(vcbuf + (32 * dt + q32) * VCROW + (32 * tile + 16 * s + 8 * hi) * 2); }
template <int MODE, int ABL = 0>
__device__ __forceinline__ void attn_unit(int b, int g, int qblk, const bf16_t* Q, bf16_t* O, const bf16_t* KSb, const bf16_t* VSb, const bf16_t* KWb, const bf16_t* VWb,
                                          const bf16_t* GN, const float* rel_bias, unsigned char* lds) {
    int tid = threadIdx.x; asm volatile("" : "+v"(tid));
    const int lane = tid & 63, wave = tid >> 6, q32 = lane & 31, hi = lane >> 5, hr = wave >> 1, th = wave & 1, h = g * 4 + hr, tl = 32 * th + q32, t = 64 * qblk + tl, bg = b * 4 + g;
    const size_t m = (size_t)b * T + t;
    float* bt = (float*)(lds + L_BT); float* impg = (float*)(lds + L_IMPG); float* impl = (float*)(lds + L_IMPL); float* imp = (float*)(lds + L_IMP); unsigned* selm = (unsigned*)(lds + L_SELM);
    bf16x8 qf[4];
#pragma unroll
    for (int sp = 0; sp < 4; ++sp) qf[sp] = *(const bf16x8*)(Q + m * QW + h * HD + 16 * sp + 8 * hi);
    const float g0 = bf2f(GN[m * 48 + h * 3 + 0]), g1 = bf2f(GN[m * 48 + h * 3 + 1]), g2 = bf2f(GN[m * 48 + h * 3 + 2]);
    f32x16 out[2];
    {
        const float* bte = bt + hr * 256 + 64; const float cbh = bt[1024 + hr];
        const int ncv = t >= 31 ? ((t - 31) >> 4) + 1 : 0;
        f32x16 sc[4]; float mx = -1e20f;
#pragma unroll
        for (int tile = 0; tile < 4; ++tile) {
            sc[tile] = qk_tile(lds + L_KC, tile, qf, q32, hi);
            __builtin_amdgcn_sched_barrier(0);
#pragma unroll
            for (int r = 0; r < 16; ++r) { const int c = 32 * tile + crow(r, hi);
                int dist = t - 31 - 16 * c; const float pen = __int_as_float(((ncv - 1 - c) >> 31) & 0xf149f2cau);
                dist = dist < 0 ? 0 : (dist > 127 ? 127 : dist);
                const float v = (sc[tile][r] + (bte[dist] + cbh)) + pen; sc[tile][r] = v; mx = fmaxf(mx, v); }
            __builtin_amdgcn_sched_barrier(0);
        }
        mx = fmaxf(mx, __shfl_xor(mx, 32));
        float l = 0.f;
#pragma unroll
        for (int tile = 0; tile < 4; ++tile)
#pragma unroll
            for (int r = 0; r < 16; ++r) { const float p = __builtin_amdgcn_exp2f(sc[tile][r] - mx); sc[tile][r] = p; l += p; }
        l += __shfl_xor(l, 32);
        const float inv = l > 0.f ? 1.f / l : 0.f;
#pragma unroll
        for (int tile = 0; tile < 4; ++tile)
#pragma unroll
            for (int r = 0; r < 16; ++r) sc[tile][r] *= inv;
        __builtin_amdgcn_sched_barrier(0);
        if (qblk > 15)
#pragma unroll
        for (int tile = 0; tile < 4; ++tile)
#pragma unroll
            for (int rg = 0; rg < 4; ++rg) { const int j = 8 * tile + 2 * rg + hi;
                impg[(hr * 64 + tl) * 33 + j] = (sc[tile][4 * rg] + sc[tile][4 * rg + 1]) + (sc[tile][4 * rg + 2] + sc[tile][4 * rg + 3]);
                impl[(hr * 64 + tl) * 33 + j] = sc[tile][4 * rg + 3]; }
        __builtin_amdgcn_sched_barrier(0);
        f32x16 o[2]; o[0] = f32x16{}; o[1] = f32x16{};
#pragma unroll
        for (int tile = 0; tile < 4; ++tile) {
#pragma unroll
            for (int s = 0; s < 2; ++s) { const bf16x8 pb = packp(sc[tile], s);
#pragma unroll
                for (int dt = 0; dt < 2; ++dt) o[dt] = __builtin_amdgcn_mfma_f32_32x32x16_bf16(vfragc(lds + L_VC, tile, s, dt, q32, hi), pb, o[dt], 0, 0, 0); }
            __builtin_amdgcn_sched_barrier(0); }
#pragma unroll
        for (int r = 0; r < 16; ++r) { out[0][r] = o[0][r] * g0; out[1][r] = o[1][r] * g0; }
    }
    const bf16_t* Kgs = KSb + (size_t)b * T * KVW + g * HD; const bf16_t* Kgw = KWb + (size_t)b * T * KVW + g * HD;
    const bf16_t* Vgs = VSb + (size_t)b * T * KVW + g * HD; const bf16_t* Vgw = VWb + (size_t)b * T * KVW + g * HD;
    Stage sfirst; stage_load_t(sfirst, Kgs + (size_t)qblk * 64 * KVW, Vgs + (size_t)qblk * 64 * KVW, tid);
    unsigned mysel, uni;
    if (qblk > 15) {
    __syncthreads();
    {
        const int stl = tid >> 3, jq = tid & 7;
#pragma unroll
        for (int e = 0; e < 4; ++e) { const int j = 4 * jq + e; float s = 0.f;
#pragma unroll
            for (int r = 0; r < 4; ++r) { s += impg[(r * 64 + stl) * 33 + j]; if (j > 0) s += impl[(r * 64 + stl) * 33 + j - 1]; }
            imp[stl * 33 + j] = s; }
        __syncthreads();
        unsigned bits = 0u;
        {
            float iv[32];
#pragma unroll
            for (int k = 0; k < 32; ++k) iv[k] = imp[stl * 33 + k];
#pragma unroll
            for (int e = 0; e < 4; ++e) { const int j = 4 * jq + e; float vj = iv[0];
#pragma unroll
                for (int k = 1; k < 32; ++k) vj = (k == j) ? iv[k] : vj;
                int rank = 0;
#pragma unroll
                for (int k = 1; k < 30; ++k) { const bool cand = k <= qblk - 2; rank += (cand && (iv[k] > vj || (iv[k] == vj && k < j))) ? 1 : 0; }
                if (j == 0 || j == qblk - 1 || j == qblk) bits |= 1u << j; else if (j < qblk - 1 && rank < 13) bits |= 1u << j; }
        }
        bits |= __shfl_xor(bits, 1); bits |= __shfl_xor(bits, 2); bits |= __shfl_xor(bits, 4);
        if (jq == 0) selm[stl] = bits;
    }
    __syncthreads();
    mysel = selm[tl]; uni = selm[lane];
#pragma unroll
    for (int o = 1; o < 64; o <<= 1) uni |= __shfl_xor(uni, o);
    } else { mysel = uni = (1u << (qblk + 1)) - 1u; }
    float* outl = (float*)(lds + L_IMPG) + wave * 2048 + lane;
#pragma unroll
    for (int r = 0; r < 16; ++r) { outl[r * 64] = out[0][r]; outl[(16 + r) * 64] = out[1][r]; }
    if (MODE & 2) branch<0, ABL>(outl, &sfirst, g1, Kgs, Vgs, qblk, uni, mysel, qf, bt + hr * 256, bt[1024 + hr], lds, tid, q32, hi, tl);
    if (MODE & 4) branch<1, ABL>(outl, nullptr, g2, Kgw, Vgw, qblk, 0xffffffffu, 0xffffffffu, qf, bt + hr * 256, bt[1024 + hr], lds, tid, q32, hi, tl);
    bf16_t* orow = O + m * QW + h * HD;
#pragma unroll
    for (int dt = 0; dt < 2; ++dt)
#pragma unroll
        for (int rg = 0; rg < 4; ++rg)
            *(unsigned long long*)(orow + 32 * dt + 8 * rg + 4 * hi) = (unsigned long long)cvtpk(outl[(16 * dt + 4 * rg) * 64], outl[(16 * dt + 4 * rg + 1) * 64]) | ((unsigned long long)cvtpk(outl[(16 * dt + 4 * rg + 2) * 64], outl[(16 * dt + 4 * rg + 3) * 64]) << 32);
}
}

__device__ __forceinline__ void tr_item(const float* W, int ldw, int kvalid, int c0, int cvalid, const float* kscale, bf16_t* WT, int ldt, int r0, int k0, float* scr, int lane) {
#pragma unroll 8
    for (int i = 0; i < 32; ++i) { const int kk = 2 * i + (lane >> 5), col = lane & 31, k = k0 + kk;
        float v = 0.f; if (k < kvalid && col < cvalid) { v = W[(size_t)k * ldw + c0 + col]; if (kscale) v *= kscale[k]; }
        scr[kk * 33 + col] = v; }
    asm volatile("s_waitcnt lgkmcnt(0)" ::: "memory");
    const int c = lane & 7;
#pragma unroll
    for (int j = 0; j < 4; ++j) { const int n = (lane >> 3) + 8 * j; const float* s = scr + (8 * c) * 33 + n;
        pg8::u32x4 o; o.x = pg8::cvt_pk_bf16(s[0 * 33], s[1 * 33]); o.y = pg8::cvt_pk_bf16(s[2 * 33], s[3 * 33]); o.z = pg8::cvt_pk_bf16(s[4 * 33], s[5 * 33]); o.w = pg8::cvt_pk_bf16(s[6 * 33], s[7 * 33]);
        *(pg8::u32x4*)(WT + (size_t)(r0 + n) * ldt + k0 + 8 * c) = o; }
    asm volatile("s_waitcnt lgkmcnt(0)" ::: "memory");
}

#define LAS __attribute__((address_space(3)))
#define XB_TMO      128
#define XB_XCNT(j)  (256  + 64 * (j))
#define XB_XSUB(j)  (1280 + 64 * (j))
#define XB_XGEN(j)  (2304 + 64 * (j))
#define XB_TOP      3328
#define XB_TOPGEN   3392
#define XCD_BAR_WORDS 3456
#define XB_SPIN_CAP (1u << 18)

__device__ __forceinline__ unsigned xb_ld(unsigned* p)              { return __hip_atomic_load(p, __ATOMIC_RELAXED, __HIP_MEMORY_SCOPE_AGENT); }
__device__ __forceinline__ unsigned xb_add(unsigned* p, unsigned v) { return __hip_atomic_fetch_add(p, v, __ATOMIC_RELAXED, __HIP_MEMORY_SCOPE_AGENT); }
__device__ __forceinline__ unsigned xb_xcc_id() { return (unsigned)__builtin_amdgcn_s_getreg((3 << 11) | 20) & 0xFu; }
#define XB_SPIN(cond, bar) do { unsigned _sp = 0; while (cond) { __builtin_amdgcn_s_sleep(1); \
    if ((++_sp & 255u) == 0u) { if (xb_ld(&(bar)[XB_TMO])) break; if (_sp > XB_SPIN_CAP) { atomicAdd(&(bar)[XB_TMO], 1u); break; } } } } while (0)

struct XcdBarrier {
    unsigned* bar; unsigned x;
    volatile LAS unsigned* st;
};

__device__ __forceinline__ XcdBarrier xcd_barrier_post(unsigned* bar, volatile LAS unsigned* st) {
    XcdBarrier b; b.bar = bar; b.x = xb_xcc_id(); b.st = st;
    if (threadIdx.x == 0) (void)xb_add(&bar[XB_XCNT(b.x)], 1u);
    return b;
}
__device__ __forceinline__ void xcd_barrier_complete(unsigned* bar, unsigned x, unsigned& nloc, unsigned& nx) {
    const unsigned G = gridDim.x * gridDim.y * gridDim.z;
    unsigned sum, cnt, mine, sp = 0u;
    for (;;) {
        sum = 0u; cnt = 0u; mine = 0u;
#pragma unroll
        for (unsigned j = 0; j < 16; ++j) { const unsigned c = xb_ld(&bar[XB_XCNT(j)]); sum += c; cnt += (c > 0u) ? 1u : 0u; mine = (j == x) ? c : mine; }
        if (sum == G) break;
        __builtin_amdgcn_s_sleep(1);
        if ((++sp & 255u) == 0u) { if (xb_ld(&bar[XB_TMO])) break; if (sp > XB_SPIN_CAP) { atomicAdd(&bar[XB_TMO], 1u); break; } }
    }
    nloc = mine > 0u ? mine : 1u; nx = cnt > 0u ? cnt : 1u;
}

__device__ __forceinline__ void xcd_barrier(const XcdBarrier& b) {
    asm volatile("s_waitcnt vmcnt(0)" ::: "memory");
    __syncthreads();
    if (threadIdx.x == 0) {
        unsigned* bar = b.bar;
        __builtin_amdgcn_s_waitcnt(0);
        unsigned nloc = b.st[0], nx = b.st[1];
        if (nloc == 0u) { xcd_barrier_complete(bar, b.x, nloc, nx); b.st[0] = nloc; b.st[1] = nx; }
        const unsigned old = xb_add(&bar[XB_XSUB(b.x)], 1u);
        const unsigned gen = old / nloc;
        if (old + 1u == (gen + 1u) * nloc) {
            __builtin_amdgcn_fence(__ATOMIC_RELEASE, "agent");
            asm volatile("s_waitcnt vmcnt(0)" ::: "memory");
            const unsigned og = xb_add(&bar[XB_TOP], 1u);
            const unsigned tg = og / nx;
            if (og + 1u == (tg + 1u) * nx) xb_add(&bar[XB_TOPGEN], 1u);
            else XB_SPIN(xb_ld(&bar[XB_TOPGEN]) == tg, bar);
            __builtin_amdgcn_fence(__ATOMIC_ACQUIRE, "agent");
            xb_add(&bar[XB_XGEN(b.x)], 1u);
            asm volatile("s_waitcnt vmcnt(0)" ::: "memory");
        } else {
            XB_SPIN(xb_ld(&bar[XB_XGEN(b.x)]) == gen, bar);
            __builtin_amdgcn_fence(__ATOMIC_ACQUIRE, "agent");
            asm volatile("s_waitcnt vmcnt(0)" ::: "memory");
        }
    }
    __syncthreads();
}

#define DECL_PTRS \
    size_t zoff_ = 0; asm volatile("" : "+s"(zoff_));     \
    unsigned char* ws = a.ws + zoff_; unsigned char* dob = (unsigned char*)a.out + zoff_; \
    const float *x = a.in[0], *norm_mix = a.in[1], *w_in = a.in[2], *conv_w = a.in[3], *conv_b = a.in[4], *gate_a_w = a.in[5], *gate_a_b = a.in[6], *gate_x_w = a.in[7], *gate_x_b = a.in[8], \
                *lam = a.in[9], *pe_k = a.in[10], *w1k = a.in[11], *w2k = a.in[12], *pe_v = a.in[13], *w1v = a.in[14], *w2v = a.in[15], *q_norm = a.in[16], *kc_norm = a.in[17], *ks_norm = a.in[18], \
                *kw_norm = a.in[19], *rel_bias = a.in[20], *proj_a = a.in[21], *proj_b = a.in[22], *w_out = a.in[23], *norm_mlp = a.in[24], *w_mlp_in = a.in[25], *w_mlp_out = a.in[26]; \
    float* RSTD = (float*)(ws + WS_RSTD); float* KCC = (float*)(ws + WS_KCC); float* VCC = (float*)(ws + WS_VCC); unsigned* SEL = (unsigned*)(ws + WS_SEL); \
    bf16_t *URNN = (bf16_t*)(ws + WS_URNN), *UGATE = (bf16_t*)(ws + WS_UGATE), *Q = (bf16_t*)(ws + WS_Q), *KV = (bf16_t*)(ws + WS_KV), *GN = (bf16_t*)(ws + WS_GN), *GA = (bf16_t*)(ws + WS_GA), *GB = (bf16_t*)(ws + WS_GB); \
    bf16_t *KCr = KV, *VCr = KV + (size_t)M * KVW, *KS = KV + 2 * (size_t)M * KVW, *VS = KV + 3 * (size_t)M * KVW, *KW = KV + 4 * (size_t)M * KVW, *VW = KV + 5 * (size_t)M * KVW; \
    bf16_t *LA = (bf16_t*)(ws + WS_LA), *UP = (bf16_t*)(ws + WS_UP), *T1 = (bf16_t*)(ws + WS_T1), *MERGED = (bf16_t*)(ws + WS_MERGED), *HB = (bf16_t*)(ws + WS_HB), *ZACT = (bf16_t*)(ws + WS_ZACT); \
    bf16_t *FLATK = (bf16_t*)(dob + DO_FLATK), *FLATV = (bf16_t*)(dob + DO_FLATV), *HIDK = (bf16_t*)(dob + DO_HIDK), *HIDV = (bf16_t*)(dob + DO_HIDV), *XC = (bf16_t*)(dob + DO_XC), *YA = (bf16_t*)(dob + DO_YA); \
    float* H = (float*)dob; \
    float* LAMC = (float*)(ws + WS_LAMC); float* NORMS = (float*)(ws + WS_NORMS); float* PES = (float*)(ws + WS_PES); float* SSQ = (float*)(ws + WS_SSQ); \
    bf16_t *WIN_T = (bf16_t*)(ws + WS_WIN), *WG_T = (bf16_t*)(ws + WS_WG), *W1_T = (bf16_t*)(ws + WS_W1), *PA_T = (bf16_t*)(ws + WS_PA), *PB_T = (bf16_t*)(ws + WS_PB), *WO_T = (bf16_t*)(ws + WS_WO), *WMI_T = (bf16_t*)(ws + WS_WMI), *WMO_T = (bf16_t*)(ws + WS_WMO); \
    float *CAR = (float*)(dob + DO_CAR), *CBR = (float*)(dob + DO_CBR); \
    bf16_t* XB = (bf16_t*)(dob + DO_XB); bf16_t *KCB = (bf16_t*)(dob + DO_KCB), *VCT = (bf16_t*)(dob + DO_VCT), *VST = (bf16_t*)(dob + DO_VST), *VWT = (bf16_t*)(dob + DO_VWT); \
    (void)0;
__global__ void __launch_bounds__(NTHREADS, 2) fwd(Args a) {
    extern __shared__ __attribute__((aligned(16))) unsigned char lds[];
    float* ldsf = (float*)lds;
    const int tid = threadIdx.x, lane = tid & 63, wave = tid >> 6;
    const int gw = blockIdx.x * 8 + wave, NGW = gridDim.x * 8;
    const size_t gtid = (size_t)blockIdx.x * NTHREADS + tid, GSZ = (size_t)gridDim.x * NTHREADS;
    unsigned char* ws0 = a.ws;
    PG8_LAS unsigned char* ldsl = (PG8_LAS unsigned char*)lds;
    const int G = gridDim.x;
    const int lo = a.ph_lo, hi = a.ph_hi;
    volatile LAS unsigned* MISC = (volatile LAS unsigned*)((LAS unsigned char*)lds + LDS_BYTES - 256);
    if (tid < 32) MISC[tid] = 0u;
    __syncthreads();
    XcdBarrier bar = xcd_barrier_post((unsigned*)(ws0 + 16384), MISC + 8);
    int ph = 0;
#ifndef PHMASK
#define PHMASK 0xFFFFFFFFu
#endif
#ifndef REPMASK
#define REPMASK 0u
#endif
#define PHASE_BEGIN if (lo <= ph && ph < hi && ((PHMASK >> ph) & 1u)) {
#define PHASE_BEGIN_R if (lo <= ph && ph < hi && ((PHMASK >> ph) & 1u)) for (int rep_ = 0; rep_ < (((REPMASK >> (16 + ph)) & 1u) ? 2 : 1); ++rep_) {
#define PHASE_END } { const bool sync_ = (lo <= ph && ph + 1 < hi); ++ph; if (sync_) xcd_barrier(bar); }

    PHASE_BEGIN_R DECL_PTRS
    for (int m0 = 2 * gw; m0 < M; m0 += 2 * NGW) {
        pg8::f32x4 v[2][4]; float s[2] = {0.f, 0.f};
#pragma unroll
        for (int u = 0; u < 2; ++u) { const pg8::f32x4* xr = (const pg8::f32x4*)(x + (size_t)(m0 + u) * D) + lane;
#pragma unroll
            for (int j = 0; j < 4; ++j) v[u][j] = xr[64 * j]; }
#pragma unroll
        for (int u = 0; u < 2; ++u)
#pragma unroll
            for (int j = 0; j < 4; ++j) s[u] += (v[u][j][0] * v[u][j][0] + v[u][j][1] * v[u][j][1]) + (v[u][j][2] * v[u][j][2] + v[u][j][3] * v[u][j][3]);
#pragma unroll
        for (int o = 1; o < 64; o <<= 1) { s[0] += __shfl_xor(s[0], o); s[1] += __shfl_xor(s[1], o); }
#pragma unroll
        for (int u = 0; u < 2; ++u) { const float r = rsqrtf(s[u] * (1.f / D) + EPS); if (lane == 0) RSTD[m0 + u] = r;
            unsigned long long* o8 = (unsigned long long*)(XB + (size_t)(m0 + u) * D) + lane;
#pragma unroll
            for (int j = 0; j < 4; ++j) { const pg8::f32x4 gg = *((const pg8::f32x4*)norm_mix + lane + 64 * j); const pg8::f32x4 y = v[u][j] * r * gg;
                o8[64 * j] = (unsigned long long)pg8::cvt_pk_bf16(y[0], y[1]) | ((unsigned long long)pg8::cvt_pk_bf16(y[2], y[3]) << 32); } }
    }
    for (size_t i = gtid; i < DRNN; i += GSZ) LAMC[i] = -8.f * log1pf(__expf(-lam[i])) * LOG2E;
    for (size_t i = gtid; i < 4096; i += GSZ) PES[i] = i < 2048 ? pe_k[i] : pe_v[i - 2048];
    for (size_t i = gtid; i < 192; i += GSZ) NORMS[i] = i < 64 ? q_norm[i] : (i < 128 ? ks_norm[i - 64] : kw_norm[i - 128]);
    {
        float* scr = ldsf + wave * (64 * 33);
        constexpr int I_WIN = (pg8::N1PAD / 32) * 16, I_W1 = 16 * 32;
        for (int it = gw; it < I_WIN + I_W1; it += NGW) {
            int r = it;
            if (r < I_WIN) { const int ch = r / 16, kb = r % 16; int c0, cv; pg8::win_src(ch, c0, cv); tr_item(w_in, DIN, D, c0, cv, nullptr, WIN_T, D, 32 * ch, 64 * kb, scr, lane); continue; } r -= I_WIN;
            { const int ch = r / 32, kb = r % 32; tr_item((ch >> 3) ? w1v : w1k, 256, 2048, (ch & 7) * 32, 32, nullptr, W1_T, 2048, 32 * ch, 64 * kb, scr, lane); }
        }
    }
    PHASE_END
    PHASE_BEGIN DECL_PTRS
    if (FAST(1)) {
        pg8::Gemm g{XB, WIN_T, M, pg8::N1PAD, D}; pg8::StaticOrder S; S.init(M, pg8::N1PAD, G, (int)blockIdx.x);
        PG8_LAS float* ctab = (PG8_LAS float*)(ldsl + 131072);
        for (int i = tid; i < 192; i += NTHREADS) ctab[i] = NORMS[i];
        for (int i = tid; i < 4096; i += NTHREADS) ctab[256 + i] = PES[i];
        __syncthreads();
        pg8::Ep1F E{URNN, UGATE, Q, KV, GN, GA, ctab, FLATK, ctab + 256};
        pg8::gemm_phase<pg8::Ep1F, pg8::StaticOrder, true, true>(ldsl, g, S, E);
#if (REPMASK >> 1) & 1
        pg8::gemm_phase<pg8::Ep1F, pg8::StaticOrder, true, true>(ldsl, g, S, E);
#endif
    } else {
        ngemm(ldsf, M, DIN, D, ALf32Scale{x, D, norm_mix}, BLf32{w_in, DIN}, Ep1{RSTD, URNN, UGATE, Q, KV, GN, GA, GB});
    }
    PHASE_END
    PHASE_BEGIN DECL_PTRS
    if (blockIdx.x >= 64) {
        float* scr = ldsf + wave * (64 * 33);
        constexpr int I_WG = 96 * 6, I_PA = 32 * 22, I_PB = 32 * 16, I_WO = 32 * 16, I_WMI = 128 * 16, I_WMO = 32 * 64;
        for (int it = ((int)blockIdx.x - 64) * 8 + wave; it < I_WG + I_PA + I_PB + I_WO + I_WMI + I_WMO; it += ((int)gridDim.x - 64) * 8) {
            int r = it;
            if (r < I_WG) { const int ch = r / 6, kb = r % 6, nb = ch / 24, rr = ch % 24, pn = rr >> 3, l0 = (rr & 7) * 32, bj = l0 >> 7, chn0 = 128 * pn + (l0 & 127);
                int cv = BW - chn0; cv = cv < 0 ? 0 : (cv > 32 ? 32 : cv);
                tr_item((bj ? gate_x_w : gate_a_w) + (size_t)nb * BW * BW, BW, BW, chn0, cv, nullptr, WG_T, XC_LD, 32 * ch, 64 * kb, scr, lane); continue; } r -= I_WG;
            if (r < I_PA) { const int ch = r / 22, kb = r % 22; tr_item(proj_a, D, DRNN, 32 * ch, 32, nullptr, PA_T, YA_LD, 32 * ch, 64 * kb, scr, lane); continue; } r -= I_PA;
            if (r < I_PB) { const int ch = r / 16, kb = r % 16; tr_item(proj_b, D, QW, 32 * ch, 32, nullptr, PB_T, QW, 32 * ch, 64 * kb, scr, lane); continue; } r -= I_PB;
            if (r < I_WO) { const int ch = r / 16, kb = r % 16; tr_item(w_out, D, D, 32 * ch, 32, nullptr, WO_T, D, 32 * ch, 64 * kb, scr, lane); continue; } r -= I_WO;
            if (r < I_WMI) { const int ch = r / 16, kb = r % 16; tr_item(w_mlp_in, DFF, D, 32 * ch, 32, norm_mlp, WMI_T, D, 32 * ch, 64 * kb, scr, lane); continue; } r -= I_WMI;
            { const int ch = r / 64, kb = r % 64; tr_item(w_mlp_out, D, DFF, 32 * ch, 32, nullptr, WMO_T, DFF, 32 * ch, 64 * kb, scr, lane); }
        }
    } else
    if (FAST(3)) {
        pg8::Gemm g{FLATK, W1_T, 16384, 512, 2048}; pg8::OrderC1 S{G, (int)blockIdx.x};
        pg8::EpGeluF E{HIDK, 256};
        pg8::gemm_phase<pg8::EpGeluF, pg8::OrderC1, true, true>(ldsl, g, S, E);
#if (REPMASK >> 3) & 1
        pg8::gemm_phase<pg8::EpGeluF, pg8::OrderC1, true, true>(ldsl, g, S, E);
#endif
    } else {
        ngemm(ldsf, 8192, 256, 2048, ALbf{FLATK, 2048}, BLf32{w1k, 256}, EpGelu{HIDK, 256});
        ngemm(ldsf, 8192, 256, 2048, ALbf{FLATV, 2048}, BLf32{w1v, 256}, EpGelu{HIDV, 256});
    }
    PHASE_END
    PHASE_BEGIN DECL_PTRS
    {
        const int vcu = (G % 8 == 0) ? ((int)blockIdx.x % 8) * (G / 8) + (int)blockIdx.x / 8 : (int)blockIdx.x;
#ifdef ATT_PROBE_MODE
#ifndef ATT_ABL
#define ATT_ABL 0
#endif
        for (int u = vcu; u < 256; u += G) {
            const int bg = u >> 2, s4 = u & 3;
            att::attn_bias_table(bg & 3, rel_bias, lds);
            att::attn_compress_l2(bg, HIDK, HIDV, w2k, w2v, kc_norm, lds);
#pragma unroll 1
            for (int i = 0; i < 8; ++i) { const int qblk = 8 * (i >> 1) + ((i & 1) ? 7 - s4 : s4);
                att::attn_unit<ATT_PROBE_MODE, ATT_ABL>(bg >> 2, bg & 3, qblk, Q, (bf16_t*)dob, KS, VS, KW, VW, GN, rel_bias, lds); }
        }
#endif
        for (int u = vcu; u < 256; u += G) {
            const int bg = u >> 2, s4 = u & 3;
            att::attn_bias_table(bg & 3, rel_bias, lds);
            att::attn_compress_l2(bg, HIDK, HIDV, w2k, w2v, kc_norm, lds);
#pragma unroll 1
            for (int i = 7; i >= 0; --i) { const int qblk = 8 * (i >> 1) + ((i & 1) ? 7 - s4 : s4);
                att::attn_unit<7>(bg >> 2, bg & 3, qblk, Q, Q, KS, VS, KW, VW, GN, rel_bias, lds); }
        }
    }
    for (unsigned it = (unsigned)gtid; it < 4u * (unsigned)(M / 8) * 48u; it += (unsigned)GSZ) {
        const unsigned ch = it % 48u, nr = it / 48u, run = nr & (unsigned)(M / 8 - 1), n = nr >> 12, m0 = run * 8u, t0 = m0 & (unsigned)(T - 1), j0 = ch * 8u;
        bf16_t* dst = XC + ((size_t)n * M + m0) * XC_LD + j0;
        if (j0 >= (unsigned)BW) {
#pragma unroll
            for (int i = 0; i < 8; ++i) *(pg8::u32x4*)(dst + (size_t)i * XC_LD) = (pg8::u32x4){0u, 0u, 0u, 0u};
            continue; }
        const unsigned c = n * BW + j0;
        pg8::u32x4 rows[11];
#pragma unroll
        for (int i = 0; i < 11; ++i) rows[i] = ((int)t0 - 3 + i >= 0) ? *(const pg8::u32x4*)(URNN + (size_t)(m0 - 3 + i) * DRNN + c) : (pg8::u32x4){0u, 0u, 0u, 0u};
        pg8::f32x4 w0[4], w1[4];
#pragma unroll
        for (int kk = 0; kk < 4; ++kk) { w0[kk] = *(const pg8::f32x4*)(conv_w + kk * DRNN + c); w1[kk] = *(const pg8::f32x4*)(conv_w + kk * DRNN + c + 4); }
        const pg8::f32x4 b0 = *(const pg8::f32x4*)(conv_b + c), b1 = *(const pg8::f32x4*)(conv_b + c + 4);
#pragma unroll
        for (int i = 0; i < 8; ++i) { pg8::f32x4 a0 = b0, a1 = b1;
#pragma unroll
            for (int kk = 0; kk < 4; ++kk) { pg8::f32x4 x0, x1; pg8::unpack8(rows[i + kk], x0, x1); a0 += w0[kk] * x0; a1 += w1[kk] * x1; }
            *(pg8::u32x4*)(dst + (size_t)i * XC_LD) = pg8::pack8(a0, a1); }
    }
    PHASE_END
    PHASE_BEGIN DECL_PTRS
    if (FAST(8)) {
        int kg = XC_LD; asm volatile("" : "+s"(kg));
        pg8::Gemm g{XC, WG_T, 4 * M, 4 * 768, kg}; pg8::OrderGate S{G, (int)blockIdx.x};
        pg8::EpGateF E{gate_a_b, gate_x_b, LAMC, XC, LA, UP};
        pg8::gemm_phase<pg8::EpGateF, pg8::OrderGate, true, true>(ldsl, g, S, E);
#if (REPMASK >> 8) & 1
        pg8::gemm_phase<pg8::EpGateF, pg8::OrderGate, true, true>(ldsl, g, S, E);
#endif
    } else {
    for (int n = 0; n < 4; ++n)
        ngemm(ldsf, M, 2 * BW, BW, ALbf{XC + (size_t)n * M * XC_LD, XC_LD}, BLgate{gate_a_w + (size_t)n * BW * BW, gate_x_w + (size_t)n * BW * BW},
              EpGate{n, gate_a_b, gate_x_b, lam, XC + (size_t)n * M * XC_LD, LA, UP});
    }
    PHASE_END
    PHASE_BEGIN_R DECL_PTRS
    for (size_t it = gtid; it < (size_t)NB * 64 * 336; it += GSZ) {
        const int slot = (int)(it % 336), bk = (int)(it / 336), kc = bk & 63, b = bk >> 6, c0 = 4 * slot; const size_t m0 = (size_t)b * T + 32 * kc;
        float h[4] = {0.f, 0.f, 0.f, 0.f}, sl[4] = {0.f, 0.f, 0.f, 0.f};
#pragma unroll 1
        for (int i0 = 0; i0 < 32; i0 += 8) {
            unsigned long long lw[8], uw[8];
#pragma unroll
            for (int i = 0; i < 8; ++i) { lw[i] = *(const unsigned long long*)(LA + (m0 + i0 + i) * DRNN + c0); uw[i] = *(const unsigned long long*)(UP + (m0 + i0 + i) * DRNN + c0); }
#pragma unroll
            for (int i = 0; i < 8; ++i)
#pragma unroll
                for (int e = 0; e < 4; ++e) { const float la = bf2f((bf16_t)(lw[i] >> (16 * e))), up = bf2f((bf16_t)(uw[i] >> (16 * e))); const float av = __builtin_amdgcn_exp2f(la);
                    const float mult = (kc == 0 && i0 + i == 0) ? 1.f : __builtin_amdgcn_sqrtf(fmaxf(0.f, 1.f - av * av)); h[e] = av * h[e] + mult * up; sl[e] += la; }
        }
        *(pg8::f32x4*)(CAR + (size_t)bk * DRNN + c0) = (pg8::f32x4){sl[0], sl[1], sl[2], sl[3]};
        *(pg8::f32x4*)(CBR + (size_t)bk * DRNN + c0) = (pg8::f32x4){h[0], h[1], h[2], h[3]};
    }
    PHASE_END
    PHASE_BEGIN_R DECL_PTRS
    for (size_t it = gtid; it < (size_t)NB * 64 * 352; it += GSZ) {
        const int slot = (int)(it % 352), bk = (int)(it / 352), kc = bk & 63, b = bk >> 6, c0 = 4 * slot; const size_t m0 = (size_t)b * T + 32 * kc;
        if (slot >= 336) { for (int i = 0; i < 32; ++i) *(unsigned long long*)(YA + (m0 + i) * YA_LD + c0) = 0ull; continue; }
        unsigned long long la_[8], ua_[8], ga_[8], lb_[8], ub_[8], gb_[8];
#define SC_LOAD(L_, U_, G_, i0_) _Pragma("unroll") for (int i = 0; i < 8; ++i) { L_[i] = *(const unsigned long long*)(LA + (m0 + (i0_) + i) * DRNN + c0); U_[i] = *(const unsigned long long*)(UP + (m0 + (i0_) + i) * DRNN + c0); G_[i] = *(const unsigned long long*)(UGATE + (m0 + (i0_) + i) * DRNN + c0); }
#define SC_SCAN(L_, U_, G_, i0_) _Pragma("unroll") for (int i = 0; i < 8; ++i) { float y[4]; \
            _Pragma("unroll") for (int e = 0; e < 4; ++e) { const float la = bf2f((bf16_t)(L_[i] >> (16 * e))), up = bf2f((bf16_t)(U_[i] >> (16 * e))); const float av = __builtin_amdgcn_exp2f(la); \
                const float mult = (kc == 0 && (i0_) + i == 0) ? 1.f : __builtin_amdgcn_sqrtf(fmaxf(0.f, 1.f - av * av)); h[e] = av * h[e] + mult * up; y[e] = h[e] * bf2f((bf16_t)(G_[i] >> (16 * e))); } \
            *(unsigned long long*)(YA + (m0 + (i0_) + i) * YA_LD + c0) = (unsigned long long)att::cvtpk(y[0], y[1]) | ((unsigned long long)att::cvtpk(y[2], y[3]) << 32); }
        SC_LOAD(la_, ua_, ga_, 0)
        float h[4] = {0.f, 0.f, 0.f, 0.f};
        for (int k0 = 0; k0 < kc; k0 += 16) {
            pg8::f32x4 sa[16], sb[16];
#pragma unroll
            for (int u = 0; u < 16; ++u) { const int k2 = k0 + u < kc ? k0 + u : kc - 1; sa[u] = *(const pg8::f32x4*)(CAR + (size_t)(b * 64 + k2) * DRNN + c0); sb[u] = *(const pg8::f32x4*)(CBR + (size_t)(b * 64 + k2) * DRNN + c0); }
#pragma unroll
            for (int u = 0; u < 16; ++u) if (k0 + u < kc) {
#pragma unroll
                for (int e = 0; e < 4; ++e) h[e] = __builtin_amdgcn_exp2f(sa[u][e]) * h[e] + sb[u][e]; }
        }
        SC_LOAD(lb_, ub_, gb_, 8)  SC_SCAN(la_, ua_, ga_, 0)
        SC_LOAD(la_, ua_, ga_, 16) SC_SCAN(lb_, ub_, gb_, 8)
        SC_LOAD(lb_, ub_, gb_, 24) SC_SCAN(la_, ua_, ga_, 16)
        SC_SCAN(lb_, ub_, gb_, 24)
#undef SC_LOAD
#undef SC_SCAN
    }
    PHASE_END
    PHASE_BEGIN DECL_PTRS
    if (FAST(10)) {
        pg8::Gemm g{YA, PA_T, M, D, YA_LD}; pg8::StaticOrder S; S.init(M, D, G, (int)blockIdx.x);
        pg8::EpT1F E{GA, T1};
        pg8::gemm_phase<pg8::EpT1F, pg8::StaticOrder, true, true>(ldsl, g, S, E);
#if (REPMASK >> 10) & 1
        pg8::gemm_phase<pg8::EpT1F, pg8::StaticOrder, true, true>(ldsl, g, S, E);
#endif
    } else ngemm(ldsf, M, D, DRNN, ALbf{YA, YA_LD}, BLf32{proj_a, D}, EpT1{GA, T1});
    if (FAST(11)) {
        pg8::Gemm g{Q, PB_T, M, D, QW}; pg8::StaticOrder S; S.init(M, D, G, (int)blockIdx.x);
        pg8::EpMergedF E{GB, T1, MERGED};
        pg8::gemm_phase<pg8::EpMergedF, pg8::StaticOrder, true, true>(ldsl, g, S, E);
#if (REPMASK >> 11) & 1
        pg8::gemm_phase<pg8::EpMergedF, pg8::StaticOrder, true, true>(ldsl, g, S, E);
#endif
    } else ngemm(ldsf, M, D, QW, ALbf{Q, QW}, BLf32{proj_b, D}, EpMerged{GB, T1, MERGED});
    PHASE_END
    PHASE_BEGIN DECL_PTRS
    if (FAST(12)) {
        pg8::Gemm g{MERGED, WO_T, M, D, D}; pg8::StaticOrder S; S.init(M, D, G, (int)blockIdx.x);
        pg8::EpHF E{x, H, HB, SSQ};
        pg8::gemm_phase<pg8::EpHF, pg8::StaticOrder, true, true>(ldsl, g, S, E);
#if (REPMASK >> 12) & 1
        pg8::gemm_phase<pg8::EpHF, pg8::StaticOrder, true, true>(ldsl, g, S, E);
#endif
    } else ngemm(ldsf, M, D, D, ALbf{MERGED, D}, BLf32{w_out, D}, EpH{x, H, HB});
    PHASE_END
    PHASE_BEGIN DECL_PTRS
    if (FAST(14)) {
        pg8::Gemm g{HB, WMI_T, M, DFF, D}; pg8::StaticOrder S; S.init(M, DFF, G, (int)blockIdx.x);
        PG8_LAS float* rtab = (PG8_LAS float*)(ldsl + 131072);
        bool tab_ok;
        { pg8::Unit uu; int i = 0;
          for (; i < 16 && S.next(i, uu); ++i) if (tid < 256) { const float* sp = SSQ + (size_t)(uu.pm * 256 + tid) * 16;
                const pg8::f32x4 s0 = *(const pg8::f32x4*)sp, s1 = *(const pg8::f32x4*)(sp + 4), s2 = *(const pg8::f32x4*)(sp + 8), s3 = *(const pg8::f32x4*)(sp + 12); const pg8::f32x4 st = (s0 + s1) + (s2 + s3);
                rtab[i * 256 + tid] = rsqrtf(((st[0] + st[1]) + (st[2] + st[3])) * (1.f / D) + EPS); }
          tab_ok = !(i == 16 && S.next(16, uu)); }
        __syncthreads();
        pg8::EpZF E{tab_ok ? rtab : (PG8_LAS float*)nullptr, SSQ, ZACT};
        pg8::gemm_phase<pg8::EpZF, pg8::StaticOrder, true, true>(ldsl, g, S, E);
#if (REPMASK >> 14) & 1
        pg8::gemm_phase<pg8::EpZF, pg8::StaticOrder, true, true>(ldsl, g, S, E);
#endif
    } else ngemm(ldsf, M, DFF, D, ALbfScale{HB, D, norm_mlp}, BLf32{w_mlp_in, DFF}, EpZ{SSQ, ZACT});
    PHASE_END
    PHASE_BEGIN DECL_PTRS
    if (FAST(15)) {
        pg8::Gemm g{ZACT, WMO_T, M, D, DFF}; pg8::StaticOrder S; S.init(M, D, G, (int)blockIdx.x);
        pg8::EpOutF E{HB, H};
        pg8::gemm_phase<pg8::EpOutF, pg8::StaticOrder, true, true>(ldsl, g, S, E);
#if (REPMASK >> 15) & 1
        pg8::gemm_phase<pg8::EpOutF, pg8::StaticOrder, true, true>(ldsl, g, S, E);
#endif
    } else ngemm(ldsf, M, D, DFF, ALbf{ZACT, DFF}, BLf32{w_mlp_out, D}, EpOut{H});
    PHASE_END
}
constexpr int NPHASES = 11;

extern "C" void kernel_launch(void* const* d_in, const int* in_sizes, int n_in, void* d_out, int out_size, void* d_ws, size_t ws_size, hipStream_t stream) {
    static int grid = 0;
    if (grid == 0) {
        if (n_in != 27 || out_size != M * D || ws_size < WS_END) { fprintf(stderr, "kernel_launch: unexpected shapes n_in %d out %d ws %zu\n", n_in, out_size, ws_size); grid = -1; return; }
        int dev = 0, cus = 0, per_cu = 0;
        (void)hipGetDevice(&dev);
        (void)hipDeviceGetAttribute(&cus, hipDeviceAttributeMultiprocessorCount, dev);
        (void)hipFuncSetAttribute((const void*)fwd, hipFuncAttributeMaxDynamicSharedMemorySize, LDS_BYTES);
        (void)hipOccupancyMaxActiveBlocksPerMultiprocessor(&per_cu, (const void*)fwd, NTHREADS, LDS_BYTES);
        fprintf(stderr, "kernel_launch: cus %d per_cu %d ws_size %zu\n", cus, per_cu, ws_size);
        grid = cus;
    }
    if (grid < 0) return;
    if (hipMemsetAsync(d_ws, 0, 65536, stream) != hipSuccess) { fprintf(stderr, "kernel_launch: hipMemsetAsync failed\n"); return; }
    Args a{};
    for (int i = 0; i < 27; ++i) a.in[i] = (const float*)d_in[i];
    a.out = (float*)d_out; a.ws = (unsigned char*)d_ws; a.ph_lo = 0; a.ph_hi = NPHASES;
    void* args[] = {&a};
    hipError_t e = hipLaunchCooperativeKernel((const void*)fwd, dim3(grid), dim3(NTHREADS), args, LDS_BYTES, stream);
    if (e != hipSuccess) fprintf(stderr, "cooperative launch failed: %s (grid %d)\n", hipGetErrorString(e), grid);
}
```

```cpp
#include <hip/hip_runtime.h>
#include <hip/hip_cooperative_groups.h>
#include <cstdio>
#include <cstdint>
#ifndef FASTMASK
#define FASTMASK 0xFFFFFFFFu
#endif
#define FAST(p) ((FASTMASK >> (p)) & 1u)
namespace cg = cooperative_groups;

typedef unsigned short bf16_t;
constexpr int NTHREADS = 512;
constexpr int LDS_BYTES = 163840;
constexpr size_t MiB = 1u << 20;

constexpr int NB = 16, T = 2048, D = 1024, M = NB * T;
constexpr int DRNN = 1344, BW = 336, QW = 1024, KVW = 256, NH = 16, HD = 64, NG = 4;
constexpr int DIN = 7344, DFF = 4096, NC = 127, NSB = 32, CROWS = NB * NG * NC;
constexpr int C_URNN = 0, C_UGATE = 1344, C_Q = 2688, C_KV = 3712, C_GN = 5248, C_GA = 5296, C_GB = 6320;
constexpr float EPS = 1e-6f, LOG2E = 1.4426950408889634f;
constexpr int YA_LD = 1408, XC_LD = 384;

constexpr size_t WS_RSTD = 1 * MiB, WS_RSTD2 = 1 * MiB + 512 * 1024, WS_KCC = 2 * MiB, WS_VCC = 4 * MiB, WS_SEL = 6 * MiB;
constexpr size_t WS_URNN = 52 * MiB, WS_UGATE = 136 * MiB, WS_Q = 220 * MiB, WS_KV = 284 * MiB  , WS_GN = 380 * MiB, WS_GA = 384 * MiB, WS_GB = 448 * MiB, WS_END = 512 * MiB;
constexpr size_t WS_PES = 1 * MiB + 448 * 1024  , WS_NORMS = 1 * MiB + 384 * 1024, WS_LAMC = 1 * MiB + 256 * 1024, WS_SSQ = 6 * MiB + 512 * 1024  ;
constexpr size_t WS_WIN = 9 * MiB  , WS_WG = 24 * MiB  , WS_W1 = 27 * MiB  , WS_PA = 29 * MiB  , WS_PB = 32 * MiB, WS_WO = 34 * MiB, WS_WMI = 36 * MiB  , WS_WMO = 44 * MiB  ;
constexpr size_t DO_KCB = 104 * MiB  , DO_VCT = 105 * MiB  ;
constexpr size_t DO_VST = 72 * MiB, DO_VWT = 88 * MiB;
constexpr size_t DO_CAR = 112 * MiB, DO_CBR = 120 * MiB;
constexpr size_t DO_XB = 0;
constexpr size_t WS_LA = WS_URNN, WS_UP = WS_KV, WS_T1 = WS_URNN, WS_MERGED = WS_UGATE, WS_HB = WS_GA, WS_ZACT = 52 * MiB;
constexpr size_t DO_FLATK = 64 * MiB, DO_FLATV = 96 * MiB, DO_HIDK = 0, DO_HIDV = 4 * MiB, DO_XC = 0, DO_YA = 0;

__device__ __constant__ unsigned char BUCKET[128] = {0, 1, 2, 3, 4, 5, 6, 7, 8, 9, 10, 11, 12, 13, 14, 15, 16, 16, 16, 17, 17, 18, 18, 18, 19, 19, 19, 20, 20, 20, 20, 21, 21, 21, 21, 22, 22, 22, 22, 22, 23, 23, 23, 23, 23, 23, 24, 24, 24, 24, 24, 24, 25, 25, 25, 25, 25, 25, 25, 26, 26, 26, 26, 26, 26, 26, 26, 27, 27, 27, 27, 27, 27, 27, 27, 27, 27, 28, 28, 28, 28, 28, 28, 28, 28, 28, 28, 29, 29, 29, 29, 29, 29, 29, 29, 29, 29, 29, 29, 30, 30, 30, 30, 30, 30, 30, 30, 30, 30, 30, 30, 30, 30, 31, 31, 31, 31, 31, 31, 31, 31, 31, 31, 31, 31, 31, 31, 31};

__device__ __forceinline__ float bf2f(bf16_t v) { return __uint_as_float((unsigned)v << 16); }
__device__ __forceinline__ bf16_t f2bf(float f) { unsigned u = __float_as_uint(f); return (bf16_t)((u + 0x7fffu + ((u >> 16) & 1u)) >> 16); }
__device__ __forceinline__ float sigmoidf_(float x) { return 1.f / (1.f + __expf(-x)); }
__device__ __forceinline__ float gelu_tanh(float x) { const float u = 0.7978845608028654f * (x + 0.044715f * x * x * x); return 0.5f * x * (1.f + tanhf(u)); }
__device__ __forceinline__ float wave_sum(float v) {
#pragma unroll
    for (int o = 1; o < 64; o <<= 1) v += __shfl_xor(v, o);
    return v;
}

struct Args { const float* in[27]; float* out; unsigned char* ws; int ph_lo, ph_hi; };

template <class AL, class BL, class EP>
__device__ __forceinline__ void ngemm(float* lds, int Mm, int Nn, int Kk, const AL& A, const BL& Bf, const EP& E) {
    float* As = lds;
    float* Bs = lds + 16 * 132;
    const int tid = threadIdx.x, tx = tid & 31, ty = tid >> 5;
    const int tm = (Mm + 127) / 128, tn = (Nn + 127) / 128, ntiles = tm * tn;
    for (int tile = blockIdx.x; tile < ntiles; tile += gridDim.x) {
        const int m0 = (tile / tn) * 128, n0 = (tile % tn) * 128;
        float acc[8][4];
#pragma unroll
        for (int i = 0; i < 8; ++i)
#pragma unroll
            for (int j = 0; j < 4; ++j) acc[i][j] = 0.f;
        for (int k0 = 0; k0 < Kk; k0 += 16) {
            {
                const int m = m0 + (tid >> 2), kb = k0 + (tid & 3) * 4;
#pragma unroll
                for (int i = 0; i < 4; ++i) As[((tid & 3) * 4 + i) * 132 + (tid >> 2)] = (m < Mm && kb + i < Kk) ? A(m, kb + i) : 0.f;
                const int k = k0 + (tid >> 5), nb = n0 + (tid & 31) * 4;
#pragma unroll
                for (int i = 0; i < 4; ++i) Bs[(tid >> 5) * 132 + (tid & 31) * 4 + i] = (k < Kk && nb + i < Nn) ? Bf(k, nb + i) : 0.f;
            }
            __syncthreads();
#pragma unroll 2
            for (int kk = 0; kk < 16; ++kk) {
                float a[8], b[4];
#pragma unroll
                for (int i = 0; i < 8; ++i) a[i] = As[kk * 132 + ty * 8 + i];
#pragma unroll
                for (int j = 0; j < 4; ++j) b[j] = Bs[kk * 132 + tx * 4 + j];
#pragma unroll
                for (int i = 0; i < 8; ++i)
#pragma unroll
                    for (int j = 0; j < 4; ++j) acc[i][j] += a[i] * b[j];
            }
            __syncthreads();
        }
#pragma unroll
        for (int i = 0; i < 8; ++i)
#pragma unroll
            for (int j = 0; j < 4; ++j) { const int m = m0 + ty * 8 + i, n = n0 + tx * 4 + j; if (m < Mm && n < Nn) E(m, n, acc[i][j]); }
    }
}

struct ALbf { const bf16_t* p; int ld; __device__ __forceinline__ float operator()(int m, int k) const { return bf2f(p[(size_t)m * ld + k]); } };
struct ALbfScale { const bf16_t* p; int ld; const float* g; __device__ __forceinline__ float operator()(int m, int k) const { return bf2f(p[(size_t)m * ld + k]) * g[k]; } };
struct ALf32Scale { const float* p; int ld; const float* g; __device__ __forceinline__ float operator()(int m, int k) const { return p[(size_t)m * ld + k] * g[k]; } };
struct BLf32 { const float* p; int ld; __device__ __forceinline__ float operator()(int k, int n) const { return p[(size_t)k * ld + n]; } };
struct BLgate { const float* wa; const float* wx; __device__ __forceinline__ float operator()(int k, int n) const { return n < BW ? wa[k * BW + n] : wx[k * BW + n - BW]; } };

struct Ep1 {
    const float* rstd; bf16_t *urnn, *ugate, *q, *kv, *gn, *ga, *gb;
    __device__ __forceinline__ void operator()(int m, int n, float v) const {
        v *= rstd[m];
        if (n < C_UGATE) urnn[(size_t)m * DRNN + n] = f2bf(v);
        else if (n < C_Q) ugate[(size_t)m * DRNN + n - C_UGATE] = f2bf(gelu_tanh(v));
        else if (n < C_KV) q[(size_t)m * QW + n - C_Q] = f2bf(v);
        else if (n < C_GN) { const int c = n - C_KV; kv[(size_t)(c >> 8) * ((size_t)M * KVW) + (size_t)m * KVW + (c & 255)] = f2bf(v); }
        else if (n < C_GA) gn[(size_t)m * 48 + n - C_GN] = f2bf(sigmoidf_(v));
        else if (n < C_GB) ga[(size_t)m * D + n - C_GA] = f2bf(sigmoidf_(v));
        else gb[(size_t)m * D + n - C_GB] = f2bf(sigmoidf_(v));
    }
};
struct EpGelu { bf16_t* o; int ld; __device__ __forceinline__ void operator()(int m, int n, float v) const { o[(size_t)m * ld + n] = f2bf(gelu_tanh(v)); } };
struct EpGate {
    int nb; const float *ba, *bx, *lam; const bf16_t* xc; bf16_t *la, *up;
    __device__ __forceinline__ void operator()(int m, int n, float v) const {
        if (n < BW) { const int c = nb * BW + n; const float r = sigmoidf_(v + ba[c]); const float sp = log1pf(__expf(-lam[c])); la[(size_t)m * DRNN + c] = f2bf(-8.f * r * sp * LOG2E); }
        else { const int j = n - BW, c = nb * BW + j; const float i = sigmoidf_(v + bx[c]); up[(size_t)m * DRNN + c] = f2bf(i * bf2f(xc[(size_t)m * XC_LD + j])); }
    }
};
struct EpT1 { const bf16_t* g; bf16_t* o; __device__ __forceinline__ void operator()(int m, int n, float v) const { o[(size_t)m * D + n] = f2bf(bf2f(g[(size_t)m * D + n]) * v); } };
struct EpMerged { const bf16_t* g; const bf16_t* t1; bf16_t* o; __device__ __forceinline__ void operator()(int m, int n, float v) const { o[(size_t)m * D + n] = f2bf(bf2f(t1[(size_t)m * D + n]) + bf2f(g[(size_t)m * D + n]) * v); } };
struct EpH { const float* x; float* h; bf16_t* hb; __device__ __forceinline__ void operator()(int m, int n, float v) const { const float r = x[(size_t)m * D + n] + v; h[(size_t)m * D + n] = r; hb[(size_t)m * D + n] = f2bf(r); } };
struct EpZ { const float* ssq; bf16_t* z; __device__ __forceinline__ void operator()(int m, int n, float v) const { float s_ = 0.f; for (int i = 0; i < 16; ++i) s_ += ssq[(size_t)m * 16 + i]; v *= rsqrtf(s_ * (1.f / D) + EPS); v = v > 0.f ? v * v : 0.f; z[(size_t)m * DFF + n] = f2bf(v); } };
struct EpOut { float* o; __device__ __forceinline__ void operator()(int m, int n, float v) const { o[(size_t)m * D + n] += v; } };

namespace pg8 {
#define PG8_LAS __attribute__((address_space(3)))
typedef unsigned short bf16_t;
typedef short bf16x8 __attribute__((ext_vector_type(8)));
typedef float f32x4 __attribute__((ext_vector_type(4)));
typedef unsigned u32x4 __attribute__((ext_vector_type(4)));
constexpr int BM = 256, BK = 64, HALF = 128, HTB = HALF * BK * 2  , STAGE_BYTES = 8 * HTB, NXCD = 8, WGM = 4;

__host__ __device__ __forceinline__ int lds_byte(int r, int c) { const int st = (r >> 4) * 2 + (c >> 5), rr = r & 15, cc = c & 31, ob = rr * 64 + cc * 2; return st * 1024 + (ob ^ (((ob >> 9) & 1) << 5)); }
__host__ __device__ __forceinline__ void stage_rc(int b, int& R, int& C) { const int st = b / 1024, sb = b % 1024, swz = sb ^ (((sb >> 9) & 1) << 5); R = (st >> 1) * 16 + swz / 64; C = (st & 1) * 32 + (swz % 64) / 2; }
__host__ __device__ __forceinline__ int perm32(int rho) { const int n = rho >> 4, i = rho & 15; return 8 * (i >> 2) + 4 * n + (i & 3); }

struct Unit { int pm, pn, ord; };
struct Gemm { const bf16_t* A; const bf16_t* Bt; int M, N, K; };

struct StaticOrder {
    int nM, nN, nwg, G, c;
    __host__ __device__ void init(int M, int N, int G_, int c_) { nM = M / BM; nN = N / BM; nwg = nM * nN; G = G_; c = c_; }
    __host__ __device__ __forceinline__ bool next(int i, Unit& u) const {
        const long L = (long)i * G + c; if (L >= nwg) return false;
        int wgid = (int)L; { const int q = nwg / NXCD, r = nwg % NXCD, xcd = wgid % NXCD, off = wgid / NXCD; wgid = (xcd < r ? xcd * (q + 1) : r * (q + 1) + (xcd - r) * q) + off; }
        const int nig = WGM * nN, gid = wgid / nig, fm = gid * WGM, gsz = (nM - fm) < WGM ? (nM - fm) : WGM;
        u.pm = fm + ((wgid % nig) % gsz); u.pn = (wgid % nig) / gsz; u.ord = i; return true;
    }
    __device__ __forceinline__ void a_ready(const Unit&) const {}
    __device__ __forceinline__ void done(const Unit&) const {}
};

__device__ __forceinline__ unsigned cvt_pk_bf16(float lo, float hi) { unsigned r; asm volatile("v_cvt_pk_bf16_f32 %0, %1, %2" : "=v"(r) : "v"(lo), "v"(hi)); return r; }
typedef float f32x2 __attribute__((ext_vector_type(2)));
template <class Epi, class Sched, bool ALIGN_EPI = false, bool SP2 = false>
__device__ __forceinline__ void gemm_phase(PG8_LAS unsigned char* lds, const Gemm g, const Sched& S, const Epi& E) {
    const int tid = threadIdx.x, wid = __builtin_amdgcn_readfirstlane(tid >> 6), lane = tid & 63, wr = wid >> 2, wc = wid & 3, fr = lane & 15, fq = lane >> 4;
    const int K = g.K, nt = K / BK;
    unsigned voffA[2], voffB[2];
#pragma unroll
    for (int i = 0; i < 2; ++i) { int R, C; stage_rc(tid * 16 + i * 8192, R, C); const int Rb = Epi::PERM ? ((R & ~31) + perm32(R & 31)) : R;
        voffA[i] = (unsigned)(R * K + C) * 2u; voffB[i] = (unsigned)(Rb * K + C) * 2u; }
    const size_t kstep = (size_t)(BK * 2);
    const size_t hstep = (size_t)HALF * K * 2;
    const size_t tstep = 2 * hstep;
    const unsigned ldsw = (unsigned)wid * 1024u;
    const int aoff = lds_byte(wr * 64 + fr, fq * 8), boff = lds_byte(wc * 32 + fr, fq * 8);
#define PG8_SA(b, h) (((b) * 2 + (h)) * HTB)
#define PG8_SB(b, h) ((4 + (b) * 2 + (h)) * HTB)
#define PG8_STAGE(bufoff, gbase, voff) do { _Pragma("unroll") for (int _i = 0; _i < 2; ++_i) \
        __builtin_amdgcn_global_load_lds((const unsigned*)((const char*)(gbase) + (voff)[_i]), (PG8_LAS unsigned*)(lds + (bufoff) + ldsw + _i * 8192), 16, 0, 0); } while (0)
#define PG8_LDA(dst, b, h) do { _Pragma("unroll") for (int m = 0; m < 4; ++m) _Pragma("unroll") for (int k = 0; k < 2; ++k) dst[m][k] = *(const PG8_LAS bf16x8*)(lds + PG8_SA(b, h) + aoff + m * 2048 + k * 1024); } while (0)
#define PG8_LDB(dst, b, h) do { _Pragma("unroll") for (int n = 0; n < 2; ++n) _Pragma("unroll") for (int k = 0; k < 2; ++k) dst[n][k] = *(const PG8_LAS bf16x8*)(lds + PG8_SB(b, h) + boff + n * 2048 + k * 1024); } while (0)
#define PG8_MMA(ai, bj, At, Bt) do { __builtin_amdgcn_s_setprio(1); _Pragma("unroll") for (int m = 0; m < 4; ++m) _Pragma("unroll") for (int n = 0; n < 2; ++n) _Pragma("unroll") for (int k = 0; k < 2; ++k) \
        acc[ai][bj][m][n] = __builtin_amdgcn_mfma_f32_16x16x32_bf16(Bt[n][k], At[m][k], acc[ai][bj][m][n], 0, 0, 0); __builtin_amdgcn_s_setprio(0); } while (0)
#define PG8_WAIT_V(n) asm volatile("s_waitcnt vmcnt(" #n ")" ::: "memory")
#define PG8_WAIT_L(n) asm volatile("s_waitcnt lgkmcnt(" #n ")" ::: "memory")
#define PG8_BAR __builtin_amdgcn_s_barrier()
#define PG8_SCHED __builtin_amdgcn_sched_barrier(0)
    Unit cur, nxt; int ui = 0;
    if (!S.next(0, cur)) return;
    f32x4 acc[2][2][4][2];
#pragma unroll
    for (int a = 0; a < 2; ++a)
#pragma unroll
        for (int b = 0; b < 2; ++b)
#pragma unroll
            for (int m = 0; m < 4; ++m)
#pragma unroll
                for (int n = 0; n < 2; ++n) acc[a][b][m][n] = (f32x4){0.f, 0.f, 0.f, 0.f};
    bf16x8 At[4][2], B0[2][2], B1[2][2];
    const char* cA = (const char*)g.A + (size_t)cur.pm * tstep; const char* cB = (const char*)g.Bt + (size_t)cur.pn * tstep;
    S.a_ready(cur);
    if constexpr (SP2) {
        PG8_STAGE(PG8_SB(0, 0), cB, voffB); PG8_STAGE(PG8_SB(0, 1), cB + hstep, voffB); PG8_STAGE(PG8_SA(0, 0), cA, voffA); PG8_STAGE(PG8_SA(0, 1), cA + hstep, voffA);
        if (wr == 1) PG8_BAR;
        PG8_WAIT_V(2); PG8_BAR;
        PG8_STAGE(PG8_SB(1, 0), cB + kstep, voffB); PG8_STAGE(PG8_SA(1, 0), cA + kstep, voffA); PG8_STAGE(PG8_SB(1, 1), cB + hstep + kstep, voffB);
        PG8_WAIT_V(6); PG8_BAR;
    } else {
        PG8_STAGE(PG8_SB(0, 0), cB, voffB); PG8_STAGE(PG8_SA(0, 0), cA, voffA); PG8_STAGE(PG8_SB(0, 1), cB + hstep, voffB); PG8_STAGE(PG8_SA(0, 1), cA + hstep, voffA);
        if (wr == 1) PG8_BAR;
        PG8_WAIT_V(4); PG8_BAR;
        PG8_STAGE(PG8_SB(1, 0), cB + kstep, voffB); PG8_STAGE(PG8_SA(1, 0), cA + kstep, voffA); PG8_STAGE(PG8_SB(1, 1), cB + hstep + kstep, voffB);
        PG8_WAIT_V(6); PG8_BAR;
    }
    for (;;) {
        const bool has_next = S.next(ui + 1, nxt);
        const char* nA = has_next ? (const char*)g.A + (size_t)nxt.pm * tstep : cA; const char* nB = has_next ? (const char*)g.Bt + (size_t)nxt.pn * tstep : cB;
        for (int t = 0; t < nt; t += 2) {
            const bool last = (t == nt - 2);
            const char* a1 = cA + (size_t)(t + 1) * kstep;
            const char* a2 = last ? nA : cA + (size_t)(t + 2) * kstep; const char* b2 = last ? nB : cB + (size_t)(t + 2) * kstep;
            const char* a3 = a2 + kstep; const char* b3 = b2 + kstep;
            if (last && has_next) S.a_ready(nxt);
            if constexpr (SP2) {
            PG8_LDB(B0, 0, 0); PG8_LDB(B1, 0, 1); PG8_SCHED; PG8_LDA(At, 0, 0); PG8_STAGE(PG8_SA(1, 1), a1 + hstep, voffA);
            PG8_WAIT_V(8); PG8_WAIT_L(0); PG8_BAR; PG8_MMA(0, 0, At, B0); PG8_MMA(0, 1, At, B1); PG8_BAR; PG8_SCHED;
            PG8_LDA(At, 0, 1); PG8_STAGE(PG8_SB(0, 0), b2, voffB); PG8_STAGE(PG8_SB(0, 1), b2 + hstep, voffB); PG8_STAGE(PG8_SA(0, 0), a2, voffA);
            PG8_WAIT_V(8); PG8_WAIT_L(0); PG8_BAR; PG8_MMA(1, 0, At, B0); PG8_MMA(1, 1, At, B1); PG8_BAR; PG8_SCHED;
            PG8_LDB(B0, 1, 0); PG8_LDB(B1, 1, 1); PG8_SCHED; PG8_LDA(At, 1, 0); PG8_STAGE(PG8_SA(0, 1), a2 + hstep, voffA);
            PG8_WAIT_V(8); PG8_WAIT_L(0); PG8_BAR; PG8_MMA(0, 0, At, B0); PG8_MMA(0, 1, At, B1); PG8_BAR; PG8_SCHED;
            PG8_LDA(At, 1, 1); PG8_STAGE(PG8_SB(1, 0), b3, voffB); PG8_STAGE(PG8_SB(1, 1), b3 + hstep, voffB); PG8_STAGE(PG8_SA(1, 0), a3, voffA);
            PG8_WAIT_V(8); PG8_WAIT_L(0); PG8_BAR; PG8_MMA(1, 0, At, B0); PG8_MMA(1, 1, At, B1); PG8_BAR; PG8_SCHED;
            } else {
            PG8_LDB(B0, 0, 0); PG8_SCHED; PG8_LDA(At, 0, 0); PG8_STAGE(PG8_SA(1, 1), a1 + hstep, voffA);
            PG8_WAIT_L(8); PG8_BAR; PG8_WAIT_L(0); PG8_MMA(0, 0, At, B0); PG8_BAR; PG8_SCHED;
            PG8_LDB(B1, 0, 1); PG8_STAGE(PG8_SB(0, 0), b2, voffB);
            PG8_BAR; PG8_WAIT_L(0); PG8_MMA(0, 1, At, B1); PG8_BAR;
            PG8_LDA(At, 0, 1); PG8_STAGE(PG8_SA(0, 0), a2, voffA);
            PG8_BAR; PG8_WAIT_L(0); PG8_MMA(1, 0, At, B0); PG8_BAR; PG8_SCHED;
            PG8_STAGE(PG8_SB(0, 1), b2 + hstep, voffB);
            PG8_WAIT_V(6); PG8_BAR; PG8_MMA(1, 1, At, B1); PG8_BAR;
            PG8_LDB(B0, 1, 0); PG8_SCHED; PG8_LDA(At, 1, 0); PG8_STAGE(PG8_SA(0, 1), a2 + hstep, voffA);
            PG8_WAIT_L(8); PG8_BAR; PG8_WAIT_L(0); PG8_MMA(0, 0, At, B0); PG8_BAR; PG8_SCHED;
            PG8_LDB(B1, 1, 1); PG8_STAGE(PG8_SB(1, 0), b3, voffB);
            PG8_BAR; PG8_WAIT_L(0); PG8_MMA(0, 1, At, B1); PG8_BAR;
            PG8_LDA(At, 1, 1); PG8_STAGE(PG8_SA(1, 0), a3, voffA);
            PG8_BAR; PG8_WAIT_L(0); PG8_MMA(1, 0, At, B0); PG8_BAR; PG8_SCHED;
            PG8_STAGE(PG8_SB(1, 1), b3 + hstep, voffB);
            PG8_WAIT_V(6); PG8_BAR; PG8_MMA(1, 1, At, B1); PG8_BAR;
            }
        }
        if constexpr (ALIGN_EPI) { if (wr == 0) PG8_BAR; }
        if constexpr (!Epi::AFTER_DRAIN) { E(acc, cur, wr, wc, fr, fq); S.done(cur); }
        if (!has_next) break;
#pragma unroll
        for (int a = 0; a < 2; ++a)
#pragma unroll
            for (int b = 0; b < 2; ++b)
#pragma unroll
                for (int m = 0; m < 4; ++m)
#pragma unroll
                    for (int n = 0; n < 2; ++n) acc[a][b][m][n] = (f32x4){0.f, 0.f, 0.f, 0.f};
        cur = nxt; cA = nA; cB = nB; ++ui;
        if constexpr (ALIGN_EPI) { if (wr == 1) PG8_BAR; }
    }
    PG8_WAIT_V(0);
    if constexpr (!ALIGN_EPI) { if (wr == 0) PG8_BAR; }
    PG8_BAR;
    if constexpr (Epi::AFTER_DRAIN) { E.fused(acc, cur, wr, wc, fr, fq, lds, wid, lane); S.done(cur); }
#undef PG8_SA
#undef PG8_SB
#undef PG8_STAGE
#undef PG8_LDA
#undef PG8_LDB
#undef PG8_MMA
#undef PG8_WAIT_V
#undef PG8_WAIT_L
#undef PG8_BAR
#undef PG8_SCHED
}
}

namespace pg8 {
__device__ __forceinline__ float sigm(float x) { return __builtin_amdgcn_rcpf(1.f + __expf(-x)); }
__device__ __forceinline__ float gelu_t(float x) { const float u = 1.5957691216057308f * (x + 0.044715f * x * x * x); return x * __builtin_amdgcn_rcpf(1.f + __expf(-u)); }
__device__ __forceinline__ u32x4 pack8(const f32x4& a, const f32x4& b) { u32x4 w; w.x = cvt_pk_bf16(a[0], a[1]); w.y = cvt_pk_bf16(a[2], a[3]); w.z = cvt_pk_bf16(b[0], b[1]); w.w = cvt_pk_bf16(b[2], b[3]); return w; }
__device__ __forceinline__ void unpack8(const u32x4& w, f32x4& a, f32x4& b) {
    a[0] = __uint_as_float(w.x << 16); a[1] = __uint_as_float(w.x & 0xffff0000u); a[2] = __uint_as_float(w.y << 16); a[3] = __uint_as_float(w.y & 0xffff0000u);
    b[0] = __uint_as_float(w.z << 16); b[1] = __uint_as_float(w.z & 0xffff0000u); b[2] = __uint_as_float(w.w << 16); b[3] = __uint_as_float(w.w & 0xffff0000u); }

__host__ __device__ __forceinline__ int wide_src(int ch) { return (ch & ~7) | (2 * (ch & 3) + ((ch >> 2) & 1)); }
__device__ __forceinline__ u32x4 ror8(const u32x4& v) { u32x4 r;
    r.x = (unsigned)__builtin_amdgcn_mov_dpp((int)v.x, 0x128, 0xf, 0xf, true); r.y = (unsigned)__builtin_amdgcn_mov_dpp((int)v.y, 0x128, 0xf, 0xf, true);
    r.z = (unsigned)__builtin_amdgcn_mov_dpp((int)v.z, 0x128, 0xf, 0xf, true); r.w = (unsigned)__builtin_amdgcn_mov_dpp((int)v.w, 0x128, 0xf, 0xf, true); return r; }
__device__ __forceinline__ u32x4 sel4(bool c, const u32x4& a, const u32x4& b) { u32x4 r; r.x = c ? a.x : b.x; r.y = c ? a.y : b.y; r.z = c ? a.z : b.z; r.w = c ? a.w : b.w; return r; }
__device__ __forceinline__ void wide_store(bf16_t* p, size_t ld8, bool lo, const u32x4& w0, const u32x4& w1) {
    const u32x4 rcv = ror8(sel4(lo, w1, w0));
    *(u32x4*)p = sel4(lo, w0, rcv); *(u32x4*)(p + ld8) = sel4(lo, rcv, w1); }

struct Ep1F {
    static constexpr bool PERM = true, AFTER_DRAIN = false;
    bf16_t *urnn, *ugate, *q, *kv, *gn, *ga; const PG8_LAS float* norms; bf16_t* flat; const PG8_LAS float* pes;
    __device__ __forceinline__ void operator()(const f32x4 (&acc)[2][2][4][2], const Unit& u, int wr, int wc, int fr, int fq) const {
        const int row0 = u.pm * BM + wr * 64 + fr, pn = u.pn;
        if (pn == 4 || pn == 5) {
            const PG8_LAS float* pe = pes + (pn - 4) * 2048; bf16_t* fl = flat + (size_t)(pn - 4) * 8192 * 2048;
#pragma unroll
            for (int ai = 0; ai < 2; ++ai)
#pragma unroll
                for (int m = 0; m < 4; ++m) { const int mt = row0 + ai * HALF + m * 16, b = mt >> 11, t = mt & (T - 1), c1 = t >> 4, l1 = t & 15; const size_t rb = (size_t)((b * 4 + wc) * NC + c1) * 2048;
#pragma unroll
                    for (int bj = 0; bj < 2; ++bj) { const int d0 = 32 * bj + 8 * fq; const f32x4 v0 = acc[ai][bj][m][0], v1 = acc[ai][bj][m][1];
                        if (c1 < NC) { const PG8_LAS float* p = pe + l1 * 64 + d0; *(u32x4*)(fl + rb + l1 * 64 + d0) = pack8(v0 + *(const PG8_LAS f32x4*)p, v1 + *(const PG8_LAS f32x4*)(p + 4)); }
                        if (c1 > 0) { const PG8_LAS float* p = pe + (l1 + 16) * 64 + d0; *(u32x4*)(fl + rb - 2048 + (l1 + 16) * 64 + d0) = pack8(v0 + *(const PG8_LAS f32x4*)p, v1 + *(const PG8_LAS f32x4*)(p + 4)); } } }
            return;
        }
        if (pn < 10) {
            const bool donorm = pn < 4 || pn == 6 || pn == 8; const PG8_LAS float* g = norms + (pn < 4 ? 0 : (pn == 6 ? 64 : 128)); const float sc = pn < 4 ? 0.125f * LOG2E : 1.f;
            bf16_t* base; int ld;
            if (pn < 4) { base = q + 256 * pn + 64 * wc + 8 * fq; ld = QW; } else { base = kv + (size_t)(pn - 4) * ((size_t)M * KVW) + 64 * wc + 8 * fq; ld = KVW; }
            f32x4 gv[2][2];
#pragma unroll
            for (int bj = 0; bj < 2; ++bj)
#pragma unroll
                for (int n = 0; n < 2; ++n) gv[bj][n] = donorm ? *(const PG8_LAS f32x4*)(g + 32 * bj + 8 * fq + 4 * n) : (f32x4){1.f, 1.f, 1.f, 1.f};
#pragma unroll
            for (int ai = 0; ai < 2; ++ai)
#pragma unroll
                for (int m = 0; m < 4; ++m) {
                    float ss = 0.f;
#pragma unroll
                    for (int bj = 0; bj < 2; ++bj)
#pragma unroll
                        for (int n = 0; n < 2; ++n) { const f32x4 v = acc[ai][bj][m][n]; ss += (v[0] * v[0] + v[1] * v[1]) + (v[2] * v[2] + v[3] * v[3]); }
                    ss += __shfl_xor(ss, 16); ss += __shfl_xor(ss, 32);
                    const float r = donorm ? rsqrtf(ss * (1.f / 64.f) + EPS) * sc : 1.f;
                    bf16_t* rowp = base + (size_t)(row0 + ai * HALF + m * 16) * ld;
#pragma unroll
                    for (int bj = 0; bj < 2; ++bj) *(u32x4*)(rowp + 32 * bj) = pack8(acc[ai][bj][m][0] * r * gv[bj][0], acc[ai][bj][m][1] * r * gv[bj][1]);
                }
        } else if (pn < 18) {
            bf16_t* base = ga + (pn < 14 ? (size_t)0 : (size_t)M * D) + 256 * ((pn - 10) & 3) + 32 * wc + 8 * fq;
#pragma unroll
            for (int ai = 0; ai < 2; ++ai)
#pragma unroll
                for (int m = 0; m < 4; ++m) { bf16_t* rowp = base + (size_t)(row0 + ai * HALF + m * 16) * D;
#pragma unroll
                    for (int bj = 0; bj < 2; ++bj) { f32x4 v0 = acc[ai][bj][m][0], v1 = acc[ai][bj][m][1];
#pragma unroll
                        for (int e = 0; e < 4; ++e) { v0[e] = sigm(v0[e]); v1[e] = sigm(v1[e]); }
                        *(u32x4*)(rowp + bj * HALF) = pack8(v0, v1); } }
        } else { seg3<0>(acc, pn, row0, wc, fq); seg3<1>(acc, pn, row0, wc, fq); }
    }
    template <int BJ> __device__ __forceinline__ void seg3(const f32x4 (&acc)[2][2][4][2], int pn, int row0, int wc, int fq) const {
        const int c = 256 * (pn - 18) + 128 * BJ + 32 * wc;
        if (c < 1344) { bf16_t* base = urnn + c + 8 * fq;
#pragma unroll
            for (int ai = 0; ai < 2; ++ai)
#pragma unroll
                for (int m = 0; m < 4; ++m) *(u32x4*)(base + (size_t)(row0 + ai * HALF + m * 16) * DRNN) = pack8(acc[ai][BJ][m][0], acc[ai][BJ][m][1]);
        } else if (c < 2688) { bf16_t* base = ugate + (c - 1344) + 8 * fq;
#pragma unroll
            for (int ai = 0; ai < 2; ++ai)
#pragma unroll
                for (int m = 0; m < 4; ++m) { f32x4 v0 = acc[ai][BJ][m][0], v1 = acc[ai][BJ][m][1];
#pragma unroll
                    for (int e = 0; e < 4; ++e) { v0[e] = gelu_t(v0[e]); v1[e] = gelu_t(v1[e]); }
                    *(u32x4*)(base + (size_t)(row0 + ai * HALF + m * 16) * DRNN) = pack8(v0, v1); }
        } else if (c + 8 * fq < 2736) { bf16_t* base = gn + (c - 2688) + 8 * fq;
#pragma unroll
            for (int ai = 0; ai < 2; ++ai)
#pragma unroll
                for (int m = 0; m < 4; ++m) { f32x4 v0 = acc[ai][BJ][m][0], v1 = acc[ai][BJ][m][1];
#pragma unroll
                    for (int e = 0; e < 4; ++e) { v0[e] = sigm(v0[e]); v1[e] = sigm(v1[e]); }
                    *(u32x4*)(base + (size_t)(row0 + ai * HALF + m * 16) * 48) = pack8(v0, v1); }
        }
    }
};
__device__ __forceinline__ void win_src(int ch, int& c0, int& cvalid) {
    const int tile = ch >> 3, l0 = (ch & 7) * 32, bj = l0 >> 7, wc = (l0 >> 5) & 3; cvalid = 32;
    if (tile < 4) c0 = C_Q + 256 * tile + 64 * wc + 32 * bj;
    else if (tile < 10) c0 = C_KV + 256 * (tile - 4) + 64 * wc + 32 * bj;
    else if (tile < 14) c0 = C_GA + 256 * (tile - 10) + l0;
    else if (tile < 18) c0 = C_GB + 256 * (tile - 14) + l0;
    else { const int c = 256 * (tile - 18) + l0; if (c < 2688) c0 = c; else if (c < 2736) { c0 = C_GN + c - 2688; cvalid = 2736 - c < 32 ? 2736 - c : 32; } else { c0 = 0; cvalid = 0; } }
}
constexpr int N1PAD = 29 * 256;

struct EpGeluF {
    static constexpr bool PERM = true, AFTER_DRAIN = false;
    bf16_t* O; int ldc;
    __device__ __forceinline__ void operator()(const f32x4 (&acc)[2][2][4][2], const Unit& u, int wr, int wc, int fr, int fq) const {
        const int row0 = u.pm * BM + wr * 64 + fr; bf16_t* base = O + wc * 32 + 8 * fq;
#pragma unroll
        for (int ai = 0; ai < 2; ++ai)
#pragma unroll
            for (int m = 0; m < 4; ++m) { bf16_t* rowp = base + (size_t)(row0 + ai * HALF + m * 16) * ldc;
#pragma unroll
                for (int bj = 0; bj < 2; ++bj) { f32x4 v0 = acc[ai][bj][m][0], v1 = acc[ai][bj][m][1];
#pragma unroll
                    for (int e = 0; e < 4; ++e) { v0[e] = gelu_t(v0[e]); v1[e] = gelu_t(v1[e]); }
                    *(u32x4*)(rowp + bj * HALF) = pack8(v0, v1); } }
    }
};
struct OrderC1 {
    int G, c;
    __device__ __forceinline__ bool next(int i, Unit& u) const { const int L = i * G + c; if (L >= 64) return false; u.pm = L; u.pn = L >> 5; u.ord = i; return true; }
    __device__ __forceinline__ void a_ready(const Unit&) const {}
    __device__ __forceinline__ void done(const Unit&) const {}
};
struct OrderGate {
    int G, c;
    __device__ __forceinline__ bool next(int i, Unit& u) const { const int L = i * G + c; if (L >= 4 * 128 * 3) return false; const int nb = L / 384, r = L % 384; u.pm = nb * 128 + r / 3; u.pn = nb * 3 + r % 3; u.ord = i; return true; }
    __device__ __forceinline__ void a_ready(const Unit&) const {}
    __device__ __forceinline__ void done(const Unit&) const {}
};
struct EpGateF {
    static constexpr bool PERM = true, AFTER_DRAIN = false;
    const float *ba, *bx, *lamc; const bf16_t* xc; bf16_t *la, *up;
    __device__ __forceinline__ void operator()(const f32x4 (&acc)[2][2][4][2], const Unit& u, int wr, int wc, int fr, int fq) const {
        const int nb = u.pn / 3, pn3 = u.pn % 3, ch0 = 128 * pn3 + 32 * wc + 8 * fq; if (ch0 >= BW) return;
        const int c0 = nb * BW + ch0, row0 = (u.pm & 127) * BM + wr * 64 + fr;
        const bf16_t* xcb = xc + (size_t)nb * ((size_t)M * XC_LD) + ch0; bf16_t* lab = la + c0; bf16_t* upb = up + c0;
        const f32x4 bav0 = *(const f32x4*)(ba + c0), bav1 = *(const f32x4*)(ba + c0 + 4), bxv0 = *(const f32x4*)(bx + c0), bxv1 = *(const f32x4*)(bx + c0 + 4), lcv0 = *(const f32x4*)(lamc + c0), lcv1 = *(const f32x4*)(lamc + c0 + 4);
        u32x4 xcv[2][4];
#pragma unroll
        for (int ai = 0; ai < 2; ++ai)
#pragma unroll
            for (int m = 0; m < 4; ++m) xcv[ai][m] = *(const u32x4*)(xcb + (unsigned)(row0 + ai * HALF + m * 16) * (unsigned)XC_LD);
#pragma unroll
        for (int ai = 0; ai < 2; ++ai)
#pragma unroll
            for (int m = 0; m < 4; ++m) { const unsigned row = (unsigned)(row0 + ai * HALF + m * 16);
                f32x4 x0, x1; unpack8(xcv[ai][m], x0, x1);
                f32x4 l0, l1, u0, u1;
#pragma unroll
                for (int e = 0; e < 4; ++e) {
                    l0[e] = sigm(acc[ai][0][m][0][e] + bav0[e]) * lcv0[e]; l1[e] = sigm(acc[ai][0][m][1][e] + bav1[e]) * lcv1[e];
                    u0[e] = sigm(acc[ai][1][m][0][e] + bxv0[e]) * x0[e];   u1[e] = sigm(acc[ai][1][m][1][e] + bxv1[e]) * x1[e]; }
                *(u32x4*)(lab + row * (unsigned)DRNN) = pack8(l0, l1); *(u32x4*)(upb + row * (unsigned)DRNN) = pack8(u0, u1);
                asm volatile("" ::: "memory"); }
    }
};
struct EpT1F {
    static constexpr bool PERM = true, AFTER_DRAIN = false;
    const bf16_t* g; bf16_t* o;
    __device__ __forceinline__ void operator()(const f32x4 (&acc)[2][2][4][2], const Unit& u, int wr, int wc, int fr, int fq) const {
        const int row0 = u.pm * BM + wr * 64 + fr, col0 = u.pn * BM + wc * 32 + 8 * fq;
        u32x4 gv[2][4][2];
#pragma unroll
        for (int ai = 0; ai < 2; ++ai)
#pragma unroll
            for (int m = 0; m < 4; ++m) { const size_t off = (size_t)(row0 + ai * HALF + m * 16) * D + col0;
#pragma unroll
                for (int bj = 0; bj < 2; ++bj) gv[ai][m][bj] = *(const u32x4*)(g + off + bj * HALF); }
#pragma unroll
        for (int ai = 0; ai < 2; ++ai)
#pragma unroll
            for (int m = 0; m < 4; ++m) { const size_t off = (size_t)(row0 + ai * HALF + m * 16) * D + col0;
#pragma unroll
                for (int bj = 0; bj < 2; ++bj) { f32x4 g0, g1; unpack8(gv[ai][m][bj], g0, g1);
                    *(u32x4*)(o + off + bj * HALF) = pack8(acc[ai][bj][m][0] * g0, acc[ai][bj][m][1] * g1); } }
    }
};
struct EpMergedF {
    static constexpr bool PERM = true, AFTER_DRAIN = false;
    const bf16_t* g; const bf16_t* t1; bf16_t* o;
    __device__ __forceinline__ void operator()(const f32x4 (&acc)[2][2][4][2], const Unit& u, int wr, int wc, int fr, int fq) const {
        const int row0 = u.pm * BM + wr * 64 + fr, col0 = u.pn * BM + wc * 32 + 8 * fq;
#pragma unroll
        for (int ai = 0; ai < 2; ++ai) {
            u32x4 gv[4][2], tv[4][2];
#pragma unroll
            for (int m = 0; m < 4; ++m) { const size_t off = (size_t)(row0 + ai * HALF + m * 16) * D + col0;
#pragma unroll
                for (int bj = 0; bj < 2; ++bj) { gv[m][bj] = *(const u32x4*)(g + off + bj * HALF); tv[m][bj] = *(const u32x4*)(t1 + off + bj * HALF); } }
#pragma unroll
            for (int m = 0; m < 4; ++m) { const size_t off = (size_t)(row0 + ai * HALF + m * 16) * D + col0;
#pragma unroll
                for (int bj = 0; bj < 2; ++bj) { f32x4 g0, g1, t0, t1v; unpack8(gv[m][bj], g0, g1); unpack8(tv[m][bj], t0, t1v);
                    *(u32x4*)(o + off + bj * HALF) = pack8(t0 + acc[ai][bj][m][0] * g0, t1v + acc[ai][bj][m][1] * g1); } }
            asm volatile("" ::: "memory");
        }
    }
};
struct EpHF {
    static constexpr bool PERM = true, AFTER_DRAIN = false;
    const float* x; float* h; bf16_t* hb; float* ssq;
    __device__ __forceinline__ void operator()(const f32x4 (&acc)[2][2][4][2], const Unit& u, int wr, int wc, int fr, int fq) const {
        const int row0 = u.pm * BM + wr * 64 + fr, col0 = u.pn * BM + wc * 32 + 8 * fq;
#pragma unroll
        for (int ai = 0; ai < 2; ++ai) {
            f32x4 xv[4][2][2];
#pragma unroll
            for (int m = 0; m < 4; ++m) { const size_t off = (size_t)(row0 + ai * HALF + m * 16) * D + col0;
#pragma unroll
                for (int bj = 0; bj < 2; ++bj) { xv[m][bj][0] = *(const f32x4*)(x + off + bj * HALF); xv[m][bj][1] = *(const f32x4*)(x + off + bj * HALF + 4); } }
#pragma unroll
            for (int m = 0; m < 4; ++m) { const size_t row = (size_t)(row0 + ai * HALF + m * 16), off = row * D + col0; float ss = 0.f;
#pragma unroll
                for (int bj = 0; bj < 2; ++bj) {
                    const f32x4 h0 = xv[m][bj][0] + acc[ai][bj][m][0], h1 = xv[m][bj][1] + acc[ai][bj][m][1];
                    *(u32x4*)(hb + off + bj * HALF) = pack8(h0, h1);
                    ss += (h0[0] * h0[0] + h0[1] * h0[1]) + (h0[2] * h0[2] + h0[3] * h0[3]) + (h1[0] * h1[0] + h1[1] * h1[1]) + (h1[2] * h1[2] + h1[3] * h1[3]); }
                ss += __shfl_xor(ss, 16); ss += __shfl_xor(ss, 32);
                if (fq == 0) ssq[row * 16 + 4 * u.pn + wc] = ss; }
            asm volatile("" ::: "memory");
        }
    }
};
struct EpZF {
    static constexpr bool PERM = true, AFTER_DRAIN = false;
    const PG8_LAS float* rtab; const float* ssq; bf16_t* z;
    __device__ __forceinline__ void operator()(const f32x4 (&acc)[2][2][4][2], const Unit& u, int wr, int wc, int fr, int fq) const {
        const int rl0 = wr * 64 + fr, row0 = u.pm * BM + rl0; const bool lo = fr < 8;
        bf16_t* zb = z + (size_t)(row0 - (lo ? 0 : 8)) * DFF + u.pn * BM + wc * 64 + (lo ? 0 : 32) + 8 * fq;
#pragma unroll
        for (int ai = 0; ai < 2; ++ai)
#pragma unroll
            for (int m = 0; m < 4; ++m) { const size_t row = (size_t)(row0 + ai * HALF + m * 16);
                float r;
                if (rtab) r = rtab[u.ord * 256 + rl0 + ai * HALF + m * 16];
                else { const f32x4 s0 = *(const f32x4*)(ssq + row * 16), s1 = *(const f32x4*)(ssq + row * 16 + 4), s2 = *(const f32x4*)(ssq + row * 16 + 8), s3 = *(const f32x4*)(ssq + row * 16 + 12);
                    const f32x4 st = (s0 + s1) + (s2 + s3); r = rsqrtf(((st[0] + st[1]) + (st[2] + st[3])) * (1.f / D) + EPS); }
                u32x4 w[2];
#pragma unroll
                for (int bj = 0; bj < 2; ++bj) { f32x4 v0 = acc[ai][bj][m][0] * r, v1 = acc[ai][bj][m][1] * r;
#pragma unroll
                    for (int e = 0; e < 4; ++e) { v0[e] = v0[e] > 0.f ? v0[e] * v0[e] : 0.f; v1[e] = v1[e] > 0.f ? v1[e] * v1[e] : 0.f; }
                    w[bj] = pack8(v0, v1); }
                wide_store(zb + (size_t)(ai * HALF + m * 16) * DFF, (size_t)8 * DFF, lo, w[0], w[1]); }
    }
};
struct EpOutF {
    static constexpr bool PERM = true, AFTER_DRAIN = false;
    const bf16_t* hb; float* o;
    __device__ __forceinline__ void operator()(const f32x4 (&acc)[2][2][4][2], const Unit& u, int wr, int wc, int fr, int fq) const {
        const int row0 = u.pm * BM + wr * 64 + fr, col0 = u.pn * BM + wc * 32 + 8 * fq;
        u32x4 hv[2][4][2];
#pragma unroll
        for (int ai = 0; ai < 2; ++ai)
#pragma unroll
            for (int m = 0; m < 4; ++m) { const size_t off = (size_t)(row0 + ai * HALF + m * 16) * D + col0;
#pragma unroll
                for (int bj = 0; bj < 2; ++bj) hv[ai][m][bj] = *(const u32x4*)(hb + off + bj * HALF); }
#pragma unroll
        for (int ai = 0; ai < 2; ++ai)
#pragma unroll
            for (int m = 0; m < 4; ++m) { float* p = o + (size_t)(row0 + ai * HALF + m * 16) * D + col0;
#pragma unroll
                for (int bj = 0; bj < 2; ++bj) { f32x4 h0, h1; unpack8(hv[ai][m][bj], h0, h1); *(f32x4*)(p + bj * HALF) = h0 + acc[ai][bj][m][0]; *(f32x4*)(p + bj * HALF + 4) = h1 + acc[ai][bj][m][1]; } }
    }
};
}

namespace att {
using pg8::bf16x8; using pg8::f32x4; using pg8::u32x4;
typedef float f32x16 __attribute__((ext_vector_type(16)));
typedef short s16x4 __attribute__((ext_vector_type(4)));
typedef float f32x2_t __attribute__((ext_vector_type(2))); typedef __bf16 bf16x2_t __attribute__((ext_vector_type(2)));
constexpr int KROW = 144, VROW = 144, KT = 64 * KROW, VT = 64 * VROW;
__device__ __forceinline__ int vperm(int kv) { return (kv & ~12) | ((kv & 4) << 1) | ((kv & 8) >> 1); }
constexpr int L_K0 = 0, L_K1 = KT, L_V0 = 2 * KT, L_V1 = 2 * KT + VT, L_BT = 2 * KT + 2 * VT  , L_IMPG = L_BT + 4096 + 64, L_IMPL = L_IMPG + 33792, L_IMP = L_IMPL + 33792, L_SELM = L_IMP + 64 * 33 * 4, L_KC = L_SELM + 512  , VCROW = 272, L_VC = L_KC + 128 * KROW  , L_END = L_VC + 64 * VCROW;
static_assert(L_END <= 163840 - 512, "attention LDS map");
__device__ __forceinline__ int crow(int r, int hi) { return (r & 3) + 8 * (r >> 2) + 4 * hi; }
__device__ __forceinline__ float max3f(float a, float b, float c) { float r; asm("v_max3_f32 %0, %1, %2, %3" : "=v"(r) : "v"(a), "v"(b), "v"(c)); return r; }
__device__ __forceinline__ unsigned cvtpk(float lo, float hi) { f32x2_t v = {lo, hi}; bf16x2_t b = __builtin_convertvector(v, bf16x2_t); return __builtin_bit_cast(unsigned, b); }
__device__ __forceinline__ bf16x8 packp(const f32x16& p, int s) {
    u32x4 w; w.x = cvtpk(p[8 * s + 0], p[8 * s + 1]); w.y = cvtpk(p[8 * s + 2], p[8 * s + 3]); w.z = cvtpk(p[8 * s + 4], p[8 * s + 5]); w.w = cvtpk(p[8 * s + 6], p[8 * s + 7]);
    return __builtin_bit_cast(bf16x8, w); }
__device__ __forceinline__ bf16x8 kfrag(const unsigned char* kbuf, int st, int sp, int q32, int hi) { return *(const bf16x8*)(kbuf + (32 * st + q32) * KROW + (16 * sp + 8 * hi) * 2); }
__device__ __forceinline__ bf16x8 vfrag(const unsigned char* vbuf, int st, int s, int dt, int q32, int hi) { return *(const bf16x8*)(vbuf + (32 * dt + q32) * VROW + (32 * st + 16 * s + 8 * hi) * 2); }
__device__ __forceinline__ f32x16 qk_tile(const unsigned char* kbuf, int st, const bf16x8 (&qf)[4], int q32, int hi) {
    f32x16 s = {};
#pragma unroll
    for (int sp = 0; sp < 4; ++sp) s = __builtin_amdgcn_mfma_f32_32x32x16_bf16(kfrag(kbuf, st, sp, q32, hi), qf[sp], s, 0, 0, 0);
    return s; }
__device__ __forceinline__ void pv_tile(f32x16 (&o)[2], const unsigned char* vbuf, int st, const f32x16& p, int q32, int hi) {
#pragma unroll
    for (int s = 0; s < 2; ++s) { const bf16x8 pb = packp(p, s);
#pragma unroll
        for (int dt = 0; dt < 2; ++dt) o[dt] = __builtin_amdgcn_mfma_f32_32x32x16_bf16(vfrag(vbuf, st, s, dt, q32, hi), pb, o[dt], 0, 0, 0); }
}
struct Stage { u32x4 k, v; };
__device__ __forceinline__ void stage_load(Stage& s, const bf16_t* Kblk  , int ldk, const bf16_t* Vblk  , int ldv, int tid) {
    const int row = tid >> 3, ch = tid & 7;
    s.k = *(const u32x4*)(Kblk + (size_t)row * ldk + ch * 8); s.v = *(const u32x4*)(Vblk + (size_t)row * ldv + ch * 8); }
__device__ __forceinline__ void stage_store(const Stage& s, unsigned char* kbuf, unsigned char* vbuf, int tid) {
    const int row = tid >> 3, ch = tid & 7;
    *(u32x4*)(kbuf + row * KROW + ch * 16) = s.k;
    *(u32x4*)(vbuf + row * VROW + ch * 16) = s.v; }

struct SoftState { float mhat, l; f32x16 cneg; };
constexpr float ATT_THR = 8.0f;
template <int BR, int ABL>
__device__ __forceinline__ void block64(f32x16 (&o)[2], SoftState& ss, const unsigned char* kbuf, const unsigned char* vbuf, int dj, bool selbit, bool anyunsel, const bf16x8 (&qf)[4], const float* bt2,
                                        int q32, int hi, int tl) {
    f32x16 s0 = ss.cneg, s1 = ss.cneg;
#pragma unroll
    for (int sp = 0; sp < 4; ++sp) { s0 = __builtin_amdgcn_mfma_f32_32x32x16_bf16(kfrag(kbuf, 0, sp, q32, hi), qf[sp], s0, 0, 0, 0); s1 = __builtin_amdgcn_mfma_f32_32x32x16_bf16(kfrag(kbuf, 1, sp, q32, hi), qf[sp], s1, 0, 0, 0); }
    __builtin_amdgcn_sched_barrier(0);
    bf16x8 vf0[2][2], vf1[2][2];
#pragma unroll
    for (int s = 0; s < 2; ++s)
#pragma unroll
        for (int dt = 0; dt < 2; ++dt) vf0[s][dt] = vfrag(vbuf, 0, s, dt, q32, hi);
    __builtin_amdgcn_sched_barrier(0);
    if (dj <= 2) {
        const int basei = 64 * dj + tl + 64 - 4 * hi - 27; const float* bt0 = bt2 + basei; const float* bt1 = bt0 - 32;
#pragma unroll
        for (int r = 0; r < 16; ++r) { const int cr = (r & 3) + 8 * (r >> 2); s0[r] += bt0[27 - cr]; s1[r] += bt1[27 - cr]; }
    } else if (BR == 1 && dj == 8) {
        const int basei = tl - 4 * hi;
#pragma unroll
        for (int r = 0; r < 16; ++r) { const int cr = (r & 3) + 8 * (r >> 2);
            s0[r] += __int_as_float(((cr - basei - 1) >> 31) & 0xf149f2cau); s1[r] += __int_as_float(((cr + 32 - basei - 1) >> 31) & 0xf149f2cau); }
    }
    float rm = max3f(s0[0], s0[1], s1[0]), rm2 = max3f(s0[2], s0[3], s1[1]);
    rm = max3f(rm, s1[2], s1[3]);
#pragma unroll
    for (int r = 4; r < 16; r += 4) { rm = max3f(rm, s0[r], s0[r + 1]); rm2 = max3f(rm2, s0[r + 2], s0[r + 3]); rm = max3f(rm, s1[r], s1[r + 1]); rm2 = max3f(rm2, s1[r + 2], s1[r + 3]); }
    rm = max3f(rm, rm2, rm2);
    if (BR == 0) rm = selbit ? rm : -1e30f;
    if (__any(rm > ATT_THR)) {
        const float rmc = fmaxf(rm, __shfl_xor(rm, 32)), dl = fmaxf(rmc, 0.f), f = __builtin_amdgcn_exp2f(-dl);
        ss.mhat += dl; ss.l *= f;
#pragma unroll
        for (int r = 0; r < 16; ++r) { s0[r] -= dl; s1[r] -= dl; ss.cneg[r] -= dl; o[0][r] *= f; o[1][r] *= f; }
    }
    float ps = 0.f, ps1 = 0.f, ps2 = 0.f, ps3 = 0.f;
#pragma unroll
    for (int r = 0; r < 16; r += 2) { s0[r] = __builtin_amdgcn_exp2f(s0[r]); s0[r + 1] = __builtin_amdgcn_exp2f(s0[r + 1]); ps += s0[r]; ps2 += s0[r + 1]; }
    const unsigned pm = (BR == 0 && !selbit) ? 0u : 0xffffffffu;
    bf16x8 pb0[2];
#pragma unroll
    for (int s = 0; s < 2; ++s) { pb0[s] = packp(s0, s);
        if (BR == 0 && anyunsel) { u32x4 w = __builtin_bit_cast(u32x4, pb0[s]); w.x &= pm; w.y &= pm; w.z &= pm; w.w &= pm; pb0[s] = __builtin_bit_cast(bf16x8, w); } }
    __builtin_amdgcn_sched_barrier(0);
#pragma unroll
    for (int i = 0; i < 4; ++i) { const int s = i >> 1, dt = i & 1;
        o[dt] = __builtin_amdgcn_mfma_f32_32x32x16_bf16(vf0[s][dt], pb0[s], o[dt], 0, 0, 0);
#pragma unroll
        for (int e = 0; e < 4; ++e) s1[4 * i + e] = __builtin_amdgcn_exp2f(s1[4 * i + e]);
        __builtin_amdgcn_sched_barrier(0); }
#pragma unroll
    for (int s = 0; s < 2; ++s)
#pragma unroll
        for (int dt = 0; dt < 2; ++dt) vf1[s][dt] = vfrag(vbuf, 1, s, dt, q32, hi);
#pragma unroll
    for (int r = 0; r < 16; r += 2) { ps1 += s1[r]; ps3 += s1[r + 1]; }
    ps = (ps + ps1) + (ps2 + ps3);
    if (BR == 0) ps = selbit ? ps : 0.f;
    ss.l += ps;
#pragma unroll
    for (int s = 0; s < 2; ++s) { bf16x8 pb = packp(s1, s);
        if (BR == 0 && anyunsel) { u32x4 w = __builtin_bit_cast(u32x4, pb); w.x &= pm; w.y &= pm; w.z &= pm; w.w &= pm; pb = __builtin_bit_cast(bf16x8, w); }
#pragma unroll
        for (int dt = 0; dt < 2; ++dt) o[dt] = __builtin_amdgcn_mfma_f32_32x32x16_bf16(vf1[s][dt], pb, o[dt], 0, 0, 0); }
}
__device__ __forceinline__ void stage_load_t(Stage& s, const bf16_t* Kblk, const bf16_t* Vblk, int tid) {
    s.k = *(const u32x4*)(Kblk + (size_t)(tid >> 3) * KVW + (tid & 7) * 8); s.v = *(const u32x4*)(Vblk + (size_t)(tid & 63) * KVW + (tid >> 6) * 8); }
__device__ __forceinline__ void stage_store_t(const Stage& s, unsigned char* kbuf, unsigned char* vbuf, int tid) {
    const int row = tid >> 3, ch = tid & 7;
    *(u32x4*)(kbuf + row * KROW + ch * 16) = s.k;
    unsigned short* vp = (unsigned short*)(vbuf + ((tid >> 6) * 8) * VROW + vperm(tid & 63) * 2);
    vp[0 * (VROW / 2)] = (unsigned short)s.v.x; vp[1 * (VROW / 2)] = (unsigned short)(s.v.x >> 16); vp[2 * (VROW / 2)] = (unsigned short)s.v.y; vp[3 * (VROW / 2)] = (unsigned short)(s.v.y >> 16);
    vp[4 * (VROW / 2)] = (unsigned short)s.v.z; vp[5 * (VROW / 2)] = (unsigned short)(s.v.z >> 16); vp[6 * (VROW / 2)] = (unsigned short)s.v.w; vp[7 * (VROW / 2)] = (unsigned short)(s.v.w >> 16); }
template <int BR, int ABL>
__device__ __forceinline__ void branch(float* outl  , const Stage* first  , float gate, const bf16_t* Kg  , const bf16_t* Vg  ,
                                       int qblk, unsigned unionmask, unsigned mysel, const bf16x8 (&qf)[4], const float* bt2  , float cb  ,
                                       unsigned char* lds, int tid, int q32, int hi, int tl) {
    const int jlo = BR == 0 ? 0 : (qblk - 8 < 0 ? 0 : qblk - 8);
    f32x16 o[2]; o[0] = f32x16{}; o[1] = f32x16{};
    SoftState ss; ss.mhat = 0.f; ss.l = 0.f;
#pragma unroll
    for (int r = 0; r < 16; ++r) ss.cneg[r] = cb;
#define ATT_NEXT(jv) do { --(jv); if (BR == 0) { while ((jv) >= jlo && !((unionmask >> (jv)) & 1u)) --(jv); } } while (0)
#define ATT_LOAD(sg, jv) do { const int jl_ = (jv) < jlo ? jlo : (jv); if (!(ABL & 8)) stage_load_t(sg, Kg + (size_t)jl_ * 64 * KVW, Vg + (size_t)jl_ * 64 * KVW, tid); else { sg.k = (u32x4){(unsigned)jl_, 0u, 0u, 0u}; sg.v = sg.k; } } while (0)
#define ATT_SEL(jv) (BR == 0 ? (((mysel >> (jv)) & 1u) != 0u) : true)
    int jA = qblk, jB = qblk, jC;
    Stage sA, sB;
    if (first) sA = *first; else ATT_LOAD(sA, jA);
    ATT_NEXT(jB); ATT_LOAD(sB, jB);
    stage_store_t(sA, lds + L_K0, lds + L_V0, tid);
    __syncthreads();
    for (;;) {
        jC = jB; if (jB >= jlo) ATT_NEXT(jC);
        ATT_LOAD(sA, jC);
        { const bool sel = ATT_SEL(jA); if (BR == 1 || __any(sel)) block64<BR, ABL>(o, ss, lds + L_K0, lds + L_V0, qblk - jA, sel, BR == 0 && __any(!sel), qf, bt2, q32, hi, tl); }
        if (jB < jlo) break;
        if (!(ABL & 16)) stage_store_t(sB, lds + L_K1, lds + L_V1, tid);
        if (!(ABL & 4)) __syncthreads();
        jA = jC; if (jC >= jlo) ATT_NEXT(jA);
        ATT_LOAD(sB, jA);
        { const bool sel = ATT_SEL(jB); if (BR == 1 || __any(sel)) block64<BR, ABL>(o, ss, lds + L_K1, lds + L_V1, qblk - jB, sel, BR == 0 && __any(!sel), qf, bt2, q32, hi, tl); }
        if (jC < jlo) break;
        if (!(ABL & 16)) stage_store_t(sA, lds + L_K0, lds + L_V0, tid);
        if (!(ABL & 4)) __syncthreads();
        jB = jA; jA = jC;
    }
#undef ATT_NEXT
#undef ATT_LOAD
#undef ATT_SEL
    float lrun = ss.l; lrun += __shfl_xor(lrun, 32);
    const float f = gate / lrun;
#pragma unroll
    for (int r = 0; r < 16; ++r) { outl[r * 64] += o[0][r] * f; outl[(16 + r) * 64] += o[1][r] * f; }
    __syncthreads();
}

__device__ __forceinline__ void attn_bias_table(int g, const float* rel_bias, unsigned char* lds) {
    float* bt = (float*)(lds + L_BT); const int tid = threadIdx.x;
#pragma unroll
    for (int i = 0; i < 2; ++i) { const int e = tid + 512 * i, hh = e >> 8, ix = (e & 255) - 64; const float cbh = rel_bias[31 * NH + g * 4 + hh] * LOG2E; bt[e] = ix < 0 ? -1e30f : rel_bias[BUCKET[ix > 127 ? 127 : ix] * NH + g * 4 + hh] * LOG2E - cbh; }
    if (tid < 4) bt[1024 + tid] = rel_bias[31 * NH + g * 4 + tid] * LOG2E;
    __syncthreads();
}
__device__ __forceinline__ void attn_compress_l2(int bg, const bf16_t* HIDK, const bf16_t* HIDV, const float* w2k, const float* w2v, const float* kc_norm, unsigned char* lds) {
    const int tid = threadIdx.x, lane = tid & 63, wave = tid >> 6, q32 = lane & 31, hi = lane >> 5, which = wave >> 2, c = 32 * (wave & 3) + q32; const bool okc = c < NC;
    const bf16_t* hrow = (which ? HIDV : HIDK) + (size_t)(bg * NC + (okc ? c : 0)) * 256; const float* w2 = which ? w2v : w2k;
    f32x16 acc[2]; acc[0] = f32x16{}; acc[1] = f32x16{};
    for (int s = 0; s < 16; ++s) {
        const bf16x8 bfrag = *(const bf16x8*)(hrow + 16 * s + 8 * hi);
#pragma unroll
        for (int nt = 0; nt < 2; ++nt) { const float* wp = w2 + (size_t)(16 * s + 8 * hi) * HD + 32 * nt + q32;
            u32x4 aw; aw.x = cvtpk(wp[0], wp[HD]); aw.y = cvtpk(wp[2 * HD], wp[3 * HD]); aw.z = cvtpk(wp[4 * HD], wp[5 * HD]); aw.w = cvtpk(wp[6 * HD], wp[7 * HD]);
            acc[nt] = __builtin_amdgcn_mfma_f32_32x32x16_bf16(__builtin_bit_cast(bf16x8, aw), bfrag, acc[nt], 0, 0, 0); }
    }
    if (which) {
        unsigned short* vp = (unsigned short*)(lds + L_VC) + vperm(c);
#pragma unroll
        for (int nt = 0; nt < 2; ++nt)
#pragma unroll
            for (int q = 0; q < 16; ++q) vp[(32 * nt + crow(q, hi)) * (VCROW / 2)] = okc ? (unsigned short)(cvtpk(acc[nt][q], 0.f) & 0xffffu) : (unsigned short)0;
    } else {
        float ss = 0.f;
#pragma unroll
        for (int nt = 0; nt < 2; ++nt)
#pragma unroll
            for (int q = 0; q < 16; ++q) ss += acc[nt][q] * acc[nt][q];
        ss += __shfl_xor(ss, 32); const float rn = okc ? rsqrtf(ss * (1.f / HD) + EPS) : 0.f;
#pragma unroll
        for (int nt = 0; nt < 2; ++nt)
#pragma unroll
            for (int rg = 0; rg < 4; ++rg) { const int n0 = 32 * nt + 8 * rg + 4 * hi; const f32x4 gk = *(const f32x4*)(kc_norm + n0);
                *(unsigned long long*)(lds + L_KC + c * KROW + n0 * 2) = (unsigned long long)cvtpk(acc[nt][4 * rg] * rn * gk[0], acc[nt][4 * rg + 1] * rn * gk[1]) | ((unsigned long long)cvtpk(acc[nt][4 * rg + 2] * rn * gk[2], acc[nt][4 * rg + 3] * rn * gk[3]) << 32); }
    }
    __syncthreads();
}
__device__ __forceinline__ bf16x8 vfragc(const unsigned char* vcbuf, int tile, int s, int dt, int q32, int hi) { return *(const bf16x8*)(vcbuf + (32 * dt + q32) * VCROW + (32 * tile + 16 * s + 8 * hi) * 2); }
template <int MODE, int ABL = 0>
__device__ __forceinline__ void attn_unit(int b, int g, int qblk, const bf16_t* Q, bf16_t* O, const bf16_t* KSb, const bf16_t* VSb, const bf16_t* KWb, const bf16_t* VWb,
                                          const bf16_t* GN, const float* rel_bias, unsigned char* lds) {
    int tid = threadIdx.x; asm volatile("" : "+v"(tid));
    const int lane = tid & 63, wave = tid >> 6, q32 = lane & 31, hi = lane >> 5, hr = wave >> 1, th = wave & 1, h = g * 4 + hr, tl = 32 * th + q32, t = 64 * qblk + tl, bg = b * 4 + g;
    const size_t m = (size_t)b * T + t;
    float* bt = (float*)(lds + L_BT); float* impg = (float*)(lds + L_IMPG); float* impl = (float*)(lds + L_IMPL); float* imp = (float*)(lds + L_IMP); unsigned* selm = (unsigned*)(lds + L_SELM);
    bf16x8 qf[4];
#pragma unroll
    for (int sp = 0; sp < 4; ++sp) qf[sp] = *(const bf16x8*)(Q + m * QW + h * HD + 16 * sp + 8 * hi);
    const float g0 = bf2f(GN[m * 48 + h * 3 + 0]), g1 = bf2f(GN[m * 48 + h * 3 + 1]), g2 = bf2f(GN[m * 48 + h * 3 + 2]);
    f32x16 out[2];
    {
        const float* bte = bt + hr * 256 + 64; const float cbh = bt[1024 + hr];
        const int ncv = t >= 31 ? ((t - 31) >> 4) + 1 : 0;
        f32x16 sc[4]; float mx = -1e20f;
#pragma unroll
        for (int tile = 0; tile < 4; ++tile) {
            sc[tile] = qk_tile(lds + L_KC, tile, qf, q32, hi);
            __builtin_amdgcn_sched_barrier(0);
#pragma unroll
            for (int r = 0; r < 16; ++r) { const int c = 32 * tile + crow(r, hi);
                int dist = t - 31 - 16 * c; const float pen = __int_as_float(((ncv - 1 - c) >> 31) & 0xf149f2cau);
                dist = dist < 0 ? 0 : (dist > 127 ? 127 : dist);
                const float v = (sc[tile][r] + (bte[dist] + cbh)) + pen; sc[tile][r] = v; mx = fmaxf(mx, v); }
            __builtin_amdgcn_sched_barrier(0);
        }
        mx = fmaxf(mx, __shfl_xor(mx, 32));
        float l = 0.f;
#pragma unroll
        for (int tile = 0; tile < 4; ++tile)
#pragma unroll
            for (int r = 0; r < 16; ++r) { const float p = __builtin_amdgcn_exp2f(sc[tile][r] - mx); sc[tile][r] = p; l += p; }
        l += __shfl_xor(l, 32);
        const float inv = l > 0.f ? 1.f / l : 0.f;
#pragma unroll
        for (int tile = 0; tile < 4; ++tile)
#pragma unroll
            for (int r = 0; r < 16; ++r) sc[tile][r] *= inv;
        __builtin_amdgcn_sched_barrier(0);
        if (qblk > 15)
#pragma unroll
        for (int tile = 0; tile < 4; ++tile)
#pragma unroll
            for (int rg = 0; rg < 4; ++rg) { const int j = 8 * tile + 2 * rg + hi;
                impg[(hr * 64 + tl) * 33 + j] = (sc[tile][4 * rg] + sc[tile][4 * rg + 1]) + (sc[tile][4 * rg + 2] + sc[tile][4 * rg + 3]);
                impl[(hr * 64 + tl) * 33 + j] = sc[tile][4 * rg + 3]; }
        __builtin_amdgcn_sched_barrier(0);
        f32x16 o[2]; o[0] = f32x16{}; o[1] = f32x16{};
#pragma unroll
        for (int tile = 0; tile < 4; ++tile) {
#pragma unroll
            for (int s = 0; s < 2; ++s) { const bf16x8 pb = packp(sc[tile], s);
#pragma unroll
                for (int dt = 0; dt < 2; ++dt) o[dt] = __builtin_amdgcn_mfma_f32_32x32x16_bf16(vfragc(lds + L_VC, tile, s, dt, q32, hi), pb, o[dt], 0, 0, 0); }
            __builtin_amdgcn_sched_barrier(0); }
#pragma unroll
        for (int r = 0; r < 16; ++r) { out[0][r] = o[0][r] * g0; out[1][r] = o[1][r] * g0; }
    }
    const bf16_t* Kgs = KSb + (size_t)b * T * KVW + g * HD; const bf16_t* Kgw = KWb + (size_t)b * T * KVW + g * HD;
    const bf16_t* Vgs = VSb + (size_t)b * T * KVW + g * HD; const bf16_t* Vgw = VWb + (size_t)b * T * KVW + g * HD;
    Stage sfirst; stage_load_t(sfirst, Kgs + (size_t)qblk * 64 * KVW, Vgs + (size_t)qblk * 64 * KVW, tid);
    unsigned mysel, uni;
    if (qblk > 15) {
    __syncthreads();
    {
        const int stl = tid >> 3, jq = tid & 7;
#pragma unroll
        for (int e = 0; e < 4; ++e) { const int j = 4 * jq + e; float s = 0.f;
#pragma unroll
            for (int r = 0; r < 4; ++r) { s += impg[(r * 64 + stl) * 33 + j]; if (j > 0) s += impl[(r * 64 + stl) * 33 + j - 1]; }
            imp[stl * 33 + j] = s; }
        __syncthreads();
        unsigned bits = 0u;
        {
            float iv[32];
#pragma unroll
            for (int k = 0; k < 32; ++k) iv[k] = imp[stl * 33 + k];
#pragma unroll
            for (int e = 0; e < 4; ++e) { const int j = 4 * jq + e; float vj = iv[0];
#pragma unroll
                for (int k = 1; k < 32; ++k) vj = (k == j) ? iv[k] : vj;
                int rank = 0;
#pragma unroll
                for (int k = 1; k < 30; ++k) { const bool cand = k <= qblk - 2; rank += (cand && (iv[k] > vj || (iv[k] == vj && k < j))) ? 1 : 0; }
                if (j == 0 || j == qblk - 1 || j == qblk) bits |= 1u << j; else if (j < qblk - 1 && rank < 13) bits |= 1u << j; }
        }
        bits |= __shfl_xor(bits, 1); bits |= __shfl_xor(bits, 2); bits |= __shfl_xor(bits, 4);
        if (jq == 0) selm[stl] = bits;
    }
    __syncthreads();
    mysel = selm[tl]; uni = selm[lane];
#pragma unroll
    for (int o = 1; o < 64; o <<= 1) uni |= __shfl_xor(uni, o);
    } else { mysel = uni = (1u << (qblk + 1)) - 1u; }
    float* outl = (float*)(lds + L_IMPG) + wave * 2048 + lane;
#pragma unroll
    for (int r = 0; r < 16; ++r) { outl[r * 64] = out[0][r]; outl[(16 + r) * 64] = out[1][r]; }
    if (MODE & 2) branch<0, ABL>(outl, &sfirst, g1, Kgs, Vgs, qblk, uni, mysel, qf, bt + hr * 256, bt[1024 + hr], lds, tid, q32, hi, tl);
    if (MODE & 4) branch<1, ABL>(outl, nullptr, g2, Kgw, Vgw, qblk, 0xffffffffu, 0xffffffffu, qf, bt + hr * 256, bt[1024 + hr], lds, tid, q32, hi, tl);
    bf16_t* orow = O + m * QW + h * HD;
#pragma unroll
    for (int dt = 0; dt < 2; ++dt)
#pragma unroll
        for (int rg = 0; rg < 4; ++rg)
            *(unsigned long long*)(orow + 32 * dt + 8 * rg + 4 * hi) = (unsigned long long)cvtpk(outl[(16 * dt + 4 * rg) * 64], outl[(16 * dt + 4 * rg + 1) * 64]) | ((unsigned long long)cvtpk(outl[(16 * dt + 4 * rg + 2) * 64], outl[(16 * dt + 4 * rg + 3) * 64]) << 32);
}
}

__device__ __forceinline__ void tr_item(const float* W, int ldw, int kvalid, int c0, int cvalid, const float* kscale, bf16_t* WT, int ldt, int r0, int k0, float* scr, int lane) {
#pragma unroll 8
    for (int i = 0; i < 32; ++i) { const int kk = 2 * i + (lane >> 5), col = lane & 31, k = k0 + kk;
        float v = 0.f; if (k < kvalid && col < cvalid) { v = W[(size_t)k * ldw + c0 + col]; if (kscale) v *= kscale[k]; }
        scr[kk * 33 + col] = v; }
    asm volatile("s_waitcnt lgkmcnt(0)" ::: "memory");
    const int c = lane & 7;
#pragma unroll
    for (int j = 0; j < 4; ++j) { const int n = (lane >> 3) + 8 * j; const float* s = scr + (8 * c) * 33 + n;
        pg8::u32x4 o; o.x = pg8::cvt_pk_bf16(s[0 * 33], s[1 * 33]); o.y = pg8::cvt_pk_bf16(s[2 * 33], s[3 * 33]); o.z = pg8::cvt_pk_bf16(s[4 * 33], s[5 * 33]); o.w = pg8::cvt_pk_bf16(s[6 * 33], s[7 * 33]);
        *(pg8::u32x4*)(WT + (size_t)(r0 + n) * ldt + k0 + 8 * c) = o; }
    asm volatile("s_waitcnt lgkmcnt(0)" ::: "memory");
}

#define LAS __attribute__((address_space(3)))
#define XB_TMO      128
#define XB_XCNT(j)  (256  + 64 * (j))
#define XB_XSUB(j)  (1280 + 64 * (j))
#define XB_XGEN(j)  (2304 + 64 * (j))
#define XB_TOP      3328
#define XB_TOPGEN   3392
#define XCD_BAR_WORDS 3456
#define XB_SPIN_CAP (1u << 18)

__device__ __forceinline__ unsigned xb_ld(unsigned* p)              { return __hip_atomic_load(p, __ATOMIC_RELAXED, __HIP_MEMORY_SCOPE_AGENT); }
__device__ __forceinline__ unsigned xb_add(unsigned* p, unsigned v) { return __hip_atomic_fetch_add(p, v, __ATOMIC_RELAXED, __HIP_MEMORY_SCOPE_AGENT); }
__device__ __forceinline__ unsigned xb_xcc_id() { return (unsigned)__builtin_amdgcn_s_getreg((3 << 11) | 20) & 0xFu; }
#define XB_SPIN(cond, bar) do { unsigned _sp = 0; while (cond) { __builtin_amdgcn_s_sleep(1); \
    if ((++_sp & 255u) == 0u) { if (xb_ld(&(bar)[XB_TMO])) break; if (_sp > XB_SPIN_CAP) { atomicAdd(&(bar)[XB_TMO], 1u); break; } } } } while (0)

struct XcdBarrier {
    unsigned* bar; unsigned x;
    volatile LAS unsigned* st;
};

__device__ __forceinline__ XcdBarrier xcd_barrier_post(unsigned* bar, volatile LAS unsigned* st) {
    XcdBarrier b; b.bar = bar; b.x = xb_xcc_id(); b.st = st;
    if (threadIdx.x == 0) (void)xb_add(&bar[XB_XCNT(b.x)], 1u);
    return b;
}
__device__ __forceinline__ void xcd_barrier_complete(unsigned* bar, unsigned x, unsigned& nloc, unsigned& nx) {
    const unsigned G = gridDim.x * gridDim.y * gridDim.z;
    unsigned sum, cnt, mine, sp = 0u;
    for (;;) {
        sum = 0u; cnt = 0u; mine = 0u;
#pragma unroll
        for (unsigned j = 0; j < 16; ++j) { const unsigned c = xb_ld(&bar[XB_XCNT(j)]); sum += c; cnt += (c > 0u) ? 1u : 0u; mine = (j == x) ? c : mine; }
        if (sum == G) break;
        __builtin_amdgcn_s_sleep(1);
        if ((++sp & 255u) == 0u) { if (xb_ld(&bar[XB_TMO])) break; if (sp > XB_SPIN_CAP) { atomicAdd(&bar[XB_TMO], 1u); break; } }
    }
    nloc = mine > 0u ? mine : 1u; nx = cnt > 0u ? cnt : 1u;
}

__device__ __forceinline__ void xcd_barrier(const XcdBarrier& b) {
    asm volatile("s_waitcnt vmcnt(0)" ::: "memory");
    __syncthreads();
    if (threadIdx.x == 0) {
        unsigned* bar = b.bar;
        __builtin_amdgcn_s_waitcnt(0);
        unsigned nloc = b.st[0], nx = b.st[1];
        if (nloc == 0u) { xcd_barrier_complete(bar, b.x, nloc, nx); b.st[0] = nloc; b.st[1] = nx; }
        const unsigned old = xb_add(&bar[XB_XSUB(b.x)], 1u);
        const unsigned gen = old / nloc;
        if (old + 1u == (gen + 1u) * nloc) {
            __builtin_amdgcn_fence(__ATOMIC_RELEASE, "agent");
            asm volatile("s_waitcnt vmcnt(0)" ::: "memory");
            const unsigned og = xb_add(&bar[XB_TOP], 1u);
            const unsigned tg = og / nx;
            if (og + 1u == (tg + 1u) * nx) xb_add(&bar[XB_TOPGEN], 1u);
            else XB_SPIN(xb_ld(&bar[XB_TOPGEN]) == tg, bar);
            __builtin_amdgcn_fence(__ATOMIC_ACQUIRE, "agent");
            xb_add(&bar[XB_XGEN(b.x)], 1u);
            asm volatile("s_waitcnt vmcnt(0)" ::: "memory");
        } else {
            XB_SPIN(xb_ld(&bar[XB_XGEN(b.x)]) == gen, bar);
            __builtin_amdgcn_fence(__ATOMIC_ACQUIRE, "agent");
            asm volatile("s_waitcnt vmcnt(0)" ::: "memory");
        }
    }
    __syncthreads();
}

#define DECL_PTRS \
    size_t zoff_ = 0; asm volatile("" : "+s"(zoff_));     \
    unsigned char* ws = a.ws + zoff_; unsigned char* dob = (unsigned char*)a.out + zoff_; \
    const float *x = a.in[0], *norm_mix = a.in[1], *w_in = a.in[2], *conv_w = a.in[3], *conv_b = a.in[4], *gate_a_w = a.in[5], *gate_a_b = a.in[6], *gate_x_w = a.in[7], *gate_x_b = a.in[8], \
                *lam = a.in[9], *pe_k = a.in[10], *w1k = a.in[11], *w2k = a.in[12], *pe_v = a.in[13], *w1v = a.in[14], *w2v = a.in[15], *q_norm = a.in[16], *kc_norm = a.in[17], *ks_norm = a.in[18], \
                *kw_norm = a.in[19], *rel_bias = a.in[20], *proj_a = a.in[21], *proj_b = a.in[22], *w_out = a.in[23], *norm_mlp = a.in[24], *w_mlp_in = a.in[25], *w_mlp_out = a.in[26]; \
    float* RSTD = (float*)(ws + WS_RSTD); float* KCC = (float*)(ws + WS_KCC); float* VCC = (float*)(ws + WS_VCC); unsigned* SEL = (unsigned*)(ws + WS_SEL); \
    bf16_t *URNN = (bf16_t*)(ws + WS_URNN), *UGATE = (bf16_t*)(ws + WS_UGATE), *Q = (bf16_t*)(ws + WS_Q), *KV = (bf16_t*)(ws + WS_KV), *GN = (bf16_t*)(ws + WS_GN), *GA = (bf16_t*)(ws + WS_GA), *GB = (bf16_t*)(ws + WS_GB); \
    bf16_t *KCr = KV, *VCr = KV + (size_t)M * KVW, *KS = KV + 2 * (size_t)M * KVW, *VS = KV + 3 * (size_t)M * KVW, *KW = KV + 4 * (size_t)M * KVW, *VW = KV + 5 * (size_t)M * KVW; \
    bf16_t *LA = (bf16_t*)(ws + WS_LA), *UP = (bf16_t*)(ws + WS_UP), *T1 = (bf16_t*)(ws + WS_T1), *MERGED = (bf16_t*)(ws + WS_MERGED), *HB = (bf16_t*)(ws + WS_HB), *ZACT = (bf16_t*)(ws + WS_ZACT); \
    bf16_t *FLATK = (bf16_t*)(dob + DO_FLATK), *FLATV = (bf16_t*)(dob + DO_FLATV), *HIDK = (bf16_t*)(dob + DO_HIDK), *HIDV = (bf16_t*)(dob + DO_HIDV), *XC = (bf16_t*)(dob + DO_XC), *YA = (bf16_t*)(dob + DO_YA); \
    float* H = (float*)dob; \
    float* LAMC = (float*)(ws + WS_LAMC); float* NORMS = (float*)(ws + WS_NORMS); float* PES = (float*)(ws + WS_PES); float* SSQ = (float*)(ws + WS_SSQ); \
    bf16_t *WIN_T = (bf16_t*)(ws + WS_WIN), *WG_T = (bf16_t*)(ws + WS_WG), *W1_T = (bf16_t*)(ws + WS_W1), *PA_T = (bf16_t*)(ws + WS_PA), *PB_T = (bf16_t*)(ws + WS_PB), *WO_T = (bf16_t*)(ws + WS_WO), *WMI_T = (bf16_t*)(ws + WS_WMI), *WMO_T = (bf16_t*)(ws + WS_WMO); \
    float *CAR = (float*)(dob + DO_CAR), *CBR = (float*)(dob + DO_CBR); \
    bf16_t* XB = (bf16_t*)(dob + DO_XB); bf16_t *KCB = (bf16_t*)(dob + DO_KCB), *VCT = (bf16_t*)(dob + DO_VCT), *VST = (bf16_t*)(dob + DO_VST), *VWT = (bf16_t*)(dob + DO_VWT); \
    (void)0;
__global__ void __launch_bounds__(NTHREADS, 2) fwd(Args a) {
    extern __shared__ __attribute__((aligned(16))) unsigned char lds[];
    float* ldsf = (float*)lds;
    const int tid = threadIdx.x, lane = tid & 63, wave = tid >> 6;
    const int gw = blockIdx.x * 8 + wave, NGW = gridDim.x * 8;
    const size_t gtid = (size_t)blockIdx.x * NTHREADS + tid, GSZ = (size_t)gridDim.x * NTHREADS;
    unsigned char* ws0 = a.ws;
    PG8_LAS unsigned char* ldsl = (PG8_LAS unsigned char*)lds;
    const int G = gridDim.x;
    const int lo = a.ph_lo, hi = a.ph_hi;
    volatile LAS unsigned* MISC = (volatile LAS unsigned*)((LAS unsigned char*)lds + LDS_BYTES - 256);
    if (tid < 32) MISC[tid] = 0u;
    __syncthreads();
    XcdBarrier bar = xcd_barrier_post((unsigned*)(ws0 + 16384), MISC + 8);
    int ph = 0;
#ifndef PHMASK
#define PHMASK 0xFFFFFFFFu
#endif
#ifndef REPMASK
#define REPMASK 0u
#endif
#define PHASE_BEGIN if (lo <= ph && ph < hi && ((PHMASK >> ph) & 1u)) {
#define PHASE_BEGIN_R if (lo <= ph && ph < hi && ((PHMASK >> ph) & 1u)) for (int rep_ = 0; rep_ < (((REPMASK >> (16 + ph)) & 1u) ? 2 : 1); ++rep_) {
#define PHASE_END } { const bool sync_ = (lo <= ph && ph + 1 < hi); ++ph; if (sync_) xcd_barrier(bar); }

    PHASE_BEGIN_R DECL_PTRS
    for (int m0 = 2 * gw; m0 < M; m0 += 2 * NGW) {
        pg8::f32x4 v[2][4]; float s[2] = {0.f, 0.f};
#pragma unroll
        for (int u = 0; u < 2; ++u) { const pg8::f32x4* xr = (const pg8::f32x4*)(x + (size_t)(m0 + u) * D) + lane;
#pragma unroll
            for (int j = 0; j < 4; ++j) v[u][j] = xr[64 * j]; }
#pragma unroll
        for (int u = 0; u < 2; ++u)
#pragma unroll
            for (int j = 0; j < 4; ++j) s[u] += (v[u][j][0] * v[u][j][0] + v[u][j][1] * v[u][j][1]) + (v[u][j][2] * v[u][j][2] + v[u][j][3] * v[u][j][3]);
#pragma unroll
        for (int o = 1; o < 64; o <<= 1) { s[0] += __shfl_xor(s[0], o); s[1] += __shfl_xor(s[1], o); }
#pragma unroll
        for (int u = 0; u < 2; ++u) { const float r = rsqrtf(s[u] * (1.f / D) + EPS); if (lane == 0) RSTD[m0 + u] = r;
            unsigned long long* o8 = (unsigned long long*)(XB + (size_t)(m0 + u) * D) + lane;
#pragma unroll
            for (int j = 0; j < 4; ++j) { const pg8::f32x4 gg = *((const pg8::f32x4*)norm_mix + lane + 64 * j); const pg8::f32x4 y = v[u][j] * r * gg;
                o8[64 * j] = (unsigned long long)pg8::cvt_pk_bf16(y[0], y[1]) | ((unsigned long long)pg8::cvt_pk_bf16(y[2], y[3]) << 32); } }
    }
    for (size_t i = gtid; i < DRNN; i += GSZ) LAMC[i] = -8.f * log1pf(__expf(-lam[i])) * LOG2E;
    for (size_t i = gtid; i < 4096; i += GSZ) PES[i] = i < 2048 ? pe_k[i] : pe_v[i - 2048];
    for (size_t i = gtid; i < 192; i += GSZ) NORMS[i] = i < 64 ? q_norm[i] : (i < 128 ? ks_norm[i - 64] : kw_norm[i - 128]);
    {
        float* scr = ldsf + wave * (64 * 33);
        constexpr int I_WIN = (pg8::N1PAD / 32) * 16, I_W1 = 16 * 32;
        for (int it = gw; it < I_WIN + I_W1; it += NGW) {
            int r = it;
            if (r < I_WIN) { const int ch = r / 16, kb = r % 16; int c0, cv; pg8::win_src(ch, c0, cv); tr_item(w_in, DIN, D, c0, cv, nullptr, WIN_T, D, 32 * ch, 64 * kb, scr, lane); continue; } r -= I_WIN;
            { const int ch = r / 32, kb = r % 32; tr_item((ch >> 3) ? w1v : w1k, 256, 2048, (ch & 7) * 32, 32, nullptr, W1_T, 2048, 32 * ch, 64 * kb, scr, lane); }
        }
    }
    PHASE_END
    PHASE_BEGIN DECL_PTRS
    if (FAST(1)) {
        pg8::Gemm g{XB, WIN_T, M, pg8::N1PAD, D}; pg8::StaticOrder S; S.init(M, pg8::N1PAD, G, (int)blockIdx.x);
        PG8_LAS float* ctab = (PG8_LAS float*)(ldsl + 131072);
        for (int i = tid; i < 192; i += NTHREADS) ctab[i] = NORMS[i];
        for (int i = tid; i < 4096; i += NTHREADS) ctab[256 + i] = PES[i];
        __syncthreads();
        pg8::Ep1F E{URNN, UGATE, Q, KV, GN, GA, ctab, FLATK, ctab + 256};
        pg8::gemm_phase<pg8::Ep1F, pg8::StaticOrder, true, true>(ldsl, g, S, E);
#if (REPMASK >> 1) & 1
        pg8::gemm_phase<pg8::Ep1F, pg8::StaticOrder, true, true>(ldsl, g, S, E);
#endif
    } else {
        ngemm(ldsf, M, DIN, D, ALf32Scale{x, D, norm_mix}, BLf32{w_in, DIN}, Ep1{RSTD, URNN, UGATE, Q, KV, GN, GA, GB});
    }
    PHASE_END
    PHASE_BEGIN DECL_PTRS
    if (blockIdx.x >= 64) {
        float* scr = ldsf + wave * (64 * 33);
        constexpr int I_WG = 96 * 6, I_PA = 32 * 22, I_PB = 32 * 16, I_WO = 32 * 16, I_WMI = 128 * 16, I_WMO = 32 * 64;
        for (int it = ((int)blockIdx.x - 64) * 8 + wave; it < I_WG + I_PA + I_PB + I_WO + I_WMI + I_WMO; it += ((int)gridDim.x - 64) * 8) {
            int r = it;
            if (r < I_WG) { const int ch = r / 6, kb = r % 6, nb = ch / 24, rr = ch % 24, pn = rr >> 3, l0 = (rr & 7) * 32, bj = l0 >> 7, chn0 = 128 * pn + (l0 & 127);
                int cv = BW - chn0; cv = cv < 0 ? 0 : (cv > 32 ? 32 : cv);
                tr_item((bj ? gate_x_w : gate_a_w) + (size_t)nb * BW * BW, BW, BW, chn0, cv, nullptr, WG_T, XC_LD, 32 * ch, 64 * kb, scr, lane); continue; } r -= I_WG;
            if (r < I_PA) { const int ch = r / 22, kb = r % 22; tr_item(proj_a, D, DRNN, 32 * ch, 32, nullptr, PA_T, YA_LD, 32 * ch, 64 * kb, scr, lane); continue; } r -= I_PA;
            if (r < I_PB) { const int ch = r / 16, kb = r % 16; tr_item(proj_b, D, QW, 32 * ch, 32, nullptr, PB_T, QW, 32 * ch, 64 * kb, scr, lane); continue; } r -= I_PB;
            if (r < I_WO) { const int ch = r / 16, kb = r % 16; tr_item(w_out, D, D, 32 * ch, 32, nullptr, WO_T, D, 32 * ch, 64 * kb, scr, lane); continue; } r -= I_WO;
            if (r < I_WMI) { const int ch = r / 16, kb = r % 16; tr_item(w_mlp_in, DFF, D, 32 * pg8::wide_src(ch), 32, norm_mlp, WMI_T, D, 32 * ch, 64 * kb, scr, lane); continue; } r -= I_WMI;
            { const int ch = r / 64, kb = r % 64; tr_item(w_mlp_out, D, DFF, 32 * ch, 32, nullptr, WMO_T, DFF, 32 * ch, 64 * kb, scr, lane); }
        }
    } else
    if (FAST(3)) {
        pg8::Gemm g{FLATK, W1_T, 16384, 512, 2048}; pg8::OrderC1 S{G, (int)blockIdx.x};
        pg8::EpGeluF E{HIDK, 256};
        pg8::gemm_phase<pg8::EpGeluF, pg8::OrderC1, true, true>(ldsl, g, S, E);
#if (REPMASK >> 3) & 1
        pg8::gemm_phase<pg8::EpGeluF, pg8::OrderC1, true, true>(ldsl, g, S, E);
#endif
    } else {
        ngemm(ldsf, 8192, 256, 2048, ALbf{FLATK, 2048}, BLf32{w1k, 256}, EpGelu{HIDK, 256});
        ngemm(ldsf, 8192, 256, 2048, ALbf{FLATV, 2048}, BLf32{w1v, 256}, EpGelu{HIDV, 256});
    }
    PHASE_END
    PHASE_BEGIN DECL_PTRS
    {
        const int vcu = (G % 8 == 0) ? ((int)blockIdx.x % 8) * (G / 8) + (int)blockIdx.x / 8 : (int)blockIdx.x;
#ifdef ATT_PROBE_MODE
#ifndef ATT_ABL
#define ATT_ABL 0
#endif
        for (int u = vcu; u < 256; u += G) {
            const int bg = u >> 2, s4 = u & 3;
            att::attn_bias_table(bg & 3, rel_bias, lds);
            att::attn_compress_l2(bg, HIDK, HIDV, w2k, w2v, kc_norm, lds);
#pragma unroll 1
            for (int i = 0; i < 8; ++i) { const int qblk = 8 * (i >> 1) + ((i & 1) ? 7 - s4 : s4);
                att::attn_unit<ATT_PROBE_MODE, ATT_ABL>(bg >> 2, bg & 3, qblk, Q, (bf16_t*)dob, KS, VS, KW, VW, GN, rel_bias, lds); }
        }
#endif
        for (int u = vcu; u < 256; u += G) {
            const int bg = u >> 2, s4 = u & 3;
            att::attn_bias_table(bg & 3, rel_bias, lds);
            att::attn_compress_l2(bg, HIDK, HIDV, w2k, w2v, kc_norm, lds);
#pragma unroll 1
            for (int i = 7; i >= 0; --i) { const int qblk = 8 * (i >> 1) + ((i & 1) ? 7 - s4 : s4);
                att::attn_unit<7>(bg >> 2, bg & 3, qblk, Q, Q, KS, VS, KW, VW, GN, rel_bias, lds); }
        }
    }
    for (unsigned it = (unsigned)gtid; it < 4u * (unsigned)(M / 8) * 48u; it += (unsigned)GSZ) {
        const unsigned ch = it % 48u, nr = it / 48u, run = nr & (unsigned)(M / 8 - 1), n = nr >> 12, m0 = run * 8u, t0 = m0 & (unsigned)(T - 1), j0 = ch * 8u;
        bf16_t* dst = XC + ((size_t)n * M + m0) * XC_LD + j0;
        if (j0 >= (unsigned)BW) {
#pragma unroll
            for (int i = 0; i < 8; ++i) *(pg8::u32x4*)(dst + (size_t)i * XC_LD) = (pg8::u32x4){0u, 0u, 0u, 0u};
            continue; }
        const unsigned c = n * BW + j0;
        pg8::u32x4 rows[11];
#pragma unroll
        for (int i = 0; i < 11; ++i) rows[i] = ((int)t0 - 3 + i >= 0) ? *(const pg8::u32x4*)(URNN + (size_t)(m0 - 3 + i) * DRNN + c) : (pg8::u32x4){0u, 0u, 0u, 0u};
        pg8::f32x4 w0[4], w1[4];
#pragma unroll
        for (int kk = 0; kk < 4; ++kk) { w0[kk] = *(const pg8::f32x4*)(conv_w + kk * DRNN + c); w1[kk] = *(const pg8::f32x4*)(conv_w + kk * DRNN + c + 4); }
        const pg8::f32x4 b0 = *(const pg8::f32x4*)(conv_b + c), b1 = *(const pg8::f32x4*)(conv_b + c + 4);
#pragma unroll
        for (int i = 0; i < 8; ++i) { pg8::f32x4 a0 = b0, a1 = b1;
#pragma unroll
            for (int kk = 0; kk < 4; ++kk) { pg8::f32x4 x0, x1; pg8::unpack8(rows[i + kk], x0, x1); a0 += w0[kk] * x0; a1 += w1[kk] * x1; }
            *(pg8::u32x4*)(dst + (size_t)i * XC_LD) = pg8::pack8(a0, a1); }
    }
    PHASE_END
    PHASE_BEGIN DECL_PTRS
    if (FAST(8)) {
        int kg = XC_LD; asm volatile("" : "+s"(kg));
        pg8::Gemm g{XC, WG_T, 4 * M, 4 * 768, kg}; pg8::OrderGate S{G, (int)blockIdx.x};
        pg8::EpGateF E{gate_a_b, gate_x_b, LAMC, XC, LA, UP};
        pg8::gemm_phase<pg8::EpGateF, pg8::OrderGate, true, true>(ldsl, g, S, E);
#if (REPMASK >> 8) & 1
        pg8::gemm_phase<pg8::EpGateF, pg8::OrderGate, true, true>(ldsl, g, S, E);
#endif
    } else {
    for (int n = 0; n < 4; ++n)
        ngemm(ldsf, M, 2 * BW, BW, ALbf{XC + (size_t)n * M * XC_LD, XC_LD}, BLgate{gate_a_w + (size_t)n * BW * BW, gate_x_w + (size_t)n * BW * BW},
              EpGate{n, gate_a_b, gate_x_b, lam, XC + (size_t)n * M * XC_LD, LA, UP});
    }
    PHASE_END
    PHASE_BEGIN_R DECL_PTRS
    for (size_t it = gtid; it < (size_t)NB * 64 * 336; it += GSZ) {
        const int slot = (int)(it % 336), bk = (int)(it / 336), kc = bk & 63, b = bk >> 6, c0 = 4 * slot; const size_t m0 = (size_t)b * T + 32 * kc;
        float h[4] = {0.f, 0.f, 0.f, 0.f}, sl[4] = {0.f, 0.f, 0.f, 0.f};
#pragma unroll 1
        for (int i0 = 0; i0 < 32; i0 += 8) {
            unsigned long long lw[8], uw[8];
#pragma unroll
            for (int i = 0; i < 8; ++i) { lw[i] = *(const unsigned long long*)(LA + (m0 + i0 + i) * DRNN + c0); uw[i] = *(const unsigned long long*)(UP + (m0 + i0 + i) * DRNN + c0); }
#pragma unroll
            for (int i = 0; i < 8; ++i)
#pragma unroll
                for (int e = 0; e < 4; ++e) { const float la = bf2f((bf16_t)(lw[i] >> (16 * e))), up = bf2f((bf16_t)(uw[i] >> (16 * e))); const float av = __builtin_amdgcn_exp2f(la);
                    const float mult = (kc == 0 && i0 + i == 0) ? 1.f : __builtin_amdgcn_sqrtf(fmaxf(0.f, 1.f - av * av)); h[e] = av * h[e] + mult * up; sl[e] += la; }
        }
        *(pg8::f32x4*)(CAR + (size_t)bk * DRNN + c0) = (pg8::f32x4){sl[0], sl[1], sl[2], sl[3]};
        *(pg8::f32x4*)(CBR + (size_t)bk * DRNN + c0) = (pg8::f32x4){h[0], h[1], h[2], h[3]};
    }
    PHASE_END
    PHASE_BEGIN_R DECL_PTRS
    for (size_t it = gtid; it < (size_t)NB * 64 * 352; it += GSZ) {
        const int slot = (int)(it % 352), bk = (int)(it / 352), kc = bk & 63, b = bk >> 6, c0 = 4 * slot; const size_t m0 = (size_t)b * T + 32 * kc;
        if (slot >= 336) { for (int i = 0; i < 32; ++i) *(unsigned long long*)(YA + (m0 + i) * YA_LD + c0) = 0ull; continue; }
        float h[4] = {0.f, 0.f, 0.f, 0.f};
        for (int k0 = 0; k0 < kc; k0 += 8) {
            pg8::f32x4 sa[8], sb[8];
#pragma unroll
            for (int u = 0; u < 8; ++u) { const int k2 = k0 + u < kc ? k0 + u : kc - 1; sa[u] = *(const pg8::f32x4*)(CAR + (size_t)(b * 64 + k2) * DRNN + c0); sb[u] = *(const pg8::f32x4*)(CBR + (size_t)(b * 64 + k2) * DRNN + c0); }
#pragma unroll
            for (int u = 0; u < 8; ++u) if (k0 + u < kc) {
#pragma unroll
                for (int e = 0; e < 4; ++e) h[e] = __builtin_amdgcn_exp2f(sa[u][e]) * h[e] + sb[u][e]; }
        }
#pragma unroll 1
        for (int i0 = 0; i0 < 32; i0 += 8) {
            unsigned long long lw[8], uw[8], gw[8];
#pragma unroll
            for (int i = 0; i < 8; ++i) { lw[i] = *(const unsigned long long*)(LA + (m0 + i0 + i) * DRNN + c0); uw[i] = *(const unsigned long long*)(UP + (m0 + i0 + i) * DRNN + c0); gw[i] = *(const unsigned long long*)(UGATE + (m0 + i0 + i) * DRNN + c0); }
#pragma unroll
            for (int i = 0; i < 8; ++i) { float y[4];
#pragma unroll
                for (int e = 0; e < 4; ++e) { const float la = bf2f((bf16_t)(lw[i] >> (16 * e))), up = bf2f((bf16_t)(uw[i] >> (16 * e))); const float av = __builtin_amdgcn_exp2f(la);
                    const float mult = (kc == 0 && i0 + i == 0) ? 1.f : __builtin_amdgcn_sqrtf(fmaxf(0.f, 1.f - av * av)); h[e] = av * h[e] + mult * up; y[e] = h[e] * bf2f((bf16_t)(gw[i] >> (16 * e))); }
                *(unsigned long long*)(YA + (m0 + i0 + i) * YA_LD + c0) = (unsigned long long)att::cvtpk(y[0], y[1]) | ((unsigned long long)att::cvtpk(y[2], y[3]) << 32); }
        }
    }
    PHASE_END
    PHASE_BEGIN DECL_PTRS
    if (FAST(10)) {
        pg8::Gemm g{YA, PA_T, M, D, YA_LD}; pg8::StaticOrder S; S.init(M, D, G, (int)blockIdx.x);
        pg8::EpT1F E{GA, T1};
        pg8::gemm_phase<pg8::EpT1F, pg8::StaticOrder, true, true>(ldsl, g, S, E);
#if (REPMASK >> 10) & 1
        pg8::gemm_phase<pg8::EpT1F, pg8::StaticOrder, true, true>(ldsl, g, S, E);
#endif
    } else ngemm(ldsf, M, D, DRNN, ALbf{YA, YA_LD}, BLf32{proj_a, D}, EpT1{GA, T1});
    if (FAST(11)) {
        pg8::Gemm g{Q, PB_T, M, D, QW}; pg8::StaticOrder S; S.init(M, D, G, (int)blockIdx.x);
        pg8::EpMergedF E{GB, T1, MERGED};
        pg8::gemm_phase<pg8::EpMergedF, pg8::StaticOrder, true, true>(ldsl, g, S, E);
#if (REPMASK >> 11) & 1
        pg8::gemm_phase<pg8::EpMergedF, pg8::StaticOrder, true, true>(ldsl, g, S, E);
#endif
    } else ngemm(ldsf, M, D, QW, ALbf{Q, QW}, BLf32{proj_b, D}, EpMerged{GB, T1, MERGED});
    PHASE_END
    PHASE_BEGIN DECL_PTRS
    if (FAST(12)) {
        pg8::Gemm g{MERGED, WO_T, M, D, D}; pg8::StaticOrder S; S.init(M, D, G, (int)blockIdx.x);
        pg8::EpHF E{x, H, HB, SSQ};
        pg8::gemm_phase<pg8::EpHF, pg8::StaticOrder, true, true>(ldsl, g, S, E);
#if (REPMASK >> 12) & 1
        pg8::gemm_phase<pg8::EpHF, pg8::StaticOrder, true, true>(ldsl, g, S, E);
#endif
    } else ngemm(ldsf, M, D, D, ALbf{MERGED, D}, BLf32{w_out, D}, EpH{x, H, HB});
    PHASE_END
    PHASE_BEGIN DECL_PTRS
    if (FAST(14)) {
        pg8::Gemm g{HB, WMI_T, M, DFF, D}; pg8::StaticOrder S; S.init(M, DFF, G, (int)blockIdx.x);
        PG8_LAS float* rtab = (PG8_LAS float*)(ldsl + 131072);
        bool tab_ok;
        { pg8::Unit uu; int i = 0;
          for (; i < 16 && S.next(i, uu); ++i) if (tid < 256) { const float* sp = SSQ + (size_t)(uu.pm * 256 + tid) * 16;
                const pg8::f32x4 s0 = *(const pg8::f32x4*)sp, s1 = *(const pg8::f32x4*)(sp + 4), s2 = *(const pg8::f32x4*)(sp + 8), s3 = *(const pg8::f32x4*)(sp + 12); const pg8::f32x4 st = (s0 + s1) + (s2 + s3);
                rtab[i * 256 + tid] = rsqrtf(((st[0] + st[1]) + (st[2] + st[3])) * (1.f / D) + EPS); }
          tab_ok = !(i == 16 && S.next(16, uu)); }
        __syncthreads();
        pg8::EpZF E{tab_ok ? rtab : (PG8_LAS float*)nullptr, SSQ, ZACT};
        pg8::gemm_phase<pg8::EpZF, pg8::StaticOrder, true, true>(ldsl, g, S, E);
#if (REPMASK >> 14) & 1
        pg8::gemm_phase<pg8::EpZF, pg8::StaticOrder, true, true>(ldsl, g, S, E);
#endif
    } else ngemm(ldsf, M, DFF, D, ALbfScale{HB, D, norm_mlp}, BLf32{w_mlp_in, DFF}, EpZ{SSQ, ZACT});
    PHASE_END
    PHASE_BEGIN DECL_PTRS
    if (FAST(15)) {
        pg8::Gemm g{ZACT, WMO_T, M, D, DFF}; pg8::StaticOrder S; S.init(M, D, G, (int)blockIdx.x);
        pg8::EpOutF E{HB, H};
        pg8::gemm_phase<pg8::EpOutF, pg8::StaticOrder, true, true>(ldsl, g, S, E);
#if (REPMASK >> 15) & 1
        pg8::gemm_phase<pg8::EpOutF, pg8::StaticOrder, true, true>(ldsl, g, S, E);
#endif
    } else ngemm(ldsf, M, D, DFF, ALbf{ZACT, DFF}, BLf32{w_mlp_out, D}, EpOut{H});
    PHASE_END
}
constexpr int NPHASES = 11;

extern "C" void kernel_launch(void* const* d_in, const int* in_sizes, int n_in, void* d_out, int out_size, void* d_ws, size_t ws_size, hipStream_t stream) {
    static int grid = 0;
    if (grid == 0) {
        if (n_in != 27 || out_size != M * D || ws_size < WS_END) { fprintf(stderr, "kernel_launch: unexpected shapes n_in %d out %d ws %zu\n", n_in, out_size, ws_size); grid = -1; return; }
        int dev = 0, cus = 0, per_cu = 0;
        (void)hipGetDevice(&dev);
        (void)hipDeviceGetAttribute(&cus, hipDeviceAttributeMultiprocessorCount, dev);
        (void)hipFuncSetAttribute((const void*)fwd, hipFuncAttributeMaxDynamicSharedMemorySize, LDS_BYTES);
        (void)hipOccupancyMaxActiveBlocksPerMultiprocessor(&per_cu, (const void*)fwd, NTHREADS, LDS_BYTES);
        fprintf(stderr, "kernel_launch: cus %d per_cu %d ws_size %zu\n", cus, per_cu, ws_size);
        grid = cus;
    }
    if (grid < 0) return;
    if (hipMemsetAsync(d_ws, 0, 65536, stream) != hipSuccess) { fprintf(stderr, "kernel_launch: hipMemsetAsync failed\n"); return; }
    Args a{};
    for (int i = 0; i < 27; ++i) a.in[i] = (const float*)d_in[i];
    a.out = (float*)d_out; a.ws = (unsigned char*)d_ws; a.ph_lo = 0; a.ph_hi = NPHASES;
    void* args[] = {&a};
    hipError_t e = hipLaunchCooperativeKernel((const void*)fwd, dim3(grid), dim3(NTHREADS), args, LDS_BYTES, stream);
    if (e != hipSuccess) fprintf(stderr, "cooperative launch failed: %s (grid %d)\n", hipGetErrorString(e), grid);
}
```

```cpp
#include <hip/hip_runtime.h>
#include <hip/hip_cooperative_groups.h>
#include <cstdio>
#include <cstdint>
#ifndef FASTMASK
#define FASTMASK 0xFFFFFFFFu
#endif
#define FAST(p) ((FASTMASK >> (p)) & 1u)
namespace cg = cooperative_groups;

typedef unsigned short bf16_t;
constexpr int NTHREADS = 512;
constexpr int LDS_BYTES = 163840;
constexpr size_t MiB = 1u << 20;

constexpr int NB = 16, T = 2048, D = 1024, M = NB * T;
constexpr int DRNN = 1344, BW = 336, QW = 1024, KVW = 256, NH = 16, HD = 64, NG = 4;
constexpr int DIN = 7344, DFF = 4096, NC = 127, NSB = 32, CROWS = NB * NG * NC;
constexpr int C_URNN = 0, C_UGATE = 1344, C_Q = 2688, C_KV = 3712, C_GN = 5248, C_GA = 5296, C_GB = 6320;
constexpr float EPS = 1e-6f, LOG2E = 1.4426950408889634f;
constexpr int YA_LD = 1408, XC_LD = 384;

constexpr size_t WS_RSTD = 1 * MiB, WS_RSTD2 = 1 * MiB + 512 * 1024, WS_KCC = 2 * MiB, WS_VCC = 4 * MiB, WS_SEL = 6 * MiB;
constexpr size_t WS_URNN = 52 * MiB, WS_UGATE = 136 * MiB, WS_Q = 220 * MiB, WS_KV = 284 * MiB  , WS_GN = 380 * MiB, WS_GA = 384 * MiB, WS_GB = 448 * MiB, WS_END = 512 * MiB;
constexpr size_t WS_PES = 1 * MiB + 448 * 1024  , WS_NORMS = 1 * MiB + 384 * 1024, WS_LAMC = 1 * MiB + 256 * 1024, WS_SSQ = 6 * MiB + 512 * 1024  ;
constexpr size_t WS_WIN = 9 * MiB  , WS_WG = 24 * MiB  , WS_W1 = 27 * MiB  , WS_PA = 29 * MiB  , WS_PB = 32 * MiB, WS_WO = 34 * MiB, WS_WMI = 36 * MiB  , WS_WMO = 44 * MiB  ;
constexpr size_t DO_KCB = 104 * MiB  , DO_VCT = 105 * MiB  ;
constexpr size_t DO_VST = 72 * MiB, DO_VWT = 88 * MiB;
constexpr size_t DO_CAR = 112 * MiB, DO_CBR = 120 * MiB;
constexpr size_t DO_XB = 0;
constexpr size_t WS_LA = WS_URNN, WS_UP = WS_KV, WS_T1 = WS_URNN, WS_MERGED = WS_UGATE, WS_HB = WS_GA, WS_ZACT = 52 * MiB;
constexpr size_t DO_FLATK = 64 * MiB, DO_FLATV = 96 * MiB, DO_HIDK = 0, DO_HIDV = 4 * MiB, DO_XC = 0, DO_YA = 0;

__device__ __constant__ unsigned char BUCKET[128] = {0, 1, 2, 3, 4, 5, 6, 7, 8, 9, 10, 11, 12, 13, 14, 15, 16, 16, 16, 17, 17, 18, 18, 18, 19, 19, 19, 20, 20, 20, 20, 21, 21, 21, 21, 22, 22, 22, 22, 22, 23, 23, 23, 23, 23, 23, 24, 24, 24, 24, 24, 24, 25, 25, 25, 25, 25, 25, 25, 26, 26, 26, 26, 26, 26, 26, 26, 27, 27, 27, 27, 27, 27, 27, 27, 27, 27, 28, 28, 28, 28, 28, 28, 28, 28, 28, 28, 29, 29, 29, 29, 29, 29, 29, 29, 29, 29, 29, 29, 30, 30, 30, 30, 30, 30, 30, 30, 30, 30, 30, 30, 30, 30, 31, 31, 31, 31, 31, 31, 31, 31, 31, 31, 31, 31, 31, 31, 31};

__device__ __forceinline__ float bf2f(bf16_t v) { return __uint_as_float((unsigned)v << 16); }
__device__ __forceinline__ bf16_t f2bf(float f) { unsigned u = __float_as_uint(f); return (bf16_t)((u + 0x7fffu + ((u >> 16) & 1u)) >> 16); }
__device__ __forceinline__ float sigmoidf_(float x) { return 1.f / (1.f + __expf(-x)); }
__device__ __forceinline__ float gelu_tanh(float x) { const float u = 0.7978845608028654f * (x + 0.044715f * x * x * x); return 0.5f * x * (1.f + tanhf(u)); }
__device__ __forceinline__ float wave_sum(float v) {
#pragma unroll
    for (int o = 1; o < 64; o <<= 1) v += __shfl_xor(v, o);
    return v;
}

struct Args { const float* in[27]; float* out; unsigned char* ws; int ph_lo, ph_hi; };

template <class AL, class BL, class EP>
__device__ __forceinline__ void ngemm(float* lds, int Mm, int Nn, int Kk, const AL& A, const BL& Bf, const EP& E) {
    float* As = lds;
    float* Bs = lds + 16 * 132;
    const int tid = threadIdx.x, tx = tid & 31, ty = tid >> 5;
    const int tm = (Mm + 127) / 128, tn = (Nn + 127) / 128, ntiles = tm * tn;
    for (int tile = blockIdx.x; tile < ntiles; tile += gridDim.x) {
        const int m0 = (tile / tn) * 128, n0 = (tile % tn) * 128;
        float acc[8][4];
#pragma unroll
        for (int i = 0; i < 8; ++i)
#pragma unroll
            for (int j = 0; j < 4; ++j) acc[i][j] = 0.f;
        for (int k0 = 0; k0 < Kk; k0 += 16) {
            {
                const int m = m0 + (tid >> 2), kb = k0 + (tid & 3) * 4;
#pragma unroll
                for (int i = 0; i < 4; ++i) As[((tid & 3) * 4 + i) * 132 + (tid >> 2)] = (m < Mm && kb + i < Kk) ? A(m, kb + i) : 0.f;
                const int k = k0 + (tid >> 5), nb = n0 + (tid & 31) * 4;
#pragma unroll
                for (int i = 0; i < 4; ++i) Bs[(tid >> 5) * 132 + (tid & 31) * 4 + i] = (k < Kk && nb + i < Nn) ? Bf(k, nb + i) : 0.f;
            }
            __syncthreads();
#pragma unroll 2
            for (int kk = 0; kk < 16; ++kk) {
                float a[8], b[4];
#pragma unroll
                for (int i = 0; i < 8; ++i) a[i] = As[kk * 132 + ty * 8 + i];
#pragma unroll
                for (int j = 0; j < 4; ++j) b[j] = Bs[kk * 132 + tx * 4 + j];
#pragma unroll
                for (int i = 0; i < 8; ++i)
#pragma unroll
                    for (int j = 0; j < 4; ++j) acc[i][j] += a[i] * b[j];
            }
            __syncthreads();
        }
#pragma unroll
        for (int i = 0; i < 8; ++i)
#pragma unroll
            for (int j = 0; j < 4; ++j) { const int m = m0 + ty * 8 + i, n = n0 + tx * 4 + j; if (m < Mm && n < Nn) E(m, n, acc[i][j]); }
    }
}

struct ALbf { const bf16_t* p; int ld; __device__ __forceinline__ float operator()(int m, int k) const { return bf2f(p[(size_t)m * ld + k]); } };
struct ALbfScale { const bf16_t* p; int ld; const float* g; __device__ __forceinline__ float operator()(int m, int k) const { return bf2f(p[(size_t)m * ld + k]) * g[k]; } };
struct ALf32Scale { const float* p; int ld; const float* g; __device__ __forceinline__ float operator()(int m, int k) const { return p[(size_t)m * ld + k] * g[k]; } };
struct BLf32 { const float* p; int ld; __device__ __forceinline__ float operator()(int k, int n) const { return p[(size_t)k * ld + n]; } };
struct BLgate { const float* wa; const float* wx; __device__ __forceinline__ float operator()(int k, int n) const { return n < BW ? wa[k * BW + n] : wx[k * BW + n - BW]; } };

struct Ep1 {
    const float* rstd; bf16_t *urnn, *ugate, *q, *kv, *gn, *ga, *gb;
    __device__ __forceinline__ void operator()(int m, int n, float v) const {
        v *= rstd[m];
        if (n < C_UGATE) urnn[(size_t)m * DRNN + n] = f2bf(v);
        else if (n < C_Q) ugate[(size_t)m * DRNN + n - C_UGATE] = f2bf(gelu_tanh(v));
        else if (n < C_KV) q[(size_t)m * QW + n - C_Q] = f2bf(v);
        else if (n < C_GN) { const int c = n - C_KV; kv[(size_t)(c >> 8) * ((size_t)M * KVW) + (size_t)m * KVW + (c & 255)] = f2bf(v); }
        else if (n < C_GA) gn[(size_t)m * 48 + n - C_GN] = f2bf(sigmoidf_(v));
        else if (n < C_GB) ga[(size_t)m * D + n - C_GA] = f2bf(sigmoidf_(v));
        else gb[(size_t)m * D + n - C_GB] = f2bf(sigmoidf_(v));
    }
};
struct EpGelu { bf16_t* o; int ld; __device__ __forceinline__ void operator()(int m, int n, float v) const { o[(size_t)m * ld + n] = f2bf(gelu_tanh(v)); } };
struct EpGate {
    int nb; const float *ba, *bx, *lam; const bf16_t* xc; bf16_t *la, *up;
    __device__ __forceinline__ void operator()(int m, int n, float v) const {
        if (n < BW) { const int c = nb * BW + n; const float r = sigmoidf_(v + ba[c]); const float sp = log1pf(__expf(-lam[c])); la[(size_t)m * DRNN + c] = f2bf(-8.f * r * sp * LOG2E); }
        else { const int j = n - BW, c = nb * BW + j; const float i = sigmoidf_(v + bx[c]); up[(size_t)m * DRNN + c] = f2bf(i * bf2f(xc[(size_t)m * XC_LD + j])); }
    }
};
struct EpT1 { const bf16_t* g; bf16_t* o; __device__ __forceinline__ void operator()(int m, int n, float v) const { o[(size_t)m * D + n] = f2bf(bf2f(g[(size_t)m * D + n]) * v); } };
struct EpMerged { const bf16_t* g; const bf16_t* t1; bf16_t* o; __device__ __forceinline__ void operator()(int m, int n, float v) const { o[(size_t)m * D + n] = f2bf(bf2f(t1[(size_t)m * D + n]) + bf2f(g[(size_t)m * D + n]) * v); } };
struct EpH { const float* x; float* h; bf16_t* hb; __device__ __forceinline__ void operator()(int m, int n, float v) const { const float r = x[(size_t)m * D + n] + v; h[(size_t)m * D + n] = r; hb[(size_t)m * D + n] = f2bf(r); } };
struct EpZ { const float* ssq; bf16_t* z; __device__ __forceinline__ void operator()(int m, int n, float v) const { float s_ = 0.f; for (int i = 0; i < 16; ++i) s_ += ssq[(size_t)m * 16 + i]; v *= rsqrtf(s_ * (1.f / D) + EPS); v = v > 0.f ? v * v : 0.f; z[(size_t)m * DFF + n] = f2bf(v); } };
struct EpOut { float* o; __device__ __forceinline__ void operator()(int m, int n, float v) const { o[(size_t)m * D + n] += v; } };

namespace pg8 {
#define PG8_LAS __attribute__((address_space(3)))
typedef unsigned short bf16_t;
typedef short bf16x8 __attribute__((ext_vector_type(8)));
typedef float f32x4 __attribute__((ext_vector_type(4)));
typedef unsigned u32x4 __attribute__((ext_vector_type(4)));
constexpr int BM = 256, BK = 64, HALF = 128, HTB = HALF * BK * 2  , STAGE_BYTES = 8 * HTB, NXCD = 8, WGM = 4;

__host__ __device__ __forceinline__ int lds_byte(int r, int c) { const int st = (r >> 4) * 2 + (c >> 5), rr = r & 15, cc = c & 31, ob = rr * 64 + cc * 2; return st * 1024 + (ob ^ (((ob >> 9) & 1) << 5)); }
__host__ __device__ __forceinline__ void stage_rc(int b, int& R, int& C) { const int st = b / 1024, sb = b % 1024, swz = sb ^ (((sb >> 9) & 1) << 5); R = (st >> 1) * 16 + swz / 64; C = (st & 1) * 32 + (swz % 64) / 2; }
__host__ __device__ __forceinline__ int perm32(int rho) { const int n = rho >> 4, i = rho & 15; return 8 * (i >> 2) + 4 * n + (i & 3); }

struct Unit { int pm, pn, ord; };
struct Gemm { const bf16_t* A; const bf16_t* Bt; int M, N, K; };

struct StaticOrder {
    int nM, nN, nwg, G, c;
    __host__ __device__ void init(int M, int N, int G_, int c_) { nM = M / BM; nN = N / BM; nwg = nM * nN; G = G_; c = c_; }
    __host__ __device__ __forceinline__ bool next(int i, Unit& u) const {
        const long L = (long)i * G + c; if (L >= nwg) return false;
        int wgid = (int)L; { const int q = nwg / NXCD, r = nwg % NXCD, xcd = wgid % NXCD, off = wgid / NXCD; wgid = (xcd < r ? xcd * (q + 1) : r * (q + 1) + (xcd - r) * q) + off; }
        const int nig = WGM * nN, gid = wgid / nig, fm = gid * WGM, gsz = (nM - fm) < WGM ? (nM - fm) : WGM;
        u.pm = fm + ((wgid % nig) % gsz); u.pn = (wgid % nig) / gsz; u.ord = i; return true;
    }
    __device__ __forceinline__ void a_ready(const Unit&) const {}
    __device__ __forceinline__ void done(const Unit&) const {}
};

__device__ __forceinline__ unsigned cvt_pk_bf16(float lo, float hi) { unsigned r; asm volatile("v_cvt_pk_bf16_f32 %0, %1, %2" : "=v"(r) : "v"(lo), "v"(hi)); return r; }
typedef float f32x2 __attribute__((ext_vector_type(2)));
template <class Epi, class Sched, bool ALIGN_EPI = false, bool SP2 = false>
__device__ __forceinline__ void gemm_phase(PG8_LAS unsigned char* lds, const Gemm g, const Sched& S, const Epi& E) {
    const int tid = threadIdx.x, wid = __builtin_amdgcn_readfirstlane(tid >> 6), lane = tid & 63, wr = wid >> 2, wc = wid & 3, fr = lane & 15, fq = lane >> 4;
    const int K = g.K, nt = K / BK;
    unsigned voffA[2], voffB[2];
#pragma unroll
    for (int i = 0; i < 2; ++i) { int R, C; stage_rc(tid * 16 + i * 8192, R, C); const int Rb = Epi::PERM ? ((R & ~31) + perm32(R & 31)) : R;
        voffA[i] = (unsigned)(R * K + C) * 2u; voffB[i] = (unsigned)(Rb * K + C) * 2u; }
    const size_t kstep = (size_t)(BK * 2);
    const size_t hstep = (size_t)HALF * K * 2;
    const size_t tstep = 2 * hstep;
    const unsigned ldsw = (unsigned)wid * 1024u;
    const int aoff = lds_byte(wr * 64 + fr, fq * 8), boff = lds_byte(wc * 32 + fr, fq * 8);
#define PG8_SA(b, h) (((b) * 2 + (h)) * HTB)
#define PG8_SB(b, h) ((4 + (b) * 2 + (h)) * HTB)
#define PG8_STAGE(bufoff, gbase, voff) do { _Pragma("unroll") for (int _i = 0; _i < 2; ++_i) \
        __builtin_amdgcn_global_load_lds((const unsigned*)((const char*)(gbase) + (voff)[_i]), (PG8_LAS unsigned*)(lds + (bufoff) + ldsw + _i * 8192), 16, 0, 0); } while (0)
#define PG8_LDA(dst, b, h) do { _Pragma("unroll") for (int m = 0; m < 4; ++m) _Pragma("unroll") for (int k = 0; k < 2; ++k) dst[m][k] = *(const PG8_LAS bf16x8*)(lds + PG8_SA(b, h) + aoff + m * 2048 + k * 1024); } while (0)
#define PG8_LDB(dst, b, h) do { _Pragma("unroll") for (int n = 0; n < 2; ++n) _Pragma("unroll") for (int k = 0; k < 2; ++k) dst[n][k] = *(const PG8_LAS bf16x8*)(lds + PG8_SB(b, h) + boff + n * 2048 + k * 1024); } while (0)
#define PG8_MMA(ai, bj, At, Bt) do { __builtin_amdgcn_s_setprio(1); _Pragma("unroll") for (int m = 0; m < 4; ++m) _Pragma("unroll") for (int n = 0; n < 2; ++n) _Pragma("unroll") for (int k = 0; k < 2; ++k) \
        acc[ai][bj][m][n] = __builtin_amdgcn_mfma_f32_16x16x32_bf16(Bt[n][k], At[m][k], acc[ai][bj][m][n], 0, 0, 0); __builtin_amdgcn_s_setprio(0); } while (0)
#define PG8_WAIT_V(n) asm volatile("s_waitcnt vmcnt(" #n ")" ::: "memory")
#define PG8_WAIT_L(n) asm volatile("s_waitcnt lgkmcnt(" #n ")" ::: "memory")
#define PG8_BAR __builtin_amdgcn_s_barrier()
#define PG8_SCHED __builtin_amdgcn_sched_barrier(0)
    Unit cur, nxt; int ui = 0;
    if (!S.next(0, cur)) return;
    f32x4 acc[2][2][4][2];
#pragma unroll
    for (int a = 0; a < 2; ++a)
#pragma unroll
        for (int b = 0; b < 2; ++b)
#pragma unroll
            for (int m = 0; m < 4; ++m)
#pragma unroll
                for (int n = 0; n < 2; ++n) acc[a][b][m][n] = (f32x4){0.f, 0.f, 0.f, 0.f};
    bf16x8 At[4][2], B0[2][2], B1[2][2];
    const char* cA = (const char*)g.A + (size_t)cur.pm * tstep; const char* cB = (const char*)g.Bt + (size_t)cur.pn * tstep;
    S.a_ready(cur);
    if constexpr (SP2) {
        PG8_STAGE(PG8_SB(0, 0), cB, voffB); PG8_STAGE(PG8_SB(0, 1), cB + hstep, voffB); PG8_STAGE(PG8_SA(0, 0), cA, voffA); PG8_STAGE(PG8_SA(0, 1), cA + hstep, voffA);
        if (wr == 1) PG8_BAR;
        PG8_WAIT_V(2); PG8_BAR;
        PG8_STAGE(PG8_SB(1, 0), cB + kstep, voffB); PG8_STAGE(PG8_SA(1, 0), cA + kstep, voffA); PG8_STAGE(PG8_SB(1, 1), cB + hstep + kstep, voffB);
        PG8_WAIT_V(6); PG8_BAR;
    } else {
        PG8_STAGE(PG8_SB(0, 0), cB, voffB); PG8_STAGE(PG8_SA(0, 0), cA, voffA); PG8_STAGE(PG8_SB(0, 1), cB + hstep, voffB); PG8_STAGE(PG8_SA(0, 1), cA + hstep, voffA);
        if (wr == 1) PG8_BAR;
        PG8_WAIT_V(4); PG8_BAR;
        PG8_STAGE(PG8_SB(1, 0), cB + kstep, voffB); PG8_STAGE(PG8_SA(1, 0), cA + kstep, voffA); PG8_STAGE(PG8_SB(1, 1), cB + hstep + kstep, voffB);
        PG8_WAIT_V(6); PG8_BAR;
    }
    for (;;) {
        const bool has_next = S.next(ui + 1, nxt);
        const char* nA = has_next ? (const char*)g.A + (size_t)nxt.pm * tstep : cA; const char* nB = has_next ? (const char*)g.Bt + (size_t)nxt.pn * tstep : cB;
        for (int t = 0; t < nt; t += 2) {
            const bool last = (t == nt - 2);
            const char* a1 = cA + (size_t)(t + 1) * kstep;
            const char* a2 = last ? nA : cA + (size_t)(t + 2) * kstep; const char* b2 = last ? nB : cB + (size_t)(t + 2) * kstep;
            const char* a3 = a2 + kstep; const char* b3 = b2 + kstep;
            if (last && has_next) S.a_ready(nxt);
            if constexpr (SP2) {
            PG8_LDB(B0, 0, 0); PG8_LDB(B1, 0, 1); PG8_SCHED; PG8_LDA(At, 0, 0); PG8_STAGE(PG8_SA(1, 1), a1 + hstep, voffA);
            PG8_WAIT_V(8); PG8_WAIT_L(0); PG8_BAR; PG8_MMA(0, 0, At, B0); PG8_MMA(0, 1, At, B1); PG8_BAR; PG8_SCHED;
            PG8_LDA(At, 0, 1); PG8_STAGE(PG8_SB(0, 0), b2, voffB); PG8_STAGE(PG8_SB(0, 1), b2 + hstep, voffB); PG8_STAGE(PG8_SA(0, 0), a2, voffA);
            PG8_WAIT_V(8); PG8_WAIT_L(0); PG8_BAR; PG8_MMA(1, 0, At, B0); PG8_MMA(1, 1, At, B1); PG8_BAR; PG8_SCHED;
            PG8_LDB(B0, 1, 0); PG8_LDB(B1, 1, 1); PG8_SCHED; PG8_LDA(At, 1, 0); PG8_STAGE(PG8_SA(0, 1), a2 + hstep, voffA);
            PG8_WAIT_V(8); PG8_WAIT_L(0); PG8_BAR; PG8_MMA(0, 0, At, B0); PG8_MMA(0, 1, At, B1); PG8_BAR; PG8_SCHED;
            PG8_LDA(At, 1, 1); PG8_STAGE(PG8_SB(1, 0), b3, voffB); PG8_STAGE(PG8_SB(1, 1), b3 + hstep, voffB); PG8_STAGE(PG8_SA(1, 0), a3, voffA);
            PG8_WAIT_V(8); PG8_WAIT_L(0); PG8_BAR; PG8_MMA(1, 0, At, B0); PG8_MMA(1, 1, At, B1); PG8_BAR; PG8_SCHED;
            } else {
            PG8_LDB(B0, 0, 0); PG8_SCHED; PG8_LDA(At, 0, 0); PG8_STAGE(PG8_SA(1, 1), a1 + hstep, voffA);
            PG8_WAIT_L(8); PG8_BAR; PG8_WAIT_L(0); PG8_MMA(0, 0, At, B0); PG8_BAR; PG8_SCHED;
            PG8_LDB(B1, 0, 1); PG8_STAGE(PG8_SB(0, 0), b2, voffB);
            PG8_BAR; PG8_WAIT_L(0); PG8_MMA(0, 1, At, B1); PG8_BAR;
            PG8_LDA(At, 0, 1); PG8_STAGE(PG8_SA(0, 0), a2, voffA);
            PG8_BAR; PG8_WAIT_L(0); PG8_MMA(1, 0, At, B0); PG8_BAR; PG8_SCHED;
            PG8_STAGE(PG8_SB(0, 1), b2 + hstep, voffB);
            PG8_WAIT_V(6); PG8_BAR; PG8_MMA(1, 1, At, B1); PG8_BAR;
            PG8_LDB(B0, 1, 0); PG8_SCHED; PG8_LDA(At, 1, 0); PG8_STAGE(PG8_SA(0, 1), a2 + hstep, voffA);
            PG8_WAIT_L(8); PG8_BAR; PG8_WAIT_L(0); PG8_MMA(0, 0, At, B0); PG8_BAR; PG8_SCHED;
            PG8_LDB(B1, 1, 1); PG8_STAGE(PG8_SB(1, 0), b3, voffB);
            PG8_BAR; PG8_WAIT_L(0); PG8_MMA(0, 1, At, B1); PG8_BAR;
            PG8_LDA(At, 1, 1); PG8_STAGE(PG8_SA(1, 0), a3, voffA);
            PG8_BAR; PG8_WAIT_L(0); PG8_MMA(1, 0, At, B0); PG8_BAR; PG8_SCHED;
            PG8_STAGE(PG8_SB(1, 1), b3 + hstep, voffB);
            PG8_WAIT_V(6); PG8_BAR; PG8_MMA(1, 1, At, B1); PG8_BAR;
            }
        }
        if constexpr (ALIGN_EPI) { if (wr == 0) PG8_BAR; }
        if constexpr (!Epi::AFTER_DRAIN) { E(acc, cur, wr, wc, fr, fq); S.done(cur); }
        if (!has_next) break;
#pragma unroll
        for (int a = 0; a < 2; ++a)
#pragma unroll
            for (int b = 0; b < 2; ++b)
#pragma unroll
                for (int m = 0; m < 4; ++m)
#pragma unroll
                    for (int n = 0; n < 2; ++n) acc[a][b][m][n] = (f32x4){0.f, 0.f, 0.f, 0.f};
        cur = nxt; cA = nA; cB = nB; ++ui;
        if constexpr (ALIGN_EPI) { if (wr == 1) PG8_BAR; }
    }
    PG8_WAIT_V(0);
    if constexpr (!ALIGN_EPI) { if (wr == 0) PG8_BAR; }
    PG8_BAR;
    if constexpr (Epi::AFTER_DRAIN) { E.fused(acc, cur, wr, wc, fr, fq, lds, wid, lane); S.done(cur); }
#undef PG8_SA
#undef PG8_SB
#undef PG8_STAGE
#undef PG8_LDA
#undef PG8_LDB
#undef PG8_MMA
#undef PG8_WAIT_V
#undef PG8_WAIT_L
#undef PG8_BAR
#undef PG8_SCHED
}
}

namespace pg8 {
__device__ __forceinline__ float sigm(float x) { return __builtin_amdgcn_rcpf(1.f + __expf(-x)); }
__device__ __forceinline__ float gelu_t(float x) { const float u = 1.5957691216057308f * (x + 0.044715f * x * x * x); return x * __builtin_amdgcn_rcpf(1.f + __expf(-u)); }
__device__ __forceinline__ u32x4 pack8(const f32x4& a, const f32x4& b) { u32x4 w; w.x = cvt_pk_bf16(a[0], a[1]); w.y = cvt_pk_bf16(a[2], a[3]); w.z = cvt_pk_bf16(b[0], b[1]); w.w = cvt_pk_bf16(b[2], b[3]); return w; }
__device__ __forceinline__ void unpack8(const u32x4& w, f32x4& a, f32x4& b) {
    a[0] = __uint_as_float(w.x << 16); a[1] = __uint_as_float(w.x & 0xffff0000u); a[2] = __uint_as_float(w.y << 16); a[3] = __uint_as_float(w.y & 0xffff0000u);
    b[0] = __uint_as_float(w.z << 16); b[1] = __uint_as_float(w.z & 0xffff0000u); b[2] = __uint_as_float(w.w << 16); b[3] = __uint_as_float(w.w & 0xffff0000u); }

struct Ep1F {
    static constexpr bool PERM = true, AFTER_DRAIN = false;
    bf16_t *urnn, *ugate, *q, *kv, *gn, *ga; const PG8_LAS float* norms; bf16_t* flat; const PG8_LAS float* pes;
    __device__ __forceinline__ void operator()(const f32x4 (&acc)[2][2][4][2], const Unit& u, int wr, int wc, int fr, int fq) const {
        const int row0 = u.pm * BM + wr * 64 + fr, pn = u.pn;
        if (pn == 4 || pn == 5) {
            const PG8_LAS float* pe = pes + (pn - 4) * 2048; bf16_t* fl = flat + (size_t)(pn - 4) * 8192 * 2048;
#pragma unroll
            for (int ai = 0; ai < 2; ++ai)
#pragma unroll
                for (int m = 0; m < 4; ++m) { const int mt = row0 + ai * HALF + m * 16, b = mt >> 11, t = mt & (T - 1), c1 = t >> 4, l1 = t & 15; const size_t rb = (size_t)((b * 4 + wc) * NC + c1) * 2048;
#pragma unroll
                    for (int bj = 0; bj < 2; ++bj) { const int d0 = 32 * bj + 8 * fq; const f32x4 v0 = acc[ai][bj][m][0], v1 = acc[ai][bj][m][1];
                        if (c1 < NC) { const PG8_LAS float* p = pe + l1 * 64 + d0; *(u32x4*)(fl + rb + l1 * 64 + d0) = pack8(v0 + *(const PG8_LAS f32x4*)p, v1 + *(const PG8_LAS f32x4*)(p + 4)); }
                        if (c1 > 0) { const PG8_LAS float* p = pe + (l1 + 16) * 64 + d0; *(u32x4*)(fl + rb - 2048 + (l1 + 16) * 64 + d0) = pack8(v0 + *(const PG8_LAS f32x4*)p, v1 + *(const PG8_LAS f32x4*)(p + 4)); } } }
            return;
        }
        if (pn < 10) {
            const bool donorm = pn < 4 || pn == 6 || pn == 8; const PG8_LAS float* g = norms + (pn < 4 ? 0 : (pn == 6 ? 64 : 128)); const float sc = pn < 4 ? 0.125f * LOG2E : 1.f;
            bf16_t* base; int ld;
            if (pn < 4) { base = q + 256 * pn + 64 * wc + 8 * fq; ld = QW; } else { base = kv + (size_t)(pn - 4) * ((size_t)M * KVW) + 64 * wc + 8 * fq; ld = KVW; }
            f32x4 gv[2][2];
#pragma unroll
            for (int bj = 0; bj < 2; ++bj)
#pragma unroll
                for (int n = 0; n < 2; ++n) gv[bj][n] = donorm ? *(const PG8_LAS f32x4*)(g + 32 * bj + 8 * fq + 4 * n) : (f32x4){1.f, 1.f, 1.f, 1.f};
#pragma unroll
            for (int ai = 0; ai < 2; ++ai)
#pragma unroll
                for (int m = 0; m < 4; ++m) {
                    float ss = 0.f;
#pragma unroll
                    for (int bj = 0; bj < 2; ++bj)
#pragma unroll
                        for (int n = 0; n < 2; ++n) { const f32x4 v = acc[ai][bj][m][n]; ss += (v[0] * v[0] + v[1] * v[1]) + (v[2] * v[2] + v[3] * v[3]); }
                    ss += __shfl_xor(ss, 16); ss += __shfl_xor(ss, 32);
                    const float r = donorm ? rsqrtf(ss * (1.f / 64.f) + EPS) * sc : 1.f;
                    bf16_t* rowp = base + (size_t)(row0 + ai * HALF + m * 16) * ld;
#pragma unroll
                    for (int bj = 0; bj < 2; ++bj) *(u32x4*)(rowp + 32 * bj) = pack8(acc[ai][bj][m][0] * r * gv[bj][0], acc[ai][bj][m][1] * r * gv[bj][1]);
                }
        } else if (pn < 18) {
            bf16_t* base = ga + (pn < 14 ? (size_t)0 : (size_t)M * D) + 256 * ((pn - 10) & 3) + 32 * wc + 8 * fq;
#pragma unroll
            for (int ai = 0; ai < 2; ++ai)
#pragma unroll
                for (int m = 0; m < 4; ++m) { bf16_t* rowp = base + (size_t)(row0 + ai * HALF + m * 16) * D;
#pragma unroll
                    for (int bj = 0; bj < 2; ++bj) { f32x4 v0 = acc[ai][bj][m][0], v1 = acc[ai][bj][m][1];
#pragma unroll
                        for (int e = 0; e < 4; ++e) { v0[e] = sigm(v0[e]); v1[e] = sigm(v1[e]); }
                        *(u32x4*)(rowp + bj * HALF) = pack8(v0, v1); } }
        } else { seg3<0>(acc, pn, row0, wc, fq); seg3<1>(acc, pn, row0, wc, fq); }
    }
    template <int BJ> __device__ __forceinline__ void seg3(const f32x4 (&acc)[2][2][4][2], int pn, int row0, int wc, int fq) const {
        const int c = 256 * (pn - 18) + 128 * BJ + 32 * wc;
        if (c < 1344) { bf16_t* base = urnn + c + 8 * fq;
#pragma unroll
            for (int ai = 0; ai < 2; ++ai)
#pragma unroll
                for (int m = 0; m < 4; ++m) *(u32x4*)(base + (size_t)(row0 + ai * HALF + m * 16) * DRNN) = pack8(acc[ai][BJ][m][0], acc[ai][BJ][m][1]);
        } else if (c < 2688) { bf16_t* base = ugate + (c - 1344) + 8 * fq;
#pragma unroll
            for (int ai = 0; ai < 2; ++ai)
#pragma unroll
                for (int m = 0; m < 4; ++m) { f32x4 v0 = acc[ai][BJ][m][0], v1 = acc[ai][BJ][m][1];
#pragma unroll
                    for (int e = 0; e < 4; ++e) { v0[e] = gelu_t(v0[e]); v1[e] = gelu_t(v1[e]); }
                    *(u32x4*)(base + (size_t)(row0 + ai * HALF + m * 16) * DRNN) = pack8(v0, v1); }
        } else if (c + 8 * fq < 2736) { bf16_t* base = gn + (c - 2688) + 8 * fq;
#pragma unroll
            for (int ai = 0; ai < 2; ++ai)
#pragma unroll
                for (int m = 0; m < 4; ++m) { f32x4 v0 = acc[ai][BJ][m][0], v1 = acc[ai][BJ][m][1];
#pragma unroll
                    for (int e = 0; e < 4; ++e) { v0[e] = sigm(v0[e]); v1[e] = sigm(v1[e]); }
                    *(u32x4*)(base + (size_t)(row0 + ai * HALF + m * 16) * 48) = pack8(v0, v1); }
        }
    }
};
__device__ __forceinline__ void win_src(int ch, int& c0, int& cvalid) {
    const int tile = ch >> 3, l0 = (ch & 7) * 32, bj = l0 >> 7, wc = (l0 >> 5) & 3; cvalid = 32;
    if (tile < 4) c0 = C_Q + 256 * tile + 64 * wc + 32 * bj;
    else if (tile < 10) c0 = C_KV + 256 * (tile - 4) + 64 * wc + 32 * bj;
    else if (tile < 14) c0 = C_GA + 256 * (tile - 10) + l0;
    else if (tile < 18) c0 = C_GB + 256 * (tile - 14) + l0;
    else { const int c = 256 * (tile - 18) + l0; if (c < 2688) c0 = c; else if (c < 2736) { c0 = C_GN + c - 2688; cvalid = 2736 - c < 32 ? 2736 - c : 32; } else { c0 = 0; cvalid = 0; } }
}
constexpr int N1PAD = 29 * 256;

struct EpGeluF {
    static constexpr bool PERM = true, AFTER_DRAIN = false;
    bf16_t* O; int ldc;
    __device__ __forceinline__ void operator()(const f32x4 (&acc)[2][2][4][2], const Unit& u, int wr, int wc, int fr, int fq) const {
        const int row0 = u.pm * BM + wr * 64 + fr; bf16_t* base = O + wc * 32 + 8 * fq;
#pragma unroll
        for (int ai = 0; ai < 2; ++ai)
#pragma unroll
            for (int m = 0; m < 4; ++m) { bf16_t* rowp = base + (size_t)(row0 + ai * HALF + m * 16) * ldc;
#pragma unroll
                for (int bj = 0; bj < 2; ++bj) { f32x4 v0 = acc[ai][bj][m][0], v1 = acc[ai][bj][m][1];
#pragma unroll
                    for (int e = 0; e < 4; ++e) { v0[e] = gelu_t(v0[e]); v1[e] = gelu_t(v1[e]); }
                    *(u32x4*)(rowp + bj * HALF) = pack8(v0, v1); } }
    }
};
struct OrderC1 {
    int G, c;
    __device__ __forceinline__ bool next(int i, Unit& u) const { const int L = i * G + c; if (L >= 64) return false; u.pm = L; u.pn = L >> 5; u.ord = i; return true; }
    __device__ __forceinline__ void a_ready(const Unit&) const {}
    __device__ __forceinline__ void done(const Unit&) const {}
};
struct OrderGate {
    int G, c;
    __device__ __forceinline__ bool next(int i, Unit& u) const { const int L = i * G + c; if (L >= 4 * 128 * 3) return false; const int nb = L / 384, r = L % 384; u.pm = nb * 128 + r / 3; u.pn = nb * 3 + r % 3; u.ord = i; return true; }
    __device__ __forceinline__ void a_ready(const Unit&) const {}
    __device__ __forceinline__ void done(const Unit&) const {}
};
struct EpGateF {
    static constexpr bool PERM = true, AFTER_DRAIN = false;
    const float *ba, *bx, *lamc; const bf16_t* xc; bf16_t *la, *up;
    __device__ __forceinline__ void operator()(const f32x4 (&acc)[2][2][4][2], const Unit& u, int wr, int wc, int fr, int fq) const {
        const int nb = u.pn / 3, pn3 = u.pn % 3, ch0 = 128 * pn3 + 32 * wc + 8 * fq; if (ch0 >= BW) return;
        const int c0 = nb * BW + ch0, row0 = (u.pm & 127) * BM + wr * 64 + fr;
        const bf16_t* xcb = xc + (size_t)nb * ((size_t)M * XC_LD) + ch0; bf16_t* lab = la + c0; bf16_t* upb = up + c0;
        const f32x4 bav0 = *(const f32x4*)(ba + c0), bav1 = *(const f32x4*)(ba + c0 + 4), bxv0 = *(const f32x4*)(bx + c0), bxv1 = *(const f32x4*)(bx + c0 + 4), lcv0 = *(const f32x4*)(lamc + c0), lcv1 = *(const f32x4*)(lamc + c0 + 4);
        u32x4 xcv[2][4];
#pragma unroll
        for (int ai = 0; ai < 2; ++ai)
#pragma unroll
            for (int m = 0; m < 4; ++m) xcv[ai][m] = *(const u32x4*)(xcb + (unsigned)(row0 + ai * HALF + m * 16) * (unsigned)XC_LD);
#pragma unroll
        for (int ai = 0; ai < 2; ++ai)
#pragma unroll
            for (int m = 0; m < 4; ++m) { const unsigned row = (unsigned)(row0 + ai * HALF + m * 16);
                f32x4 x0, x1; unpack8(xcv[ai][m], x0, x1);
                f32x4 l0, l1, u0, u1;
#pragma unroll
                for (int e = 0; e < 4; ++e) {
                    l0[e] = sigm(acc[ai][0][m][0][e] + bav0[e]) * lcv0[e]; l1[e] = sigm(acc[ai][0][m][1][e] + bav1[e]) * lcv1[e];
                    u0[e] = sigm(acc[ai][1][m][0][e] + bxv0[e]) * x0[e];   u1[e] = sigm(acc[ai][1][m][1][e] + bxv1[e]) * x1[e]; }
                *(u32x4*)(lab + row * (unsigned)DRNN) = pack8(l0, l1); *(u32x4*)(upb + row * (unsigned)DRNN) = pack8(u0, u1);
                asm volatile("" ::: "memory"); }
    }
};
struct EpT1F {
    static constexpr bool PERM = true, AFTER_DRAIN = false;
    const bf16_t* g; bf16_t* o;
    __device__ __forceinline__ void operator()(const f32x4 (&acc)[2][2][4][2], const Unit& u, int wr, int wc, int fr, int fq) const {
        const int row0 = u.pm * BM + wr * 64 + fr, col0 = u.pn * BM + wc * 32 + 8 * fq;
        u32x4 gv[2][4][2];
#pragma unroll
        for (int ai = 0; ai < 2; ++ai)
#pragma unroll
            for (int m = 0; m < 4; ++m) { const size_t off = (size_t)(row0 + ai * HALF + m * 16) * D + col0;
#pragma unroll
                for (int bj = 0; bj < 2; ++bj) gv[ai][m][bj] = *(const u32x4*)(g + off + bj * HALF); }
#pragma unroll
        for (int ai = 0; ai < 2; ++ai)
#pragma unroll
            for (int m = 0; m < 4; ++m) { const size_t off = (size_t)(row0 + ai * HALF + m * 16) * D + col0;
#pragma unroll
                for (int bj = 0; bj < 2; ++bj) { f32x4 g0, g1; unpack8(gv[ai][m][bj], g0, g1);
                    *(u32x4*)(o + off + bj * HALF) = pack8(acc[ai][bj][m][0] * g0, acc[ai][bj][m][1] * g1); } }
    }
};
struct EpMergedF {
    static constexpr bool PERM = true, AFTER_DRAIN = false;
    const bf16_t* g; const bf16_t* t1; bf16_t* o;
    __device__ __forceinline__ void operator()(const f32x4 (&acc)[2][2][4][2], const Unit& u, int wr, int wc, int fr, int fq) const {
        const int row0 = u.pm * BM + wr * 64 + fr, col0 = u.pn * BM + wc * 32 + 8 * fq;
#pragma unroll
        for (int ai = 0; ai < 2; ++ai) {
            u32x4 gv[4][2], tv[4][2];
#pragma unroll
            for (int m = 0; m < 4; ++m) { const size_t off = (size_t)(row0 + ai * HALF + m * 16) * D + col0;
#pragma unroll
                for (int bj = 0; bj < 2; ++bj) { gv[m][bj] = *(const u32x4*)(g + off + bj * HALF); tv[m][bj] = *(const u32x4*)(t1 + off + bj * HALF); } }
#pragma unroll
            for (int m = 0; m < 4; ++m) { const size_t off = (size_t)(row0 + ai * HALF + m * 16) * D + col0;
#pragma unroll
                for (int bj = 0; bj < 2; ++bj) { f32x4 g0, g1, t0, t1v; unpack8(gv[m][bj], g0, g1); unpack8(tv[m][bj], t0, t1v);
                    *(u32x4*)(o + off + bj * HALF) = pack8(t0 + acc[ai][bj][m][0] * g0, t1v + acc[ai][bj][m][1] * g1); } }
            asm volatile("" ::: "memory");
        }
    }
};
struct EpHF {
    static constexpr bool PERM = true, AFTER_DRAIN = false;
    const float* x; float* h; bf16_t* hb; float* ssq;
    __device__ __forceinline__ void operator()(const f32x4 (&acc)[2][2][4][2], const Unit& u, int wr, int wc, int fr, int fq) const {
        const int row0 = u.pm * BM + wr * 64 + fr, col0 = u.pn * BM + wc * 32 + 8 * fq;
#pragma unroll
        for (int ai = 0; ai < 2; ++ai) {
            f32x4 xv[4][2][2];
#pragma unroll
            for (int m = 0; m < 4; ++m) { const size_t off = (size_t)(row0 + ai * HALF + m * 16) * D + col0;
#pragma unroll
                for (int bj = 0; bj < 2; ++bj) { xv[m][bj][0] = *(const f32x4*)(x + off + bj * HALF); xv[m][bj][1] = *(const f32x4*)(x + off + bj * HALF + 4); } }
#pragma unroll
            for (int m = 0; m < 4; ++m) { const size_t row = (size_t)(row0 + ai * HALF + m * 16), off = row * D + col0; float ss = 0.f;
#pragma unroll
                for (int bj = 0; bj < 2; ++bj) {
                    const f32x4 h0 = xv[m][bj][0] + acc[ai][bj][m][0], h1 = xv[m][bj][1] + acc[ai][bj][m][1];
                    *(u32x4*)(hb + off + bj * HALF) = pack8(h0, h1);
                    ss += (h0[0] * h0[0] + h0[1] * h0[1]) + (h0[2] * h0[2] + h0[3] * h0[3]) + (h1[0] * h1[0] + h1[1] * h1[1]) + (h1[2] * h1[2] + h1[3] * h1[3]); }
                ss += __shfl_xor(ss, 16); ss += __shfl_xor(ss, 32);
                if (fq == 0) ssq[row * 16 + 4 * u.pn + wc] = ss; }
            asm volatile("" ::: "memory");
        }
    }
};
struct EpZF {
    static constexpr bool PERM = true, AFTER_DRAIN = false;
    const PG8_LAS float* rtab; const float* ssq; bf16_t* z;
    __device__ __forceinline__ void operator()(const f32x4 (&acc)[2][2][4][2], const Unit& u, int wr, int wc, int fr, int fq) const {
        const int rl0 = wr * 64 + fr, row0 = u.pm * BM + rl0, col0 = u.pn * BM + wc * 32 + 8 * fq;
#pragma unroll
        for (int ai = 0; ai < 2; ++ai)
#pragma unroll
            for (int m = 0; m < 4; ++m) { const size_t row = (size_t)(row0 + ai * HALF + m * 16);
                float r;
                if (rtab) r = rtab[u.ord * 256 + rl0 + ai * HALF + m * 16];
                else { const f32x4 s0 = *(const f32x4*)(ssq + row * 16), s1 = *(const f32x4*)(ssq + row * 16 + 4), s2 = *(const f32x4*)(ssq + row * 16 + 8), s3 = *(const f32x4*)(ssq + row * 16 + 12);
                    const f32x4 st = (s0 + s1) + (s2 + s3); r = rsqrtf(((st[0] + st[1]) + (st[2] + st[3])) * (1.f / D) + EPS); }
#pragma unroll
                for (int bj = 0; bj < 2; ++bj) { f32x4 v0 = acc[ai][bj][m][0] * r, v1 = acc[ai][bj][m][1] * r;
#pragma unroll
                    for (int e = 0; e < 4; ++e) { v0[e] = v0[e] > 0.f ? v0[e] * v0[e] : 0.f; v1[e] = v1[e] > 0.f ? v1[e] * v1[e] : 0.f; }
                    *(u32x4*)(z + row * DFF + col0 + bj * HALF) = pack8(v0, v1); } }
    }
};
struct EpOutF {
    static constexpr bool PERM = true, AFTER_DRAIN = false;
    const bf16_t* hb; float* o;
    __device__ __forceinline__ void operator()(const f32x4 (&acc)[2][2][4][2], const Unit& u, int wr, int wc, int fr, int fq) const {
        const int row0 = u.pm * BM + wr * 64 + fr, col0 = u.pn * BM + wc * 32 + 8 * fq;
        u32x4 hv[2][4][2];
#pragma unroll
        for (int ai = 0; ai < 2; ++ai)
#pragma unroll
            for (int m = 0; m < 4; ++m) { const size_t off = (size_t)(row0 + ai * HALF + m * 16) * D + col0;
#pragma unroll
                for (int bj = 0; bj < 2; ++bj) hv[ai][m][bj] = *(const u32x4*)(hb + off + bj * HALF); }
#pragma unroll
        for (int ai = 0; ai < 2; ++ai)
#pragma unroll
            for (int m = 0; m < 4; ++m) { float* p = o + (size_t)(row0 + ai * HALF + m * 16) * D + col0;
#pragma unroll
                for (int bj = 0; bj < 2; ++bj) { f32x4 h0, h1; unpack8(hv[ai][m][bj], h0, h1); *(f32x4*)(p + bj * HALF) = h0 + acc[ai][bj][m][0]; *(f32x4*)(p + bj * HALF + 4) = h1 + acc[ai][bj][m][1]; } }
    }
};
}

namespace att {
using pg8::bf16x8; using pg8::f32x4; using pg8::u32x4;
typedef float f32x16 __attribute__((ext_vector_type(16)));
typedef short s16x4 __attribute__((ext_vector_type(4)));
typedef float f32x2_t __attribute__((ext_vector_type(2))); typedef __bf16 bf16x2_t __attribute__((ext_vector_type(2)));
constexpr int KROW = 144, VROW = 144, KT = 64 * KROW, VT = 64 * VROW;
__device__ __forceinline__ int vperm(int kv) { return (kv & ~12) | ((kv & 4) << 1) | ((kv & 8) >> 1); }
constexpr int L_K0 = 0, L_K1 = KT, L_V0 = 2 * KT, L_V1 = 2 * KT + VT, L_BT = 2 * KT + 2 * VT  , L_IMPG = L_BT + 4096 + 64, L_IMPL = L_IMPG + 33792, L_IMP = L_IMPL + 33792, L_SELM = L_IMP + 64 * 33 * 4, L_KC = L_SELM + 512  , VCROW = 272, L_VC = L_KC + 128 * KROW  , L_END = L_VC + 64 * VCROW;
static_assert(L_END <= 163840 - 512, "attention LDS map");
__device__ __forceinline__ int crow(int r, int hi) { return (r & 3) + 8 * (r >> 2) + 4 * hi; }
__device__ __forceinline__ float max3f(float a, float b, float c) { float r; asm("v_max3_f32 %0, %1, %2, %3" : "=v"(r) : "v"(a), "v"(b), "v"(c)); return r; }
__device__ __forceinline__ unsigned cvtpk(float lo, float hi) { f32x2_t v = {lo, hi}; bf16x2_t b = __builtin_convertvector(v, bf16x2_t); return __builtin_bit_cast(unsigned, b); }
__device__ __forceinline__ bf16x8 packp(const f32x16& p, int s) {
    u32x4 w; w.x = cvtpk(p[8 * s + 0], p[8 * s + 1]); w.y = cvtpk(p[8 * s + 2], p[8 * s + 3]); w.z = cvtpk(p[8 * s + 4], p[8 * s + 5]); w.w = cvtpk(p[8 * s + 6], p[8 * s + 7]);
    return __builtin_bit_cast(bf16x8, w); }
__device__ __forceinline__ bf16x8 kfrag(const unsigned char* kbuf, int st, int sp, int q32, int hi) { return *(const bf16x8*)(kbuf + (32 * st + q32) * KROW + (16 * sp + 8 * hi) * 2); }
__device__ __forceinline__ bf16x8 vfrag(const unsigned char* vbuf, int st, int s, int dt, int q32, int hi) { return *(const bf16x8*)(vbuf + (32 * dt + q32) * VROW + (32 * st + 16 * s + 8 * hi) * 2); }
__device__ __forceinline__ f32x16 qk_tile(const unsigned char* kbuf, int st, const bf16x8 (&qf)[4], int q32, int hi) {
    f32x16 s = {};
#pragma unroll
    for (int sp = 0; sp < 4; ++sp) s = __builtin_amdgcn_mfma_f32_32x32x16_bf16(kfrag(kbuf, st, sp, q32, hi), qf[sp], s, 0, 0, 0);
    return s; }
__device__ __forceinline__ void pv_tile(f32x16 (&o)[2], const unsigned char* vbuf, int st, const f32x16& p, int q32, int hi) {
#pragma unroll
    for (int s = 0; s < 2; ++s) { const bf16x8 pb = packp(p, s);
#pragma unroll
        for (int dt = 0; dt < 2; ++dt) o[dt] = __builtin_amdgcn_mfma_f32_32x32x16_bf16(vfrag(vbuf, st, s, dt, q32, hi), pb, o[dt], 0, 0, 0); }
}
struct Stage { u32x4 k, v; };
__device__ __forceinline__ void stage_load(Stage& s, const bf16_t* Kblk  , int ldk, const bf16_t* Vblk  , int ldv, int tid) {
    const int row = tid >> 3, ch = tid & 7;
    s.k = *(const u32x4*)(Kblk + (size_t)row * ldk + ch * 8); s.v = *(const u32x4*)(Vblk + (size_t)row * ldv + ch * 8); }
__device__ __forceinline__ void stage_store(const Stage& s, unsigned char* kbuf, unsigned char* vbuf, int tid) {
    const int row = tid >> 3, ch = tid & 7;
    *(u32x4*)(kbuf + row * KROW + ch * 16) = s.k;
    *(u32x4*)(vbuf + row * VROW + ch * 16) = s.v; }

struct SoftState { float mhat, l; f32x16 cneg; };
constexpr float ATT_THR = 8.0f;
template <int BR, int ABL>
__device__ __forceinline__ void block64(f32x16 (&o)[2], SoftState& ss, const unsigned char* kbuf, const unsigned char* vbuf, int dj, bool selbit, bool anyunsel, const bf16x8 (&qf)[4], const float* bt2,
                                        int q32, int hi, int tl) {
    f32x16 s0 = ss.cneg, s1 = ss.cneg;
#pragma unroll
    for (int sp = 0; sp < 4; ++sp) { s0 = __builtin_amdgcn_mfma_f32_32x32x16_bf16(kfrag(kbuf, 0, sp, q32, hi), qf[sp], s0, 0, 0, 0); s1 = __builtin_amdgcn_mfma_f32_32x32x16_bf16(kfrag(kbuf, 1, sp, q32, hi), qf[sp], s1, 0, 0, 0); }
    __builtin_amdgcn_sched_barrier(0);
    bf16x8 vf0[2][2], vf1[2][2];
#pragma unroll
    for (int s = 0; s < 2; ++s)
#pragma unroll
        for (int dt = 0; dt < 2; ++dt) vf0[s][dt] = vfrag(vbuf, 0, s, dt, q32, hi);
    __builtin_amdgcn_sched_barrier(0);
    if (dj <= 2) {
        const int basei = 64 * dj + tl + 64 - 4 * hi - 27; const float* bt0 = bt2 + basei; const float* bt1 = bt0 - 32;
#pragma unroll
        for (int r = 0; r < 16; ++r) { const int cr = (r & 3) + 8 * (r >> 2); s0[r] += bt0[27 - cr]; s1[r] += bt1[27 - cr]; }
    } else if (BR == 1 && dj == 8) {
        const int basei = tl - 4 * hi;
#pragma unroll
        for (int r = 0; r < 16; ++r) { const int cr = (r & 3) + 8 * (r >> 2);
            s0[r] += __int_as_float(((cr - basei - 1) >> 31) & 0xf149f2cau); s1[r] += __int_as_float(((cr + 32 - basei - 1) >> 31) & 0xf149f2cau); }
    }
    float rm = max3f(s0[0], s0[1], s1[0]), rm2 = max3f(s0[2], s0[3], s1[1]);
    rm = max3f(rm, s1[2], s1[3]);
#pragma unroll
    for (int r = 4; r < 16; r += 4) { rm = max3f(rm, s0[r], s0[r + 1]); rm2 = max3f(rm2, s0[r + 2], s0[r + 3]); rm = max3f(rm, s1[r], s1[r + 1]); rm2 = max3f(rm2, s1[r + 2], s1[r + 3]); }
    rm = max3f(rm, rm2, rm2);
    if (BR == 0) rm = selbit ? rm : -1e30f;
    if (__any(rm > ATT_THR)) {
        const float rmc = fmaxf(rm, __shfl_xor(rm, 32)), dl = fmaxf(rmc, 0.f), f = __builtin_amdgcn_exp2f(-dl);
        ss.mhat += dl; ss.l *= f;
#pragma unroll
        for (int r = 0; r < 16; ++r) { s0[r] -= dl; s1[r] -= dl; ss.cneg[r] -= dl; o[0][r] *= f; o[1][r] *= f; }
    }
    float ps = 0.f, ps1 = 0.f, ps2 = 0.f, ps3 = 0.f;
#pragma unroll
    for (int r = 0; r < 16; r += 2) { s0[r] = __builtin_amdgcn_exp2f(s0[r]); s0[r + 1] = __builtin_amdgcn_exp2f(s0[r + 1]); ps += s0[r]; ps2 += s0[r + 1]; }
    const unsigned pm = (BR == 0 && !selbit) ? 0u : 0xffffffffu;
    bf16x8 pb0[2];
#pragma unroll
    for (int s = 0; s < 2; ++s) { pb0[s] = packp(s0, s);
        if (BR == 0 && anyunsel) { u32x4 w = __builtin_bit_cast(u32x4, pb0[s]); w.x &= pm; w.y &= pm; w.z &= pm; w.w &= pm; pb0[s] = __builtin_bit_cast(bf16x8, w); } }
    __builtin_amdgcn_sched_barrier(0);
#pragma unroll
    for (int i = 0; i < 4; ++i) { const int s = i >> 1, dt = i & 1;
        o[dt] = __builtin_amdgcn_mfma_f32_32x32x16_bf16(vf0[s][dt], pb0[s], o[dt], 0, 0, 0);
#pragma unroll
        for (int e = 0; e < 4; ++e) s1[4 * i + e] = __builtin_amdgcn_exp2f(s1[4 * i + e]);
        __builtin_amdgcn_sched_barrier(0); }
#pragma unroll
    for (int s = 0; s < 2; ++s)
#pragma unroll
        for (int dt = 0; dt < 2; ++dt) vf1[s][dt] = vfrag(vbuf, 1, s, dt, q32, hi);
#pragma unroll
    for (int r = 0; r < 16; r += 2) { ps1 += s1[r]; ps3 += s1[r + 1]; }
    ps = (ps + ps1) + (ps2 + ps3);
    if (BR == 0) ps = selbit ? ps : 0.f;
    ss.l += ps;
#pragma unroll
    for (int s = 0; s < 2; ++s) { bf16x8 pb = packp(s1, s);
        if (BR == 0 && anyunsel) { u32x4 w = __builtin_bit_cast(u32x4, pb); w.x &= pm; w.y &= pm; w.z &= pm; w.w &= pm; pb = __builtin_bit_cast(bf16x8, w); }
#pragma unroll
        for (int dt = 0; dt < 2; ++dt) o[dt] = __builtin_amdgcn_mfma_f32_32x32x16_bf16(vf1[s][dt], pb, o[dt], 0, 0, 0); }
}
__device__ __forceinline__ void stage_load_t(Stage& s, const bf16_t* Kblk, const bf16_t* Vblk, int tid) {
    s.k = *(const u32x4*)(Kblk + (size_t)(tid >> 3) * KVW + (tid & 7) * 8); s.v = *(const u32x4*)(Vblk + (size_t)(tid & 63) * KVW + (tid >> 6) * 8); }
__device__ __forceinline__ void stage_store_t(const Stage& s, unsigned char* kbuf, unsigned char* vbuf, int tid) {
    const int row = tid >> 3, ch = tid & 7;
    *(u32x4*)(kbuf + row * KROW + ch * 16) = s.k;
    unsigned short* vp = (unsigned short*)(vbuf + ((tid >> 6) * 8) * VROW + vperm(tid & 63) * 2);
    vp[0 * (VROW / 2)] = (unsigned short)s.v.x; vp[1 * (VROW / 2)] = (unsigned short)(s.v.x >> 16); vp[2 * (VROW / 2)] = (unsigned short)s.v.y; vp[3 * (VROW / 2)] = (unsigned short)(s.v.y >> 16);
    vp[4 * (VROW / 2)] = (unsigned short)s.v.z; vp[5 * (VROW / 2)] = (unsigned short)(s.v.z >> 16); vp[6 * (VROW / 2)] = (unsigned short)s.v.w; vp[7 * (VROW / 2)] = (unsigned short)(s.v.w >> 16); }
template <int BR, int ABL>
__device__ __forceinline__ void branch(float* outl  , const Stage* first  , float gate, const bf16_t* Kg  , const bf16_t* Vg  ,
                                       int qblk, unsigned unionmask, unsigned mysel, const bf16x8 (&qf)[4], const float* bt2  , float cb  ,
                                       unsigned char* lds, int tid, int q32, int hi, int tl) {
    const int jlo = BR == 0 ? 0 : (qblk - 8 < 0 ? 0 : qblk - 8);
    f32x16 o[2]; o[0] = f32x16{}; o[1] = f32x16{};
    SoftState ss; ss.mhat = 0.f; ss.l = 0.f;
#pragma unroll
    for (int r = 0; r < 16; ++r) ss.cneg[r] = cb;
#define ATT_NEXT(jv) do { --(jv); if (BR == 0) { while ((jv) >= jlo && !((unionmask >> (jv)) & 1u)) --(jv); } } while (0)
#define ATT_LOAD(sg, jv) do { const int jl_ = (jv) < jlo ? jlo : (jv); if (!(ABL & 8)) stage_load_t(sg, Kg + (size_t)jl_ * 64 * KVW, Vg + (size_t)jl_ * 64 * KVW, tid); else { sg.k = (u32x4){(unsigned)jl_, 0u, 0u, 0u}; sg.v = sg.k; } } while (0)
#define ATT_SEL(jv) (BR == 0 ? (((mysel >> (jv)) & 1u) != 0u) : true)
    int jA = qblk, jB = qblk, jC;
    Stage sA, sB;
    if (first) sA = *first; else ATT_LOAD(sA, jA);
    ATT_NEXT(jB); ATT_LOAD(sB, jB);
    stage_store_t(sA, lds + L_K0, lds + L_V0, tid);
    __syncthreads();
    for (;;) {
        jC = jB; if (jB >= jlo) ATT_NEXT(jC);
        ATT_LOAD(sA, jC);
        { const bool sel = ATT_SEL(jA); if (BR == 1 || __any(sel)) block64<BR, ABL>(o, ss, lds + L_K0, lds + L_V0, qblk - jA, sel, BR == 0 && __any(!sel), qf, bt2, q32, hi, tl); }
        if (jB < jlo) break;
        if (!(ABL & 16)) stage_store_t(sB, lds + L_K1, lds + L_V1, tid);
        if (!(ABL & 4)) __syncthreads();
        jA = jC; if (jC >= jlo) ATT_NEXT(jA);
        ATT_LOAD(sB, jA);
        { const bool sel = ATT_SEL(jB); if (BR == 1 || __any(sel)) block64<BR, ABL>(o, ss, lds + L_K1, lds + L_V1, qblk - jB, sel, BR == 0 && __any(!sel), qf, bt2, q32, hi, tl); }
        if (jC < jlo) break;
        if (!(ABL & 16)) stage_store_t(sA, lds + L_K0, lds + L_V0, tid);
        if (!(ABL & 4)) __syncthreads();
        jB = jA; jA = jC;
    }
#undef ATT_NEXT
#undef ATT_LOAD
#undef ATT_SEL
    float lrun = ss.l; lrun += __shfl_xor(lrun, 32);
    const float f = gate / lrun;
#pragma unroll
    for (int r = 0; r < 16; ++r) { outl[r * 64] += o[0][r] * f; outl[(16 + r) * 64] += o[1][r] * f; }
    __syncthreads();
}

__device__ __forceinline__ void attn_bias_table(int g, const float* rel_bias, unsigned char* lds) {
    float* bt = (float*)(lds + L_BT); const int tid = threadIdx.x;
#pragma unroll
    for (int i = 0; i < 2; ++i) { const int e = tid + 512 * i, hh = e >> 8, ix = (e & 255) - 64; const float cbh = rel_bias[31 * NH + g * 4 + hh] * LOG2E; bt[e] = ix < 0 ? -1e30f : rel_bias[BUCKET[ix > 127 ? 127 : ix] * NH + g * 4 + hh] * LOG2E - cbh; }
    if (tid < 4) bt[1024 + tid] = rel_bias[31 * NH + g * 4 + tid] * LOG2E;
    __syncthreads();
}
__device__ __forceinline__ void attn_compress_l2(int bg, const bf16_t* HIDK, const bf16_t* HIDV, const float* w2k, const float* w2v, const float* kc_norm, unsigned char* lds) {
    const int tid = threadIdx.x, lane = tid & 63, wave = tid >> 6, q32 = lane & 31, hi = lane >> 5, which = wave >> 2, c = 32 * (wave & 3) + q32; const bool okc = c < NC;
    const bf16_t* hrow = (which ? HIDV : HIDK) + (size_t)(bg * NC + (okc ? c : 0)) * 256; const float* w2 = which ? w2v : w2k;
    f32x16 acc[2]; acc[0] = f32x16{}; acc[1] = f32x16{};
    for (int s = 0; s < 16; ++s) {
        const bf16x8 bfrag = *(const bf16x8*)(hrow + 16 * s + 8 * hi);
#pragma unroll
        for (int nt = 0; nt < 2; ++nt) { const float* wp = w2 + (size_t)(16 * s + 8 * hi) * HD + 32 * nt + q32;
            u32x4 aw; aw.x = cvtpk(wp[0], wp[HD]); aw.y = cvtpk(wp[2 * HD], wp[3 * HD]); aw.z = cvtpk(wp[4 * HD], wp[5 * HD]); aw.w = cvtpk(wp[6 * HD], wp[7 * HD]);
            acc[nt] = __builtin_amdgcn_mfma_f32_32x32x16_bf16(__builtin_bit_cast(bf16x8, aw), bfrag, acc[nt], 0, 0, 0); }
    }
    if (which) {
        unsigned short* vp = (unsigned short*)(lds + L_VC) + vperm(c);
#pragma unroll
        for (int nt = 0; nt < 2; ++nt)
#pragma unroll
            for (int q = 0; q < 16; ++q) vp[(32 * nt + crow(q, hi)) * (VCROW / 2)] = okc ? (unsigned short)(cvtpk(acc[nt][q], 0.f) & 0xffffu) : (unsigned short)0;
    } else {
        float ss = 0.f;
#pragma unroll
        for (int nt = 0; nt < 2; ++nt)
#pragma unroll
            for (int q = 0; q < 16; ++q) ss += acc[nt][q] * acc[nt][q];
        ss += __shfl_xor(ss, 32); const float rn = okc ? rsqrtf(ss * (1.f / HD) + EPS) : 0.f;
#pragma unroll
        for (int nt = 0; nt < 2; ++nt)
#pragma unroll
            for (int rg = 0; rg < 4; ++rg) { const int n0 = 32 * nt + 8 * rg + 4 * hi; const f32x4 gk = *(const f32x4*)(kc_norm + n0);
                *(unsigned long long*)(lds + L_KC + c * KROW + n0 * 2) = (unsigned long long)cvtpk(acc[nt][4 * rg] * rn * gk[0], acc[nt][4 * rg + 1] * rn * gk[1]) | ((unsigned long long)cvtpk(acc[nt][4 * rg + 2] * rn * gk[2], acc[nt][4 * rg + 3] * rn * gk[3]) << 32); }
    }
    __syncthreads();
}
__device__ __forceinline__ bf16x8 vfragc(const unsigned char* vcbuf, int tile, int s, int dt, int q32, int hi) { return *(const bf16x8*)(vcbuf + (32 * dt + q32) * VCROW + (32 * tile + 16 * s + 8 * hi) * 2); }
template <int MODE, int ABL = 0>
__device__ __forceinline__ void attn_unit(int b, int g, int qblk, const bf16_t* Q, bf16_t* O, const bf16_t* KSb, const bf16_t* VSb, const bf16_t* KWb, const bf16_t* VWb,
                                          const bf16_t* GN, const float* rel_bias, unsigned char* lds) {
    int tid = threadIdx.x; asm volatile("" : "+v"(tid));
    const int lane = tid & 63, wave = tid >> 6, q32 = lane & 31, hi = lane >> 5, hr = wave >> 1, th = wave & 1, h = g * 4 + hr, tl = 32 * th + q32, t = 64 * qblk + tl, bg = b * 4 + g;
    const size_t m = (size_t)b * T + t;
    float* bt = (float*)(lds + L_BT); float* impg = (float*)(lds + L_IMPG); float* impl = (float*)(lds + L_IMPL); float* imp = (float*)(lds + L_IMP); unsigned* selm = (unsigned*)(lds + L_SELM);
    bf16x8 qf[4];
#pragma unroll
    for (int sp = 0; sp < 4; ++sp) qf[sp] = *(const bf16x8*)(Q + m * QW + h * HD + 16 * sp + 8 * hi);
    const float g0 = bf2f(GN[m * 48 + h * 3 + 0]), g1 = bf2f(GN[m * 48 + h * 3 + 1]), g2 = bf2f(GN[m * 48 + h * 3 + 2]);
    f32x16 out[2];
    {
        const float* bte = bt + hr * 256 + 64; const float cbh = bt[1024 + hr];
        const int ncv = t >= 31 ? ((t - 31) >> 4) + 1 : 0;
        f32x16 sc[4]; float mx = -1e20f;
#pragma unroll
        for (int tile = 0; tile < 4; ++tile) {
            sc[tile] = qk_tile(lds + L_KC, tile, qf, q32, hi);
            __builtin_amdgcn_sched_barrier(0);
#pragma unroll
            for (int r = 0; r < 16; ++r) { const int c = 32 * tile + crow(r, hi);
                int dist = t - 31 - 16 * c; const float pen = __int_as_float(((ncv - 1 - c) >> 31) & 0xf149f2cau);
                dist = dist < 0 ? 0 : (dist > 127 ? 127 : dist);
                const float v = (sc[tile][r] + (bte[dist] + cbh)) + pen; sc[tile][r] = v; mx = fmaxf(mx, v); }
            __builtin_amdgcn_sched_barrier(0);
        }
        mx = fmaxf(mx, __shfl_xor(mx, 32));
        float l = 0.f;
#pragma unroll
        for (int tile = 0; tile < 4; ++tile)
#pragma unroll
            for (int r = 0; r < 16; ++r) { const float p = __builtin_amdgcn_exp2f(sc[tile][r] - mx); sc[tile][r] = p; l += p; }
        l += __shfl_xor(l, 32);
        const float inv = l > 0.f ? 1.f / l : 0.f;
#pragma unroll
        for (int tile = 0; tile < 4; ++tile)
#pragma unroll
            for (int r = 0; r < 16; ++r) sc[tile][r] *= inv;
        __builtin_amdgcn_sched_barrier(0);
        if (qblk > 15)
#pragma unroll
        for (int tile = 0; tile < 4; ++tile)
#pragma unroll
            for (int rg = 0; rg < 4; ++rg) { const int j = 8 * tile + 2 * rg + hi;
                impg[(hr * 64 + tl) * 33 + j] = (sc[tile][4 * rg] + sc[tile][4 * rg + 1]) + (sc[tile][4 * rg + 2] + sc[tile][4 * rg + 3]);
                impl[(hr * 64 + tl) * 33 + j] = sc[tile][4 * rg + 3]; }
        __builtin_amdgcn_sched_barrier(0);
        f32x16 o[2]; o[0] = f32x16{}; o[1] = f32x16{};
#pragma unroll
        for (int tile = 0; tile < 4; ++tile) {
#pragma unroll
            for (int s = 0; s < 2; ++s) { const bf16x8 pb = packp(sc[tile], s);
#pragma unroll
                for (int dt = 0; dt < 2; ++dt) o[dt] = __builtin_amdgcn_mfma_f32_32x32x16_bf16(vfragc(lds + L_VC, tile, s, dt, q32, hi), pb, o[dt], 0, 0, 0); }
            __builtin_amdgcn_sched_barrier(0); }
#pragma unroll
        for (int r = 0; r < 16; ++r) { out[0][r] = o[0][r] * g0; out[1][r] = o[1][r] * g0; }
    }
    const bf16_t* Kgs = KSb + (size_t)b * T * KVW + g * HD; const bf16_t* Kgw = KWb + (size_t)b * T * KVW + g * HD;
    const bf16_t* Vgs = VSb + (size_t)b * T * KVW + g * HD; const bf16_t* Vgw = VWb + (size_t)b * T * KVW + g * HD;
    Stage sfirst; stage_load_t(sfirst, Kgs + (size_t)qblk * 64 * KVW, Vgs + (size_t)qblk * 64 * KVW, tid);
    unsigned mysel, uni;
    if (qblk > 15) {
    __syncthreads();
    {
        const int stl = tid >> 3, jq = tid & 7;
#pragma unroll
        for (int e = 0; e < 4; ++e) { const int j = 4 * jq + e; float s = 0.f;
#pragma unroll
            for (int r = 0; r < 4; ++r) { s += impg[(r * 64 + stl) * 33 + j]; if (j > 0) s += impl[(r * 64 + stl) * 33 + j - 1]; }
            imp[stl * 33 + j] = s; }
        __syncthreads();
        unsigned bits = 0u;
        {
            float iv[32];
#pragma unroll
            for (int k = 0; k < 32; ++k) iv[k] = imp[stl * 33 + k];
#pragma unroll
            for (int e = 0; e < 4; ++e) { const int j = 4 * jq + e; float vj = iv[0];
#pragma unroll
                for (int k = 1; k < 32; ++k) vj = (k == j) ? iv[k] : vj;
                int rank = 0;
#pragma unroll
                for (int k = 1; k < 30; ++k) { const bool cand = k <= qblk - 2; rank += (cand && (iv[k] > vj || (iv[k] == vj && k < j))) ? 1 : 0; }
                if (j == 0 || j == qblk - 1 || j == qblk) bits |= 1u << j; else if (j < qblk - 1 && rank < 13) bits |= 1u << j; }
        }
        bits |= __shfl_xor(bits, 1); bits |= __shfl_xor(bits, 2); bits |= __shfl_xor(bits, 4);
        if (jq == 0) selm[stl] = bits;
    }
    __syncthreads();
    mysel = selm[tl]; uni = selm[lane];
#pragma unroll
    for (int o = 1; o < 64; o <<= 1) uni |= __shfl_xor(uni, o);
    } else { mysel = uni = (1u << (qblk + 1)) - 1u; }
    float* outl = (float*)(lds + L_IMPG) + wave * 2048 + lane;
#pragma unroll
    for (int r = 0; r < 16; ++r) { outl[r * 64] = out[0][r]; outl[(16 + r) * 64] = out[1][r]; }
    if (MODE & 2) branch<0, ABL>(outl, &sfirst, g1, Kgs, Vgs, qblk, uni, mysel, qf, bt + hr * 256, bt[1024 + hr], lds, tid, q32, hi, tl);
    if (MODE & 4) branch<1, ABL>(outl, nullptr, g2, Kgw, Vgw, qblk, 0xffffffffu, 0xffffffffu, qf, bt + hr * 256, bt[1024 + hr], lds, tid, q32, hi, tl);
    bf16_t* orow = O + m * QW + h * HD;
#pragma unroll
    for (int dt = 0; dt < 2; ++dt)
#pragma unroll
        for (int rg = 0; rg < 4; ++rg)
            *(unsigned long long*)(orow + 32 * dt + 8 * rg + 4 * hi) = (unsigned long long)cvtpk(outl[(16 * dt + 4 * rg) * 64], outl[(16 * dt + 4 * rg + 1) * 64]) | ((unsigned long long)cvtpk(outl[(16 * dt + 4 * rg + 2) * 64], outl[(16 * dt + 4 * rg + 3) * 64]) << 32);
}
}

__device__ __forceinline__ void tr_item(const float* W, int ldw, int kvalid, int c0, int cvalid, const float* kscale, bf16_t* WT, int ldt, int r0, int k0, float* scr, int lane) {
#pragma unroll
    for (int i = 0; i < 32; ++i) { const int kk = 2 * i + (lane >> 5), col = lane & 31, k = k0 + kk;
        float v = 0.f; if (k < kvalid && col < cvalid) { v = W[(size_t)k * ldw + c0 + col]; if (kscale) v *= kscale[k]; }
        scr[kk * 33 + col] = v; }
    asm volatile("s_waitcnt lgkmcnt(0)" ::: "memory");
    const int c = lane & 7;
#pragma unroll
    for (int j = 0; j < 4; ++j) { const int n = (lane >> 3) + 8 * j; const float* s = scr + (8 * c) * 33 + n;
        pg8::u32x4 o; o.x = pg8::cvt_pk_bf16(s[0 * 33], s[1 * 33]); o.y = pg8::cvt_pk_bf16(s[2 * 33], s[3 * 33]); o.z = pg8::cvt_pk_bf16(s[4 * 33], s[5 * 33]); o.w = pg8::cvt_pk_bf16(s[6 * 33], s[7 * 33]);
        *(pg8::u32x4*)(WT + (size_t)(r0 + n) * ldt + k0 + 8 * c) = o; }
    asm volatile("s_waitcnt lgkmcnt(0)" ::: "memory");
}

#define LAS __attribute__((address_space(3)))
#define XB_TMO      128
#define XB_XCNT(j)  (256  + 64 * (j))
#define XB_XSUB(j)  (1280 + 64 * (j))
#define XB_XGEN(j)  (2304 + 64 * (j))
#define XB_TOP      3328
#define XB_TOPGEN   3392
#define XCD_BAR_WORDS 3456
#define XB_SPIN_CAP (1u << 18)

__device__ __forceinline__ unsigned xb_ld(unsigned* p)              { return __hip_atomic_load(p, __ATOMIC_RELAXED, __HIP_MEMORY_SCOPE_AGENT); }
__device__ __forceinline__ unsigned xb_add(unsigned* p, unsigned v) { return __hip_atomic_fetch_add(p, v, __ATOMIC_RELAXED, __HIP_MEMORY_SCOPE_AGENT); }
__device__ __forceinline__ unsigned xb_xcc_id() { return (unsigned)__builtin_amdgcn_s_getreg((3 << 11) | 20) & 0xFu; }
#define XB_SPIN(cond, bar) do { unsigned _sp = 0; while (cond) { __builtin_amdgcn_s_sleep(1); \
    if ((++_sp & 255u) == 0u) { if (xb_ld(&(bar)[XB_TMO])) break; if (_sp > XB_SPIN_CAP) { atomicAdd(&(bar)[XB_TMO], 1u); break; } } } } while (0)

struct XcdBarrier {
    unsigned* bar; unsigned x;
    volatile LAS unsigned* st;
};

__device__ __forceinline__ XcdBarrier xcd_barrier_post(unsigned* bar, volatile LAS unsigned* st) {
    XcdBarrier b; b.bar = bar; b.x = xb_xcc_id(); b.st = st;
    if (threadIdx.x == 0) (void)xb_add(&bar[XB_XCNT(b.x)], 1u);
    return b;
}
__device__ __forceinline__ void xcd_barrier_complete(unsigned* bar, unsigned x, unsigned& nloc, unsigned& nx) {
    const unsigned G = gridDim.x * gridDim.y * gridDim.z;
    unsigned sum, cnt, mine, sp = 0u;
    for (;;) {
        sum = 0u; cnt = 0u; mine = 0u;
#pragma unroll
        for (unsigned j = 0; j < 16; ++j) { const unsigned c = xb_ld(&bar[XB_XCNT(j)]); sum += c; cnt += (c > 0u) ? 1u : 0u; mine = (j == x) ? c : mine; }
        if (sum == G) break;
        __builtin_amdgcn_s_sleep(1);
        if ((++sp & 255u) == 0u) { if (xb_ld(&bar[XB_TMO])) break; if (sp > XB_SPIN_CAP) { atomicAdd(&bar[XB_TMO], 1u); break; } }
    }
    nloc = mine > 0u ? mine : 1u; nx = cnt > 0u ? cnt : 1u;
}

__device__ __forceinline__ void xcd_barrier(const XcdBarrier& b) {
    asm volatile("s_waitcnt vmcnt(0)" ::: "memory");
    __syncthreads();
    if (threadIdx.x == 0) {
        unsigned* bar = b.bar;
        __builtin_amdgcn_s_waitcnt(0);
        unsigned nloc = b.st[0], nx = b.st[1];
        if (nloc == 0u) { xcd_barrier_complete(bar, b.x, nloc, nx); b.st[0] = nloc; b.st[1] = nx; }
        const unsigned old = xb_add(&bar[XB_XSUB(b.x)], 1u);
        const unsigned gen = old / nloc;
        if (old + 1u == (gen + 1u) * nloc) {
            __builtin_amdgcn_fence(__ATOMIC_RELEASE, "agent");
            asm volatile("s_waitcnt vmcnt(0)" ::: "memory");
            const unsigned og = xb_add(&bar[XB_TOP], 1u);
            const unsigned tg = og / nx;
            if (og + 1u == (tg + 1u) * nx) xb_add(&bar[XB_TOPGEN], 1u);
            else XB_SPIN(xb_ld(&bar[XB_TOPGEN]) == tg, bar);
            __builtin_amdgcn_fence(__ATOMIC_ACQUIRE, "agent");
            xb_add(&bar[XB_XGEN(b.x)], 1u);
            asm volatile("s_waitcnt vmcnt(0)" ::: "memory");
        } else {
            XB_SPIN(xb_ld(&bar[XB_XGEN(b.x)]) == gen, bar);
            __builtin_amdgcn_fence(__ATOMIC_ACQUIRE, "agent");
            asm volatile("s_waitcnt vmcnt(0)" ::: "memory");
        }
    }
    __syncthreads();
}

#define DECL_PTRS \
    size_t zoff_ = 0; asm volatile("" : "+s"(zoff_));     \
    unsigned char* ws = a.ws + zoff_; unsigned char* dob = (unsigned char*)a.out + zoff_; \
    const float *x = a.in[0], *norm_mix = a.in[1], *w_in = a.in[2], *conv_w = a.in[3], *conv_b = a.in[4], *gate_a_w = a.in[5], *gate_a_b = a.in[6], *gate_x_w = a.in[7], *gate_x_b = a.in[8], \
                *lam = a.in[9], *pe_k = a.in[10], *w1k = a.in[11], *w2k = a.in[12], *pe_v = a.in[13], *w1v = a.in[14], *w2v = a.in[15], *q_norm = a.in[16], *kc_norm = a.in[17], *ks_norm = a.in[18], \
                *kw_norm = a.in[19], *rel_bias = a.in[20], *proj_a = a.in[21], *proj_b = a.in[22], *w_out = a.in[23], *norm_mlp = a.in[24], *w_mlp_in = a.in[25], *w_mlp_out = a.in[26]; \
    float* RSTD = (float*)(ws + WS_RSTD); float* KCC = (float*)(ws + WS_KCC); float* VCC = (float*)(ws + WS_VCC); unsigned* SEL = (unsigned*)(ws + WS_SEL); \
    bf16_t *URNN = (bf16_t*)(ws + WS_URNN), *UGATE = (bf16_t*)(ws + WS_UGATE), *Q = (bf16_t*)(ws + WS_Q), *KV = (bf16_t*)(ws + WS_KV), *GN = (bf16_t*)(ws + WS_GN), *GA = (bf16_t*)(ws + WS_GA), *GB = (bf16_t*)(ws + WS_GB); \
    bf16_t *KCr = KV, *VCr = KV + (size_t)M * KVW, *KS = KV + 2 * (size_t)M * KVW, *VS = KV + 3 * (size_t)M * KVW, *KW = KV + 4 * (size_t)M * KVW, *VW = KV + 5 * (size_t)M * KVW; \
    bf16_t *LA = (bf16_t*)(ws + WS_LA), *UP = (bf16_t*)(ws + WS_UP), *T1 = (bf16_t*)(ws + WS_T1), *MERGED = (bf16_t*)(ws + WS_MERGED), *HB = (bf16_t*)(ws + WS_HB), *ZACT = (bf16_t*)(ws + WS_ZACT); \
    bf16_t *FLATK = (bf16_t*)(dob + DO_FLATK), *FLATV = (bf16_t*)(dob + DO_FLATV), *HIDK = (bf16_t*)(dob + DO_HIDK), *HIDV = (bf16_t*)(dob + DO_HIDV), *XC = (bf16_t*)(dob + DO_XC), *YA = (bf16_t*)(dob + DO_YA); \
    float* H = (float*)dob; \
    float* LAMC = (float*)(ws + WS_LAMC); float* NORMS = (float*)(ws + WS_NORMS); float* PES = (float*)(ws + WS_PES); float* SSQ = (float*)(ws + WS_SSQ); \
    bf16_t *WIN_T = (bf16_t*)(ws + WS_WIN), *WG_T = (bf16_t*)(ws + WS_WG), *W1_T = (bf16_t*)(ws + WS_W1), *PA_T = (bf16_t*)(ws + WS_PA), *PB_T = (bf16_t*)(ws + WS_PB), *WO_T = (bf16_t*)(ws + WS_WO), *WMI_T = (bf16_t*)(ws + WS_WMI), *WMO_T = (bf16_t*)(ws + WS_WMO); \
    float *CAR = (float*)(dob + DO_CAR), *CBR = (float*)(dob + DO_CBR); \
    bf16_t* XB = (bf16_t*)(dob + DO_XB); bf16_t *KCB = (bf16_t*)(dob + DO_KCB), *VCT = (bf16_t*)(dob + DO_VCT), *VST = (bf16_t*)(dob + DO_VST), *VWT = (bf16_t*)(dob + DO_VWT); \
    (void)0;
__global__ void __launch_bounds__(NTHREADS, 2) fwd(Args a) {
    extern __shared__ __attribute__((aligned(16))) unsigned char lds[];
    float* ldsf = (float*)lds;
    const int tid = threadIdx.x, lane = tid & 63, wave = tid >> 6;
    const int gw = blockIdx.x * 8 + wave, NGW = gridDim.x * 8;
    const size_t gtid = (size_t)blockIdx.x * NTHREADS + tid, GSZ = (size_t)gridDim.x * NTHREADS;
    unsigned char* ws0 = a.ws;
    PG8_LAS unsigned char* ldsl = (PG8_LAS unsigned char*)lds;
    const int G = gridDim.x;
    const int lo = a.ph_lo, hi = a.ph_hi;
    volatile LAS unsigned* MISC = (volatile LAS unsigned*)((LAS unsigned char*)lds + LDS_BYTES - 256);
    if (tid < 32) MISC[tid] = 0u;
    __syncthreads();
    XcdBarrier bar = xcd_barrier_post((unsigned*)(ws0 + 16384), MISC + 8);
    int ph = 0;
#ifndef PHMASK
#define PHMASK 0xFFFFFFFFu
#endif
#ifndef REPMASK
#define REPMASK 0u
#endif
#define PHASE_BEGIN if (lo <= ph && ph < hi && ((PHMASK >> ph) & 1u)) {
#define PHASE_BEGIN_R if (lo <= ph && ph < hi && ((PHMASK >> ph) & 1u)) for (int rep_ = 0; rep_ < (((REPMASK >> (16 + ph)) & 1u) ? 2 : 1); ++rep_) {
#define PHASE_END } { const bool sync_ = (lo <= ph && ph + 1 < hi); ++ph; if (sync_) xcd_barrier(bar); }

    PHASE_BEGIN_R DECL_PTRS
    for (int m0 = 2 * gw; m0 < M; m0 += 2 * NGW) {
        pg8::f32x4 v[2][4]; float s[2] = {0.f, 0.f};
#pragma unroll
        for (int u = 0; u < 2; ++u) { const pg8::f32x4* xr = (const pg8::f32x4*)(x + (size_t)(m0 + u) * D) + lane;
#pragma unroll
            for (int j = 0; j < 4; ++j) v[u][j] = xr[64 * j]; }
#pragma unroll
        for (int u = 0; u < 2; ++u)
#pragma unroll
            for (int j = 0; j < 4; ++j) s[u] += (v[u][j][0] * v[u][j][0] + v[u][j][1] * v[u][j][1]) + (v[u][j][2] * v[u][j][2] + v[u][j][3] * v[u][j][3]);
#pragma unroll
        for (int o = 1; o < 64; o <<= 1) { s[0] += __shfl_xor(s[0], o); s[1] += __shfl_xor(s[1], o); }
#pragma unroll
        for (int u = 0; u < 2; ++u) { const float r = rsqrtf(s[u] * (1.f / D) + EPS); if (lane == 0) RSTD[m0 + u] = r;
            unsigned long long* o8 = (unsigned long long*)(XB + (size_t)(m0 + u) * D) + lane;
#pragma unroll
            for (int j = 0; j < 4; ++j) { const pg8::f32x4 gg = *((const pg8::f32x4*)norm_mix + lane + 64 * j); const pg8::f32x4 y = v[u][j] * r * gg;
                o8[64 * j] = (unsigned long long)pg8::cvt_pk_bf16(y[0], y[1]) | ((unsigned long long)pg8::cvt_pk_bf16(y[2], y[3]) << 32); } }
    }
    for (size_t i = gtid; i < DRNN; i += GSZ) LAMC[i] = -8.f * log1pf(__expf(-lam[i])) * LOG2E;
    for (size_t i = gtid; i < 4096; i += GSZ) PES[i] = i < 2048 ? pe_k[i] : pe_v[i - 2048];
    for (size_t i = gtid; i < 192; i += GSZ) NORMS[i] = i < 64 ? q_norm[i] : (i < 128 ? ks_norm[i - 64] : kw_norm[i - 128]);
    {
        float* scr = ldsf + wave * (64 * 33);
        constexpr int I_WIN = (pg8::N1PAD / 32) * 16, I_W1 = 16 * 32;
        for (int it = gw; it < I_WIN + I_W1; it += NGW) {
            int r = it;
            if (r < I_WIN) { const int ch = r / 16, kb = r % 16; int c0, cv; pg8::win_src(ch, c0, cv); tr_item(w_in, DIN, D, c0, cv, nullptr, WIN_T, D, 32 * ch, 64 * kb, scr, lane); continue; } r -= I_WIN;
            { const int ch = r / 32, kb = r % 32; tr_item((ch >> 3) ? w1v : w1k, 256, 2048, (ch & 7) * 32, 32, nullptr, W1_T, 2048, 32 * ch, 64 * kb, scr, lane); }
        }
    }
    PHASE_END
    PHASE_BEGIN DECL_PTRS
    if (FAST(1)) {
        pg8::Gemm g{XB, WIN_T, M, pg8::N1PAD, D}; pg8::StaticOrder S; S.init(M, pg8::N1PAD, G, (int)blockIdx.x);
        PG8_LAS float* ctab = (PG8_LAS float*)(ldsl + 131072);
        for (int i = tid; i < 192; i += NTHREADS) ctab[i] = NORMS[i];
        for (int i = tid; i < 4096; i += NTHREADS) ctab[256 + i] = PES[i];
        __syncthreads();
        pg8::Ep1F E{URNN, UGATE, Q, KV, GN, GA, ctab, FLATK, ctab + 256};
        pg8::gemm_phase<pg8::Ep1F, pg8::StaticOrder, true, true>(ldsl, g, S, E);
#if (REPMASK >> 1) & 1
        pg8::gemm_phase<pg8::Ep1F, pg8::StaticOrder, true, true>(ldsl, g, S, E);
#endif
    } else {
        ngemm(ldsf, M, DIN, D, ALf32Scale{x, D, norm_mix}, BLf32{w_in, DIN}, Ep1{RSTD, URNN, UGATE, Q, KV, GN, GA, GB});
    }
    PHASE_END
    PHASE_BEGIN DECL_PTRS
    if (blockIdx.x >= 64) {
        float* scr = ldsf + wave * (64 * 33);
        constexpr int I_WG = 96 * 6, I_PA = 32 * 22, I_PB = 32 * 16, I_WO = 32 * 16, I_WMI = 128 * 16, I_WMO = 32 * 64;
        for (int it = ((int)blockIdx.x - 64) * 8 + wave; it < I_WG + I_PA + I_PB + I_WO + I_WMI + I_WMO; it += ((int)gridDim.x - 64) * 8) {
            int r = it;
            if (r < I_WG) { const int ch = r / 6, kb = r % 6, nb = ch / 24, rr = ch % 24, pn = rr >> 3, l0 = (rr & 7) * 32, bj = l0 >> 7, chn0 = 128 * pn + (l0 & 127);
                int cv = BW - chn0; cv = cv < 0 ? 0 : (cv > 32 ? 32 : cv);
                tr_item((bj ? gate_x_w : gate_a_w) + (size_t)nb * BW * BW, BW, BW, chn0, cv, nullptr, WG_T, XC_LD, 32 * ch, 64 * kb, scr, lane); continue; } r -= I_WG;
            if (r < I_PA) { const int ch = r / 22, kb = r % 22; tr_item(proj_a, D, DRNN, 32 * ch, 32, nullptr, PA_T, YA_LD, 32 * ch, 64 * kb, scr, lane); continue; } r -= I_PA;
            if (r < I_PB) { const int ch = r / 16, kb = r % 16; tr_item(proj_b, D, QW, 32 * ch, 32, nullptr, PB_T, QW, 32 * ch, 64 * kb, scr, lane); continue; } r -= I_PB;
            if (r < I_WO) { const int ch = r / 16, kb = r % 16; tr_item(w_out, D, D, 32 * ch, 32, nullptr, WO_T, D, 32 * ch, 64 * kb, scr, lane); continue; } r -= I_WO;
            if (r < I_WMI) { const int ch = r / 16, kb = r % 16; tr_item(w_mlp_in, DFF, D, 32 * ch, 32, norm_mlp, WMI_T, D, 32 * ch, 64 * kb, scr, lane); continue; } r -= I_WMI;
            { const int ch = r / 64, kb = r % 64; tr_item(w_mlp_out, D, DFF, 32 * ch, 32, nullptr, WMO_T, DFF, 32 * ch, 64 * kb, scr, lane); }
        }
    } else
    if (FAST(3)) {
        pg8::Gemm g{FLATK, W1_T, 16384, 512, 2048}; pg8::OrderC1 S{G, (int)blockIdx.x};
        pg8::EpGeluF E{HIDK, 256};
        pg8::gemm_phase<pg8::EpGeluF, pg8::OrderC1, true, true>(ldsl, g, S, E);
#if (REPMASK >> 3) & 1
        pg8::gemm_phase<pg8::EpGeluF, pg8::OrderC1, true, true>(ldsl, g, S, E);
#endif
    } else {
        ngemm(ldsf, 8192, 256, 2048, ALbf{FLATK, 2048}, BLf32{w1k, 256}, EpGelu{HIDK, 256});
        ngemm(ldsf, 8192, 256, 2048, ALbf{FLATV, 2048}, BLf32{w1v, 256}, EpGelu{HIDV, 256});
    }
    PHASE_END
    PHASE_BEGIN DECL_PTRS
    {
        const int vcu = (G % 8 == 0) ? ((int)blockIdx.x % 8) * (G / 8) + (int)blockIdx.x / 8 : (int)blockIdx.x;
#ifdef ATT_PROBE_MODE
#ifndef ATT_ABL
#define ATT_ABL 0
#endif
        for (int u = vcu; u < 256; u += G) {
            const int bg = u >> 2, s4 = u & 3;
            att::attn_bias_table(bg & 3, rel_bias, lds);
            att::attn_compress_l2(bg, HIDK, HIDV, w2k, w2v, kc_norm, lds);
#pragma unroll 1
            for (int i = 0; i < 8; ++i) { const int qblk = 8 * (i >> 1) + ((i & 1) ? 7 - s4 : s4);
                att::attn_unit<ATT_PROBE_MODE, ATT_ABL>(bg >> 2, bg & 3, qblk, Q, (bf16_t*)dob, KS, VS, KW, VW, GN, rel_bias, lds); }
        }
#endif
        for (int u = vcu; u < 256; u += G) {
            const int bg = u >> 2, s4 = u & 3;
            att::attn_bias_table(bg & 3, rel_bias, lds);
            att::attn_compress_l2(bg, HIDK, HIDV, w2k, w2v, kc_norm, lds);
#pragma unroll 1
            for (int i = 7; i >= 0; --i) { const int qblk = 8 * (i >> 1) + ((i & 1) ? 7 - s4 : s4);
                att::attn_unit<7>(bg >> 2, bg & 3, qblk, Q, Q, KS, VS, KW, VW, GN, rel_bias, lds); }
        }
    }
    for (unsigned it = (unsigned)gtid; it < 4u * (unsigned)(M / 8) * 48u; it += (unsigned)GSZ) {
        const unsigned ch = it % 48u, nr = it / 48u, run = nr & (unsigned)(M / 8 - 1), n = nr >> 12, m0 = run * 8u, t0 = m0 & (unsigned)(T - 1), j0 = ch * 8u;
        bf16_t* dst = XC + ((size_t)n * M + m0) * XC_LD + j0;
        if (j0 >= (unsigned)BW) {
#pragma unroll
            for (int i = 0; i < 8; ++i) *(pg8::u32x4*)(dst + (size_t)i * XC_LD) = (pg8::u32x4){0u, 0u, 0u, 0u};
            continue; }
        const unsigned c = n * BW + j0;
        pg8::u32x4 rows[11];
#pragma unroll
        for (int i = 0; i < 11; ++i) rows[i] = ((int)t0 - 3 + i >= 0) ? *(const pg8::u32x4*)(URNN + (size_t)(m0 - 3 + i) * DRNN + c) : (pg8::u32x4){0u, 0u, 0u, 0u};
        pg8::f32x4 w0[4], w1[4];
#pragma unroll
        for (int kk = 0; kk < 4; ++kk) { w0[kk] = *(const pg8::f32x4*)(conv_w + kk * DRNN + c); w1[kk] = *(const pg8::f32x4*)(conv_w + kk * DRNN + c + 4); }
        const pg8::f32x4 b0 = *(const pg8::f32x4*)(conv_b + c), b1 = *(const pg8::f32x4*)(conv_b + c + 4);
#pragma unroll
        for (int i = 0; i < 8; ++i) { pg8::f32x4 a0 = b0, a1 = b1;
#pragma unroll
            for (int kk = 0; kk < 4; ++kk) { pg8::f32x4 x0, x1; pg8::unpack8(rows[i + kk], x0, x1); a0 += w0[kk] * x0; a1 += w1[kk] * x1; }
            *(pg8::u32x4*)(dst + (size_t)i * XC_LD) = pg8::pack8(a0, a1); }
    }
    PHASE_END
    PHASE_BEGIN DECL_PTRS
    if (FAST(8)) {
        int kg = XC_LD; asm volatile("" : "+s"(kg));
        pg8::Gemm g{XC, WG_T, 4 * M, 4 * 768, kg}; pg8::OrderGate S{G, (int)blockIdx.x};
        pg8::EpGateF E{gate_a_b, gate_x_b, LAMC, XC, LA, UP};
        pg8::gemm_phase<pg8::EpGateF, pg8::OrderGate, true, true>(ldsl, g, S, E);
#if (REPMASK >> 8) & 1
        pg8::gemm_phase<pg8::EpGateF, pg8::OrderGate, true, true>(ldsl, g, S, E);
#endif
    } else {
    for (int n = 0; n < 4; ++n)
        ngemm(ldsf, M, 2 * BW, BW, ALbf{XC + (size_t)n * M * XC_LD, XC_LD}, BLgate{gate_a_w + (size_t)n * BW * BW, gate_x_w + (size_t)n * BW * BW},
              EpGate{n, gate_a_b, gate_x_b, lam, XC + (size_t)n * M * XC_LD, LA, UP});
    }
    PHASE_END
    PHASE_BEGIN_R DECL_PTRS
    for (size_t it = gtid; it < (size_t)NB * 64 * 336; it += GSZ) {
        const int slot = (int)(it % 336), bk = (int)(it / 336), kc = bk & 63, b = bk >> 6, c0 = 4 * slot; const size_t m0 = (size_t)b * T + 32 * kc;
        float h[4] = {0.f, 0.f, 0.f, 0.f}, sl[4] = {0.f, 0.f, 0.f, 0.f};
#pragma unroll 1
        for (int i0 = 0; i0 < 32; i0 += 8) {
            unsigned long long lw[8], uw[8];
#pragma unroll
            for (int i = 0; i < 8; ++i) { lw[i] = *(const unsigned long long*)(LA + (m0 + i0 + i) * DRNN + c0); uw[i] = *(const unsigned long long*)(UP + (m0 + i0 + i) * DRNN + c0); }
#pragma unroll
            for (int i = 0; i < 8; ++i)
#pragma unroll
                for (int e = 0; e < 4; ++e) { const float la = bf2f((bf16_t)(lw[i] >> (16 * e))), up = bf2f((bf16_t)(uw[i] >> (16 * e))); const float av = __builtin_amdgcn_exp2f(la);
                    const float mult = (kc == 0 && i0 + i == 0) ? 1.f : __builtin_amdgcn_sqrtf(fmaxf(0.f, 1.f - av * av)); h[e] = av * h[e] + mult * up; sl[e] += la; }
        }
        *(pg8::f32x4*)(CAR + (size_t)bk * DRNN + c0) = (pg8::f32x4){sl[0], sl[1], sl[2], sl[3]};
        *(pg8::f32x4*)(CBR + (size_t)bk * DRNN + c0) = (pg8::f32x4){h[0], h[1], h[2], h[3]};
    }
    PHASE_END
    PHASE_BEGIN_R DECL_PTRS
    for (size_t it = gtid; it < (size_t)NB * 16 * 352; it += GSZ) {
        const int slot = (int)(it % 352), bs = (int)(it / 352), kg = bs & 15, b = bs >> 4, kc0 = 4 * kg, c0 = 4 * slot; const size_t m0 = (size_t)b * T + 128 * kg;
        if (slot >= 336) { for (int i = 0; i < 128; ++i) *(unsigned long long*)(YA + (m0 + i) * YA_LD + c0) = 0ull; continue; }
        unsigned long long la_[8], ua_[8], ga_[8], lb_[8], ub_[8], gb_[8];
#define SC_LOAD(L_, U_, G_, i0_) _Pragma("unroll") for (int i = 0; i < 8; ++i) { L_[i] = *(const unsigned long long*)(LA + (m0 + (i0_) + i) * DRNN + c0); U_[i] = *(const unsigned long long*)(UP + (m0 + (i0_) + i) * DRNN + c0); G_[i] = *(const unsigned long long*)(UGATE + (m0 + (i0_) + i) * DRNN + c0); }
#define SC_SCAN(L_, U_, G_, i0_) _Pragma("unroll") for (int i = 0; i < 8; ++i) { float y[4]; \
            _Pragma("unroll") for (int e = 0; e < 4; ++e) { const float la = bf2f((bf16_t)(L_[i] >> (16 * e))), up = bf2f((bf16_t)(U_[i] >> (16 * e))); const float av = __builtin_amdgcn_exp2f(la); \
                const float mult = (kg == 0 && (i0_) + i == 0) ? 1.f : __builtin_amdgcn_sqrtf(fmaxf(0.f, 1.f - av * av)); h[e] = av * h[e] + mult * up; y[e] = h[e] * bf2f((bf16_t)(G_[i] >> (16 * e))); } \
            *(unsigned long long*)(YA + (m0 + (i0_) + i) * YA_LD + c0) = (unsigned long long)att::cvtpk(y[0], y[1]) | ((unsigned long long)att::cvtpk(y[2], y[3]) << 32); }
        SC_LOAD(la_, ua_, ga_, 0)
        float h[4] = {0.f, 0.f, 0.f, 0.f};
        for (int k0 = 0; k0 < kc0; k0 += 16) {
            pg8::f32x4 sa[16], sb[16];
#pragma unroll
            for (int u = 0; u < 16; ++u) { const int k2 = k0 + u < kc0 ? k0 + u : kc0 - 1; sa[u] = *(const pg8::f32x4*)(CAR + (size_t)(b * 64 + k2) * DRNN + c0); sb[u] = *(const pg8::f32x4*)(CBR + (size_t)(b * 64 + k2) * DRNN + c0); }
#pragma unroll
            for (int u = 0; u < 16; ++u) if (k0 + u < kc0) {
#pragma unroll
                for (int e = 0; e < 4; ++e) h[e] = __builtin_amdgcn_exp2f(sa[u][e]) * h[e] + sb[u][e]; }
        }
#pragma unroll 1
        for (int r0 = 0; r0 < 128; r0 += 16) {
            SC_LOAD(lb_, ub_, gb_, r0 + 8) SC_SCAN(la_, ua_, ga_, r0)
            if (r0 + 16 < 128) { SC_LOAD(la_, ua_, ga_, r0 + 16) }
            SC_SCAN(lb_, ub_, gb_, r0 + 8)
        }
#undef SC_LOAD
#undef SC_SCAN
    }
    PHASE_END
    PHASE_BEGIN DECL_PTRS
    if (FAST(10)) {
        pg8::Gemm g{YA, PA_T, M, D, YA_LD}; pg8::StaticOrder S; S.init(M, D, G, (int)blockIdx.x);
        pg8::EpT1F E{GA, T1};
        pg8::gemm_phase<pg8::EpT1F, pg8::StaticOrder, true, true>(ldsl, g, S, E);
#if (REPMASK >> 10) & 1
        pg8::gemm_phase<pg8::EpT1F, pg8::StaticOrder, true, true>(ldsl, g, S, E);
#endif
    } else ngemm(ldsf, M, D, DRNN, ALbf{YA, YA_LD}, BLf32{proj_a, D}, EpT1{GA, T1});
    if (FAST(11)) {
        pg8::Gemm g{Q, PB_T, M, D, QW}; pg8::StaticOrder S; S.init(M, D, G, (int)blockIdx.x);
        pg8::EpMergedF E{GB, T1, MERGED};
        pg8::gemm_phase<pg8::EpMergedF, pg8::StaticOrder, true, true>(ldsl, g, S, E);
#if (REPMASK >> 11) & 1
        pg8::gemm_phase<pg8::EpMergedF, pg8::StaticOrder, true, true>(ldsl, g, S, E);
#endif
    } else ngemm(ldsf, M, D, QW, ALbf{Q, QW}, BLf32{proj_b, D}, EpMerged{GB, T1, MERGED});
    PHASE_END
    PHASE_BEGIN DECL_PTRS
    if (FAST(12)) {
        pg8::Gemm g{MERGED, WO_T, M, D, D}; pg8::StaticOrder S; S.init(M, D, G, (int)blockIdx.x);
        pg8::EpHF E{x, H, HB, SSQ};
        pg8::gemm_phase<pg8::EpHF, pg8::StaticOrder, true, true>(ldsl, g, S, E);
#if (REPMASK >> 12) & 1
        pg8::gemm_phase<pg8::EpHF, pg8::StaticOrder, true, true>(ldsl, g, S, E);
#endif
    } else ngemm(ldsf, M, D, D, ALbf{MERGED, D}, BLf32{w_out, D}, EpH{x, H, HB});
    PHASE_END
    PHASE_BEGIN DECL_PTRS
    if (FAST(14)) {
        pg8::Gemm g{HB, WMI_T, M, DFF, D}; pg8::StaticOrder S; S.init(M, DFF, G, (int)blockIdx.x);
        PG8_LAS float* rtab = (PG8_LAS float*)(ldsl + 131072);
        bool tab_ok;
        { pg8::Unit uu; int i = 0;
          for (; i < 16 && S.next(i, uu); ++i) if (tid < 256) { const float* sp = SSQ + (size_t)(uu.pm * 256 + tid) * 16;
                const pg8::f32x4 s0 = *(const pg8::f32x4*)sp, s1 = *(const pg8::f32x4*)(sp + 4), s2 = *(const pg8::f32x4*)(sp + 8), s3 = *(const pg8::f32x4*)(sp + 12); const pg8::f32x4 st = (s0 + s1) + (s2 + s3);
                rtab[i * 256 + tid] = rsqrtf(((st[0] + st[1]) + (st[2] + st[3])) * (1.f / D) + EPS); }
          tab_ok = !(i == 16 && S.next(16, uu)); }
        __syncthreads();
        pg8::EpZF E{tab_ok ? rtab : (PG8_LAS float*)nullptr, SSQ, ZACT};
        pg8::gemm_phase<pg8::EpZF, pg8::StaticOrder, true, true>(ldsl, g, S, E);
#if (REPMASK >> 14) & 1
        pg8::gemm_phase<pg8::EpZF, pg8::StaticOrder, true, true>(ldsl, g, S, E);
#endif
    } else ngemm(ldsf, M, DFF, D, ALbfScale{HB, D, norm_mlp}, BLf32{w_mlp_in, DFF}, EpZ{SSQ, ZACT});
    PHASE_END
    PHASE_BEGIN DECL_PTRS
    if (FAST(15)) {
        pg8::Gemm g{ZACT, WMO_T, M, D, DFF}; pg8::StaticOrder S; S.init(M, D, G, (int)blockIdx.x);
        pg8::EpOutF E{HB, H};
        pg8::gemm_phase<pg8::EpOutF, pg8::StaticOrder, true, true>(ldsl, g, S, E);
#if (REPMASK >> 15) & 1
        pg8::gemm_phase<pg8::EpOutF, pg8::StaticOrder, true, true>(ldsl, g, S, E);
#endif
    } else ngemm(ldsf, M, D, DFF, ALbf{ZACT, DFF}, BLf32{w_mlp_out, D}, EpOut{H});
    PHASE_END
}
constexpr int NPHASES = 11;

extern "C" void kernel_launch(void* const* d_in, const int* in_sizes, int n_in, void* d_out, int out_size, void* d_ws, size_t ws_size, hipStream_t stream) {
    static int grid = 0;
    if (grid == 0) {
        if (n_in != 27 || out_size != M * D || ws_size < WS_END) { fprintf(stderr, "kernel_launch: unexpected shapes n_in %d out %d ws %zu\n", n_in, out_size, ws_size); grid = -1; return; }
        int dev = 0, cus = 0, per_cu = 0;
        (void)hipGetDevice(&dev);
        (void)hipDeviceGetAttribute(&cus, hipDeviceAttributeMultiprocessorCount, dev);
        (void)hipFuncSetAttribute((const void*)fwd, hipFuncAttributeMaxDynamicSharedMemorySize, LDS_BYTES);
        (void)hipOccupancyMaxActiveBlocksPerMultiprocessor(&per_cu, (const void*)fwd, NTHREADS, LDS_BYTES);
        fprintf(stderr, "kernel_launch: cus %d per_cu %d ws_size %zu\n", cus, per_cu, ws_size);
        grid = cus;
    }
    if (grid < 0) return;
    if (hipMemsetAsync(d_ws, 0, 65536, stream) != hipSuccess) { fprintf(stderr, "kernel_launch: hipMemsetAsync failed\n"); return; }
    Args a{};
    for (int i = 0; i < 27; ++i) a.in[i] = (const float*)d_in[i];
    a.out = (float*)d_out; a.ws = (unsigned char*)d_ws; a.ph_lo = 0; a.ph_hi = NPHASES;
    void* args[] = {&a};
    hipError_t e = hipLaunchCooperativeKernel((const void*)fwd, dim3(grid), dim3(NTHREADS), args, LDS_BYTES, stream);
    if (e != hipSuccess) fprintf(stderr, "cooperative launch failed: %s (grid %d)\n", hipGetErrorString(e), grid);
}
```

```cpp
#include <hip/hip_runtime.h>
#include <hip/hip_cooperative_groups.h>
#include <cstdio>
#include <cstdint>
#ifndef FASTMASK
#define FASTMASK 0xFFFFFFFFu
#endif
#define FAST(p) ((FASTMASK >> (p)) & 1u)
namespace cg = cooperative_groups;

typedef unsigned short bf16_t;
constexpr int NTHREADS = 512;
constexpr int LDS_BYTES = 163840;
constexpr size_t MiB = 1u << 20;

constexpr int NB = 16, T = 2048, D = 1024, M = NB * T;
constexpr int DRNN = 1344, BW = 336, QW = 1024, KVW = 256, NH = 16, HD = 64, NG = 4;
constexpr int DIN = 7344, DFF = 4096, NC = 127, NSB = 32, CROWS = NB * NG * NC;
constexpr int C_URNN = 0, C_UGATE = 1344, C_Q = 2688, C_KV = 3712, C_GN = 5248, C_GA = 5296, C_GB = 6320;
constexpr float EPS = 1e-6f, LOG2E = 1.4426950408889634f;
constexpr int YA_LD = 1408, XC_LD = 384;

constexpr size_t WS_RSTD = 1 * MiB, WS_RSTD2 = 1 * MiB + 512 * 1024, WS_KCC = 2 * MiB, WS_VCC = 4 * MiB, WS_SEL = 6 * MiB;
constexpr size_t WS_URNN = 52 * MiB, WS_UGATE = 136 * MiB, WS_Q = 220 * MiB, WS_KV = 284 * MiB  , WS_GN = 380 * MiB, WS_GA = 384 * MiB, WS_GB = 448 * MiB, WS_END = 512 * MiB;
constexpr size_t WS_PES = 1 * MiB + 448 * 1024  , WS_NORMS = 1 * MiB + 384 * 1024, WS_LAMC = 1 * MiB + 256 * 1024, WS_SSQ = 6 * MiB + 512 * 1024  ;
constexpr size_t WS_WIN = 9 * MiB  , WS_WG = 24 * MiB  , WS_W1 = 27 * MiB  , WS_PA = 29 * MiB  , WS_PB = 32 * MiB, WS_WO = 34 * MiB, WS_WMI = 36 * MiB  , WS_WMO = 44 * MiB  ;
constexpr size_t DO_KCB = 104 * MiB  , DO_VCT = 105 * MiB  ;
constexpr size_t DO_VST = 72 * MiB, DO_VWT = 88 * MiB;
constexpr size_t DO_CAR = 112 * MiB, DO_CBR = 120 * MiB;
constexpr size_t DO_XB = 0;
constexpr size_t WS_LA = WS_URNN, WS_UP = WS_KV, WS_T1 = WS_URNN, WS_MERGED = WS_UGATE, WS_HB = WS_GA, WS_ZACT = 52 * MiB;
constexpr size_t DO_FLATK = 64 * MiB, DO_FLATV = 96 * MiB, DO_HIDK = 0, DO_HIDV = 4 * MiB, DO_XC = 0, DO_YA = 0;

__device__ __constant__ unsigned char BUCKET[128] = {0, 1, 2, 3, 4, 5, 6, 7, 8, 9, 10, 11, 12, 13, 14, 15, 16, 16, 16, 17, 17, 18, 18, 18, 19, 19, 19, 20, 20, 20, 20, 21, 21, 21, 21, 22, 22, 22, 22, 22, 23, 23, 23, 23, 23, 23, 24, 24, 24, 24, 24, 24, 25, 25, 25, 25, 25, 25, 25, 26, 26, 26, 26, 26, 26, 26, 26, 27, 27, 27, 27, 27, 27, 27, 27, 27, 27, 28, 28, 28, 28, 28, 28, 28, 28, 28, 28, 29, 29, 29, 29, 29, 29, 29, 29, 29, 29, 29, 29, 30, 30, 30, 30, 30, 30, 30, 30, 30, 30, 30, 30, 30, 30, 31, 31, 31, 31, 31, 31, 31, 31, 31, 31, 31, 31, 31, 31, 31};

__device__ __forceinline__ float bf2f(bf16_t v) { return __uint_as_float((unsigned)v << 16); }
__device__ __forceinline__ bf16_t f2bf(float f) { unsigned u = __float_as_uint(f); return (bf16_t)((u + 0x7fffu + ((u >> 16) & 1u)) >> 16); }
__device__ __forceinline__ float sigmoidf_(float x) { return 1.f / (1.f + __expf(-x)); }
__device__ __forceinline__ float gelu_tanh(float x) { const float u = 0.7978845608028654f * (x + 0.044715f * x * x * x); return 0.5f * x * (1.f + tanhf(u)); }
__device__ __forceinline__ float wave_sum(float v) {
#pragma unroll
    for (int o = 1; o < 64; o <<= 1) v += __shfl_xor(v, o);
    return v;
}

struct Args { const float* in[27]; float* out; unsigned char* ws; int ph_lo, ph_hi; };

template <class AL, class BL, class EP>
__device__ __forceinline__ void ngemm(float* lds, int Mm, int Nn, int Kk, const AL& A, const BL& Bf, const EP& E) {
    float* As = lds;
    float* Bs = lds + 16 * 132;
    const int tid = threadIdx.x, tx = tid & 31, ty = tid >> 5;
    const int tm = (Mm + 127) / 128, tn = (Nn + 127) / 128, ntiles = tm * tn;
    for (int tile = blockIdx.x; tile < ntiles; tile += gridDim.x) {
        const int m0 = (tile / tn) * 128, n0 = (tile % tn) * 128;
        float acc[8][4];
#pragma unroll
        for (int i = 0; i < 8; ++i)
#pragma unroll
            for (int j = 0; j < 4; ++j) acc[i][j] = 0.f;
        for (int k0 = 0; k0 < Kk; k0 += 16) {
            {
                const int m = m0 + (tid >> 2), kb = k0 + (tid & 3) * 4;
#pragma unroll
                for (int i = 0; i < 4; ++i) As[((tid & 3) * 4 + i) * 132 + (tid >> 2)] = (m < Mm && kb + i < Kk) ? A(m, kb + i) : 0.f;
                const int k = k0 + (tid >> 5), nb = n0 + (tid & 31) * 4;
#pragma unroll
                for (int i = 0; i < 4; ++i) Bs[(tid >> 5) * 132 + (tid & 31) * 4 + i] = (k < Kk && nb + i < Nn) ? Bf(k, nb + i) : 0.f;
            }
            __syncthreads();
#pragma unroll 2
            for (int kk = 0; kk < 16; ++kk) {
                float a[8], b[4];
#pragma unroll
                for (int i = 0; i < 8; ++i) a[i] = As[kk * 132 + ty * 8 + i];
#pragma unroll
                for (int j = 0; j < 4; ++j) b[j] = Bs[kk * 132 + tx * 4 + j];
#pragma unroll
                for (int i = 0; i < 8; ++i)
#pragma unroll
                    for (int j = 0; j < 4; ++j) acc[i][j] += a[i] * b[j];
            }
            __syncthreads();
        }
#pragma unroll
        for (int i = 0; i < 8; ++i)
#pragma unroll
            for (int j = 0; j < 4; ++j) { const int m = m0 + ty * 8 + i, n = n0 + tx * 4 + j; if (m < Mm && n < Nn) E(m, n, acc[i][j]); }
    }
}

struct ALbf { const bf16_t* p; int ld; __device__ __forceinline__ float operator()(int m, int k) const { return bf2f(p[(size_t)m * ld + k]); } };
struct ALbfScale { const bf16_t* p; int ld; const float* g; __device__ __forceinline__ float operator()(int m, int k) const { return bf2f(p[(size_t)m * ld + k]) * g[k]; } };
struct ALf32Scale { const float* p; int ld; const float* g; __device__ __forceinline__ float operator()(int m, int k) const { return p[(size_t)m * ld + k] * g[k]; } };
struct BLf32 { const float* p; int ld; __device__ __forceinline__ float operator()(int k, int n) const { return p[(size_t)k * ld + n]; } };
struct BLgate { const float* wa; const float* wx; __device__ __forceinline__ float operator()(int k, int n) const { return n < BW ? wa[k * BW + n] : wx[k * BW + n - BW]; } };

struct Ep1 {
    const float* rstd; bf16_t *urnn, *ugate, *q, *kv, *gn, *ga, *gb;
    __device__ __forceinline__ void operator()(int m, int n, float v) const {
        v *= rstd[m];
        if (n < C_UGATE) urnn[(size_t)m * DRNN + n] = f2bf(v);
        else if (n < C_Q) ugate[(size_t)m * DRNN + n - C_UGATE] = f2bf(gelu_tanh(v));
        else if (n < C_KV) q[(size_t)m * QW + n - C_Q] = f2bf(v);
        else if (n < C_GN) { const int c = n - C_KV; kv[(size_t)(c >> 8) * ((size_t)M * KVW) + (size_t)m * KVW + (c & 255)] = f2bf(v); }
        else if (n < C_GA) gn[(size_t)m * 48 + n - C_GN] = f2bf(sigmoidf_(v));
        else if (n < C_GB) ga[(size_t)m * D + n - C_GA] = f2bf(sigmoidf_(v));
        else gb[(size_t)m * D + n - C_GB] = f2bf(sigmoidf_(v));
    }
};
struct EpGelu { bf16_t* o; int ld; __device__ __forceinline__ void operator()(int m, int n, float v) const { o[(size_t)m * ld + n] = f2bf(gelu_tanh(v)); } };
struct EpGate {
    int nb; const float *ba, *bx, *lam; const bf16_t* xc; bf16_t *la, *up;
    __device__ __forceinline__ void operator()(int m, int n, float v) const {
        if (n < BW) { const int c = nb * BW + n; const float r = sigmoidf_(v + ba[c]); const float sp = log1pf(__expf(-lam[c])); la[(size_t)m * DRNN + c] = f2bf(-8.f * r * sp * LOG2E); }
        else { const int j = n - BW, c = nb * BW + j; const float i = sigmoidf_(v + bx[c]); up[(size_t)m * DRNN + c] = f2bf(i * bf2f(xc[(size_t)m * XC_LD + j])); }
    }
};
struct EpT1 { const bf16_t* g; bf16_t* o; __device__ __forceinline__ void operator()(int m, int n, float v) const { o[(size_t)m * D + n] = f2bf(bf2f(g[(size_t)m * D + n]) * v); } };
struct EpMerged { const bf16_t* g; const bf16_t* t1; bf16_t* o; __device__ __forceinline__ void operator()(int m, int n, float v) const { o[(size_t)m * D + n] = f2bf(bf2f(t1[(size_t)m * D + n]) + bf2f(g[(size_t)m * D + n]) * v); } };
struct EpH { const float* x; float* h; bf16_t* hb; __device__ __forceinline__ void operator()(int m, int n, float v) const { const float r = x[(size_t)m * D + n] + v; h[(size_t)m * D + n] = r; hb[(size_t)m * D + n] = f2bf(r); } };
struct EpZ { const float* ssq; bf16_t* z; __device__ __forceinline__ void operator()(int m, int n, float v) const { float s_ = 0.f; for (int i = 0; i < 16; ++i) s_ += ssq[(size_t)m * 16 + i]; v *= rsqrtf(s_ * (1.f / D) + EPS); v = v > 0.f ? v * v : 0.f; z[(size_t)m * DFF + n] = f2bf(v); } };
struct EpOut { float* o; __device__ __forceinline__ void operator()(int m, int n, float v) const { o[(size_t)m * D + n] += v; } };

namespace pg8 {
#define PG8_LAS __attribute__((address_space(3)))
typedef unsigned short bf16_t;
typedef short bf16x8 __attribute__((ext_vector_type(8)));
typedef float f32x4 __attribute__((ext_vector_type(4)));
typedef unsigned u32x4 __attribute__((ext_vector_type(4)));
constexpr int BM = 256, BK = 64, HALF = 128, HTB = HALF * BK * 2  , STAGE_BYTES = 8 * HTB, NXCD = 8, WGM = 4;

__host__ __device__ __forceinline__ int lds_byte(int r, int c) { const int st = (r >> 4) * 2 + (c >> 5), rr = r & 15, cc = c & 31, ob = rr * 64 + cc * 2; return st * 1024 + (ob ^ (((ob >> 9) & 1) << 5)); }
__host__ __device__ __forceinline__ void stage_rc(int b, int& R, int& C) { const int st = b / 1024, sb = b % 1024, swz = sb ^ (((sb >> 9) & 1) << 5); R = (st >> 1) * 16 + swz / 64; C = (st & 1) * 32 + (swz % 64) / 2; }
__host__ __device__ __forceinline__ int perm32(int rho) { const int n = rho >> 4, i = rho & 15; return 8 * (i >> 2) + 4 * n + (i & 3); }

struct Unit { int pm, pn, ord; };
struct Gemm { const bf16_t* A; const bf16_t* Bt; int M, N, K; };

struct StaticOrder {
    int nM, nN, nwg, G, c;
    __host__ __device__ void init(int M, int N, int G_, int c_) { nM = M / BM; nN = N / BM; nwg = nM * nN; G = G_; c = c_; }
    __host__ __device__ __forceinline__ bool next(int i, Unit& u) const {
        const long L = (long)i * G + c; if (L >= nwg) return false;
        int wgid = (int)L; { const int q = nwg / NXCD, r = nwg % NXCD, xcd = wgid % NXCD, off = wgid / NXCD; wgid = (xcd < r ? xcd * (q + 1) : r * (q + 1) + (xcd - r) * q) + off; }
        const int nig = WGM * nN, gid = wgid / nig, fm = gid * WGM, gsz = (nM - fm) < WGM ? (nM - fm) : WGM;
        u.pm = fm + ((wgid % nig) % gsz); u.pn = (wgid % nig) / gsz; u.ord = i; return true;
    }
    __device__ __forceinline__ void a_ready(const Unit&) const {}
    __device__ __forceinline__ void done(const Unit&) const {}
};

__device__ __forceinline__ unsigned cvt_pk_bf16(float lo, float hi) { unsigned r; asm volatile("v_cvt_pk_bf16_f32 %0, %1, %2" : "=v"(r) : "v"(lo), "v"(hi)); return r; }
typedef float f32x2 __attribute__((ext_vector_type(2)));
template <class Epi, class Sched, bool ALIGN_EPI = false, bool SP2 = false>
__device__ __forceinline__ void gemm_phase(PG8_LAS unsigned char* lds, const Gemm g, const Sched& S, const Epi& E) {
    const int tid = threadIdx.x, wid = __builtin_amdgcn_readfirstlane(tid >> 6), lane = tid & 63, wr = wid >> 2, wc = wid & 3, fr = lane & 15, fq = lane >> 4;
    const int K = g.K, nt = K / BK;
    unsigned voffA[2], voffB[2];
#pragma unroll
    for (int i = 0; i < 2; ++i) { int R, C; stage_rc(tid * 16 + i * 8192, R, C); const int Rb = Epi::PERM ? ((R & ~31) + perm32(R & 31)) : R;
        voffA[i] = (unsigned)(R * K + C) * 2u; voffB[i] = (unsigned)(Rb * K + C) * 2u; }
    const size_t kstep = (size_t)(BK * 2);
    const size_t hstep = (size_t)HALF * K * 2;
    const size_t tstep = 2 * hstep;
    const unsigned ldsw = (unsigned)wid * 1024u;
    const int aoff = lds_byte(wr * 64 + fr, fq * 8), boff = lds_byte(wc * 32 + fr, fq * 8);
#define PG8_SA(b, h) (((b) * 2 + (h)) * HTB)
#define PG8_SB(b, h) ((4 + (b) * 2 + (h)) * HTB)
#define PG8_STAGE(bufoff, gbase, voff) do { _Pragma("unroll") for (int _i = 0; _i < 2; ++_i) \
        __builtin_amdgcn_global_load_lds((const unsigned*)((const char*)(gbase) + (voff)[_i]), (PG8_LAS unsigned*)(lds + (bufoff) + ldsw + _i * 8192), 16, 0, 0); } while (0)
#define PG8_LDA(dst, b, h) do { _Pragma("unroll") for (int m = 0; m < 4; ++m) _Pragma("unroll") for (int k = 0; k < 2; ++k) dst[m][k] = *(const PG8_LAS bf16x8*)(lds + PG8_SA(b, h) + aoff + m * 2048 + k * 1024); } while (0)
#define PG8_LDB(dst, b, h) do { _Pragma("unroll") for (int n = 0; n < 2; ++n) _Pragma("unroll") for (int k = 0; k < 2; ++k) dst[n][k] = *(const PG8_LAS bf16x8*)(lds + PG8_SB(b, h) + boff + n * 2048 + k * 1024); } while (0)
#define PG8_MMA(ai, bj, At, Bt) do { __builtin_amdgcn_s_setprio(1); _Pragma("unroll") for (int m = 0; m < 4; ++m) _Pragma("unroll") for (int n = 0; n < 2; ++n) _Pragma("unroll") for (int k = 0; k < 2; ++k) \
        acc[ai][bj][m][n] = __builtin_amdgcn_mfma_f32_16x16x32_bf16(Bt[n][k], At[m][k], acc[ai][bj][m][n], 0, 0, 0); __builtin_amdgcn_s_setprio(0); } while (0)
#define PG8_WAIT_V(n) asm volatile("s_waitcnt vmcnt(" #n ")" ::: "memory")
#define PG8_WAIT_L(n) asm volatile("s_waitcnt lgkmcnt(" #n ")" ::: "memory")
#define PG8_BAR __builtin_amdgcn_s_barrier()
#define PG8_SCHED __builtin_amdgcn_sched_barrier(0)
    Unit cur, nxt; int ui = 0;
    if (!S.next(0, cur)) return;
    f32x4 acc[2][2][4][2];
#pragma unroll
    for (int a = 0; a < 2; ++a)
#pragma unroll
        for (int b = 0; b < 2; ++b)
#pragma unroll
            for (int m = 0; m < 4; ++m)
#pragma unroll
                for (int n = 0; n < 2; ++n) acc[a][b][m][n] = (f32x4){0.f, 0.f, 0.f, 0.f};
    bf16x8 At[4][2], B0[2][2], B1[2][2];
    const char* cA = (const char*)g.A + (size_t)cur.pm * tstep; const char* cB = (const char*)g.Bt + (size_t)cur.pn * tstep;
    S.a_ready(cur);
    if constexpr (SP2) {
        PG8_STAGE(PG8_SB(0, 0), cB, voffB); PG8_STAGE(PG8_SB(0, 1), cB + hstep, voffB); PG8_STAGE(PG8_SA(0, 0), cA, voffA); PG8_STAGE(PG8_SA(0, 1), cA + hstep, voffA);
        if (wr == 1) PG8_BAR;
        PG8_WAIT_V(2); PG8_BAR;
        PG8_STAGE(PG8_SB(1, 0), cB + kstep, voffB); PG8_STAGE(PG8_SA(1, 0), cA + kstep, voffA); PG8_STAGE(PG8_SB(1, 1), cB + hstep + kstep, voffB);
        PG8_WAIT_V(6); PG8_BAR;
    } else {
        PG8_STAGE(PG8_SB(0, 0), cB, voffB); PG8_STAGE(PG8_SA(0, 0), cA, voffA); PG8_STAGE(PG8_SB(0, 1), cB + hstep, voffB); PG8_STAGE(PG8_SA(0, 1), cA + hstep, voffA);
        if (wr == 1) PG8_BAR;
        PG8_WAIT_V(4); PG8_BAR;
        PG8_STAGE(PG8_SB(1, 0), cB + kstep, voffB); PG8_STAGE(PG8_SA(1, 0), cA + kstep, voffA); PG8_STAGE(PG8_SB(1, 1), cB + hstep + kstep, voffB);
        PG8_WAIT_V(6); PG8_BAR;
    }
    for (;;) {
        const bool has_next = S.next(ui + 1, nxt);
        const char* nA = has_next ? (const char*)g.A + (size_t)nxt.pm * tstep : cA; const char* nB = has_next ? (const char*)g.Bt + (size_t)nxt.pn * tstep : cB;
        for (int t = 0; t < nt; t += 2) {
            const bool last = (t == nt - 2);
            const char* a1 = cA + (size_t)(t + 1) * kstep;
            const char* a2 = last ? nA : cA + (size_t)(t + 2) * kstep; const char* b2 = last ? nB : cB + (size_t)(t + 2) * kstep;
            const char* a3 = a2 + kstep; const char* b3 = b2 + kstep;
            if (last && has_next) S.a_ready(nxt);
            if constexpr (SP2) {
            PG8_LDB(B0, 0, 0); PG8_LDB(B1, 0, 1); PG8_SCHED; PG8_LDA(At, 0, 0); PG8_STAGE(PG8_SA(1, 1), a1 + hstep, voffA);
            PG8_WAIT_V(8); PG8_WAIT_L(0); PG8_BAR; PG8_MMA(0, 0, At, B0); PG8_MMA(0, 1, At, B1); PG8_BAR; PG8_SCHED;
            PG8_LDA(At, 0, 1); PG8_STAGE(PG8_SB(0, 0), b2, voffB); PG8_STAGE(PG8_SB(0, 1), b2 + hstep, voffB); PG8_STAGE(PG8_SA(0, 0), a2, voffA);
            PG8_WAIT_V(8); PG8_WAIT_L(0); PG8_BAR; PG8_MMA(1, 0, At, B0); PG8_MMA(1, 1, At, B1); PG8_BAR; PG8_SCHED;
            PG8_LDB(B0, 1, 0); PG8_LDB(B1, 1, 1); PG8_SCHED; PG8_LDA(At, 1, 0); PG8_STAGE(PG8_SA(0, 1), a2 + hstep, voffA);
            PG8_WAIT_V(8); PG8_WAIT_L(0); PG8_BAR; PG8_MMA(0, 0, At, B0); PG8_MMA(0, 1, At, B1); PG8_BAR; PG8_SCHED;
            PG8_LDA(At, 1, 1); PG8_STAGE(PG8_SB(1, 0), b3, voffB); PG8_STAGE(PG8_SB(1, 1), b3 + hstep, voffB); PG8_STAGE(PG8_SA(1, 0), a3, voffA);
            PG8_WAIT_V(8); PG8_WAIT_L(0); PG8_BAR; PG8_MMA(1, 0, At, B0); PG8_MMA(1, 1, At, B1); PG8_BAR; PG8_SCHED;
            } else {
            PG8_LDB(B0, 0, 0); PG8_SCHED; PG8_LDA(At, 0, 0); PG8_STAGE(PG8_SA(1, 1), a1 + hstep, voffA);
            PG8_WAIT_L(8); PG8_BAR; PG8_WAIT_L(0); PG8_MMA(0, 0, At, B0); PG8_BAR; PG8_SCHED;
            PG8_LDB(B1, 0, 1); PG8_STAGE(PG8_SB(0, 0), b2, voffB);
            PG8_BAR; PG8_WAIT_L(0); PG8_MMA(0, 1, At, B1); PG8_BAR;
            PG8_LDA(At, 0, 1); PG8_STAGE(PG8_SA(0, 0), a2, voffA);
            PG8_BAR; PG8_WAIT_L(0); PG8_MMA(1, 0, At, B0); PG8_BAR; PG8_SCHED;
            PG8_STAGE(PG8_SB(0, 1), b2 + hstep, voffB);
            PG8_WAIT_V(6); PG8_BAR; PG8_MMA(1, 1, At, B1); PG8_BAR;
            PG8_LDB(B0, 1, 0); PG8_SCHED; PG8_LDA(At, 1, 0); PG8_STAGE(PG8_SA(0, 1), a2 + hstep, voffA);
            PG8_WAIT_L(8); PG8_BAR; PG8_WAIT_L(0); PG8_MMA(0, 0, At, B0); PG8_BAR; PG8_SCHED;
            PG8_LDB(B1, 1, 1); PG8_STAGE(PG8_SB(1, 0), b3, voffB);
            PG8_BAR; PG8_WAIT_L(0); PG8_MMA(0, 1, At, B1); PG8_BAR;
            PG8_LDA(At, 1, 1); PG8_STAGE(PG8_SA(1, 0), a3, voffA);
            PG8_BAR; PG8_WAIT_L(0); PG8_MMA(1, 0, At, B0); PG8_BAR; PG8_SCHED;
            PG8_STAGE(PG8_SB(1, 1), b3 + hstep, voffB);
            PG8_WAIT_V(6); PG8_BAR; PG8_MMA(1, 1, At, B1); PG8_BAR;
            }
        }
        if constexpr (ALIGN_EPI) { if (wr == 0) PG8_BAR; }
        if constexpr (!Epi::AFTER_DRAIN) { E(acc, cur, wr, wc, fr, fq); S.done(cur); }
        if (!has_next) break;
#pragma unroll
        for (int a = 0; a < 2; ++a)
#pragma unroll
            for (int b = 0; b < 2; ++b)
#pragma unroll
                for (int m = 0; m < 4; ++m)
#pragma unroll
                    for (int n = 0; n < 2; ++n) acc[a][b][m][n] = (f32x4){0.f, 0.f, 0.f, 0.f};
        cur = nxt; cA = nA; cB = nB; ++ui;
        if constexpr (ALIGN_EPI) { if (wr == 1) PG8_BAR; }
    }
    PG8_WAIT_V(0);
    if constexpr (!ALIGN_EPI) { if (wr == 0) PG8_BAR; }
    PG8_BAR;
    if constexpr (Epi::AFTER_DRAIN) { E.fused(acc, cur, wr, wc, fr, fq, lds, wid, lane); S.done(cur); }
#undef PG8_SA
#undef PG8_SB
#undef PG8_STAGE
#undef PG8_LDA
#undef PG8_LDB
#undef PG8_MMA
#undef PG8_WAIT_V
#undef PG8_WAIT_L
#undef PG8_BAR
#undef PG8_SCHED
}
}

namespace pg8 {
__device__ __forceinline__ float sigm(float x) { return __builtin_amdgcn_rcpf(1.f + __expf(-x)); }
__device__ __forceinline__ float gelu_t(float x) { const float u = 1.5957691216057308f * (x + 0.044715f * x * x * x); return x * __builtin_amdgcn_rcpf(1.f + __expf(-u)); }
__device__ __forceinline__ u32x4 pack8(const f32x4& a, const f32x4& b) { u32x4 w; w.x = cvt_pk_bf16(a[0], a[1]); w.y = cvt_pk_bf16(a[2], a[3]); w.z = cvt_pk_bf16(b[0], b[1]); w.w = cvt_pk_bf16(b[2], b[3]); return w; }
__device__ __forceinline__ void unpack8(const u32x4& w, f32x4& a, f32x4& b) {
    a[0] = __uint_as_float(w.x << 16); a[1] = __uint_as_float(w.x & 0xffff0000u); a[2] = __uint_as_float(w.y << 16); a[3] = __uint_as_float(w.y & 0xffff0000u);
    b[0] = __uint_as_float(w.z << 16); b[1] = __uint_as_float(w.z & 0xffff0000u); b[2] = __uint_as_float(w.w << 16); b[3] = __uint_as_float(w.w & 0xffff0000u); }

struct Ep1F {
    static constexpr bool PERM = true, AFTER_DRAIN = false;
    bf16_t *urnn, *ugate, *q, *kv, *gn, *ga; const PG8_LAS float* norms; bf16_t* flat; const PG8_LAS float* pes;
    __device__ __forceinline__ void operator()(const f32x4 (&acc)[2][2][4][2], const Unit& u, int wr, int wc, int fr, int fq) const {
        const int row0 = u.pm * BM + wr * 64 + fr, pn = u.pn;
        if (pn == 4 || pn == 5) {
            const PG8_LAS float* pe = pes + (pn - 4) * 2048; bf16_t* fl = flat + (size_t)(pn - 4) * 8192 * 2048;
#pragma unroll
            for (int ai = 0; ai < 2; ++ai)
#pragma unroll
                for (int m = 0; m < 4; ++m) { const int mt = row0 + ai * HALF + m * 16, b = mt >> 11, t = mt & (T - 1), c1 = t >> 4, l1 = t & 15; const size_t rb = (size_t)((b * 4 + wc) * NC + c1) * 2048;
#pragma unroll
                    for (int bj = 0; bj < 2; ++bj) { const int d0 = 32 * bj + 8 * fq; const f32x4 v0 = acc[ai][bj][m][0], v1 = acc[ai][bj][m][1];
                        if (c1 < NC) { const PG8_LAS float* p = pe + l1 * 64 + d0; *(u32x4*)(fl + rb + l1 * 64 + d0) = pack8(v0 + *(const PG8_LAS f32x4*)p, v1 + *(const PG8_LAS f32x4*)(p + 4)); }
                        if (c1 > 0) { const PG8_LAS float* p = pe + (l1 + 16) * 64 + d0; *(u32x4*)(fl + rb - 2048 + (l1 + 16) * 64 + d0) = pack8(v0 + *(const PG8_LAS f32x4*)p, v1 + *(const PG8_LAS f32x4*)(p + 4)); } } }
            return;
        }
        if (pn < 10) {
            const bool donorm = pn < 4 || pn == 6 || pn == 8; const PG8_LAS float* g = norms + (pn < 4 ? 0 : (pn == 6 ? 64 : 128)); const float sc = pn < 4 ? 0.125f * LOG2E : 1.f;
            bf16_t* base; int ld;
            if (pn < 4) { base = q + 256 * pn + 64 * wc + 8 * fq; ld = QW; } else { base = kv + (size_t)(pn - 4) * ((size_t)M * KVW) + 64 * wc + 8 * fq; ld = KVW; }
            f32x4 gv[2][2];
#pragma unroll
            for (int bj = 0; bj < 2; ++bj)
#pragma unroll
                for (int n = 0; n < 2; ++n) gv[bj][n] = donorm ? *(const PG8_LAS f32x4*)(g + 32 * bj + 8 * fq + 4 * n) : (f32x4){1.f, 1.f, 1.f, 1.f};
#pragma unroll
            for (int ai = 0; ai < 2; ++ai)
#pragma unroll
                for (int m = 0; m < 4; ++m) {
                    float ss = 0.f;
#pragma unroll
                    for (int bj = 0; bj < 2; ++bj)
#pragma unroll
                        for (int n = 0; n < 2; ++n) { const f32x4 v = acc[ai][bj][m][n]; ss += (v[0] * v[0] + v[1] * v[1]) + (v[2] * v[2] + v[3] * v[3]); }
                    ss += __shfl_xor(ss, 16); ss += __shfl_xor(ss, 32);
                    const float r = donorm ? rsqrtf(ss * (1.f / 64.f) + EPS) * sc : 1.f;
                    bf16_t* rowp = base + (size_t)(row0 + ai * HALF + m * 16) * ld;
#pragma unroll
                    for (int bj = 0; bj < 2; ++bj) *(u32x4*)(rowp + 32 * bj) = pack8(acc[ai][bj][m][0] * r * gv[bj][0], acc[ai][bj][m][1] * r * gv[bj][1]);
                }
        } else if (pn < 18) {
            bf16_t* base = ga + (pn < 14 ? (size_t)0 : (size_t)M * D) + 256 * ((pn - 10) & 3) + 32 * wc + 8 * fq;
#pragma unroll
            for (int ai = 0; ai < 2; ++ai)
#pragma unroll
                for (int m = 0; m < 4; ++m) { bf16_t* rowp = base + (size_t)(row0 + ai * HALF + m * 16) * D;
#pragma unroll
                    for (int bj = 0; bj < 2; ++bj) { f32x4 v0 = acc[ai][bj][m][0], v1 = acc[ai][bj][m][1];
#pragma unroll
                        for (int e = 0; e < 4; ++e) { v0[e] = sigm(v0[e]); v1[e] = sigm(v1[e]); }
                        *(u32x4*)(rowp + bj * HALF) = pack8(v0, v1); } }
        } else { seg3<0>(acc, pn, row0, wc, fq); seg3<1>(acc, pn, row0, wc, fq); }
    }
    template <int BJ> __device__ __forceinline__ void seg3(const f32x4 (&acc)[2][2][4][2], int pn, int row0, int wc, int fq) const {
        const int c = 256 * (pn - 18) + 128 * BJ + 32 * wc;
        if (c < 1344) { bf16_t* base = urnn + c + 8 * fq;
#pragma unroll
            for (int ai = 0; ai < 2; ++ai)
#pragma unroll
                for (int m = 0; m < 4; ++m) *(u32x4*)(base + (size_t)(row0 + ai * HALF + m * 16) * DRNN) = pack8(acc[ai][BJ][m][0], acc[ai][BJ][m][1]);
        } else if (c < 2688) { bf16_t* base = ugate + (c - 1344) + 8 * fq;
#pragma unroll
            for (int ai = 0; ai < 2; ++ai)
#pragma unroll
                for (int m = 0; m < 4; ++m) { f32x4 v0 = acc[ai][BJ][m][0], v1 = acc[ai][BJ][m][1];
#pragma unroll
                    for (int e = 0; e < 4; ++e) { v0[e] = gelu_t(v0[e]); v1[e] = gelu_t(v1[e]); }
                    *(u32x4*)(base + (size_t)(row0 + ai * HALF + m * 16) * DRNN) = pack8(v0, v1); }
        } else if (c + 8 * fq < 2736) { bf16_t* base = gn + (c - 2688) + 8 * fq;
#pragma unroll
            for (int ai = 0; ai < 2; ++ai)
#pragma unroll
                for (int m = 0; m < 4; ++m) { f32x4 v0 = acc[ai][BJ][m][0], v1 = acc[ai][BJ][m][1];
#pragma unroll
                    for (int e = 0; e < 4; ++e) { v0[e] = sigm(v0[e]); v1[e] = sigm(v1[e]); }
                    *(u32x4*)(base + (size_t)(row0 + ai * HALF + m * 16) * 48) = pack8(v0, v1); }
        }
    }
};
__device__ __forceinline__ void win_src(int ch, int& c0, int& cvalid) {
    const int tile = ch >> 3, l0 = (ch & 7) * 32, bj = l0 >> 7, wc = (l0 >> 5) & 3; cvalid = 32;
    if (tile < 4) c0 = C_Q + 256 * tile + 64 * wc + 32 * bj;
    else if (tile < 10) c0 = C_KV + 256 * (tile - 4) + 64 * wc + 32 * bj;
    else if (tile < 14) c0 = C_GA + 256 * (tile - 10) + l0;
    else if (tile < 18) c0 = C_GB + 256 * (tile - 14) + l0;
    else { const int c = 256 * (tile - 18) + l0; if (c < 2688) c0 = c; else if (c < 2736) { c0 = C_GN + c - 2688; cvalid = 2736 - c < 32 ? 2736 - c : 32; } else { c0 = 0; cvalid = 0; } }
}
constexpr int N1PAD = 29 * 256;

struct EpGeluF {
    static constexpr bool PERM = true, AFTER_DRAIN = false;
    bf16_t* O; int ldc;
    __device__ __forceinline__ void operator()(const f32x4 (&acc)[2][2][4][2], const Unit& u, int wr, int wc, int fr, int fq) const {
        const int row0 = u.pm * BM + wr * 64 + fr; bf16_t* base = O + wc * 32 + 8 * fq;
#pragma unroll
        for (int ai = 0; ai < 2; ++ai)
#pragma unroll
            for (int m = 0; m < 4; ++m) { bf16_t* rowp = base + (size_t)(row0 + ai * HALF + m * 16) * ldc;
#pragma unroll
                for (int bj = 0; bj < 2; ++bj) { f32x4 v0 = acc[ai][bj][m][0], v1 = acc[ai][bj][m][1];
#pragma unroll
                    for (int e = 0; e < 4; ++e) { v0[e] = gelu_t(v0[e]); v1[e] = gelu_t(v1[e]); }
                    *(u32x4*)(rowp + bj * HALF) = pack8(v0, v1); } }
    }
};
struct OrderC1 {
    int G, c;
    __device__ __forceinline__ bool next(int i, Unit& u) const { const int L = i * G + c; if (L >= 64) return false; u.pm = L; u.pn = L >> 5; u.ord = i; return true; }
    __device__ __forceinline__ void a_ready(const Unit&) const {}
    __device__ __forceinline__ void done(const Unit&) const {}
};
struct OrderGate {
    int G, c;
    __device__ __forceinline__ bool next(int i, Unit& u) const { const int L = i * G + c; if (L >= 4 * 128 * 3) return false; const int nb = L / 384, r = L % 384; u.pm = nb * 128 + r / 3; u.pn = nb * 3 + r % 3; u.ord = i; return true; }
    __device__ __forceinline__ void a_ready(const Unit&) const {}
    __device__ __forceinline__ void done(const Unit&) const {}
};
struct EpGateF {
    static constexpr bool PERM = true, AFTER_DRAIN = false;
    const float *ba, *bx, *lamc; const bf16_t* xc; bf16_t *la, *up;
    __device__ __forceinline__ void operator()(const f32x4 (&acc)[2][2][4][2], const Unit& u, int wr, int wc, int fr, int fq) const {
        const int nb = u.pn / 3, pn3 = u.pn % 3, ch0 = 128 * pn3 + 32 * wc + 8 * fq; if (ch0 >= BW) return;
        const int c0 = nb * BW + ch0, row0 = (u.pm & 127) * BM + wr * 64 + fr;
        const bf16_t* xcb = xc + (size_t)nb * ((size_t)M * XC_LD) + ch0; bf16_t* lab = la + c0; bf16_t* upb = up + c0;
        const f32x4 bav0 = *(const f32x4*)(ba + c0), bav1 = *(const f32x4*)(ba + c0 + 4), bxv0 = *(const f32x4*)(bx + c0), bxv1 = *(const f32x4*)(bx + c0 + 4), lcv0 = *(const f32x4*)(lamc + c0), lcv1 = *(const f32x4*)(lamc + c0 + 4);
        u32x4 xcv[2][4];
#pragma unroll
        for (int ai = 0; ai < 2; ++ai)
#pragma unroll
            for (int m = 0; m < 4; ++m) xcv[ai][m] = *(const u32x4*)(xcb + (unsigned)(row0 + ai * HALF + m * 16) * (unsigned)XC_LD);
#pragma unroll
        for (int ai = 0; ai < 2; ++ai)
#pragma unroll
            for (int m = 0; m < 4; ++m) { const unsigned row = (unsigned)(row0 + ai * HALF + m * 16);
                f32x4 x0, x1; unpack8(xcv[ai][m], x0, x1);
                f32x4 l0, l1, u0, u1;
#pragma unroll
                for (int e = 0; e < 4; ++e) {
                    l0[e] = sigm(acc[ai][0][m][0][e] + bav0[e]) * lcv0[e]; l1[e] = sigm(acc[ai][0][m][1][e] + bav1[e]) * lcv1[e];
                    u0[e] = sigm(acc[ai][1][m][0][e] + bxv0[e]) * x0[e];   u1[e] = sigm(acc[ai][1][m][1][e] + bxv1[e]) * x1[e]; }
                *(u32x4*)(lab + row * (unsigned)DRNN) = pack8(l0, l1); *(u32x4*)(upb + row * (unsigned)DRNN) = pack8(u0, u1);
                asm volatile("" ::: "memory"); }
    }
};
struct EpT1F {
    static constexpr bool PERM = true, AFTER_DRAIN = false;
    const bf16_t* g; bf16_t* o;
    __device__ __forceinline__ void operator()(const f32x4 (&acc)[2][2][4][2], const Unit& u, int wr, int wc, int fr, int fq) const {
        const int row0 = u.pm * BM + wr * 64 + fr, col0 = u.pn * BM + wc * 32 + 8 * fq;
        u32x4 gv[2][4][2];
#pragma unroll
        for (int ai = 0; ai < 2; ++ai)
#pragma unroll
            for (int m = 0; m < 4; ++m) { const size_t off = (size_t)(row0 + ai * HALF + m * 16) * D + col0;
#pragma unroll
                for (int bj = 0; bj < 2; ++bj) gv[ai][m][bj] = *(const u32x4*)(g + off + bj * HALF); }
#pragma unroll
        for (int ai = 0; ai < 2; ++ai)
#pragma unroll
            for (int m = 0; m < 4; ++m) { const size_t off = (size_t)(row0 + ai * HALF + m * 16) * D + col0;
#pragma unroll
                for (int bj = 0; bj < 2; ++bj) { f32x4 g0, g1; unpack8(gv[ai][m][bj], g0, g1);
                    *(u32x4*)(o + off + bj * HALF) = pack8(acc[ai][bj][m][0] * g0, acc[ai][bj][m][1] * g1); } }
    }
};
struct EpMergedF {
    static constexpr bool PERM = true, AFTER_DRAIN = false;
    const bf16_t* g; const bf16_t* t1; bf16_t* o;
    __device__ __forceinline__ void operator()(const f32x4 (&acc)[2][2][4][2], const Unit& u, int wr, int wc, int fr, int fq) const {
        const int row0 = u.pm * BM + wr * 64 + fr, col0 = u.pn * BM + wc * 32 + 8 * fq;
#pragma unroll
        for (int ai = 0; ai < 2; ++ai) {
            u32x4 gv[4][2], tv[4][2];
#pragma unroll
            for (int m = 0; m < 4; ++m) { const size_t off = (size_t)(row0 + ai * HALF + m * 16) * D + col0;
#pragma unroll
                for (int bj = 0; bj < 2; ++bj) { gv[m][bj] = *(const u32x4*)(g + off + bj * HALF); tv[m][bj] = *(const u32x4*)(t1 + off + bj * HALF); } }
#pragma unroll
            for (int m = 0; m < 4; ++m) { const size_t off = (size_t)(row0 + ai * HALF + m * 16) * D + col0;
#pragma unroll
                for (int bj = 0; bj < 2; ++bj) { f32x4 g0, g1, t0, t1v; unpack8(gv[m][bj], g0, g1); unpack8(tv[m][bj], t0, t1v);
                    *(u32x4*)(o + off + bj * HALF) = pack8(t0 + acc[ai][bj][m][0] * g0, t1v + acc[ai][bj][m][1] * g1); } }
            asm volatile("" ::: "memory");
        }
    }
};
struct EpHF {
    static constexpr bool PERM = true, AFTER_DRAIN = false;
    const float* x; float* h; bf16_t* hb; float* ssq;
    __device__ __forceinline__ void operator()(const f32x4 (&acc)[2][2][4][2], const Unit& u, int wr, int wc, int fr, int fq) const {
        const int row0 = u.pm * BM + wr * 64 + fr, col0 = u.pn * BM + wc * 32 + 8 * fq;
#pragma unroll
        for (int ai = 0; ai < 2; ++ai) {
            f32x4 xv[4][2][2];
#pragma unroll
            for (int m = 0; m < 4; ++m) { const size_t off = (size_t)(row0 + ai * HALF + m * 16) * D + col0;
#pragma unroll
                for (int bj = 0; bj < 2; ++bj) { xv[m][bj][0] = *(const f32x4*)(x + off + bj * HALF); xv[m][bj][1] = *(const f32x4*)(x + off + bj * HALF + 4); } }
#pragma unroll
            for (int m = 0; m < 4; ++m) { const size_t row = (size_t)(row0 + ai * HALF + m * 16), off = row * D + col0; float ss = 0.f;
#pragma unroll
                for (int bj = 0; bj < 2; ++bj) {
                    const f32x4 h0 = xv[m][bj][0] + acc[ai][bj][m][0], h1 = xv[m][bj][1] + acc[ai][bj][m][1];
                    *(u32x4*)(hb + off + bj * HALF) = pack8(h0, h1);
                    ss += (h0[0] * h0[0] + h0[1] * h0[1]) + (h0[2] * h0[2] + h0[3] * h0[3]) + (h1[0] * h1[0] + h1[1] * h1[1]) + (h1[2] * h1[2] + h1[3] * h1[3]); }
                ss += __shfl_xor(ss, 16); ss += __shfl_xor(ss, 32);
                if (fq == 0) ssq[row * 16 + 4 * u.pn + wc] = ss; }
            asm volatile("" ::: "memory");
        }
    }
};
struct EpZF {
    static constexpr bool PERM = true, AFTER_DRAIN = false;
    const PG8_LAS float* rtab; const float* ssq; bf16_t* z;
    __device__ __forceinline__ void operator()(const f32x4 (&acc)[2][2][4][2], const Unit& u, int wr, int wc, int fr, int fq) const {
        const int rl0 = wr * 64 + fr, row0 = u.pm * BM + rl0, col0 = u.pn * BM + wc * 32 + 8 * fq;
#pragma unroll
        for (int ai = 0; ai < 2; ++ai)
#pragma unroll
            for (int m = 0; m < 4; ++m) { const size_t row = (size_t)(row0 + ai * HALF + m * 16);
                float r;
                if (rtab) r = rtab[u.ord * 256 + rl0 + ai * HALF + m * 16];
                else { const f32x4 s0 = *(const f32x4*)(ssq + row * 16), s1 = *(const f32x4*)(ssq + row * 16 + 4), s2 = *(const f32x4*)(ssq + row * 16 + 8), s3 = *(const f32x4*)(ssq + row * 16 + 12);
                    const f32x4 st = (s0 + s1) + (s2 + s3); r = rsqrtf(((st[0] + st[1]) + (st[2] + st[3])) * (1.f / D) + EPS); }
#pragma unroll
                for (int bj = 0; bj < 2; ++bj) { f32x4 v0 = acc[ai][bj][m][0] * r, v1 = acc[ai][bj][m][1] * r;
#pragma unroll
                    for (int e = 0; e < 4; ++e) { v0[e] = v0[e] > 0.f ? v0[e] * v0[e] : 0.f; v1[e] = v1[e] > 0.f ? v1[e] * v1[e] : 0.f; }
                    *(u32x4*)(z + row * DFF + col0 + bj * HALF) = pack8(v0, v1); } }
    }
};
struct EpOutF {
    static constexpr bool PERM = true, AFTER_DRAIN = false;
    const bf16_t* hb; float* o;
    __device__ __forceinline__ void operator()(const f32x4 (&acc)[2][2][4][2], const Unit& u, int wr, int wc, int fr, int fq) const {
        const int row0 = u.pm * BM + wr * 64 + fr, col0 = u.pn * BM + wc * 32 + 8 * fq;
        u32x4 hv[2][4][2];
#pragma unroll
        for (int ai = 0; ai < 2; ++ai)
#pragma unroll
            for (int m = 0; m < 4; ++m) { const size_t off = (size_t)(row0 + ai * HALF + m * 16) * D + col0;
#pragma unroll
                for (int bj = 0; bj < 2; ++bj) hv[ai][m][bj] = *(const u32x4*)(hb + off + bj * HALF); }
#pragma unroll
        for (int ai = 0; ai < 2; ++ai)
#pragma unroll
            for (int m = 0; m < 4; ++m) { float* p = o + (size_t)(row0 + ai * HALF + m * 16) * D + col0;
#pragma unroll
                for (int bj = 0; bj < 2; ++bj) { f32x4 h0, h1; unpack8(hv[ai][m][bj], h0, h1); *(f32x4*)(p + bj * HALF) = h0 + acc[ai][bj][m][0]; *(f32x4*)(p + bj * HALF + 4) = h1 + acc[ai][bj][m][1]; } }
    }
};
}

namespace att {
using pg8::bf16x8; using pg8::f32x4; using pg8::u32x4;
typedef float f32x16 __attribute__((ext_vector_type(16)));
typedef short s16x4 __attribute__((ext_vector_type(4)));
typedef float f32x2_t __attribute__((ext_vector_type(2))); typedef __bf16 bf16x2_t __attribute__((ext_vector_type(2)));
constexpr int KROW = 144, VROW = 144, KT = 64 * KROW, VT = 64 * VROW;
__device__ __forceinline__ int vperm(int kv) { return (kv & ~12) | ((kv & 4) << 1) | ((kv & 8) >> 1); }
constexpr int L_K0 = 0, L_K1 = KT, L_V0 = 2 * KT, L_V1 = 2 * KT + VT, L_BT = 2 * KT + 2 * VT  , L_IMPG = L_BT + 4096 + 64, L_IMPL = L_IMPG + 33792, L_IMP = L_IMPL + 33792, L_SELM = L_IMP + 64 * 33 * 4, L_KC = L_SELM + 512  , VCROW = 272, L_VC = L_KC + 128 * KROW  , L_END = L_VC + 64 * VCROW;
static_assert(L_END <= 163840 - 512, "attention LDS map");
__device__ __forceinline__ int crow(int r, int hi) { return (r & 3) + 8 * (r >> 2) + 4 * hi; }
__device__ __forceinline__ float max3f(float a, float b, float c) { float r; asm("v_max3_f32 %0, %1, %2, %3" : "=v"(r) : "v"(a), "v"(b), "v"(c)); return r; }
__device__ __forceinline__ unsigned cvtpk(float lo, float hi) { f32x2_t v = {lo, hi}; bf16x2_t b = __builtin_convertvector(v, bf16x2_t); return __builtin_bit_cast(unsigned, b); }
__device__ __forceinline__ bf16x8 packp(const f32x16& p, int s) {
    u32x4 w; w.x = cvtpk(p[8 * s + 0], p[8 * s + 1]); w.y = cvtpk(p[8 * s + 2], p[8 * s + 3]); w.z = cvtpk(p[8 * s + 4], p[8 * s + 5]); w.w = cvtpk(p[8 * s + 6], p[8 * s + 7]);
    return __builtin_bit_cast(bf16x8, w); }
__device__ __forceinline__ bf16x8 kfrag(const unsigned char* kbuf, int st, int sp, int q32, int hi) { return *(const bf16x8*)(kbuf + (32 * st + q32) * KROW + (16 * sp + 8 * hi) * 2); }
__device__ __forceinline__ bf16x8 vfrag(const unsigned char* vbuf, int st, int s, int dt, int q32, int hi) { return *(const bf16x8*)(vbuf + (32 * dt + q32) * VROW + (32 * st + 16 * s + 8 * hi) * 2); }
__device__ __forceinline__ f32x16 qk_tile(const unsigned char* kbuf, int st, const bf16x8 (&qf)[4], int q32, int hi) {
    f32x16 s = {};
#pragma unroll
    for (int sp = 0; sp < 4; ++sp) s = __builtin_amdgcn_mfma_f32_32x32x16_bf16(kfrag(kbuf, st, sp, q32, hi), qf[sp], s, 0, 0, 0);
    return s; }
__device__ __forceinline__ void pv_tile(f32x16 (&o)[2], const unsigned char* vbuf, int st, const f32x16& p, int q32, int hi) {
#pragma unroll
    for (int s = 0; s < 2; ++s) { const bf16x8 pb = packp(p, s);
#pragma unroll
        for (int dt = 0; dt < 2; ++dt) o[dt] = __builtin_amdgcn_mfma_f32_32x32x16_bf16(vfrag(vbuf, st, s, dt, q32, hi), pb, o[dt], 0, 0, 0); }
}
struct Stage { u32x4 k, v; };
__device__ __forceinline__ void stage_load(Stage& s, const bf16_t* Kblk  , int ldk, const bf16_t* Vblk  , int ldv, int tid) {
    const int row = tid >> 3, ch = tid & 7;
    s.k = *(const u32x4*)(Kblk + (size_t)row * ldk + ch * 8); s.v = *(const u32x4*)(Vblk + (size_t)row * ldv + ch * 8); }
__device__ __forceinline__ void stage_store(const Stage& s, unsigned char* kbuf, unsigned char* vbuf, int tid) {
    const int row = tid >> 3, ch = tid & 7;
    *(u32x4*)(kbuf + row * KROW + ch * 16) = s.k;
    *(u32x4*)(vbuf + row * VROW + ch * 16) = s.v; }

struct SoftState { float mhat, l; f32x16 cneg; };
constexpr float ATT_THR = 8.0f;
template <int BR, int ABL>
__device__ __forceinline__ void block64(f32x16 (&o)[2], SoftState& ss, const unsigned char* kbuf, const unsigned char* vbuf, int dj, bool selbit, bool anyunsel, const bf16x8 (&qf)[4], const float* bt2,
                                        int q32, int hi, int tl) {
    f32x16 s0 = ss.cneg, s1 = ss.cneg;
#pragma unroll
    for (int sp = 0; sp < 4; ++sp) { s0 = __builtin_amdgcn_mfma_f32_32x32x16_bf16(kfrag(kbuf, 0, sp, q32, hi), qf[sp], s0, 0, 0, 0); s1 = __builtin_amdgcn_mfma_f32_32x32x16_bf16(kfrag(kbuf, 1, sp, q32, hi), qf[sp], s1, 0, 0, 0); }
    __builtin_amdgcn_sched_barrier(0);
    bf16x8 vf0[2][2], vf1[2][2];
#pragma unroll
    for (int s = 0; s < 2; ++s)
#pragma unroll
        for (int dt = 0; dt < 2; ++dt) vf0[s][dt] = vfrag(vbuf, 0, s, dt, q32, hi);
    __builtin_amdgcn_sched_barrier(0);
    if (dj <= 2) {
        const int basei = 64 * dj + tl + 64 - 4 * hi - 27; const float* bt0 = bt2 + basei; const float* bt1 = bt0 - 32;
#pragma unroll
        for (int r = 0; r < 16; ++r) { const int cr = (r & 3) + 8 * (r >> 2); s0[r] += bt0[27 - cr]; s1[r] += bt1[27 - cr]; }
    } else if (BR == 1 && dj == 8) {
        const int basei = tl - 4 * hi;
#pragma unroll
        for (int r = 0; r < 16; ++r) { const int cr = (r & 3) + 8 * (r >> 2);
            s0[r] += __int_as_float(((cr - basei - 1) >> 31) & 0xf149f2cau); s1[r] += __int_as_float(((cr + 32 - basei - 1) >> 31) & 0xf149f2cau); }
    }
    if (!(ABL & 64)) {
    float rm = max3f(s0[0], s0[1], s1[0]), rm2 = max3f(s0[2], s0[3], s1[1]);
    rm = max3f(rm, s1[2], s1[3]);
#pragma unroll
    for (int r = 4; r < 16; r += 4) { rm = max3f(rm, s0[r], s0[r + 1]); rm2 = max3f(rm2, s0[r + 2], s0[r + 3]); rm = max3f(rm, s1[r], s1[r + 1]); rm2 = max3f(rm2, s1[r + 2], s1[r + 3]); }
    rm = max3f(rm, rm2, rm2);
    if (BR == 0) rm = selbit ? rm : -1e30f;
    if (__any(rm > ATT_THR)) {
        const float rmc = fmaxf(rm, __shfl_xor(rm, 32)), dl = fmaxf(rmc, 0.f), f = __builtin_amdgcn_exp2f(-dl);
        ss.mhat += dl; ss.l *= f;
#pragma unroll
        for (int r = 0; r < 16; ++r) { s0[r] -= dl; s1[r] -= dl; ss.cneg[r] -= dl; o[0][r] *= f; o[1][r] *= f; }
    }
    }
    float ps = 0.f, ps1 = 0.f, ps2 = 0.f, ps3 = 0.f;
#pragma unroll
    for (int r = 0; r < 16; r += 2) { s0[r] = __builtin_amdgcn_exp2f(s0[r]); s0[r + 1] = __builtin_amdgcn_exp2f(s0[r + 1]); ps += s0[r]; ps2 += s0[r + 1]; }
    const unsigned pm = (BR == 0 && !selbit) ? 0u : 0xffffffffu;
    bf16x8 pb0[2];
#pragma unroll
    for (int s = 0; s < 2; ++s) { pb0[s] = packp(s0, s);
        if (BR == 0 && anyunsel) { u32x4 w = __builtin_bit_cast(u32x4, pb0[s]); w.x &= pm; w.y &= pm; w.z &= pm; w.w &= pm; pb0[s] = __builtin_bit_cast(bf16x8, w); } }
    __builtin_amdgcn_sched_barrier(0);
#pragma unroll
    for (int i = 0; i < 4; ++i) { const int s = i >> 1, dt = i & 1;
        o[dt] = __builtin_amdgcn_mfma_f32_32x32x16_bf16(vf0[s][dt], pb0[s], o[dt], 0, 0, 0);
#pragma unroll
        for (int e = 0; e < 4; ++e) s1[4 * i + e] = __builtin_amdgcn_exp2f(s1[4 * i + e]);
        __builtin_amdgcn_sched_barrier(0); }
#pragma unroll
    for (int s = 0; s < 2; ++s)
#pragma unroll
        for (int dt = 0; dt < 2; ++dt) vf1[s][dt] = vfrag(vbuf, 1, s, dt, q32, hi);
#pragma unroll
    for (int r = 0; r < 16; r += 2) { ps1 += s1[r]; ps3 += s1[r + 1]; }
    ps = (ps + ps1) + (ps2 + ps3);
    if (BR == 0) ps = selbit ? ps : 0.f;
    ss.l += ps;
#pragma unroll
    for (int s = 0; s < 2; ++s) { bf16x8 pb = packp(s1, s);
        if (BR == 0 && anyunsel) { u32x4 w = __builtin_bit_cast(u32x4, pb); w.x &= pm; w.y &= pm; w.z &= pm; w.w &= pm; pb = __builtin_bit_cast(bf16x8, w); }
#pragma unroll
        for (int dt = 0; dt < 2; ++dt) o[dt] = __builtin_amdgcn_mfma_f32_32x32x16_bf16(vf1[s][dt], pb, o[dt], 0, 0, 0); }
}
__device__ __forceinline__ void stage_load_t(Stage& s, const bf16_t* Kblk, const bf16_t* Vblk, int tid) {
    s.k = *(const u32x4*)(Kblk + (size_t)(tid >> 3) * KVW + (tid & 7) * 8); s.v = *(const u32x4*)(Vblk + (size_t)(tid & 63) * KVW + (tid >> 6) * 8); }
__device__ __forceinline__ void stage_store_t(const Stage& s, unsigned char* kbuf, unsigned char* vbuf, int tid) {
    const int row = tid >> 3, ch = tid & 7;
    *(u32x4*)(kbuf + row * KROW + ch * 16) = s.k;
    unsigned short* vp = (unsigned short*)(vbuf + ((tid >> 6) * 8) * VROW + vperm(tid & 63) * 2);
    vp[0 * (VROW / 2)] = (unsigned short)s.v.x; vp[1 * (VROW / 2)] = (unsigned short)(s.v.x >> 16); vp[2 * (VROW / 2)] = (unsigned short)s.v.y; vp[3 * (VROW / 2)] = (unsigned short)(s.v.y >> 16);
    vp[4 * (VROW / 2)] = (unsigned short)s.v.z; vp[5 * (VROW / 2)] = (unsigned short)(s.v.z >> 16); vp[6 * (VROW / 2)] = (unsigned short)s.v.w; vp[7 * (VROW / 2)] = (unsigned short)(s.v.w >> 16); }
template <int BR, int ABL>
__device__ __forceinline__ void branch(float* outl  , const Stage* first  , float gate, const bf16_t* Kg  , const bf16_t* Vg  ,
                                       int qblk, unsigned unionmask, unsigned mysel, const bf16x8 (&qf)[4], const float* bt2  , float cb  ,
                                       unsigned char* lds, int tid, int q32, int hi, int tl) {
    const int jlo = BR == 0 ? 0 : (qblk - 8 < 0 ? 0 : qblk - 8);
    f32x16 o[2]; o[0] = f32x16{}; o[1] = f32x16{};
    SoftState ss; ss.mhat = 0.f; ss.l = 0.f;
#pragma unroll
    for (int r = 0; r < 16; ++r) ss.cneg[r] = cb;
#define ATT_NEXT(jv) do { --(jv); if (BR == 0) { while ((jv) >= jlo && !((unionmask >> (jv)) & 1u)) --(jv); } } while (0)
#define ATT_LOAD(sg, jv) do { const int jl_ = (jv) < jlo ? jlo : (jv); if (!(ABL & 8)) stage_load_t(sg, Kg + (size_t)jl_ * 64 * KVW, Vg + (size_t)jl_ * 64 * KVW, tid); else { sg.k = (u32x4){(unsigned)jl_, 0u, 0u, 0u}; sg.v = sg.k; } } while (0)
#define ATT_SEL(jv) (BR == 0 ? (((mysel >> (jv)) & 1u) != 0u) : true)
    int jA = qblk, jB = qblk, jC;
    Stage sA, sB;
    if (first) sA = *first; else ATT_LOAD(sA, jA);
    ATT_NEXT(jB); ATT_LOAD(sB, jB);
    stage_store_t(sA, lds + L_K0, lds + L_V0, tid);
    __syncthreads();
    for (;;) {
        jC = jB; if (jB >= jlo) ATT_NEXT(jC);
        ATT_LOAD(sA, jC);
        { const bool sel = ATT_SEL(jA); if (BR == 1 || __any(sel)) block64<BR, ABL>(o, ss, lds + L_K0, lds + L_V0, qblk - jA, sel, BR == 0 && __any(!sel), qf, bt2, q32, hi, tl); }
        if (jB < jlo) break;
        if (!(ABL & 16)) stage_store_t(sB, lds + L_K1, lds + L_V1, tid);
        if (!(ABL & 4)) __syncthreads();
        jA = jC; if (jC >= jlo) ATT_NEXT(jA);
        ATT_LOAD(sB, jA);
        { const bool sel = ATT_SEL(jB); if (BR == 1 || __any(sel)) block64<BR, ABL>(o, ss, lds + L_K1, lds + L_V1, qblk - jB, sel, BR == 0 && __any(!sel), qf, bt2, q32, hi, tl); }
        if (jC < jlo) break;
        if (!(ABL & 16)) stage_store_t(sA, lds + L_K0, lds + L_V0, tid);
        if (!(ABL & 4)) __syncthreads();
        jB = jA; jA = jC;
    }
#undef ATT_NEXT
#undef ATT_LOAD
#undef ATT_SEL
    float lrun = ss.l; lrun += __shfl_xor(lrun, 32);
    const float f = gate / lrun;
#pragma unroll
    for (int r = 0; r < 16; ++r) { outl[r * 64] += o[0][r] * f; outl[(16 + r) * 64] += o[1][r] * f; }
    __syncthreads();
}

__device__ __forceinline__ void attn_bias_table(int g, const float* rel_bias, unsigned char* lds) {
    float* bt = (float*)(lds + L_BT); const int tid = threadIdx.x;
#pragma unroll
    for (int i = 0; i < 2; ++i) { const int e = tid + 512 * i, hh = e >> 8, ix = (e & 255) - 64; const float cbh = rel_bias[31 * NH + g * 4 + hh] * LOG2E; bt[e] = ix < 0 ? -1e30f : rel_bias[BUCKET[ix > 127 ? 127 : ix] * NH + g * 4 + hh] * LOG2E - cbh; }
    if (tid < 4) bt[1024 + tid] = rel_bias[31 * NH + g * 4 + tid] * LOG2E;
    __syncthreads();
}
__device__ __forceinline__ void attn_compress_l2(int bg, const bf16_t* HIDK, const bf16_t* HIDV, const float* w2k, const float* w2v, const float* kc_norm, unsigned char* lds) {
    const int tid = threadIdx.x, lane = tid & 63, wave = tid >> 6, q32 = lane & 31, hi = lane >> 5, which = wave >> 2, c = 32 * (wave & 3) + q32; const bool okc = c < NC;
    const bf16_t* hrow = (which ? HIDV : HIDK) + (size_t)(bg * NC + (okc ? c : 0)) * 256; const float* w2 = which ? w2v : w2k;
    f32x16 acc[2]; acc[0] = f32x16{}; acc[1] = f32x16{};
    for (int s = 0; s < 16; ++s) {
        const bf16x8 bfrag = *(const bf16x8*)(hrow + 16 * s + 8 * hi);
#pragma unroll
        for (int nt = 0; nt < 2; ++nt) { const float* wp = w2 + (size_t)(16 * s + 8 * hi) * HD + 32 * nt + q32;
            u32x4 aw; aw.x = cvtpk(wp[0], wp[HD]); aw.y = cvtpk(wp[2 * HD], wp[3 * HD]); aw.z = cvtpk(wp[4 * HD], wp[5 * HD]); aw.w = cvtpk(wp[6 * HD], wp[7 * HD]);
            acc[nt] = __builtin_amdgcn_mfma_f32_32x32x16_bf16(__builtin_bit_cast(bf16x8, aw), bfrag, acc[nt], 0, 0, 0); }
    }
    if (which) {
        unsigned short* vp = (unsigned short*)(lds + L_VC) + vperm(c);
#pragma unroll
        for (int nt = 0; nt < 2; ++nt)
#pragma unroll
            for (int q = 0; q < 16; ++q) vp[(32 * nt + crow(q, hi)) * (VCROW / 2)] = okc ? (unsigned short)(cvtpk(acc[nt][q], 0.f) & 0xffffu) : (unsigned short)0;
    } else {
        float ss = 0.f;
#pragma unroll
        for (int nt = 0; nt < 2; ++nt)
#pragma unroll
            for (int q = 0; q < 16; ++q) ss += acc[nt][q] * acc[nt][q];
        ss += __shfl_xor(ss, 32); const float rn = okc ? rsqrtf(ss * (1.f / HD) + EPS) : 0.f;
#pragma unroll
        for (int nt = 0; nt < 2; ++nt)
#pragma unroll
            for (int rg = 0; rg < 4; ++rg) { const int n0 = 32 * nt + 8 * rg + 4 * hi; const f32x4 gk = *(const f32x4*)(kc_norm + n0);
                *(unsigned long long*)(lds + L_KC + c * KROW + n0 * 2) = (unsigned long long)cvtpk(acc[nt][4 * rg] * rn * gk[0], acc[nt][4 * rg + 1] * rn * gk[1]) | ((unsigned long long)cvtpk(acc[nt][4 * rg + 2] * rn * gk[2], acc[nt][4 * rg + 3] * rn * gk[3]) << 32); }
    }
    __syncthreads();
}
__device__ __forceinline__ bf16x8 vfragc(const unsigned char* vcbuf, int tile, int s, int dt, int q32, int hi) { return *(const bf16x8*)(vcbuf + (32 * dt + q32) * VCROW + (32 * tile + 16 * s + 8 * hi) * 2); }
template <int MODE, int ABL = 0>
__device__ __forceinline__ void attn_unit(int b, int g, int qblk, const bf16_t* Q, bf16_t* O, const bf16_t* KSb, const bf16_t* VSb, const bf16_t* KWb, const bf16_t* VWb,
                                          const bf16_t* GN, const float* rel_bias, unsigned char* lds) {
    int tid = threadIdx.x; asm volatile("" : "+v"(tid));
    const int lane = tid & 63, wave = tid >> 6, q32 = lane & 31, hi = lane >> 5, hr = wave >> 1, th = wave & 1, h = g * 4 + hr, tl = 32 * th + q32, t = 64 * qblk + tl, bg = b * 4 + g;
    const size_t m = (size_t)b * T + t;
    float* bt = (float*)(lds + L_BT); float* impg = (float*)(lds + L_IMPG); float* impl = (float*)(lds + L_IMPL); float* imp = (float*)(lds + L_IMP); unsigned* selm = (unsigned*)(lds + L_SELM);
    bf16x8 qf[4];
#pragma unroll
    for (int sp = 0; sp < 4; ++sp) qf[sp] = *(const bf16x8*)(Q + m * QW + h * HD + 16 * sp + 8 * hi);
    const float g0 = bf2f(GN[m * 48 + h * 3 + 0]), g1 = bf2f(GN[m * 48 + h * 3 + 1]), g2 = bf2f(GN[m * 48 + h * 3 + 2]);
    f32x16 out[2];
    {
        const float* bte = bt + hr * 256 + 64; const float cbh = bt[1024 + hr];
        const int ncv = t >= 31 ? ((t - 31) >> 4) + 1 : 0;
        f32x16 sc[4]; float mx = -1e20f;
#pragma unroll
        for (int tile = 0; tile < 4; ++tile) {
            sc[tile] = qk_tile(lds + L_KC, tile, qf, q32, hi);
            __builtin_amdgcn_sched_barrier(0);
#pragma unroll
            for (int r = 0; r < 16; ++r) { const int c = 32 * tile + crow(r, hi);
                int dist = t - 31 - 16 * c; const float pen = __int_as_float(((ncv - 1 - c) >> 31) & 0xf149f2cau);
                dist = dist < 0 ? 0 : (dist > 127 ? 127 : dist);
                const float v = (sc[tile][r] + (bte[dist] + cbh)) + pen; sc[tile][r] = v; mx = fmaxf(mx, v); }
            __builtin_amdgcn_sched_barrier(0);
        }
        mx = fmaxf(mx, __shfl_xor(mx, 32));
        float l = 0.f;
#pragma unroll
        for (int tile = 0; tile < 4; ++tile)
#pragma unroll
            for (int r = 0; r < 16; ++r) { const float p = __builtin_amdgcn_exp2f(sc[tile][r] - mx); sc[tile][r] = p; l += p; }
        l += __shfl_xor(l, 32);
        const float inv = l > 0.f ? 1.f / l : 0.f;
#pragma unroll
        for (int tile = 0; tile < 4; ++tile)
#pragma unroll
            for (int r = 0; r < 16; ++r) sc[tile][r] *= inv;
        __builtin_amdgcn_sched_barrier(0);
        if (qblk > 15)
#pragma unroll
        for (int tile = 0; tile < 4; ++tile)
#pragma unroll
            for (int rg = 0; rg < 4; ++rg) { const int j = 8 * tile + 2 * rg + hi;
                impg[(hr * 64 + tl) * 33 + j] = (sc[tile][4 * rg] + sc[tile][4 * rg + 1]) + (sc[tile][4 * rg + 2] + sc[tile][4 * rg + 3]);
                impl[(hr * 64 + tl) * 33 + j] = sc[tile][4 * rg + 3]; }
        __builtin_amdgcn_sched_barrier(0);
        f32x16 o[2]; o[0] = f32x16{}; o[1] = f32x16{};
#pragma unroll
        for (int tile = 0; tile < 4; ++tile) {
#pragma unroll
            for (int s = 0; s < 2; ++s) { const bf16x8 pb = packp(sc[tile], s);
#pragma unroll
                for (int dt = 0; dt < 2; ++dt) o[dt] = __builtin_amdgcn_mfma_f32_32x32x16_bf16(vfragc(lds + L_VC, tile, s, dt, q32, hi), pb, o[dt], 0, 0, 0); }
            __builtin_amdgcn_sched_barrier(0); }
#pragma unroll
        for (int r = 0; r < 16; ++r) { out[0][r] = o[0][r] * g0; out[1][r] = o[1][r] * g0; }
    }
    const bf16_t* Kgs = KSb + (size_t)b * T * KVW + g * HD; const bf16_t* Kgw = KWb + (size_t)b * T * KVW + g * HD;
    const bf16_t* Vgs = VSb + (size_t)b * T * KVW + g * HD; const bf16_t* Vgw = VWb + (size_t)b * T * KVW + g * HD;
    Stage sfirst; stage_load_t(sfirst, Kgs + (size_t)qblk * 64 * KVW, Vgs + (size_t)qblk * 64 * KVW, tid);
    unsigned mysel, uni;
    if (qblk > 15) {
    __syncthreads();
    {
        const int stl = tid >> 3, jq = tid & 7;
#pragma unroll
        for (int e = 0; e < 4; ++e) { const int j = 4 * jq + e; float s = 0.f;
#pragma unroll
            for (int r = 0; r < 4; ++r) { s += impg[(r * 64 + stl) * 33 + j]; if (j > 0) s += impl[(r * 64 + stl) * 33 + j - 1]; }
            imp[stl * 33 + j] = s; }
        __syncthreads();
        unsigned bits = 0u;
        {
            float iv[32];
#pragma unroll
            for (int k = 0; k < 32; ++k) iv[k] = imp[stl * 33 + k];
#pragma unroll
            for (int e = 0; e < 4; ++e) { const int j = 4 * jq + e; float vj = iv[0];
#pragma unroll
                for (int k = 1; k < 32; ++k) vj = (k == j) ? iv[k] : vj;
                int rank = 0;
#pragma unroll
                for (int k = 1; k < 30; ++k) { const bool cand = k <= qblk - 2; rank += (cand && (iv[k] > vj || (iv[k] == vj && k < j))) ? 1 : 0; }
                if (j == 0 || j == qblk - 1 || j == qblk) bits |= 1u << j; else if (j < qblk - 1 && rank < 13) bits |= 1u << j; }
        }
        bits |= __shfl_xor(bits, 1); bits |= __shfl_xor(bits, 2); bits |= __shfl_xor(bits, 4);
        if (jq == 0) selm[stl] = bits;
    }
    __syncthreads();
    mysel = selm[tl]; uni = selm[lane];
#pragma unroll
    for (int o = 1; o < 64; o <<= 1) uni |= __shfl_xor(uni, o);
    } else { mysel = uni = (1u << (qblk + 1)) - 1u; }
    float* outl = (float*)(lds + L_IMPG) + wave * 2048 + lane;
#pragma unroll
    for (int r = 0; r < 16; ++r) { outl[r * 64] = out[0][r]; outl[(16 + r) * 64] = out[1][r]; }
    if (MODE & 2) branch<0, ABL>(outl, &sfirst, g1, Kgs, Vgs, qblk, uni, mysel, qf, bt + hr * 256, bt[1024 + hr], lds, tid, q32, hi, tl);
    if (MODE & 4) branch<1, ABL>(outl, nullptr, g2, Kgw, Vgw, qblk, 0xffffffffu, 0xffffffffu, qf, bt + hr * 256, bt[1024 + hr], lds, tid, q32, hi, tl);
    bf16_t* orow = O + m * QW + h * HD;
#pragma unroll
    for (int dt = 0; dt < 2; ++dt)
#pragma unroll
        for (int rg = 0; rg < 4; ++rg)
            *(unsigned long long*)(orow + 32 * dt + 8 * rg + 4 * hi) = (unsigned long long)cvtpk(outl[(16 * dt + 4 * rg) * 64], outl[(16 * dt + 4 * rg + 1) * 64]) | ((unsigned long long)cvtpk(outl[(16 * dt + 4 * rg + 2) * 64], outl[(16 * dt + 4 * rg + 3) * 64]) << 32);
}
}

__device__ __forceinline__ void tr_item(const float* W, int ldw, int kvalid, int c0, int cvalid, const float* kscale, bf16_t* WT, int ldt, int r0, int k0, float* scr, int lane) {
#pragma unroll
    for (int i = 0; i < 32; ++i) { const int kk = 2 * i + (lane >> 5), col = lane & 31, k = k0 + kk;
        float v = 0.f; if (k < kvalid && col < cvalid) { v = W[(size_t)k * ldw + c0 + col]; if (kscale) v *= kscale[k]; }
        scr[kk * 33 + col] = v; }
    asm volatile("s_waitcnt lgkmcnt(0)" ::: "memory");
    const int c = lane & 7;
#pragma unroll
    for (int j = 0; j < 4; ++j) { const int n = (lane >> 3) + 8 * j; const float* s = scr + (8 * c) * 33 + n;
        pg8::u32x4 o; o.x = pg8::cvt_pk_bf16(s[0 * 33], s[1 * 33]); o.y = pg8::cvt_pk_bf16(s[2 * 33], s[3 * 33]); o.z = pg8::cvt_pk_bf16(s[4 * 33], s[5 * 33]); o.w = pg8::cvt_pk_bf16(s[6 * 33], s[7 * 33]);
        *(pg8::u32x4*)(WT + (size_t)(r0 + n) * ldt + k0 + 8 * c) = o; }
    asm volatile("s_waitcnt lgkmcnt(0)" ::: "memory");
}

#define LAS __attribute__((address_space(3)))
#define XB_TMO      128
#define XB_XCNT(j)  (256  + 64 * (j))
#define XB_XSUB(j)  (1280 + 64 * (j))
#define XB_XGEN(j)  (2304 + 64 * (j))
#define XB_TOP      3328
#define XB_TOPGEN   3392
#define XCD_BAR_WORDS 3456
#define XB_SPIN_CAP (1u << 18)

__device__ __forceinline__ unsigned xb_ld(unsigned* p)              { return __hip_atomic_load(p, __ATOMIC_RELAXED, __HIP_MEMORY_SCOPE_AGENT); }
__device__ __forceinline__ unsigned xb_add(unsigned* p, unsigned v) { return __hip_atomic_fetch_add(p, v, __ATOMIC_RELAXED, __HIP_MEMORY_SCOPE_AGENT); }
__device__ __forceinline__ unsigned xb_xcc_id() { return (unsigned)__builtin_amdgcn_s_getreg((3 << 11) | 20) & 0xFu; }
#define XB_SPIN(cond, bar) do { unsigned _sp = 0; while (cond) { __builtin_amdgcn_s_sleep(1); \
    if ((++_sp & 255u) == 0u) { if (xb_ld(&(bar)[XB_TMO])) break; if (_sp > XB_SPIN_CAP) { atomicAdd(&(bar)[XB_TMO], 1u); break; } } } } while (0)

struct XcdBarrier {
    unsigned* bar; unsigned x;
    volatile LAS unsigned* st;
};

__device__ __forceinline__ XcdBarrier xcd_barrier_post(unsigned* bar, volatile LAS unsigned* st) {
    XcdBarrier b; b.bar = bar; b.x = xb_xcc_id(); b.st = st;
    if (threadIdx.x == 0) (void)xb_add(&bar[XB_XCNT(b.x)], 1u);
    return b;
}
__device__ __forceinline__ void xcd_barrier_complete(unsigned* bar, unsigned x, unsigned& nloc, unsigned& nx) {
    const unsigned G = gridDim.x * gridDim.y * gridDim.z;
    unsigned sum, cnt, mine, sp = 0u;
    for (;;) {
        sum = 0u; cnt = 0u; mine = 0u;
#pragma unroll
        for (unsigned j = 0; j < 16; ++j) { const unsigned c = xb_ld(&bar[XB_XCNT(j)]); sum += c; cnt += (c > 0u) ? 1u : 0u; mine = (j == x) ? c : mine; }
        if (sum == G) break;
        __builtin_amdgcn_s_sleep(1);
        if ((++sp & 255u) == 0u) { if (xb_ld(&bar[XB_TMO])) break; if (sp > XB_SPIN_CAP) { atomicAdd(&bar[XB_TMO], 1u); break; } }
    }
    nloc = mine > 0u ? mine : 1u; nx = cnt > 0u ? cnt : 1u;
}

__device__ __forceinline__ void xcd_barrier(const XcdBarrier& b) {
    asm volatile("s_waitcnt vmcnt(0)" ::: "memory");
    __syncthreads();
    if (threadIdx.x == 0) {
        unsigned* bar = b.bar;
        __builtin_amdgcn_s_waitcnt(0);
        unsigned nloc = b.st[0], nx = b.st[1];
        if (nloc == 0u) { xcd_barrier_complete(bar, b.x, nloc, nx); b.st[0] = nloc; b.st[1] = nx; }
        const unsigned old = xb_add(&bar[XB_XSUB(b.x)], 1u);
        const unsigned gen = old / nloc;
        if (old + 1u == (gen + 1u) * nloc) {
            __builtin_amdgcn_fence(__ATOMIC_RELEASE, "agent");
            asm volatile("s_waitcnt vmcnt(0)" ::: "memory");
            const unsigned og = xb_add(&bar[XB_TOP], 1u);
            const unsigned tg = og / nx;
            if (og + 1u == (tg + 1u) * nx) xb_add(&bar[XB_TOPGEN], 1u);
            else XB_SPIN(xb_ld(&bar[XB_TOPGEN]) == tg, bar);
            __builtin_amdgcn_fence(__ATOMIC_ACQUIRE, "agent");
            xb_add(&bar[XB_XGEN(b.x)], 1u);
            asm volatile("s_waitcnt vmcnt(0)" ::: "memory");
        } else {
            XB_SPIN(xb_ld(&bar[XB_XGEN(b.x)]) == gen, bar);
            __builtin_amdgcn_fence(__ATOMIC_ACQUIRE, "agent");
            asm volatile("s_waitcnt vmcnt(0)" ::: "memory");
        }
    }
    __syncthreads();
}

#define DECL_PTRS \
    size_t zoff_ = 0; asm volatile("" : "+s"(zoff_));     \
    unsigned char* ws = a.ws + zoff_; unsigned char* dob = (unsigned char*)a.out + zoff_; \
    const float *x = a.in[0], *norm_mix = a.in[1], *w_in = a.in[2], *conv_w = a.in[3], *conv_b = a.in[4], *gate_a_w = a.in[5], *gate_a_b = a.in[6], *gate_x_w = a.in[7], *gate_x_b = a.in[8], \
                *lam = a.in[9], *pe_k = a.in[10], *w1k = a.in[11], *w2k = a.in[12], *pe_v = a.in[13], *w1v = a.in[14], *w2v = a.in[15], *q_norm = a.in[16], *kc_norm = a.in[17], *ks_norm = a.in[18], \
                *kw_norm = a.in[19], *rel_bias = a.in[20], *proj_a = a.in[21], *proj_b = a.in[22], *w_out = a.in[23], *norm_mlp = a.in[24], *w_mlp_in = a.in[25], *w_mlp_out = a.in[26]; \
    float* RSTD = (float*)(ws + WS_RSTD); float* KCC = (float*)(ws + WS_KCC); float* VCC = (float*)(ws + WS_VCC); unsigned* SEL = (unsigned*)(ws + WS_SEL); \
    bf16_t *URNN = (bf16_t*)(ws + WS_URNN), *UGATE = (bf16_t*)(ws + WS_UGATE), *Q = (bf16_t*)(ws + WS_Q), *KV = (bf16_t*)(ws + WS_KV), *GN = (bf16_t*)(ws + WS_GN), *GA = (bf16_t*)(ws + WS_GA), *GB = (bf16_t*)(ws + WS_GB); \
    bf16_t *KCr = KV, *VCr = KV + (size_t)M * KVW, *KS = KV + 2 * (size_t)M * KVW, *VS = KV + 3 * (size_t)M * KVW, *KW = KV + 4 * (size_t)M * KVW, *VW = KV + 5 * (size_t)M * KVW; \
    bf16_t *LA = (bf16_t*)(ws + WS_LA), *UP = (bf16_t*)(ws + WS_UP), *T1 = (bf16_t*)(ws + WS_T1), *MERGED = (bf16_t*)(ws + WS_MERGED), *HB = (bf16_t*)(ws + WS_HB), *ZACT = (bf16_t*)(ws + WS_ZACT); \
    bf16_t *FLATK = (bf16_t*)(dob + DO_FLATK), *FLATV = (bf16_t*)(dob + DO_FLATV), *HIDK = (bf16_t*)(dob + DO_HIDK), *HIDV = (bf16_t*)(dob + DO_HIDV), *XC = (bf16_t*)(dob + DO_XC), *YA = (bf16_t*)(dob + DO_YA); \
    float* H = (float*)dob; \
    float* LAMC = (float*)(ws + WS_LAMC); float* NORMS = (float*)(ws + WS_NORMS); float* PES = (float*)(ws + WS_PES); float* SSQ = (float*)(ws + WS_SSQ); \
    bf16_t *WIN_T = (bf16_t*)(ws + WS_WIN), *WG_T = (bf16_t*)(ws + WS_WG), *W1_T = (bf16_t*)(ws + WS_W1), *PA_T = (bf16_t*)(ws + WS_PA), *PB_T = (bf16_t*)(ws + WS_PB), *WO_T = (bf16_t*)(ws + WS_WO), *WMI_T = (bf16_t*)(ws + WS_WMI), *WMO_T = (bf16_t*)(ws + WS_WMO); \
    float *CAR = (float*)(dob + DO_CAR), *CBR = (float*)(dob + DO_CBR); \
    bf16_t* XB = (bf16_t*)(dob + DO_XB); bf16_t *KCB = (bf16_t*)(dob + DO_KCB), *VCT = (bf16_t*)(dob + DO_VCT), *VST = (bf16_t*)(dob + DO_VST), *VWT = (bf16_t*)(dob + DO_VWT); \
    (void)0;
__global__ void __launch_bounds__(NTHREADS, 2) fwd(Args a) {
    extern __shared__ __attribute__((aligned(16))) unsigned char lds[];
    float* ldsf = (float*)lds;
    const int tid = threadIdx.x, lane = tid & 63, wave = tid >> 6;
    const int gw = blockIdx.x * 8 + wave, NGW = gridDim.x * 8;
    const size_t gtid = (size_t)blockIdx.x * NTHREADS + tid, GSZ = (size_t)gridDim.x * NTHREADS;
    unsigned char* ws0 = a.ws;
    PG8_LAS unsigned char* ldsl = (PG8_LAS unsigned char*)lds;
    const int G = gridDim.x;
    const int lo = a.ph_lo, hi = a.ph_hi;
    volatile LAS unsigned* MISC = (volatile LAS unsigned*)((LAS unsigned char*)lds + LDS_BYTES - 256);
    if (tid < 32) MISC[tid] = 0u;
    __syncthreads();
    XcdBarrier bar = xcd_barrier_post((unsigned*)(ws0 + 16384), MISC + 8);
    int ph = 0;
#ifndef PHMASK
#define PHMASK 0xFFFFFFFFu
#endif
#ifndef REPMASK
#define REPMASK 0u
#endif
#define PHASE_BEGIN if (lo <= ph && ph < hi && ((PHMASK >> ph) & 1u)) {
#define PHASE_BEGIN_R if (lo <= ph && ph < hi && ((PHMASK >> ph) & 1u)) for (int rep_ = 0; rep_ < (((REPMASK >> (16 + ph)) & 1u) ? 2 : 1); ++rep_) {
#define PHASE_END } { const bool sync_ = (lo <= ph && ph + 1 < hi); ++ph; if (sync_) xcd_barrier(bar); }

    PHASE_BEGIN_R DECL_PTRS
    for (int m0 = 2 * gw; m0 < M; m0 += 2 * NGW) {
        pg8::f32x4 v[2][4]; float s[2] = {0.f, 0.f};
#pragma unroll
        for (int u = 0; u < 2; ++u) { const pg8::f32x4* xr = (const pg8::f32x4*)(x + (size_t)(m0 + u) * D) + lane;
#pragma unroll
            for (int j = 0; j < 4; ++j) v[u][j] = xr[64 * j]; }
#pragma unroll
        for (int u = 0; u < 2; ++u)
#pragma unroll
            for (int j = 0; j < 4; ++j) s[u] += (v[u][j][0] * v[u][j][0] + v[u][j][1] * v[u][j][1]) + (v[u][j][2] * v[u][j][2] + v[u][j][3] * v[u][j][3]);
#pragma unroll
        for (int o = 1; o < 64; o <<= 1) { s[0] += __shfl_xor(s[0], o); s[1] += __shfl_xor(s[1], o); }
#pragma unroll
        for (int u = 0; u < 2; ++u) { const float r = rsqrtf(s[u] * (1.f / D) + EPS); if (lane == 0) RSTD[m0 + u] = r;
            unsigned long long* o8 = (unsigned long long*)(XB + (size_t)(m0 + u) * D) + lane;
#pragma unroll
            for (int j = 0; j < 4; ++j) { const pg8::f32x4 gg = *((const pg8::f32x4*)norm_mix + lane + 64 * j); const pg8::f32x4 y = v[u][j] * r * gg;
                o8[64 * j] = (unsigned long long)pg8::cvt_pk_bf16(y[0], y[1]) | ((unsigned long long)pg8::cvt_pk_bf16(y[2], y[3]) << 32); } }
    }
    for (size_t i = gtid; i < DRNN; i += GSZ) LAMC[i] = -8.f * log1pf(__expf(-lam[i])) * LOG2E;
    for (size_t i = gtid; i < 4096; i += GSZ) PES[i] = i < 2048 ? pe_k[i] : pe_v[i - 2048];
    for (size_t i = gtid; i < 192; i += GSZ) NORMS[i] = i < 64 ? q_norm[i] : (i < 128 ? ks_norm[i - 64] : kw_norm[i - 128]);
    {
        float* scr = ldsf + wave * (64 * 33);
        constexpr int I_WIN = (pg8::N1PAD / 32) * 16, I_W1 = 16 * 32;
        for (int it = gw; it < I_WIN + I_W1; it += NGW) {
            int r = it;
            if (r < I_WIN) { const int ch = r / 16, kb = r % 16; int c0, cv; pg8::win_src(ch, c0, cv); tr_item(w_in, DIN, D, c0, cv, nullptr, WIN_T, D, 32 * ch, 64 * kb, scr, lane); continue; } r -= I_WIN;
            { const int ch = r / 32, kb = r % 32; tr_item((ch >> 3) ? w1v : w1k, 256, 2048, (ch & 7) * 32, 32, nullptr, W1_T, 2048, 32 * ch, 64 * kb, scr, lane); }
        }
    }
    PHASE_END
    PHASE_BEGIN DECL_PTRS
    if (FAST(1)) {
        pg8::Gemm g{XB, WIN_T, M, pg8::N1PAD, D}; pg8::StaticOrder S; S.init(M, pg8::N1PAD, G, (int)blockIdx.x);
        PG8_LAS float* ctab = (PG8_LAS float*)(ldsl + 131072);
        for (int i = tid; i < 192; i += NTHREADS) ctab[i] = NORMS[i];
        for (int i = tid; i < 4096; i += NTHREADS) ctab[256 + i] = PES[i];
        __syncthreads();
        pg8::Ep1F E{URNN, UGATE, Q, KV, GN, GA, ctab, FLATK, ctab + 256};
        pg8::gemm_phase<pg8::Ep1F, pg8::StaticOrder, true, true>(ldsl, g, S, E);
#if (REPMASK >> 1) & 1
        pg8::gemm_phase<pg8::Ep1F, pg8::StaticOrder, true, true>(ldsl, g, S, E);
#endif
    } else {
        ngemm(ldsf, M, DIN, D, ALf32Scale{x, D, norm_mix}, BLf32{w_in, DIN}, Ep1{RSTD, URNN, UGATE, Q, KV, GN, GA, GB});
    }
    PHASE_END
    PHASE_BEGIN DECL_PTRS
    if (blockIdx.x >= 64) {
        float* scr = ldsf + wave * (64 * 33);
        constexpr int I_WG = 96 * 6, I_PA = 32 * 22, I_PB = 32 * 16, I_WO = 32 * 16, I_WMI = 128 * 16, I_WMO = 32 * 64;
        for (int it = ((int)blockIdx.x - 64) * 8 + wave; it < I_WG + I_PA + I_PB + I_WO + I_WMI + I_WMO; it += ((int)gridDim.x - 64) * 8) {
            int r = it;
            if (r < I_WG) { const int ch = r / 6, kb = r % 6, nb = ch / 24, rr = ch % 24, pn = rr >> 3, l0 = (rr & 7) * 32, bj = l0 >> 7, chn0 = 128 * pn + (l0 & 127);
                int cv = BW - chn0; cv = cv < 0 ? 0 : (cv > 32 ? 32 : cv);
                tr_item((bj ? gate_x_w : gate_a_w) + (size_t)nb * BW * BW, BW, BW, chn0, cv, nullptr, WG_T, XC_LD, 32 * ch, 64 * kb, scr, lane); continue; } r -= I_WG;
            if (r < I_PA) { const int ch = r / 22, kb = r % 22; tr_item(proj_a, D, DRNN, 32 * ch, 32, nullptr, PA_T, YA_LD, 32 * ch, 64 * kb, scr, lane); continue; } r -= I_PA;
            if (r < I_PB) { const int ch = r / 16, kb = r % 16; tr_item(proj_b, D, QW, 32 * ch, 32, nullptr, PB_T, QW, 32 * ch, 64 * kb, scr, lane); continue; } r -= I_PB;
            if (r < I_WO) { const int ch = r / 16, kb = r % 16; tr_item(w_out, D, D, 32 * ch, 32, nullptr, WO_T, D, 32 * ch, 64 * kb, scr, lane); continue; } r -= I_WO;
            if (r < I_WMI) { const int ch = r / 16, kb = r % 16; tr_item(w_mlp_in, DFF, D, 32 * ch, 32, norm_mlp, WMI_T, D, 32 * ch, 64 * kb, scr, lane); continue; } r -= I_WMI;
            { const int ch = r / 64, kb = r % 64; tr_item(w_mlp_out, D, DFF, 32 * ch, 32, nullptr, WMO_T, DFF, 32 * ch, 64 * kb, scr, lane); }
        }
    } else
    if (FAST(3)) {
        pg8::Gemm g{FLATK, W1_T, 16384, 512, 2048}; pg8::OrderC1 S{G, (int)blockIdx.x};
        pg8::EpGeluF E{HIDK, 256};
        pg8::gemm_phase<pg8::EpGeluF, pg8::OrderC1, true, true>(ldsl, g, S, E);
#if (REPMASK >> 3) & 1
        pg8::gemm_phase<pg8::EpGeluF, pg8::OrderC1, true, true>(ldsl, g, S, E);
#endif
    } else {
        ngemm(ldsf, 8192, 256, 2048, ALbf{FLATK, 2048}, BLf32{w1k, 256}, EpGelu{HIDK, 256});
        ngemm(ldsf, 8192, 256, 2048, ALbf{FLATV, 2048}, BLf32{w1v, 256}, EpGelu{HIDV, 256});
    }
    PHASE_END
    PHASE_BEGIN DECL_PTRS
    {
        const int vcu = (G % 8 == 0) ? ((int)blockIdx.x % 8) * (G / 8) + (int)blockIdx.x / 8 : (int)blockIdx.x;
#ifdef ATT_PROBE_MODE
#ifndef ATT_ABL
#define ATT_ABL 0
#endif
        for (int u = vcu; u < 256; u += G) {
            const int bg = u >> 2, s4 = u & 3;
            att::attn_bias_table(bg & 3, rel_bias, lds);
            att::attn_compress_l2(bg, HIDK, HIDV, w2k, w2v, kc_norm, lds);
#pragma unroll 1
            for (int i = 0; i < 8; ++i) { const int qblk = 8 * (i >> 1) + ((i & 1) ? 7 - s4 : s4);
                att::attn_unit<ATT_PROBE_MODE, ATT_ABL>(bg >> 2, bg & 3, qblk, Q, (bf16_t*)dob, KS, VS, KW, VW, GN, rel_bias, lds); }
        }
#endif
        bool nomax;
        {   float* red = (float*)(lds + 159744);
            float v = 0.f; if (tid < 64) v = fabsf(q_norm[tid]); else if (tid < 128) v = fabsf(ks_norm[tid - 64]); else if (tid < 192) v = fabsf(kw_norm[tid - 128]);
            float bb = fabsf(rel_bias[tid]);
#pragma unroll
            for (int o = 32; o; o >>= 1) { v = fmaxf(v, __shfl_xor(v, o)); bb = fmaxf(bb, __shfl_xor(bb, o)); }
            if (lane == 0) { red[wave] = v; red[8 + wave] = bb; }
            __syncthreads();
            const float bm = fmaxf(fmaxf(fmaxf(red[8], red[9]), fmaxf(red[10], red[11])), fmaxf(fmaxf(red[12], red[13]), fmaxf(red[14], red[15])));
            nomax = 11.55f * red[0] * fmaxf(red[1], red[2]) + 1.4427f * bm <= 60.f;
        }
#define ATT_UNITS(ABLV) for (int u = vcu; u < 256; u += G) {     \
            const int bg = u >> 2, s4 = u & 3; \
            att::attn_bias_table(bg & 3, rel_bias, lds); \
            att::attn_compress_l2(bg, HIDK, HIDV, w2k, w2v, kc_norm, lds); \
            _Pragma("unroll 1") for (int i = 7; i >= 0; --i) { const int qblk = 8 * (i >> 1) + ((i & 1) ? 7 - s4 : s4);     \
                att::attn_unit<7, ABLV>(bg >> 2, bg & 3, qblk, Q, Q, KS, VS, KW, VW, GN, rel_bias, lds); } }
        if (nomax) { ATT_UNITS(64) } else { ATT_UNITS(0) }
#undef ATT_UNITS
    }
    for (unsigned it = (unsigned)gtid; it < 4u * (unsigned)(M / 8) * 48u; it += (unsigned)GSZ) {
        const unsigned ch = it % 48u, nr = it / 48u, run = nr & (unsigned)(M / 8 - 1), n = nr >> 12, m0 = run * 8u, t0 = m0 & (unsigned)(T - 1), j0 = ch * 8u;
        bf16_t* dst = XC + ((size_t)n * M + m0) * XC_LD + j0;
        if (j0 >= (unsigned)BW) {
#pragma unroll
            for (int i = 0; i < 8; ++i) *(pg8::u32x4*)(dst + (size_t)i * XC_LD) = (pg8::u32x4){0u, 0u, 0u, 0u};
            continue; }
        const unsigned c = n * BW + j0;
        pg8::u32x4 rows[11];
#pragma unroll
        for (int i = 0; i < 11; ++i) rows[i] = ((int)t0 - 3 + i >= 0) ? *(const pg8::u32x4*)(URNN + (size_t)(m0 - 3 + i) * DRNN + c) : (pg8::u32x4){0u, 0u, 0u, 0u};
        pg8::f32x4 w0[4], w1[4];
#pragma unroll
        for (int kk = 0; kk < 4; ++kk) { w0[kk] = *(const pg8::f32x4*)(conv_w + kk * DRNN + c); w1[kk] = *(const pg8::f32x4*)(conv_w + kk * DRNN + c + 4); }
        const pg8::f32x4 b0 = *(const pg8::f32x4*)(conv_b + c), b1 = *(const pg8::f32x4*)(conv_b + c + 4);
#pragma unroll
        for (int i = 0; i < 8; ++i) { pg8::f32x4 a0 = b0, a1 = b1;
#pragma unroll
            for (int kk = 0; kk < 4; ++kk) { pg8::f32x4 x0, x1; pg8::unpack8(rows[i + kk], x0, x1); a0 += w0[kk] * x0; a1 += w1[kk] * x1; }
            *(pg8::u32x4*)(dst + (size_t)i * XC_LD) = pg8::pack8(a0, a1); }
    }
    PHASE_END
    PHASE_BEGIN DECL_PTRS
    if (FAST(8)) {
        int kg = XC_LD; asm volatile("" : "+s"(kg));
        pg8::Gemm g{XC, WG_T, 4 * M, 4 * 768, kg}; pg8::OrderGate S{G, (int)blockIdx.x};
        pg8::EpGateF E{gate_a_b, gate_x_b, LAMC, XC, LA, UP};
        pg8::gemm_phase<pg8::EpGateF, pg8::OrderGate, true, true>(ldsl, g, S, E);
#if (REPMASK >> 8) & 1
        pg8::gemm_phase<pg8::EpGateF, pg8::OrderGate, true, true>(ldsl, g, S, E);
#endif
    } else {
    for (int n = 0; n < 4; ++n)
        ngemm(ldsf, M, 2 * BW, BW, ALbf{XC + (size_t)n * M * XC_LD, XC_LD}, BLgate{gate_a_w + (size_t)n * BW * BW, gate_x_w + (size_t)n * BW * BW},
              EpGate{n, gate_a_b, gate_x_b, lam, XC + (size_t)n * M * XC_LD, LA, UP});
    }
    PHASE_END
    PHASE_BEGIN_R DECL_PTRS
    for (size_t it = gtid; it < (size_t)NB * 64 * 336; it += GSZ) {
        const int slot = (int)(it % 336), bk = (int)(it / 336), kc = bk & 63, b = bk >> 6, c0 = 4 * slot; const size_t m0 = (size_t)b * T + 32 * kc;
        float h[4] = {0.f, 0.f, 0.f, 0.f}, sl[4] = {0.f, 0.f, 0.f, 0.f};
#pragma unroll 1
        for (int i0 = 0; i0 < 32; i0 += 8) {
            unsigned long long lw[8], uw[8];
#pragma unroll
            for (int i = 0; i < 8; ++i) { lw[i] = *(const unsigned long long*)(LA + (m0 + i0 + i) * DRNN + c0); uw[i] = *(const unsigned long long*)(UP + (m0 + i0 + i) * DRNN + c0); }
#pragma unroll
            for (int i = 0; i < 8; ++i)
#pragma unroll
                for (int e = 0; e < 4; ++e) { const float la = bf2f((bf16_t)(lw[i] >> (16 * e))), up = bf2f((bf16_t)(uw[i] >> (16 * e))); const float av = __builtin_amdgcn_exp2f(la);
                    const float mult = (kc == 0 && i0 + i == 0) ? 1.f : __builtin_amdgcn_sqrtf(fmaxf(0.f, 1.f - av * av)); h[e] = av * h[e] + mult * up; sl[e] += la; }
        }
        *(pg8::f32x4*)(CAR + (size_t)bk * DRNN + c0) = (pg8::f32x4){sl[0], sl[1], sl[2], sl[3]};
        *(pg8::f32x4*)(CBR + (size_t)bk * DRNN + c0) = (pg8::f32x4){h[0], h[1], h[2], h[3]};
    }
    PHASE_END
    PHASE_BEGIN_R DECL_PTRS
    for (size_t it = gtid; it < (size_t)NB * 16 * 352; it += GSZ) {
        const int slot = (int)(it % 352), bs = (int)(it / 352), kg = bs & 15, b = bs >> 4, kc0 = 4 * kg, c0 = 4 * slot; const size_t m0 = (size_t)b * T + 128 * kg;
        if (slot >= 336) { for (int i = 0; i < 128; ++i) *(unsigned long long*)(YA + (m0 + i) * YA_LD + c0) = 0ull; continue; }
        unsigned long long la_[8], ua_[8], ga_[8], lb_[8], ub_[8], gb_[8];
#define SC_LOAD(L_, U_, G_, i0_) _Pragma("unroll") for (int i = 0; i < 8; ++i) { L_[i] = *(const unsigned long long*)(LA + (m0 + (i0_) + i) * DRNN + c0); U_[i] = *(const unsigned long long*)(UP + (m0 + (i0_) + i) * DRNN + c0); G_[i] = *(const unsigned long long*)(UGATE + (m0 + (i0_) + i) * DRNN + c0); }
#define SC_SCAN(L_, U_, G_, i0_) _Pragma("unroll") for (int i = 0; i < 8; ++i) { float y[4]; \
            _Pragma("unroll") for (int e = 0; e < 4; ++e) { const float la = bf2f((bf16_t)(L_[i] >> (16 * e))), up = bf2f((bf16_t)(U_[i] >> (16 * e))); const float av = __builtin_amdgcn_exp2f(la); \
                const float mult = (kg == 0 && (i0_) + i == 0) ? 1.f : __builtin_amdgcn_sqrtf(fmaxf(0.f, 1.f - av * av)); h[e] = av * h[e] + mult * up; y[e] = h[e] * bf2f((bf16_t)(G_[i] >> (16 * e))); } \
            *(unsigned long long*)(YA + (m0 + (i0_) + i) * YA_LD + c0) = (unsigned long long)att::cvtpk(y[0], y[1]) | ((unsigned long long)att::cvtpk(y[2], y[3]) << 32); }
        SC_LOAD(la_, ua_, ga_, 0)
        float h[4] = {0.f, 0.f, 0.f, 0.f};
        for (int k0 = 0; k0 < kc0; k0 += 16) {
            pg8::f32x4 sa[16], sb[16];
#pragma unroll
            for (int u = 0; u < 16; ++u) { const int k2 = k0 + u < kc0 ? k0 + u : kc0 - 1; sa[u] = *(const pg8::f32x4*)(CAR + (size_t)(b * 64 + k2) * DRNN + c0); sb[u] = *(const pg8::f32x4*)(CBR + (size_t)(b * 64 + k2) * DRNN + c0); }
#pragma unroll
            for (int u = 0; u < 16; ++u) if (k0 + u < kc0) {
#pragma unroll
                for (int e = 0; e < 4; ++e) h[e] = __builtin_amdgcn_exp2f(sa[u][e]) * h[e] + sb[u][e]; }
        }
#pragma unroll 1
        for (int r0 = 0; r0 < 128; r0 += 16) {
            SC_LOAD(lb_, ub_, gb_, r0 + 8) SC_SCAN(la_, ua_, ga_, r0)
            if (r0 + 16 < 128) { SC_LOAD(la_, ua_, ga_, r0 + 16) }
            SC_SCAN(lb_, ub_, gb_, r0 + 8)
        }
#undef SC_LOAD
#undef SC_SCAN
    }
    PHASE_END
    PHASE_BEGIN DECL_PTRS
    if (FAST(10)) {
        pg8::Gemm g{YA, PA_T, M, D, YA_LD}; pg8::StaticOrder S; S.init(M, D, G, (int)blockIdx.x);
        pg8::EpT1F E{GA, T1};
        pg8::gemm_phase<pg8::EpT1F, pg8::StaticOrder, true, true>(ldsl, g, S, E);
#if (REPMASK >> 10) & 1
        pg8::gemm_phase<pg8::EpT1F, pg8::StaticOrder, true, true>(ldsl, g, S, E);
#endif
    } else ngemm(ldsf, M, D, DRNN, ALbf{YA, YA_LD}, BLf32{proj_a, D}, EpT1{GA, T1});
    if (FAST(11)) {
        pg8::Gemm g{Q, PB_T, M, D, QW}; pg8::StaticOrder S; S.init(M, D, G, (int)blockIdx.x);
        pg8::EpMergedF E{GB, T1, MERGED};
        pg8::gemm_phase<pg8::EpMergedF, pg8::StaticOrder, true, true>(ldsl, g, S, E);
#if (REPMASK >> 11) & 1
        pg8::gemm_phase<pg8::EpMergedF, pg8::StaticOrder, true, true>(ldsl, g, S, E);
#endif
    } else ngemm(ldsf, M, D, QW, ALbf{Q, QW}, BLf32{proj_b, D}, EpMerged{GB, T1, MERGED});
    PHASE_END
    PHASE_BEGIN DECL_PTRS
    if (FAST(12)) {
        pg8::Gemm g{MERGED, WO_T, M, D, D}; pg8::StaticOrder S; S.init(M, D, G, (int)blockIdx.x);
        pg8::EpHF E{x, H, HB, SSQ};
        pg8::gemm_phase<pg8::EpHF, pg8::StaticOrder, true, true>(ldsl, g, S, E);
#if (REPMASK >> 12) & 1
        pg8::gemm_phase<pg8::EpHF, pg8::StaticOrder, true, true>(ldsl, g, S, E);
#endif
    } else ngemm(ldsf, M, D, D, ALbf{MERGED, D}, BLf32{w_out, D}, EpH{x, H, HB});
    PHASE_END
    PHASE_BEGIN DECL_PTRS
    if (FAST(14)) {
        pg8::Gemm g{HB, WMI_T, M, DFF, D}; pg8::StaticOrder S; S.init(M, DFF, G, (int)blockIdx.x);
        PG8_LAS float* rtab = (PG8_LAS float*)(ldsl + 131072);
        bool tab_ok;
        { pg8::Unit uu; int i = 0;
          for (; i < 16 && S.next(i, uu); ++i) if (tid < 256) { const float* sp = SSQ + (size_t)(uu.pm * 256 + tid) * 16;
                const pg8::f32x4 s0 = *(const pg8::f32x4*)sp, s1 = *(const pg8::f32x4*)(sp + 4), s2 = *(const pg8::f32x4*)(sp + 8), s3 = *(const pg8::f32x4*)(sp + 12); const pg8::f32x4 st = (s0 + s1) + (s2 + s3);
                rtab[i * 256 + tid] = rsqrtf(((st[0] + st[1]) + (st[2] + st[3])) * (1.f / D) + EPS); }
          tab_ok = !(i == 16 && S.next(16, uu)); }
        __syncthreads();
        pg8::EpZF E{tab_ok ? rtab : (PG8_LAS float*)nullptr, SSQ, ZACT};
        pg8::gemm_phase<pg8::EpZF, pg8::StaticOrder, true, true>(ldsl, g, S, E);
#if (REPMASK >> 14) & 1
        pg8::gemm_phase<pg8::EpZF, pg8::StaticOrder, true, true>(ldsl, g, S, E);
#endif
    } else ngemm(ldsf, M, DFF, D, ALbfScale{HB, D, norm_mlp}, BLf32{w_mlp_in, DFF}, EpZ{SSQ, ZACT});
    PHASE_END
    PHASE_BEGIN DECL_PTRS
    if (FAST(15)) {
        pg8::Gemm g{ZACT, WMO_T, M, D, DFF}; pg8::StaticOrder S; S.init(M, D, G, (int)blockIdx.x);
        pg8::EpOutF E{HB, H};
        pg8::gemm_phase<pg8::EpOutF, pg8::StaticOrder, true, true>(ldsl, g, S, E);
#if (REPMASK >> 15) & 1
        pg8::gemm_phase<pg8::EpOutF, pg8::StaticOrder, true, true>(ldsl, g, S, E);
#endif
    } else ngemm(ldsf, M, D, DFF, ALbf{ZACT, DFF}, BLf32{w_mlp_out, D}, EpOut{H});
    PHASE_END
}
constexpr int NPHASES = 11;

extern "C" void kernel_launch(void* const* d_in, const int* in_sizes, int n_in, void* d_out, int out_size, void* d_ws, size_t ws_size, hipStream_t stream) {
    static int grid = 0;
    if (grid == 0) {
        if (n_in != 27 || out_size != M * D || ws_size < WS_END) { fprintf(stderr, "kernel_launch: unexpected shapes n_in %d out %d ws %zu\n", n_in, out_size, ws_size); grid = -1; return; }
        int dev = 0, cus = 0, per_cu = 0;
        (void)hipGetDevice(&dev);
        (void)hipDeviceGetAttribute(&cus, hipDeviceAttributeMultiprocessorCount, dev);
        (void)hipFuncSetAttribute((const void*)fwd, hipFuncAttributeMaxDynamicSharedMemorySize, LDS_BYTES);
        (void)hipOccupancyMaxActiveBlocksPerMultiprocessor(&per_cu, (const void*)fwd, NTHREADS, LDS_BYTES);
        fprintf(stderr, "kernel_launch: cus %d per_cu %d ws_size %zu\n", cus, per_cu, ws_size);
        grid = cus;
    }
    if (grid < 0) return;
    if (hipMemsetAsync(d_ws, 0, 65536, stream) != hipSuccess) { fprintf(stderr, "kernel_launch: hipMemsetAsync failed\n"); return; }
    Args a{};
    for (int i = 0; i < 27; ++i) a.in[i] = (const float*)d_in[i];
    a.out = (float*)d_out; a.ws = (unsigned char*)d_ws; a.ph_lo = 0; a.ph_hi = NPHASES;
    void* args[] = {&a};
    hipError_t e = hipLaunchCooperativeKernel((const void*)fwd, dim3(grid), dim3(NTHREADS), args, LDS_BYTES, stream);
    if (e != hipSuccess) fprintf(stderr, "cooperative launch failed: %s (grid %d)\n", hipGetErrorString(e), grid);
}
```

```cpp
#include <hip/hip_runtime.h>
#include <hip/hip_cooperative_groups.h>
#include <cstdio>
#include <cstdint>
#ifndef FASTMASK
#define FASTMASK 0xFFFFFFFFu
#endif
#define FAST(p) ((FASTMASK >> (p)) & 1u)
namespace cg = cooperative_groups;

typedef unsigned short bf16_t;
constexpr int NTHREADS = 512;
constexpr int LDS_BYTES = 163840;
constexpr size_t MiB = 1u << 20;

constexpr int NB = 16, T = 2048, D = 1024, M = NB * T;
constexpr int DRNN = 1344, BW = 336, QW = 1024, KVW = 256, NH = 16, HD = 64, NG = 4;
constexpr int DIN = 7344, DFF = 4096, NC = 127, NSB = 32, CROWS = NB * NG * NC;
constexpr int C_URNN = 0, C_UGATE = 1344, C_Q = 2688, C_KV = 3712, C_GN = 5248, C_GA = 5296, C_GB = 6320;
constexpr float EPS = 1e-6f, LOG2E = 1.4426950408889634f;
constexpr int YA_LD = 1408, XC_LD = 384;

constexpr size_t WS_RSTD = 1 * MiB, WS_RSTD2 = 1 * MiB + 512 * 1024, WS_KCC = 2 * MiB, WS_VCC = 4 * MiB, WS_SEL = 6 * MiB;
constexpr size_t WS_URNN = 52 * MiB, WS_UGATE = 136 * MiB, WS_Q = 220 * MiB, WS_KV = 284 * MiB  , WS_GN = 380 * MiB, WS_GA = 384 * MiB, WS_GB = 448 * MiB, WS_END = 512 * MiB;
constexpr size_t WS_PES = 1 * MiB + 448 * 1024  , WS_NORMS = 1 * MiB + 384 * 1024, WS_LAMC = 1 * MiB + 256 * 1024, WS_SSQ = 6 * MiB + 512 * 1024  ;
constexpr size_t WS_WIN = 9 * MiB  , WS_WG = 24 * MiB  , WS_W1 = 27 * MiB  , WS_PA = 29 * MiB  , WS_PB = 32 * MiB, WS_WO = 34 * MiB, WS_WMI = 36 * MiB  , WS_WMO = 44 * MiB  ;
constexpr size_t DO_KCB = 104 * MiB  , DO_VCT = 105 * MiB  ;
constexpr size_t DO_VST = 72 * MiB, DO_VWT = 88 * MiB;
constexpr size_t DO_CAR = 112 * MiB, DO_CBR = 120 * MiB;
constexpr size_t DO_XB = 0;
constexpr size_t WS_LA = WS_URNN, WS_UP = WS_KV, WS_T1 = WS_URNN, WS_MERGED = WS_UGATE, WS_HB = WS_GA, WS_ZACT = 52 * MiB;
constexpr size_t DO_FLATK = 64 * MiB, DO_FLATV = 96 * MiB, DO_HIDK = 0, DO_HIDV = 4 * MiB, DO_XC = 0, DO_YA = 0;

__device__ __constant__ unsigned char BUCKET[128] = {0, 1, 2, 3, 4, 5, 6, 7, 8, 9, 10, 11, 12, 13, 14, 15, 16, 16, 16, 17, 17, 18, 18, 18, 19, 19, 19, 20, 20, 20, 20, 21, 21, 21, 21, 22, 22, 22, 22, 22, 23, 23, 23, 23, 23, 23, 24, 24, 24, 24, 24, 24, 25, 25, 25, 25, 25, 25, 25, 26, 26, 26, 26, 26, 26, 26, 26, 27, 27, 27, 27, 27, 27, 27, 27, 27, 27, 28, 28, 28, 28, 28, 28, 28, 28, 28, 28, 29, 29, 29, 29, 29, 29, 29, 29, 29, 29, 29, 29, 30, 30, 30, 30, 30, 30, 30, 30, 30, 30, 30, 30, 30, 30, 31, 31, 31, 31, 31, 31, 31, 31, 31, 31, 31, 31, 31, 31, 31};

__device__ __forceinline__ float bf2f(bf16_t v) { return __uint_as_float((unsigned)v << 16); }
__device__ __forceinline__ bf16_t f2bf(float f) { unsigned u = __float_as_uint(f); return (bf16_t)((u + 0x7fffu + ((u >> 16) & 1u)) >> 16); }
__device__ __forceinline__ float sigmoidf_(float x) { return 1.f / (1.f + __expf(-x)); }
__device__ __forceinline__ float gelu_tanh(float x) { const float u = 0.7978845608028654f * (x + 0.044715f * x * x * x); return 0.5f * x * (1.f + tanhf(u)); }
__device__ __forceinline__ float wave_sum(float v) {
#pragma unroll
    for (int o = 1; o < 64; o <<= 1) v += __shfl_xor(v, o);
    return v;
}

struct Args { const float* in[27]; float* out; unsigned char* ws; int ph_lo, ph_hi; };

template <class AL, class BL, class EP>
__device__ __forceinline__ void ngemm(float* lds, int Mm, int Nn, int Kk, const AL& A, const BL& Bf, const EP& E) {
    float* As = lds;
    float* Bs = lds + 16 * 132;
    const int tid = threadIdx.x, tx = tid & 31, ty = tid >> 5;
    const int tm = (Mm + 127) / 128, tn = (Nn + 127) / 128, ntiles = tm * tn;
    for (int tile = blockIdx.x; tile < ntiles; tile += gridDim.x) {
        const int m0 = (tile / tn) * 128, n0 = (tile % tn) * 128;
        float acc[8][4];
#pragma unroll
        for (int i = 0; i < 8; ++i)
#pragma unroll
            for (int j = 0; j < 4; ++j) acc[i][j] = 0.f;
        for (int k0 = 0; k0 < Kk; k0 += 16) {
            {
                const int m = m0 + (tid >> 2), kb = k0 + (tid & 3) * 4;
#pragma unroll
                for (int i = 0; i < 4; ++i) As[((tid & 3) * 4 + i) * 132 + (tid >> 2)] = (m < Mm && kb + i < Kk) ? A(m, kb + i) : 0.f;
                const int k = k0 + (tid >> 5), nb = n0 + (tid & 31) * 4;
#pragma unroll
                for (int i = 0; i < 4; ++i) Bs[(tid >> 5) * 132 + (tid & 31) * 4 + i] = (k < Kk && nb + i < Nn) ? Bf(k, nb + i) : 0.f;
            }
            __syncthreads();
#pragma unroll 2
            for (int kk = 0; kk < 16; ++kk) {
                float a[8], b[4];
#pragma unroll
                for (int i = 0; i < 8; ++i) a[i] = As[kk * 132 + ty * 8 + i];
#pragma unroll
                for (int j = 0; j < 4; ++j) b[j] = Bs[kk * 132 + tx * 4 + j];
#pragma unroll
                for (int i = 0; i < 8; ++i)
#pragma unroll
                    for (int j = 0; j < 4; ++j) acc[i][j] += a[i] * b[j];
            }
            __syncthreads();
        }
#pragma unroll
        for (int i = 0; i < 8; ++i)
#pragma unroll
            for (int j = 0; j < 4; ++j) { const int m = m0 + ty * 8 + i, n = n0 + tx * 4 + j; if (m < Mm && n < Nn) E(m, n, acc[i][j]); }
    }
}

struct ALbf { const bf16_t* p; int ld; __device__ __forceinline__ float operator()(int m, int k) const { return bf2f(p[(size_t)m * ld + k]); } };
struct ALbfScale { const bf16_t* p; int ld; const float* g; __device__ __forceinline__ float operator()(int m, int k) const { return bf2f(p[(size_t)m * ld + k]) * g[k]; } };
struct ALf32Scale { const float* p; int ld; const float* g; __device__ __forceinline__ float operator()(int m, int k) const { return p[(size_t)m * ld + k] * g[k]; } };
struct BLf32 { const float* p; int ld; __device__ __forceinline__ float operator()(int k, int n) const { return p[(size_t)k * ld + n]; } };
struct BLgate { const float* wa; const float* wx; __device__ __forceinline__ float operator()(int k, int n) const { return n < BW ? wa[k * BW + n] : wx[k * BW + n - BW]; } };

struct Ep1 {
    const float* rstd; bf16_t *urnn, *ugate, *q, *kv, *gn, *ga, *gb;
    __device__ __forceinline__ void operator()(int m, int n, float v) const {
        v *= rstd[m];
        if (n < C_UGATE) urnn[(size_t)m * DRNN + n] = f2bf(v);
        else if (n < C_Q) ugate[(size_t)m * DRNN + n - C_UGATE] = f2bf(gelu_tanh(v));
        else if (n < C_KV) q[(size_t)m * QW + n - C_Q] = f2bf(v);
        else if (n < C_GN) { const int c = n - C_KV; kv[(size_t)(c >> 8) * ((size_t)M * KVW) + (size_t)m * KVW + (c & 255)] = f2bf(v); }
        else if (n < C_GA) gn[(size_t)m * 48 + n - C_GN] = f2bf(sigmoidf_(v));
        else if (n < C_GB) ga[(size_t)m * D + n - C_GA] = f2bf(sigmoidf_(v));
        else gb[(size_t)m * D + n - C_GB] = f2bf(sigmoidf_(v));
    }
};
struct EpGelu { bf16_t* o; int ld; __device__ __forceinline__ void operator()(int m, int n, float v) const { o[(size_t)m * ld + n] = f2bf(gelu_tanh(v)); } };
struct EpGate {
    int nb; const float *ba, *bx, *lam; const bf16_t* xc; bf16_t *la, *up;
    __device__ __forceinline__ void operator()(int m, int n, float v) const {
        if (n < BW) { const int c = nb * BW + n; const float r = sigmoidf_(v + ba[c]); const float sp = log1pf(__expf(-lam[c])); la[(size_t)m * DRNN + c] = f2bf(-8.f * r * sp * LOG2E); }
        else { const int j = n - BW, c = nb * BW + j; const float i = sigmoidf_(v + bx[c]); up[(size_t)m * DRNN + c] = f2bf(i * bf2f(xc[(size_t)m * XC_LD + j])); }
    }
};
struct EpT1 { const bf16_t* g; bf16_t* o; __device__ __forceinline__ void operator()(int m, int n, float v) const { o[(size_t)m * D + n] = f2bf(bf2f(g[(size_t)m * D + n]) * v); } };
struct EpMerged { const bf16_t* g; const bf16_t* t1; bf16_t* o; __device__ __forceinline__ void operator()(int m, int n, float v) const { o[(size_t)m * D + n] = f2bf(bf2f(t1[(size_t)m * D + n]) + bf2f(g[(size_t)m * D + n]) * v); } };
struct EpH { const float* x; float* h; bf16_t* hb; __device__ __forceinline__ void operator()(int m, int n, float v) const { const float r = x[(size_t)m * D + n] + v; h[(size_t)m * D + n] = r; hb[(size_t)m * D + n] = f2bf(r); } };
struct EpZ { const float* ssq; bf16_t* z; __device__ __forceinline__ void operator()(int m, int n, float v) const { float s_ = 0.f; for (int i = 0; i < 16; ++i) s_ += ssq[(size_t)m * 16 + i]; v *= rsqrtf(s_ * (1.f / D) + EPS); v = v > 0.f ? v * v : 0.f; z[(size_t)m * DFF + n] = f2bf(v); } };
struct EpOut { float* o; __device__ __forceinline__ void operator()(int m, int n, float v) const { o[(size_t)m * D + n] += v; } };

namespace pg8 {
#define PG8_LAS __attribute__((address_space(3)))
typedef unsigned short bf16_t;
typedef short bf16x8 __attribute__((ext_vector_type(8)));
typedef float f32x4 __attribute__((ext_vector_type(4)));
typedef unsigned u32x4 __attribute__((ext_vector_type(4)));
constexpr int BM = 256, BK = 64, HALF = 128, HTB = HALF * BK * 2  , STAGE_BYTES = 8 * HTB, NXCD = 8, WGM = 4;

__host__ __device__ __forceinline__ int lds_byte(int r, int c) { const int st = (r >> 4) * 2 + (c >> 5), rr = r & 15, cc = c & 31, ob = rr * 64 + cc * 2; return st * 1024 + (ob ^ (((ob >> 9) & 1) << 5)); }
__host__ __device__ __forceinline__ void stage_rc(int b, int& R, int& C) { const int st = b / 1024, sb = b % 1024, swz = sb ^ (((sb >> 9) & 1) << 5); R = (st >> 1) * 16 + swz / 64; C = (st & 1) * 32 + (swz % 64) / 2; }
__host__ __device__ __forceinline__ int perm32(int rho) { const int n = rho >> 4, i = rho & 15; return 8 * (i >> 2) + 4 * n + (i & 3); }

struct Unit { int pm, pn, ord; };
struct Gemm { const bf16_t* A; const bf16_t* Bt; int M, N, K; };

struct StaticOrder {
    int nM, nN, nwg, G, c;
    __host__ __device__ void init(int M, int N, int G_, int c_) { nM = M / BM; nN = N / BM; nwg = nM * nN; G = G_; c = c_; }
    __host__ __device__ __forceinline__ bool next(int i, Unit& u) const {
        const long L = (long)i * G + c; if (L >= nwg) return false;
        int wgid = (int)L; { const int q = nwg / NXCD, r = nwg % NXCD, xcd = wgid % NXCD, off = wgid / NXCD; wgid = (xcd < r ? xcd * (q + 1) : r * (q + 1) + (xcd - r) * q) + off; }
        const int nig = WGM * nN, gid = wgid / nig, fm = gid * WGM, gsz = (nM - fm) < WGM ? (nM - fm) : WGM;
        u.pm = fm + ((wgid % nig) % gsz); u.pn = (wgid % nig) / gsz; u.ord = i; return true;
    }
    __device__ __forceinline__ void a_ready(const Unit&) const {}
    __device__ __forceinline__ void done(const Unit&) const {}
};

__device__ __forceinline__ unsigned cvt_pk_bf16(float lo, float hi) { unsigned r; asm volatile("v_cvt_pk_bf16_f32 %0, %1, %2" : "=v"(r) : "v"(lo), "v"(hi)); return r; }
typedef float f32x2 __attribute__((ext_vector_type(2)));
template <class Epi, class Sched, bool ALIGN_EPI = false, bool SP2 = false>
__device__ __forceinline__ void gemm_phase(PG8_LAS unsigned char* lds, const Gemm g, const Sched& S, const Epi& E) {
    const int tid = threadIdx.x, wid = __builtin_amdgcn_readfirstlane(tid >> 6), lane = tid & 63, wr = wid >> 2, wc = wid & 3, fr = lane & 15, fq = lane >> 4;
    const int K = g.K, nt = K / BK;
    unsigned voffA[2], voffB[2];
#pragma unroll
    for (int i = 0; i < 2; ++i) { int R, C; stage_rc(tid * 16 + i * 8192, R, C); const int Rb = Epi::PERM ? ((R & ~31) + perm32(R & 31)) : R;
        voffA[i] = (unsigned)(R * K + C) * 2u; voffB[i] = (unsigned)(Rb * K + C) * 2u; }
    const size_t kstep = (size_t)(BK * 2);
    const size_t hstep = (size_t)HALF * K * 2;
    const size_t tstep = 2 * hstep;
    const unsigned ldsw = (unsigned)wid * 1024u;
    const int aoff = lds_byte(wr * 64 + fr, fq * 8), boff = lds_byte(wc * 32 + fr, fq * 8);
#define PG8_SA(b, h) (((b) * 2 + (h)) * HTB)
#define PG8_SB(b, h) ((4 + (b) * 2 + (h)) * HTB)
#define PG8_STAGE(bufoff, gbase, voff) do { _Pragma("unroll") for (int _i = 0; _i < 2; ++_i) \
        __builtin_amdgcn_global_load_lds((const unsigned*)((const char*)(gbase) + (voff)[_i]), (PG8_LAS unsigned*)(lds + (bufoff) + ldsw + _i * 8192), 16, 0, 0); } while (0)
#define PG8_LDA(dst, b, h) do { _Pragma("unroll") for (int m = 0; m < 4; ++m) _Pragma("unroll") for (int k = 0; k < 2; ++k) dst[m][k] = *(const PG8_LAS bf16x8*)(lds + PG8_SA(b, h) + aoff + m * 2048 + k * 1024); } while (0)
#define PG8_LDB(dst, b, h) do { _Pragma("unroll") for (int n = 0; n < 2; ++n) _Pragma("unroll") for (int k = 0; k < 2; ++k) dst[n][k] = *(const PG8_LAS bf16x8*)(lds + PG8_SB(b, h) + boff + n * 2048 + k * 1024); } while (0)
#define PG8_MMA(ai, bj, At, Bt) do { __builtin_amdgcn_s_setprio(1); _Pragma("unroll") for (int m = 0; m < 4; ++m) _Pragma("unroll") for (int n = 0; n < 2; ++n) _Pragma("unroll") for (int k = 0; k < 2; ++k) \
        acc[ai][bj][m][n] = __builtin_amdgcn_mfma_f32_16x16x32_bf16(Bt[n][k], At[m][k], acc[ai][bj][m][n], 0, 0, 0); __builtin_amdgcn_s_setprio(0); } while (0)
#define PG8_WAIT_V(n) asm volatile("s_waitcnt vmcnt(" #n ")" ::: "memory")
#define PG8_WAIT_L(n) asm volatile("s_waitcnt lgkmcnt(" #n ")" ::: "memory")
#define PG8_BAR __builtin_amdgcn_s_barrier()
#define PG8_SCHED __builtin_amdgcn_sched_barrier(0)
    Unit cur, nxt; int ui = 0;
    if (!S.next(0, cur)) return;
    f32x4 acc[2][2][4][2];
#pragma unroll
    for (int a = 0; a < 2; ++a)
#pragma unroll
        for (int b = 0; b < 2; ++b)
#pragma unroll
            for (int m = 0; m < 4; ++m)
#pragma unroll
                for (int n = 0; n < 2; ++n) acc[a][b][m][n] = (f32x4){0.f, 0.f, 0.f, 0.f};
    bf16x8 At[4][2], B0[2][2], B1[2][2];
    const char* cA = (const char*)g.A + (size_t)cur.pm * tstep; const char* cB = (const char*)g.Bt + (size_t)cur.pn * tstep;
    S.a_ready(cur);
    if constexpr (SP2) {
        PG8_STAGE(PG8_SB(0, 0), cB, voffB); PG8_STAGE(PG8_SB(0, 1), cB + hstep, voffB); PG8_STAGE(PG8_SA(0, 0), cA, voffA); PG8_STAGE(PG8_SA(0, 1), cA + hstep, voffA);
        if (wr == 1) PG8_BAR;
        PG8_WAIT_V(2); PG8_BAR;
        PG8_STAGE(PG8_SB(1, 0), cB + kstep, voffB); PG8_STAGE(PG8_SA(1, 0), cA + kstep, voffA); PG8_STAGE(PG8_SB(1, 1), cB + hstep + kstep, voffB);
        PG8_WAIT_V(6); PG8_BAR;
    } else {
        PG8_STAGE(PG8_SB(0, 0), cB, voffB); PG8_STAGE(PG8_SA(0, 0), cA, voffA); PG8_STAGE(PG8_SB(0, 1), cB + hstep, voffB); PG8_STAGE(PG8_SA(0, 1), cA + hstep, voffA);
        if (wr == 1) PG8_BAR;
        PG8_WAIT_V(4); PG8_BAR;
        PG8_STAGE(PG8_SB(1, 0), cB + kstep, voffB); PG8_STAGE(PG8_SA(1, 0), cA + kstep, voffA); PG8_STAGE(PG8_SB(1, 1), cB + hstep + kstep, voffB);
        PG8_WAIT_V(6); PG8_BAR;
    }
    for (;;) {
        const bool has_next = S.next(ui + 1, nxt);
        const char* nA = has_next ? (const char*)g.A + (size_t)nxt.pm * tstep : cA; const char* nB = has_next ? (const char*)g.Bt + (size_t)nxt.pn * tstep : cB;
        for (int t = 0; t < nt; t += 2) {
            const bool last = (t == nt - 2);
            const char* a1 = cA + (size_t)(t + 1) * kstep;
            const char* a2 = last ? nA : cA + (size_t)(t + 2) * kstep; const char* b2 = last ? nB : cB + (size_t)(t + 2) * kstep;
            const char* a3 = a2 + kstep; const char* b3 = b2 + kstep;
            if (last && has_next) S.a_ready(nxt);
            if constexpr (SP2) {
            PG8_LDB(B0, 0, 0); PG8_LDB(B1, 0, 1); PG8_SCHED; PG8_LDA(At, 0, 0); PG8_STAGE(PG8_SA(1, 1), a1 + hstep, voffA);
            PG8_WAIT_V(8); PG8_WAIT_L(0); PG8_BAR; PG8_MMA(0, 0, At, B0); PG8_MMA(0, 1, At, B1); PG8_BAR; PG8_SCHED;
            PG8_LDA(At, 0, 1); PG8_STAGE(PG8_SB(0, 0), b2, voffB); PG8_STAGE(PG8_SB(0, 1), b2 + hstep, voffB); PG8_STAGE(PG8_SA(0, 0), a2, voffA);
            PG8_WAIT_V(8); PG8_WAIT_L(0); PG8_BAR; PG8_MMA(1, 0, At, B0); PG8_MMA(1, 1, At, B1); PG8_BAR; PG8_SCHED;
            PG8_LDB(B0, 1, 0); PG8_LDB(B1, 1, 1); PG8_SCHED; PG8_LDA(At, 1, 0); PG8_STAGE(PG8_SA(0, 1), a2 + hstep, voffA);
            PG8_WAIT_V(8); PG8_WAIT_L(0); PG8_BAR; PG8_MMA(0, 0, At, B0); PG8_MMA(0, 1, At, B1); PG8_BAR; PG8_SCHED;
            PG8_LDA(At, 1, 1); PG8_STAGE(PG8_SB(1, 0), b3, voffB); PG8_STAGE(PG8_SB(1, 1), b3 + hstep, voffB); PG8_STAGE(PG8_SA(1, 0), a3, voffA);
            PG8_WAIT_V(8); PG8_WAIT_L(0); PG8_BAR; PG8_MMA(1, 0, At, B0); PG8_MMA(1, 1, At, B1); PG8_BAR; PG8_SCHED;
            } else {
            PG8_LDB(B0, 0, 0); PG8_SCHED; PG8_LDA(At, 0, 0); PG8_STAGE(PG8_SA(1, 1), a1 + hstep, voffA);
            PG8_WAIT_L(8); PG8_BAR; PG8_WAIT_L(0); PG8_MMA(0, 0, At, B0); PG8_BAR; PG8_SCHED;
            PG8_LDB(B1, 0, 1); PG8_STAGE(PG8_SB(0, 0), b2, voffB);
            PG8_BAR; PG8_WAIT_L(0); PG8_MMA(0, 1, At, B1); PG8_BAR;
            PG8_LDA(At, 0, 1); PG8_STAGE(PG8_SA(0, 0), a2, voffA);
            PG8_BAR; PG8_WAIT_L(0); PG8_MMA(1, 0, At, B0); PG8_BAR; PG8_SCHED;
            PG8_STAGE(PG8_SB(0, 1), b2 + hstep, voffB);
            PG8_WAIT_V(6); PG8_BAR; PG8_MMA(1, 1, At, B1); PG8_BAR;
            PG8_LDB(B0, 1, 0); PG8_SCHED; PG8_LDA(At, 1, 0); PG8_STAGE(PG8_SA(0, 1), a2 + hstep, voffA);
            PG8_WAIT_L(8); PG8_BAR; PG8_WAIT_L(0); PG8_MMA(0, 0, At, B0); PG8_BAR; PG8_SCHED;
            PG8_LDB(B1, 1, 1); PG8_STAGE(PG8_SB(1, 0), b3, voffB);
            PG8_BAR; PG8_WAIT_L(0); PG8_MMA(0, 1, At, B1); PG8_BAR;
            PG8_LDA(At, 1, 1); PG8_STAGE(PG8_SA(1, 0), a3, voffA);
            PG8_BAR; PG8_WAIT_L(0); PG8_MMA(1, 0, At, B0); PG8_BAR; PG8_SCHED;
            PG8_STAGE(PG8_SB(1, 1), b3 + hstep, voffB);
            PG8_WAIT_V(6); PG8_BAR; PG8_MMA(1, 1, At, B1); PG8_BAR;
            }
        }
        if constexpr (ALIGN_EPI) { if (wr == 0) PG8_BAR; }
        if constexpr (!Epi::AFTER_DRAIN) { E(acc, cur, wr, wc, fr, fq); S.done(cur); }
        if (!has_next) break;
#pragma unroll
        for (int a = 0; a < 2; ++a)
#pragma unroll
            for (int b = 0; b < 2; ++b)
#pragma unroll
                for (int m = 0; m < 4; ++m)
#pragma unroll
                    for (int n = 0; n < 2; ++n) acc[a][b][m][n] = (f32x4){0.f, 0.f, 0.f, 0.f};
        cur = nxt; cA = nA; cB = nB; ++ui;
        if constexpr (ALIGN_EPI) { if (wr == 1) PG8_BAR; }
    }
    PG8_WAIT_V(0);
    if constexpr (!ALIGN_EPI) { if (wr == 0) PG8_BAR; }
    PG8_BAR;
    if constexpr (Epi::AFTER_DRAIN) { E.fused(acc, cur, wr, wc, fr, fq, lds, wid, lane); S.done(cur); }
#undef PG8_SA
#undef PG8_SB
#undef PG8_STAGE
#undef PG8_LDA
#undef PG8_LDB
#undef PG8_MMA
#undef PG8_WAIT_V
#undef PG8_WAIT_L
#undef PG8_BAR
#undef PG8_SCHED
}
}

namespace pg8 {
__device__ __forceinline__ float sigm(float x) { return __builtin_amdgcn_rcpf(1.f + __expf(-x)); }
__device__ __forceinline__ float gelu_t(float x) { const float u = 1.5957691216057308f * (x + 0.044715f * x * x * x); return x * __builtin_amdgcn_rcpf(1.f + __expf(-u)); }
__device__ __forceinline__ u32x4 pack8(const f32x4& a, const f32x4& b) { u32x4 w; w.x = cvt_pk_bf16(a[0], a[1]); w.y = cvt_pk_bf16(a[2], a[3]); w.z = cvt_pk_bf16(b[0], b[1]); w.w = cvt_pk_bf16(b[2], b[3]); return w; }
__device__ __forceinline__ void unpack8(const u32x4& w, f32x4& a, f32x4& b) {
    a[0] = __uint_as_float(w.x << 16); a[1] = __uint_as_float(w.x & 0xffff0000u); a[2] = __uint_as_float(w.y << 16); a[3] = __uint_as_float(w.y & 0xffff0000u);
    b[0] = __uint_as_float(w.z << 16); b[1] = __uint_as_float(w.z & 0xffff0000u); b[2] = __uint_as_float(w.w << 16); b[3] = __uint_as_float(w.w & 0xffff0000u); }

struct Ep1F {
    static constexpr bool PERM = true, AFTER_DRAIN = false;
    bf16_t *urnn, *ugate, *q, *kv, *gn, *ga; const PG8_LAS float* norms; bf16_t* flat; const PG8_LAS float* pes;
    __device__ __forceinline__ void operator()(const f32x4 (&acc)[2][2][4][2], const Unit& u, int wr, int wc, int fr, int fq) const {
        const int row0 = u.pm * BM + wr * 64 + fr, pn = u.pn;
        if (pn == 4 || pn == 5) {
            const PG8_LAS float* pe = pes + (pn - 4) * 2048; bf16_t* fl = flat + (size_t)(pn - 4) * 8192 * 2048;
#pragma unroll
            for (int ai = 0; ai < 2; ++ai)
#pragma unroll
                for (int m = 0; m < 4; ++m) { const int mt = row0 + ai * HALF + m * 16, b = mt >> 11, t = mt & (T - 1), c1 = t >> 4, l1 = t & 15; const size_t rb = (size_t)((b * 4 + wc) * NC + c1) * 2048;
#pragma unroll
                    for (int bj = 0; bj < 2; ++bj) { const int d0 = 32 * bj + 8 * fq; const f32x4 v0 = acc[ai][bj][m][0], v1 = acc[ai][bj][m][1];
                        if (c1 < NC) { const PG8_LAS float* p = pe + l1 * 64 + d0; *(u32x4*)(fl + rb + l1 * 64 + d0) = pack8(v0 + *(const PG8_LAS f32x4*)p, v1 + *(const PG8_LAS f32x4*)(p + 4)); }
                        if (c1 > 0) { const PG8_LAS float* p = pe + (l1 + 16) * 64 + d0; *(u32x4*)(fl + rb - 2048 + (l1 + 16) * 64 + d0) = pack8(v0 + *(const PG8_LAS f32x4*)p, v1 + *(const PG8_LAS f32x4*)(p + 4)); } } }
            return;
        }
        if (pn < 10) {
            const bool donorm = pn < 4 || pn == 6 || pn == 8; const PG8_LAS float* g = norms + (pn < 4 ? 0 : (pn == 6 ? 64 : 128)); const float sc = pn < 4 ? 0.125f * LOG2E : 1.f;
            bf16_t* base; int ld;
            if (pn < 4) { base = q + 256 * pn + 64 * wc + 8 * fq; ld = QW; } else { base = kv + (size_t)(pn - 4) * ((size_t)M * KVW) + 64 * wc + 8 * fq; ld = KVW; }
            f32x4 gv[2][2];
#pragma unroll
            for (int bj = 0; bj < 2; ++bj)
#pragma unroll
                for (int n = 0; n < 2; ++n) gv[bj][n] = donorm ? *(const PG8_LAS f32x4*)(g + 32 * bj + 8 * fq + 4 * n) : (f32x4){1.f, 1.f, 1.f, 1.f};
#pragma unroll
            for (int ai = 0; ai < 2; ++ai)
#pragma unroll
                for (int m = 0; m < 4; ++m) {
                    float ss = 0.f;
#pragma unroll
                    for (int bj = 0; bj < 2; ++bj)
#pragma unroll
                        for (int n = 0; n < 2; ++n) { const f32x4 v = acc[ai][bj][m][n]; ss += (v[0] * v[0] + v[1] * v[1]) + (v[2] * v[2] + v[3] * v[3]); }
                    ss += __shfl_xor(ss, 16); ss += __shfl_xor(ss, 32);
                    const float r = donorm ? rsqrtf(ss * (1.f / 64.f) + EPS) * sc : 1.f;
                    bf16_t* rowp = base + (size_t)(row0 + ai * HALF + m * 16) * ld;
#pragma unroll
                    for (int bj = 0; bj < 2; ++bj) *(u32x4*)(rowp + 32 * bj) = pack8(acc[ai][bj][m][0] * r * gv[bj][0], acc[ai][bj][m][1] * r * gv[bj][1]);
                }
        } else if (pn < 18) {
            bf16_t* base = ga + (pn < 14 ? (size_t)0 : (size_t)M * D) + 256 * ((pn - 10) & 3) + 32 * wc + 8 * fq;
#pragma unroll
            for (int ai = 0; ai < 2; ++ai)
#pragma unroll
                for (int m = 0; m < 4; ++m) { bf16_t* rowp = base + (size_t)(row0 + ai * HALF + m * 16) * D;
#pragma unroll
                    for (int bj = 0; bj < 2; ++bj) { f32x4 v0 = acc[ai][bj][m][0], v1 = acc[ai][bj][m][1];
#pragma unroll
                        for (int e = 0; e < 4; ++e) { v0[e] = sigm(v0[e]); v1[e] = sigm(v1[e]); }
                        *(u32x4*)(rowp + bj * HALF) = pack8(v0, v1); } }
        } else { seg3<0>(acc, pn, row0, wc, fq); seg3<1>(acc, pn, row0, wc, fq); }
    }
    template <int BJ> __device__ __forceinline__ void seg3(const f32x4 (&acc)[2][2][4][2], int pn, int row0, int wc, int fq) const {
        const int c = 256 * (pn - 18) + 128 * BJ + 32 * wc;
        if (c < 1344) { bf16_t* base = urnn + c + 8 * fq;
#pragma unroll
            for (int ai = 0; ai < 2; ++ai)
#pragma unroll
                for (int m = 0; m < 4; ++m) *(u32x4*)(base + (size_t)(row0 + ai * HALF + m * 16) * DRNN) = pack8(acc[ai][BJ][m][0], acc[ai][BJ][m][1]);
        } else if (c < 2688) { bf16_t* base = ugate + (c - 1344) + 8 * fq;
#pragma unroll
            for (int ai = 0; ai < 2; ++ai)
#pragma unroll
                for (int m = 0; m < 4; ++m) { f32x4 v0 = acc[ai][BJ][m][0], v1 = acc[ai][BJ][m][1];
#pragma unroll
                    for (int e = 0; e < 4; ++e) { v0[e] = gelu_t(v0[e]); v1[e] = gelu_t(v1[e]); }
                    *(u32x4*)(base + (size_t)(row0 + ai * HALF + m * 16) * DRNN) = pack8(v0, v1); }
        } else if (c + 8 * fq < 2736) { bf16_t* base = gn + (c - 2688) + 8 * fq;
#pragma unroll
            for (int ai = 0; ai < 2; ++ai)
#pragma unroll
                for (int m = 0; m < 4; ++m) { f32x4 v0 = acc[ai][BJ][m][0], v1 = acc[ai][BJ][m][1];
#pragma unroll
                    for (int e = 0; e < 4; ++e) { v0[e] = sigm(v0[e]); v1[e] = sigm(v1[e]); }
                    *(u32x4*)(base + (size_t)(row0 + ai * HALF + m * 16) * 48) = pack8(v0, v1); }
        }
    }
};
__device__ __forceinline__ void win_src(int ch, int& c0, int& cvalid) {
    const int tile = ch >> 3, l0 = (ch & 7) * 32, bj = l0 >> 7, wc = (l0 >> 5) & 3; cvalid = 32;
    if (tile < 4) c0 = C_Q + 256 * tile + 64 * wc + 32 * bj;
    else if (tile < 10) c0 = C_KV + 256 * (tile - 4) + 64 * wc + 32 * bj;
    else if (tile < 14) c0 = C_GA + 256 * (tile - 10) + l0;
    else if (tile < 18) c0 = C_GB + 256 * (tile - 14) + l0;
    else { const int c = 256 * (tile - 18) + l0; if (c < 2688) c0 = c; else if (c < 2736) { c0 = C_GN + c - 2688; cvalid = 2736 - c < 32 ? 2736 - c : 32; } else { c0 = 0; cvalid = 0; } }
}
constexpr int N1PAD = 29 * 256;

struct EpGeluF {
    static constexpr bool PERM = true, AFTER_DRAIN = false;
    bf16_t* O; int ldc;
    __device__ __forceinline__ void operator()(const f32x4 (&acc)[2][2][4][2], const Unit& u, int wr, int wc, int fr, int fq) const {
        const int row0 = u.pm * BM + wr * 64 + fr; bf16_t* base = O + wc * 32 + 8 * fq;
#pragma unroll
        for (int ai = 0; ai < 2; ++ai)
#pragma unroll
            for (int m = 0; m < 4; ++m) { bf16_t* rowp = base + (size_t)(row0 + ai * HALF + m * 16) * ldc;
#pragma unroll
                for (int bj = 0; bj < 2; ++bj) { f32x4 v0 = acc[ai][bj][m][0], v1 = acc[ai][bj][m][1];
#pragma unroll
                    for (int e = 0; e < 4; ++e) { v0[e] = gelu_t(v0[e]); v1[e] = gelu_t(v1[e]); }
                    *(u32x4*)(rowp + bj * HALF) = pack8(v0, v1); } }
    }
};
struct OrderC1 {
    int G, c;
    __device__ __forceinline__ bool next(int i, Unit& u) const { const int L = i * G + c; if (L >= 64) return false; u.pm = L; u.pn = L >> 5; u.ord = i; return true; }
    __device__ __forceinline__ void a_ready(const Unit&) const {}
    __device__ __forceinline__ void done(const Unit&) const {}
};
struct OrderGate {
    int G, c;
    __device__ __forceinline__ bool next(int i, Unit& u) const { const int L = i * G + c; if (L >= 4 * 128 * 3) return false; const int nb = L / 384, r = L % 384; u.pm = nb * 128 + r / 3; u.pn = nb * 3 + r % 3; u.ord = i; return true; }
    __device__ __forceinline__ void a_ready(const Unit&) const {}
    __device__ __forceinline__ void done(const Unit&) const {}
};
struct EpGateF {
    static constexpr bool PERM = true, AFTER_DRAIN = false;
    const float *ba, *bx, *lamc; const bf16_t* xc; bf16_t *la, *up;
    __device__ __forceinline__ void operator()(const f32x4 (&acc)[2][2][4][2], const Unit& u, int wr, int wc, int fr, int fq) const {
        const int nb = u.pn / 3, pn3 = u.pn % 3, ch0 = 128 * pn3 + 32 * wc + 8 * fq; if (ch0 >= BW) return;
        const int c0 = nb * BW + ch0, row0 = (u.pm & 127) * BM + wr * 64 + fr;
        const bf16_t* xcb = xc + (size_t)nb * ((size_t)M * XC_LD) + ch0; bf16_t* lab = la + c0; bf16_t* upb = up + c0;
        const f32x4 bav0 = *(const f32x4*)(ba + c0), bav1 = *(const f32x4*)(ba + c0 + 4), bxv0 = *(const f32x4*)(bx + c0), bxv1 = *(const f32x4*)(bx + c0 + 4), lcv0 = *(const f32x4*)(lamc + c0), lcv1 = *(const f32x4*)(lamc + c0 + 4);
        u32x4 xcv[2][4];
#pragma unroll
        for (int ai = 0; ai < 2; ++ai)
#pragma unroll
            for (int m = 0; m < 4; ++m) xcv[ai][m] = *(const u32x4*)(xcb + (unsigned)(row0 + ai * HALF + m * 16) * (unsigned)XC_LD);
#pragma unroll
        for (int ai = 0; ai < 2; ++ai)
#pragma unroll
            for (int m = 0; m < 4; ++m) { const unsigned row = (unsigned)(row0 + ai * HALF + m * 16);
                f32x4 x0, x1; unpack8(xcv[ai][m], x0, x1);
                f32x4 l0, l1, u0, u1;
#pragma unroll
                for (int e = 0; e < 4; ++e) {
                    l0[e] = sigm(acc[ai][0][m][0][e] + bav0[e]) * lcv0[e]; l1[e] = sigm(acc[ai][0][m][1][e] + bav1[e]) * lcv1[e];
                    u0[e] = sigm(acc[ai][1][m][0][e] + bxv0[e]) * x0[e];   u1[e] = sigm(acc[ai][1][m][1][e] + bxv1[e]) * x1[e]; }
                *(u32x4*)(lab + row * (unsigned)DRNN) = pack8(l0, l1); *(u32x4*)(upb + row * (unsigned)DRNN) = pack8(u0, u1);
                asm volatile("" ::: "memory"); }
    }
};
struct EpT1F {
    static constexpr bool PERM = true, AFTER_DRAIN = false;
    const bf16_t* g; bf16_t* o;
    __device__ __forceinline__ void operator()(const f32x4 (&acc)[2][2][4][2], const Unit& u, int wr, int wc, int fr, int fq) const {
        const int row0 = u.pm * BM + wr * 64 + fr, col0 = u.pn * BM + wc * 32 + 8 * fq;
        u32x4 gv[2][4][2];
#pragma unroll
        for (int ai = 0; ai < 2; ++ai)
#pragma unroll
            for (int m = 0; m < 4; ++m) { const size_t off = (size_t)(row0 + ai * HALF + m * 16) * D + col0;
#pragma unroll
                for (int bj = 0; bj < 2; ++bj) gv[ai][m][bj] = *(const u32x4*)(g + off + bj * HALF); }
#pragma unroll
        for (int ai = 0; ai < 2; ++ai)
#pragma unroll
            for (int m = 0; m < 4; ++m) { const size_t off = (size_t)(row0 + ai * HALF + m * 16) * D + col0;
#pragma unroll
                for (int bj = 0; bj < 2; ++bj) { f32x4 g0, g1; unpack8(gv[ai][m][bj], g0, g1);
                    *(u32x4*)(o + off + bj * HALF) = pack8(acc[ai][bj][m][0] * g0, acc[ai][bj][m][1] * g1); } }
    }
};
struct EpMergedF {
    static constexpr bool PERM = true, AFTER_DRAIN = false;
    const bf16_t* g; const bf16_t* t1; bf16_t* o;
    __device__ __forceinline__ void operator()(const f32x4 (&acc)[2][2][4][2], const Unit& u, int wr, int wc, int fr, int fq) const {
        const int row0 = u.pm * BM + wr * 64 + fr, col0 = u.pn * BM + wc * 32 + 8 * fq;
#pragma unroll
        for (int ai = 0; ai < 2; ++ai) {
            u32x4 gv[4][2], tv[4][2];
#pragma unroll
            for (int m = 0; m < 4; ++m) { const size_t off = (size_t)(row0 + ai * HALF + m * 16) * D + col0;
#pragma unroll
                for (int bj = 0; bj < 2; ++bj) { gv[m][bj] = *(const u32x4*)(g + off + bj * HALF); tv[m][bj] = *(const u32x4*)(t1 + off + bj * HALF); } }
#pragma unroll
            for (int m = 0; m < 4; ++m) { const size_t off = (size_t)(row0 + ai * HALF + m * 16) * D + col0;
#pragma unroll
                for (int bj = 0; bj < 2; ++bj) { f32x4 g0, g1, t0, t1v; unpack8(gv[m][bj], g0, g1); unpack8(tv[m][bj], t0, t1v);
                    *(u32x4*)(o + off + bj * HALF) = pack8(t0 + acc[ai][bj][m][0] * g0, t1v + acc[ai][bj][m][1] * g1); } }
            asm volatile("" ::: "memory");
        }
    }
};
struct EpHF {
    static constexpr bool PERM = true, AFTER_DRAIN = false;
    const float* x; float* h; bf16_t* hb; float* ssq;
    __device__ __forceinline__ void operator()(const f32x4 (&acc)[2][2][4][2], const Unit& u, int wr, int wc, int fr, int fq) const {
        const int row0 = u.pm * BM + wr * 64 + fr, col0 = u.pn * BM + wc * 32 + 8 * fq;
#pragma unroll
        for (int ai = 0; ai < 2; ++ai) {
            f32x4 xv[4][2][2];
#pragma unroll
            for (int m = 0; m < 4; ++m) { const size_t off = (size_t)(row0 + ai * HALF + m * 16) * D + col0;
#pragma unroll
                for (int bj = 0; bj < 2; ++bj) { xv[m][bj][0] = *(const f32x4*)(x + off + bj * HALF); xv[m][bj][1] = *(const f32x4*)(x + off + bj * HALF + 4); } }
#pragma unroll
            for (int m = 0; m < 4; ++m) { const size_t row = (size_t)(row0 + ai * HALF + m * 16), off = row * D + col0; float ss = 0.f;
#pragma unroll
                for (int bj = 0; bj < 2; ++bj) {
                    const f32x4 h0 = xv[m][bj][0] + acc[ai][bj][m][0], h1 = xv[m][bj][1] + acc[ai][bj][m][1];
                    *(u32x4*)(hb + off + bj * HALF) = pack8(h0, h1);
                    ss += (h0[0] * h0[0] + h0[1] * h0[1]) + (h0[2] * h0[2] + h0[3] * h0[3]) + (h1[0] * h1[0] + h1[1] * h1[1]) + (h1[2] * h1[2] + h1[3] * h1[3]); }
                ss += __shfl_xor(ss, 16); ss += __shfl_xor(ss, 32);
                if (fq == 0) ssq[row * 16 + 4 * u.pn + wc] = ss; }
            asm volatile("" ::: "memory");
        }
    }
};
struct EpZF {
    static constexpr bool PERM = true, AFTER_DRAIN = false;
    const PG8_LAS float* rtab; const float* ssq; bf16_t* z;
    __device__ __forceinline__ void operator()(const f32x4 (&acc)[2][2][4][2], const Unit& u, int wr, int wc, int fr, int fq) const {
        const int rl0 = wr * 64 + fr, row0 = u.pm * BM + rl0, col0 = u.pn * BM + wc * 32 + 8 * fq;
#pragma unroll
        for (int ai = 0; ai < 2; ++ai)
#pragma unroll
            for (int m = 0; m < 4; ++m) { const size_t row = (size_t)(row0 + ai * HALF + m * 16);
                float r;
                if (rtab) r = rtab[u.ord * 256 + rl0 + ai * HALF + m * 16];
                else { const f32x4 s0 = *(const f32x4*)(ssq + row * 16), s1 = *(const f32x4*)(ssq + row * 16 + 4), s2 = *(const f32x4*)(ssq + row * 16 + 8), s3 = *(const f32x4*)(ssq + row * 16 + 12);
                    const f32x4 st = (s0 + s1) + (s2 + s3); r = rsqrtf(((st[0] + st[1]) + (st[2] + st[3])) * (1.f / D) + EPS); }
#pragma unroll
                for (int bj = 0; bj < 2; ++bj) { f32x4 v0 = acc[ai][bj][m][0] * r, v1 = acc[ai][bj][m][1] * r;
#pragma unroll
                    for (int e = 0; e < 4; ++e) { v0[e] = v0[e] > 0.f ? v0[e] * v0[e] : 0.f; v1[e] = v1[e] > 0.f ? v1[e] * v1[e] : 0.f; }
                    *(u32x4*)(z + row * DFF + col0 + bj * HALF) = pack8(v0, v1); } }
    }
};
struct EpOutF {
    static constexpr bool PERM = true, AFTER_DRAIN = false;
    const bf16_t* hb; float* o;
    __device__ __forceinline__ void operator()(const f32x4 (&acc)[2][2][4][2], const Unit& u, int wr, int wc, int fr, int fq) const {
        const int row0 = u.pm * BM + wr * 64 + fr, col0 = u.pn * BM + wc * 32 + 8 * fq;
        u32x4 hv[2][4][2];
#pragma unroll
        for (int ai = 0; ai < 2; ++ai)
#pragma unroll
            for (int m = 0; m < 4; ++m) { const size_t off = (size_t)(row0 + ai * HALF + m * 16) * D + col0;
#pragma unroll
                for (int bj = 0; bj < 2; ++bj) hv[ai][m][bj] = *(const u32x4*)(hb + off + bj * HALF); }
#pragma unroll
        for (int ai = 0; ai < 2; ++ai)
#pragma unroll
            for (int m = 0; m < 4; ++m) { float* p = o + (size_t)(row0 + ai * HALF + m * 16) * D + col0;
#pragma unroll
                for (int bj = 0; bj < 2; ++bj) { f32x4 h0, h1; unpack8(hv[ai][m][bj], h0, h1); *(f32x4*)(p + bj * HALF) = h0 + acc[ai][bj][m][0]; *(f32x4*)(p + bj * HALF + 4) = h1 + acc[ai][bj][m][1]; } }
    }
};
}

namespace att {
using pg8::bf16x8; using pg8::f32x4; using pg8::u32x4;
typedef float f32x16 __attribute__((ext_vector_type(16)));
typedef short s16x4 __attribute__((ext_vector_type(4)));
typedef float f32x2_t __attribute__((ext_vector_type(2))); typedef __bf16 bf16x2_t __attribute__((ext_vector_type(2)));
constexpr int KROW = 144, VROW = 144, KT = 64 * KROW, VT = 64 * VROW;
__device__ __forceinline__ int vperm(int kv) { return (kv & ~12) | ((kv & 4) << 1) | ((kv & 8) >> 1); }
constexpr int L_K0 = 0, L_K1 = KT, L_V0 = 2 * KT, L_V1 = 2 * KT + VT, L_BT = 2 * KT + 2 * VT  , L_IMPG = L_BT + 4096 + 64, L_IMPL = L_IMPG + 33792, L_IMP = L_IMPL + 33792, L_SELM = L_IMP + 64 * 33 * 4, L_KC = L_SELM + 512  , VCROW = 272, L_VC = L_KC + 128 * KROW  , L_END = L_VC + 64 * VCROW;
static_assert(L_END <= 163840 - 512, "attention LDS map");
__device__ __forceinline__ int crow(int r, int hi) { return (r & 3) + 8 * (r >> 2) + 4 * hi; }
__device__ __forceinline__ float max3f(float a, float b, float c) { float r; asm("v_max3_f32 %0, %1, %2, %3" : "=v"(r) : "v"(a), "v"(b), "v"(c)); return r; }
__device__ __forceinline__ unsigned cvtpk(float lo, float hi) { f32x2_t v = {lo, hi}; bf16x2_t b = __builtin_convertvector(v, bf16x2_t); return __builtin_bit_cast(unsigned, b); }
__device__ __forceinline__ bf16x8 packp(const f32x16& p, int s) {
    u32x4 w; w.x = cvtpk(p[8 * s + 0], p[8 * s + 1]); w.y = cvtpk(p[8 * s + 2], p[8 * s + 3]); w.z = cvtpk(p[8 * s + 4], p[8 * s + 5]); w.w = cvtpk(p[8 * s + 6], p[8 * s + 7]);
    return __builtin_bit_cast(bf16x8, w); }
__device__ __forceinline__ bf16x8 kfrag(const unsigned char* kbuf, int st, int sp, int q32, int hi) { return *(const bf16x8*)(kbuf + (32 * st + q32) * KROW + (16 * sp + 8 * hi) * 2); }
__device__ __forceinline__ bf16x8 vfrag(const unsigned char* vbuf, int st, int s, int dt, int q32, int hi) { return *(const bf16x8*)(vbuf + (32 * dt + q32) * VROW + (32 * st + 16 * s + 8 * hi) * 2); }
__device__ __forceinline__ f32x16 qk_tile(const unsigned char* kbuf, int st, const bf16x8 (&qf)[4], int q32, int hi) {
    f32x16 s = {};
#pragma unroll
    for (int sp = 0; sp < 4; ++sp) s = __builtin_amdgcn_mfma_f32_32x32x16_bf16(kfrag(kbuf, st, sp, q32, hi), qf[sp], s, 0, 0, 0);
    return s; }
__device__ __forceinline__ void pv_tile(f32x16 (&o)[2], const unsigned char* vbuf, int st, const f32x16& p, int q32, int hi) {
#pragma unroll
    for (int s = 0; s < 2; ++s) { const bf16x8 pb = packp(p, s);
#pragma unroll
        for (int dt = 0; dt < 2; ++dt) o[dt] = __builtin_amdgcn_mfma_f32_32x32x16_bf16(vfrag(vbuf, st, s, dt, q32, hi), pb, o[dt], 0, 0, 0); }
}
struct Stage { u32x4 k, v; };
__device__ __forceinline__ void stage_load(Stage& s, const bf16_t* Kblk  , int ldk, const bf16_t* Vblk  , int ldv, int tid) {
    const int row = tid >> 3, ch = tid & 7;
    s.k = *(const u32x4*)(Kblk + (size_t)row * ldk + ch * 8); s.v = *(const u32x4*)(Vblk + (size_t)row * ldv + ch * 8); }
__device__ __forceinline__ void stage_store(const Stage& s, unsigned char* kbuf, unsigned char* vbuf, int tid) {
    const int row = tid >> 3, ch = tid & 7;
    *(u32x4*)(kbuf + row * KROW + ch * 16) = s.k;
    *(u32x4*)(vbuf + row * VROW + ch * 16) = s.v; }

struct SoftState { float mhat, l; f32x16 cneg; };
constexpr float ATT_THR = 8.0f;
template <int BR, int ABL>
__device__ __forceinline__ void block64(f32x16 (&o)[2], SoftState& ss, const unsigned char* kbuf, const unsigned char* vbuf, int dj, bool selbit, bool anyunsel, const bf16x8 (&qf)[4], const float* bt2,
                                        int q32, int hi, int tl) {
    f32x16 s0 = ss.cneg, s1 = ss.cneg;
#pragma unroll
    for (int sp = 0; sp < 4; ++sp) { s0 = __builtin_amdgcn_mfma_f32_32x32x16_bf16(kfrag(kbuf, 0, sp, q32, hi), qf[sp], s0, 0, 0, 0); if (!(ABL & 64)) s1 = __builtin_amdgcn_mfma_f32_32x32x16_bf16(kfrag(kbuf, 1, sp, q32, hi), qf[sp], s1, 0, 0, 0); }
    if (ABL & 64) {
#pragma unroll
        for (int sp = 0; sp < 4; ++sp) s1 = __builtin_amdgcn_mfma_f32_32x32x16_bf16(kfrag(kbuf, 1, sp, q32, hi), qf[sp], s1, 0, 0, 0); }
    __builtin_amdgcn_sched_barrier(0);
    bf16x8 vf0[2][2], vf1[2][2];
#pragma unroll
    for (int s = 0; s < 2; ++s)
#pragma unroll
        for (int dt = 0; dt < 2; ++dt) vf0[s][dt] = vfrag(vbuf, 0, s, dt, q32, hi);
    __builtin_amdgcn_sched_barrier(0);
    if (dj <= 2) {
        const int basei = 64 * dj + tl + 64 - 4 * hi - 27; const float* bt0 = bt2 + basei; const float* bt1 = bt0 - 32;
#pragma unroll
        for (int r = 0; r < 16; ++r) { const int cr = (r & 3) + 8 * (r >> 2); s0[r] += bt0[27 - cr]; s1[r] += bt1[27 - cr]; }
    } else if (BR == 1 && dj == 8) {
        const int basei = tl - 4 * hi;
#pragma unroll
        for (int r = 0; r < 16; ++r) { const int cr = (r & 3) + 8 * (r >> 2);
            s0[r] += __int_as_float(((cr - basei - 1) >> 31) & 0xf149f2cau); s1[r] += __int_as_float(((cr + 32 - basei - 1) >> 31) & 0xf149f2cau); }
    }
    if (!(ABL & 64)) {
    float rm = max3f(s0[0], s0[1], s1[0]), rm2 = max3f(s0[2], s0[3], s1[1]);
    rm = max3f(rm, s1[2], s1[3]);
#pragma unroll
    for (int r = 4; r < 16; r += 4) { rm = max3f(rm, s0[r], s0[r + 1]); rm2 = max3f(rm2, s0[r + 2], s0[r + 3]); rm = max3f(rm, s1[r], s1[r + 1]); rm2 = max3f(rm2, s1[r + 2], s1[r + 3]); }
    rm = max3f(rm, rm2, rm2);
    if (BR == 0) rm = selbit ? rm : -1e30f;
    if (__any(rm > ATT_THR)) {
        const float rmc = fmaxf(rm, __shfl_xor(rm, 32)), dl = fmaxf(rmc, 0.f), f = __builtin_amdgcn_exp2f(-dl);
        ss.mhat += dl; ss.l *= f;
#pragma unroll
        for (int r = 0; r < 16; ++r) { s0[r] -= dl; s1[r] -= dl; ss.cneg[r] -= dl; o[0][r] *= f; o[1][r] *= f; }
    }
    }
    float ps = 0.f, ps1 = 0.f, ps2 = 0.f, ps3 = 0.f;
#pragma unroll
    for (int r = 0; r < 16; r += 2) { s0[r] = __builtin_amdgcn_exp2f(s0[r]); s0[r + 1] = __builtin_amdgcn_exp2f(s0[r + 1]); ps += s0[r]; ps2 += s0[r + 1]; }
    const unsigned pm = (BR == 0 && !selbit) ? 0u : 0xffffffffu;
    bf16x8 pb0[2];
#pragma unroll
    for (int s = 0; s < 2; ++s) { pb0[s] = packp(s0, s);
        if (BR == 0 && anyunsel) { u32x4 w = __builtin_bit_cast(u32x4, pb0[s]); w.x &= pm; w.y &= pm; w.z &= pm; w.w &= pm; pb0[s] = __builtin_bit_cast(bf16x8, w); } }
    __builtin_amdgcn_sched_barrier(0);
#pragma unroll
    for (int i = 0; i < 4; ++i) { const int s = i >> 1, dt = i & 1;
        o[dt] = __builtin_amdgcn_mfma_f32_32x32x16_bf16(vf0[s][dt], pb0[s], o[dt], 0, 0, 0);
#pragma unroll
        for (int e = 0; e < 4; ++e) s1[4 * i + e] = __builtin_amdgcn_exp2f(s1[4 * i + e]);
        __builtin_amdgcn_sched_barrier(0); }
#pragma unroll
    for (int s = 0; s < 2; ++s)
#pragma unroll
        for (int dt = 0; dt < 2; ++dt) vf1[s][dt] = vfrag(vbuf, 1, s, dt, q32, hi);
#pragma unroll
    for (int r = 0; r < 16; r += 2) { ps1 += s1[r]; ps3 += s1[r + 1]; }
    ps = (ps + ps1) + (ps2 + ps3);
    if (BR == 0) ps = selbit ? ps : 0.f;
    ss.l += ps;
#pragma unroll
    for (int s = 0; s < 2; ++s) { bf16x8 pb = packp(s1, s);
        if (BR == 0 && anyunsel) { u32x4 w = __builtin_bit_cast(u32x4, pb); w.x &= pm; w.y &= pm; w.z &= pm; w.w &= pm; pb = __builtin_bit_cast(bf16x8, w); }
#pragma unroll
        for (int dt = 0; dt < 2; ++dt) o[dt] = __builtin_amdgcn_mfma_f32_32x32x16_bf16(vf1[s][dt], pb, o[dt], 0, 0, 0); }
}
__device__ __forceinline__ void stage_load_t(Stage& s, const bf16_t* Kblk, const bf16_t* Vblk, int tid) {
    s.k = *(const u32x4*)(Kblk + (size_t)(tid >> 3) * KVW + (tid & 7) * 8); s.v = *(const u32x4*)(Vblk + (size_t)(tid & 63) * KVW + (tid >> 6) * 8); }
__device__ __forceinline__ void stage_store_t(const Stage& s, unsigned char* kbuf, unsigned char* vbuf, int tid) {
    const int row = tid >> 3, ch = tid & 7;
    *(u32x4*)(kbuf + row * KROW + ch * 16) = s.k;
    unsigned short* vp = (unsigned short*)(vbuf + ((tid >> 6) * 8) * VROW + vperm(tid & 63) * 2);
    vp[0 * (VROW / 2)] = (unsigned short)s.v.x; vp[1 * (VROW / 2)] = (unsigned short)(s.v.x >> 16); vp[2 * (VROW / 2)] = (unsigned short)s.v.y; vp[3 * (VROW / 2)] = (unsigned short)(s.v.y >> 16);
    vp[4 * (VROW / 2)] = (unsigned short)s.v.z; vp[5 * (VROW / 2)] = (unsigned short)(s.v.z >> 16); vp[6 * (VROW / 2)] = (unsigned short)s.v.w; vp[7 * (VROW / 2)] = (unsigned short)(s.v.w >> 16); }
template <int BR, int ABL>
__device__ __forceinline__ void branch(float* outl  , const Stage* first  , float gate, const bf16_t* Kg  , const bf16_t* Vg  ,
                                       int qblk, unsigned unionmask, unsigned mysel, const bf16x8 (&qf)[4], const float* bt2  , float cb  ,
                                       unsigned char* lds, int tid, int q32, int hi, int tl) {
    const int jlo = BR == 0 ? 0 : (qblk - 8 < 0 ? 0 : qblk - 8);
    f32x16 o[2]; o[0] = f32x16{}; o[1] = f32x16{};
    SoftState ss; ss.mhat = 0.f; ss.l = 0.f;
#pragma unroll
    for (int r = 0; r < 16; ++r) ss.cneg[r] = cb;
#define ATT_NEXT(jv) do { --(jv); if (BR == 0) { while ((jv) >= jlo && !((unionmask >> (jv)) & 1u)) --(jv); } } while (0)
#define ATT_LOAD(sg, jv) do { const int jl_ = (jv) < jlo ? jlo : (jv); if (!(ABL & 8)) stage_load_t(sg, Kg + (size_t)jl_ * 64 * KVW, Vg + (size_t)jl_ * 64 * KVW, tid); else { sg.k = (u32x4){(unsigned)jl_, 0u, 0u, 0u}; sg.v = sg.k; } } while (0)
#define ATT_SEL(jv) (BR == 0 ? (((mysel >> (jv)) & 1u) != 0u) : true)
    int jA = qblk, jB = qblk, jC;
    Stage sA, sB;
    if (first) sA = *first; else ATT_LOAD(sA, jA);
    ATT_NEXT(jB); ATT_LOAD(sB, jB);
    stage_store_t(sA, lds + L_K0, lds + L_V0, tid);
    __syncthreads();
    for (;;) {
        jC = jB; if (jB >= jlo) ATT_NEXT(jC);
        ATT_LOAD(sA, jC);
        { const bool sel = ATT_SEL(jA); if (BR == 1 || __any(sel)) block64<BR, ABL>(o, ss, lds + L_K0, lds + L_V0, qblk - jA, sel, BR == 0 && __any(!sel), qf, bt2, q32, hi, tl); }
        if (jB < jlo) break;
        if (!(ABL & 16)) stage_store_t(sB, lds + L_K1, lds + L_V1, tid);
        if (!(ABL & 4)) __syncthreads();
        jA = jC; if (jC >= jlo) ATT_NEXT(jA);
        ATT_LOAD(sB, jA);
        { const bool sel = ATT_SEL(jB); if (BR == 1 || __any(sel)) block64<BR, ABL>(o, ss, lds + L_K1, lds + L_V1, qblk - jB, sel, BR == 0 && __any(!sel), qf, bt2, q32, hi, tl); }
        if (jC < jlo) break;
        if (!(ABL & 16)) stage_store_t(sA, lds + L_K0, lds + L_V0, tid);
        if (!(ABL & 4)) __syncthreads();
        jB = jA; jA = jC;
    }
#undef ATT_NEXT
#undef ATT_LOAD
#undef ATT_SEL
    float lrun = ss.l; lrun += __shfl_xor(lrun, 32);
    const float f = gate / lrun;
#pragma unroll
    for (int r = 0; r < 16; ++r) { outl[r * 64] += o[0][r] * f; outl[(16 + r) * 64] += o[1][r] * f; }
    __syncthreads();
}

__device__ __forceinline__ void attn_bias_table(int g, const float* rel_bias, unsigned char* lds) {
    float* bt = (float*)(lds + L_BT); const int tid = threadIdx.x;
#pragma unroll
    for (int i = 0; i < 2; ++i) { const int e = tid + 512 * i, hh = e >> 8, ix = (e & 255) - 64; const float cbh = rel_bias[31 * NH + g * 4 + hh] * LOG2E; bt[e] = ix < 0 ? -1e30f : rel_bias[BUCKET[ix > 127 ? 127 : ix] * NH + g * 4 + hh] * LOG2E - cbh; }
    if (tid < 4) bt[1024 + tid] = rel_bias[31 * NH + g * 4 + tid] * LOG2E;
    __syncthreads();
}
__device__ __forceinline__ void attn_compress_l2(int bg, const bf16_t* HIDK, const bf16_t* HIDV, const float* w2k, const float* w2v, const float* kc_norm, unsigned char* lds) {
    const int tid = threadIdx.x, lane = tid & 63, wave = tid >> 6, q32 = lane & 31, hi = lane >> 5, which = wave >> 2, c = 32 * (wave & 3) + q32; const bool okc = c < NC;
    const bf16_t* hrow = (which ? HIDV : HIDK) + (size_t)(bg * NC + (okc ? c : 0)) * 256; const float* w2 = which ? w2v : w2k;
    f32x16 acc[2]; acc[0] = f32x16{}; acc[1] = f32x16{};
    for (int s = 0; s < 16; ++s) {
        const bf16x8 bfrag = *(const bf16x8*)(hrow + 16 * s + 8 * hi);
#pragma unroll
        for (int nt = 0; nt < 2; ++nt) { const float* wp = w2 + (size_t)(16 * s + 8 * hi) * HD + 32 * nt + q32;
            u32x4 aw; aw.x = cvtpk(wp[0], wp[HD]); aw.y = cvtpk(wp[2 * HD], wp[3 * HD]); aw.z = cvtpk(wp[4 * HD], wp[5 * HD]); aw.w = cvtpk(wp[6 * HD], wp[7 * HD]);
            acc[nt] = __builtin_amdgcn_mfma_f32_32x32x16_bf16(__builtin_bit_cast(bf16x8, aw), bfrag, acc[nt], 0, 0, 0); }
    }
    if (which) {
        unsigned short* vp = (unsigned short*)(lds + L_VC) + vperm(c);
#pragma unroll
        for (int nt = 0; nt < 2; ++nt)
#pragma unroll
            for (int q = 0; q < 16; ++q) vp[(32 * nt + crow(q, hi)) * (VCROW / 2)] = okc ? (unsigned short)(cvtpk(acc[nt][q], 0.f) & 0xffffu) : (unsigned short)0;
    } else {
        float ss = 0.f;
#pragma unroll
        for (int nt = 0; nt < 2; ++nt)
#pragma unroll
            for (int q = 0; q < 16; ++q) ss += acc[nt][q] * acc[nt][q];
        ss += __shfl_xor(ss, 32); const float rn = okc ? rsqrtf(ss * (1.f / HD) + EPS) : 0.f;
#pragma unroll
        for (int nt = 0; nt < 2; ++nt)
#pragma unroll
            for (int rg = 0; rg < 4; ++rg) { const int n0 = 32 * nt + 8 * rg + 4 * hi; const f32x4 gk = *(const f32x4*)(kc_norm + n0);
                *(unsigned long long*)(lds + L_KC + c * KROW + n0 * 2) = (unsigned long long)cvtpk(acc[nt][4 * rg] * rn * gk[0], acc[nt][4 * rg + 1] * rn * gk[1]) | ((unsigned long long)cvtpk(acc[nt][4 * rg + 2] * rn * gk[2], acc[nt][4 * rg + 3] * rn * gk[3]) << 32); }
    }
    __syncthreads();
}
__device__ __forceinline__ bf16x8 vfragc(const unsigned char* vcbuf, int tile, int s, int dt, int q32, int hi) { return *(const bf16x8*)(vcbuf + (32 * dt + q32) * VCROW + (32 * tile + 16 * s + 8 * hi) * 2); }
template <int MODE, int ABL = 0>
__device__ __forceinline__ void attn_unit(int b, int g, int qblk, const bf16_t* Q, bf16_t* O, const bf16_t* KSb, const bf16_t* VSb, const bf16_t* KWb, const bf16_t* VWb,
                                          const bf16_t* GN, const float* rel_bias, unsigned char* lds) {
    int tid = threadIdx.x; asm volatile("" : "+v"(tid));
    const int lane = tid & 63, wave = tid >> 6, q32 = lane & 31, hi = lane >> 5, hr = wave >> 1, th = wave & 1, h = g * 4 + hr, tl = 32 * th + q32, t = 64 * qblk + tl, bg = b * 4 + g;
    const size_t m = (size_t)b * T + t;
    float* bt = (float*)(lds + L_BT); float* impg = (float*)(lds + L_IMPG); float* impl = (float*)(lds + L_IMPL); float* imp = (float*)(lds + L_IMP); unsigned* selm = (unsigned*)(lds + L_SELM);
    bf16x8 qf[4];
#pragma unroll
    for (int sp = 0; sp < 4; ++sp) qf[sp] = *(const bf16x8*)(Q + m * QW + h * HD + 16 * sp + 8 * hi);
    const float g0 = bf2f(GN[m * 48 + h * 3 + 0]), g1 = bf2f(GN[m * 48 + h * 3 + 1]), g2 = bf2f(GN[m * 48 + h * 3 + 2]);
    f32x16 out[2];
    {
        const float* bte = bt + hr * 256 + 64; const float cbh = bt[1024 + hr];
        const int ncv = t >= 31 ? ((t - 31) >> 4) + 1 : 0;
        f32x16 sc[4]; float mx = -1e20f;
#pragma unroll
        for (int tile = 0; tile < 4; ++tile) {
            sc[tile] = qk_tile(lds + L_KC, tile, qf, q32, hi);
            __builtin_amdgcn_sched_barrier(0);
#pragma unroll
            for (int r = 0; r < 16; ++r) { const int c = 32 * tile + crow(r, hi);
                int dist = t - 31 - 16 * c; const float pen = __int_as_float(((ncv - 1 - c) >> 31) & 0xf149f2cau);
                dist = dist < 0 ? 0 : (dist > 127 ? 127 : dist);
                const float v = (sc[tile][r] + (bte[dist] + cbh)) + pen; sc[tile][r] = v; mx = fmaxf(mx, v); }
            __builtin_amdgcn_sched_barrier(0);
        }
        mx = fmaxf(mx, __shfl_xor(mx, 32));
        float l = 0.f;
#pragma unroll
        for (int tile = 0; tile < 4; ++tile)
#pragma unroll
            for (int r = 0; r < 16; ++r) { const float p = __builtin_amdgcn_exp2f(sc[tile][r] - mx); sc[tile][r] = p; l += p; }
        l += __shfl_xor(l, 32);
        const float inv = l > 0.f ? 1.f / l : 0.f;
#pragma unroll
        for (int tile = 0; tile < 4; ++tile)
#pragma unroll
            for (int r = 0; r < 16; ++r) sc[tile][r] *= inv;
        __builtin_amdgcn_sched_barrier(0);
        if (qblk > 15)
#pragma unroll
        for (int tile = 0; tile < 4; ++tile)
#pragma unroll
            for (int rg = 0; rg < 4; ++rg) { const int j = 8 * tile + 2 * rg + hi;
                impg[(hr * 64 + tl) * 33 + j] = (sc[tile][4 * rg] + sc[tile][4 * rg + 1]) + (sc[tile][4 * rg + 2] + sc[tile][4 * rg + 3]);
                impl[(hr * 64 + tl) * 33 + j] = sc[tile][4 * rg + 3]; }
        __builtin_amdgcn_sched_barrier(0);
        f32x16 o[2]; o[0] = f32x16{}; o[1] = f32x16{};
#pragma unroll
        for (int tile = 0; tile < 4; ++tile) {
#pragma unroll
            for (int s = 0; s < 2; ++s) { const bf16x8 pb = packp(sc[tile], s);
#pragma unroll
                for (int dt = 0; dt < 2; ++dt) o[dt] = __builtin_amdgcn_mfma_f32_32x32x16_bf16(vfragc(lds + L_VC, tile, s, dt, q32, hi), pb, o[dt], 0, 0, 0); }
            __builtin_amdgcn_sched_barrier(0); }
#pragma unroll
        for (int r = 0; r < 16; ++r) { out[0][r] = o[0][r] * g0; out[1][r] = o[1][r] * g0; }
    }
    const bf16_t* Kgs = KSb + (size_t)b * T * KVW + g * HD; const bf16_t* Kgw = KWb + (size_t)b * T * KVW + g * HD;
    const bf16_t* Vgs = VSb + (size_t)b * T * KVW + g * HD; const bf16_t* Vgw = VWb + (size_t)b * T * KVW + g * HD;
    Stage sfirst; stage_load_t(sfirst, Kgs + (size_t)qblk * 64 * KVW, Vgs + (size_t)qblk * 64 * KVW, tid);
    unsigned mysel, uni;
    if (qblk > 15) {
    __syncthreads();
    {
        const int stl = tid >> 3, jq = tid & 7;
#pragma unroll
        for (int e = 0; e < 4; ++e) { const int j = 4 * jq + e; float s = 0.f;
#pragma unroll
            for (int r = 0; r < 4; ++r) { s += impg[(r * 64 + stl) * 33 + j]; if (j > 0) s += impl[(r * 64 + stl) * 33 + j - 1]; }
            imp[stl * 33 + j] = s; }
        __syncthreads();
        unsigned bits = 0u;
        {
            float iv[32];
#pragma unroll
            for (int k = 0; k < 32; ++k) iv[k] = imp[stl * 33 + k];
#pragma unroll
            for (int e = 0; e < 4; ++e) { const int j = 4 * jq + e; float vj = iv[0];
#pragma unroll
                for (int k = 1; k < 32; ++k) vj = (k == j) ? iv[k] : vj;
                int rank = 0;
#pragma unroll
                for (int k = 1; k < 30; ++k) { const bool cand = k <= qblk - 2; rank += (cand && (iv[k] > vj || (iv[k] == vj && k < j))) ? 1 : 0; }
                if (j == 0 || j == qblk - 1 || j == qblk) bits |= 1u << j; else if (j < qblk - 1 && rank < 13) bits |= 1u << j; }
        }
        bits |= __shfl_xor(bits, 1); bits |= __shfl_xor(bits, 2); bits |= __shfl_xor(bits, 4);
        if (jq == 0) selm[stl] = bits;
    }
    __syncthreads();
    mysel = selm[tl]; uni = selm[lane];
#pragma unroll
    for (int o = 1; o < 64; o <<= 1) uni |= __shfl_xor(uni, o);
    } else { mysel = uni = (1u << (qblk + 1)) - 1u; }
    float* outl = (float*)(lds + L_IMPG) + wave * 2048 + lane;
#pragma unroll
    for (int r = 0; r < 16; ++r) { outl[r * 64] = out[0][r]; outl[(16 + r) * 64] = out[1][r]; }
    if (MODE & 2) branch<0, ABL>(outl, &sfirst, g1, Kgs, Vgs, qblk, uni, mysel, qf, bt + hr * 256, bt[1024 + hr], lds, tid, q32, hi, tl);
    if (MODE & 4) branch<1, ABL>(outl, nullptr, g2, Kgw, Vgw, qblk, 0xffffffffu, 0xffffffffu, qf, bt + hr * 256, bt[1024 + hr], lds, tid, q32, hi, tl);
    bf16_t* orow = O + m * QW + h * HD;
#pragma unroll
    for (int dt = 0; dt < 2; ++dt)
#pragma unroll
        for (int rg = 0; rg < 4; ++rg)
            *(unsigned long long*)(orow + 32 * dt + 8 * rg + 4 * hi) = (unsigned long long)cvtpk(outl[(16 * dt + 4 * rg) * 64], outl[(16 * dt + 4 * rg + 1) * 64]) | ((unsigned long long)cvtpk(outl[(16 * dt + 4 * rg + 2) * 64], outl[(16 * dt + 4 * rg + 3) * 64]) << 32);
}
}

__device__ __forceinline__ void tr_item(const float* W, int ldw, int kvalid, int c0, int cvalid, const float* kscale, bf16_t* WT, int ldt, int r0, int k0, float* scr, int lane) {
#pragma unroll
    for (int i = 0; i < 32; ++i) { const int kk = 2 * i + (lane >> 5), col = lane & 31, k = k0 + kk;
        float v = 0.f; if (k < kvalid && col < cvalid) { v = W[(size_t)k * ldw + c0 + col]; if (kscale) v *= kscale[k]; }
        scr[kk * 33 + col] = v; }
    asm volatile("s_waitcnt lgkmcnt(0)" ::: "memory");
    const int c = lane & 7;
#pragma unroll
    for (int j = 0; j < 4; ++j) { const int n = (lane >> 3) + 8 * j; const float* s = scr + (8 * c) * 33 + n;
        pg8::u32x4 o; o.x = pg8::cvt_pk_bf16(s[0 * 33], s[1 * 33]); o.y = pg8::cvt_pk_bf16(s[2 * 33], s[3 * 33]); o.z = pg8::cvt_pk_bf16(s[4 * 33], s[5 * 33]); o.w = pg8::cvt_pk_bf16(s[6 * 33], s[7 * 33]);
        *(pg8::u32x4*)(WT + (size_t)(r0 + n) * ldt + k0 + 8 * c) = o; }
    asm volatile("s_waitcnt lgkmcnt(0)" ::: "memory");
}

#define LAS __attribute__((address_space(3)))
#define XB_TMO      128
#define XB_XCNT(j)  (256  + 64 * (j))
#define XB_XSUB(j)  (1280 + 64 * (j))
#define XB_XGEN(j)  (2304 + 64 * (j))
#define XB_TOP      3328
#define XB_TOPGEN   3392
#define XCD_BAR_WORDS 3456
#define XB_SPIN_CAP (1u << 18)

__device__ __forceinline__ unsigned xb_ld(unsigned* p)              { return __hip_atomic_load(p, __ATOMIC_RELAXED, __HIP_MEMORY_SCOPE_AGENT); }
__device__ __forceinline__ unsigned xb_add(unsigned* p, unsigned v) { return __hip_atomic_fetch_add(p, v, __ATOMIC_RELAXED, __HIP_MEMORY_SCOPE_AGENT); }
__device__ __forceinline__ unsigned xb_xcc_id() { return (unsigned)__builtin_amdgcn_s_getreg((3 << 11) | 20) & 0xFu; }
#define XB_SPIN(cond, bar) do { unsigned _sp = 0; while (cond) { __builtin_amdgcn_s_sleep(1); \
    if ((++_sp & 255u) == 0u) { if (xb_ld(&(bar)[XB_TMO])) break; if (_sp > XB_SPIN_CAP) { atomicAdd(&(bar)[XB_TMO], 1u); break; } } } } while (0)

struct XcdBarrier {
    unsigned* bar; unsigned x;
    volatile LAS unsigned* st;
};

__device__ __forceinline__ XcdBarrier xcd_barrier_post(unsigned* bar, volatile LAS unsigned* st) {
    XcdBarrier b; b.bar = bar; b.x = xb_xcc_id(); b.st = st;
    if (threadIdx.x == 0) (void)xb_add(&bar[XB_XCNT(b.x)], 1u);
    return b;
}
__device__ __forceinline__ void xcd_barrier_complete(unsigned* bar, unsigned x, unsigned& nloc, unsigned& nx) {
    const unsigned G = gridDim.x * gridDim.y * gridDim.z;
    unsigned sum, cnt, mine, sp = 0u;
    for (;;) {
        sum = 0u; cnt = 0u; mine = 0u;
#pragma unroll
        for (unsigned j = 0; j < 16; ++j) { const unsigned c = xb_ld(&bar[XB_XCNT(j)]); sum += c; cnt += (c > 0u) ? 1u : 0u; mine = (j == x) ? c : mine; }
        if (sum == G) break;
        __builtin_amdgcn_s_sleep(1);
        if ((++sp & 255u) == 0u) { if (xb_ld(&bar[XB_TMO])) break; if (sp > XB_SPIN_CAP) { atomicAdd(&bar[XB_TMO], 1u); break; } }
    }
    nloc = mine > 0u ? mine : 1u; nx = cnt > 0u ? cnt : 1u;
}

__device__ __forceinline__ void xcd_barrier(const XcdBarrier& b) {
    asm volatile("s_waitcnt vmcnt(0)" ::: "memory");
    __syncthreads();
    if (threadIdx.x == 0) {
        unsigned* bar = b.bar;
        __builtin_amdgcn_s_waitcnt(0);
        unsigned nloc = b.st[0], nx = b.st[1];
        if (nloc == 0u) { xcd_barrier_complete(bar, b.x, nloc, nx); b.st[0] = nloc; b.st[1] = nx; }
        const unsigned old = xb_add(&bar[XB_XSUB(b.x)], 1u);
        const unsigned gen = old / nloc;
        if (old + 1u == (gen + 1u) * nloc) {
            __builtin_amdgcn_fence(__ATOMIC_RELEASE, "agent");
            asm volatile("s_waitcnt vmcnt(0)" ::: "memory");
            const unsigned og = xb_add(&bar[XB_TOP], 1u);
            const unsigned tg = og / nx;
            if (og + 1u == (tg + 1u) * nx) xb_add(&bar[XB_TOPGEN], 1u);
            else XB_SPIN(xb_ld(&bar[XB_TOPGEN]) == tg, bar);
            __builtin_amdgcn_fence(__ATOMIC_ACQUIRE, "agent");
            xb_add(&bar[XB_XGEN(b.x)], 1u);
            asm volatile("s_waitcnt vmcnt(0)" ::: "memory");
        } else {
            XB_SPIN(xb_ld(&bar[XB_XGEN(b.x)]) == gen, bar);
            __builtin_amdgcn_fence(__ATOMIC_ACQUIRE, "agent");
            asm volatile("s_waitcnt vmcnt(0)" ::: "memory");
        }
    }
    __syncthreads();
}

#define DECL_PTRS \
    size_t zoff_ = 0; asm volatile("" : "+s"(zoff_));     \
    unsigned char* ws = a.ws + zoff_; unsigned char* dob = (unsigned char*)a.out + zoff_; \
    const float *x = a.in[0], *norm_mix = a.in[1], *w_in = a.in[2], *conv_w = a.in[3], *conv_b = a.in[4], *gate_a_w = a.in[5], *gate_a_b = a.in[6], *gate_x_w = a.in[7], *gate_x_b = a.in[8], \
                *lam = a.in[9], *pe_k = a.in[10], *w1k = a.in[11], *w2k = a.in[12], *pe_v = a.in[13], *w1v = a.in[14], *w2v = a.in[15], *q_norm = a.in[16], *kc_norm = a.in[17], *ks_norm = a.in[18], \
                *kw_norm = a.in[19], *rel_bias = a.in[20], *proj_a = a.in[21], *proj_b = a.in[22], *w_out = a.in[23], *norm_mlp = a.in[24], *w_mlp_in = a.in[25], *w_mlp_out = a.in[26]; \
    float* RSTD = (float*)(ws + WS_RSTD); float* KCC = (float*)(ws + WS_KCC); float* VCC = (float*)(ws + WS_VCC); unsigned* SEL = (unsigned*)(ws + WS_SEL); \
    bf16_t *URNN = (bf16_t*)(ws + WS_URNN), *UGATE = (bf16_t*)(ws + WS_UGATE), *Q = (bf16_t*)(ws + WS_Q), *KV = (bf16_t*)(ws + WS_KV), *GN = (bf16_t*)(ws + WS_GN), *GA = (bf16_t*)(ws + WS_GA), *GB = (bf16_t*)(ws + WS_GB); \
    bf16_t *KCr = KV, *VCr = KV + (size_t)M * KVW, *KS = KV + 2 * (size_t)M * KVW, *VS = KV + 3 * (size_t)M * KVW, *KW = KV + 4 * (size_t)M * KVW, *VW = KV + 5 * (size_t)M * KVW; \
    bf16_t *LA = (bf16_t*)(ws + WS_LA), *UP = (bf16_t*)(ws + WS_UP), *T1 = (bf16_t*)(ws + WS_T1), *MERGED = (bf16_t*)(ws + WS_MERGED), *HB = (bf16_t*)(ws + WS_HB), *ZACT = (bf16_t*)(ws + WS_ZACT); \
    bf16_t *FLATK = (bf16_t*)(dob + DO_FLATK), *FLATV = (bf16_t*)(dob + DO_FLATV), *HIDK = (bf16_t*)(dob + DO_HIDK), *HIDV = (bf16_t*)(dob + DO_HIDV), *XC = (bf16_t*)(dob + DO_XC), *YA = (bf16_t*)(dob + DO_YA); \
    float* H = (float*)dob; \
    float* LAMC = (float*)(ws + WS_LAMC); float* NORMS = (float*)(ws + WS_NORMS); float* PES = (float*)(ws + WS_PES); float* SSQ = (float*)(ws + WS_SSQ); \
    bf16_t *WIN_T = (bf16_t*)(ws + WS_WIN), *WG_T = (bf16_t*)(ws + WS_WG), *W1_T = (bf16_t*)(ws + WS_W1), *PA_T = (bf16_t*)(ws + WS_PA), *PB_T = (bf16_t*)(ws + WS_PB), *WO_T = (bf16_t*)(ws + WS_WO), *WMI_T = (bf16_t*)(ws + WS_WMI), *WMO_T = (bf16_t*)(ws + WS_WMO); \
    float *CAR = (float*)(dob + DO_CAR), *CBR = (float*)(dob + DO_CBR); \
    bf16_t* XB = (bf16_t*)(dob + DO_XB); bf16_t *KCB = (bf16_t*)(dob + DO_KCB), *VCT = (bf16_t*)(dob + DO_VCT), *VST = (bf16_t*)(dob + DO_VST), *VWT = (bf16_t*)(dob + DO_VWT); \
    (void)0;
__global__ void __launch_bounds__(NTHREADS, 2) fwd(Args a) {
    extern __shared__ __attribute__((aligned(16))) unsigned char lds[];
    float* ldsf = (float*)lds;
    const int tid = threadIdx.x, lane = tid & 63, wave = tid >> 6;
    const int gw = blockIdx.x * 8 + wave, NGW = gridDim.x * 8;
    const size_t gtid = (size_t)blockIdx.x * NTHREADS + tid, GSZ = (size_t)gridDim.x * NTHREADS;
    unsigned char* ws0 = a.ws;
    PG8_LAS unsigned char* ldsl = (PG8_LAS unsigned char*)lds;
    const int G = gridDim.x;
    const int lo = a.ph_lo, hi = a.ph_hi;
    volatile LAS unsigned* MISC = (volatile LAS unsigned*)((LAS unsigned char*)lds + LDS_BYTES - 256);
    if (tid < 32) MISC[tid] = 0u;
    __syncthreads();
    XcdBarrier bar = xcd_barrier_post((unsigned*)(ws0 + 16384), MISC + 8);
    int ph = 0;
#ifndef PHMASK
#define PHMASK 0xFFFFFFFFu
#endif
#ifndef REPMASK
#define REPMASK 0u
#endif
#define PHASE_BEGIN if (lo <= ph && ph < hi && ((PHMASK >> ph) & 1u)) {
#define PHASE_BEGIN_R if (lo <= ph && ph < hi && ((PHMASK >> ph) & 1u)) for (int rep_ = 0; rep_ < (((REPMASK >> (16 + ph)) & 1u) ? 2 : 1); ++rep_) {
#define PHASE_END } { const bool sync_ = (lo <= ph && ph + 1 < hi); ++ph; if (sync_) xcd_barrier(bar); }

    PHASE_BEGIN_R DECL_PTRS
    for (int m0 = 2 * gw; m0 < M; m0 += 2 * NGW) {
        pg8::f32x4 v[2][4]; float s[2] = {0.f, 0.f};
#pragma unroll
        for (int u = 0; u < 2; ++u) { const pg8::f32x4* xr = (const pg8::f32x4*)(x + (size_t)(m0 + u) * D) + lane;
#pragma unroll
            for (int j = 0; j < 4; ++j) v[u][j] = xr[64 * j]; }
#pragma unroll
        for (int u = 0; u < 2; ++u)
#pragma unroll
            for (int j = 0; j < 4; ++j) s[u] += (v[u][j][0] * v[u][j][0] + v[u][j][1] * v[u][j][1]) + (v[u][j][2] * v[u][j][2] + v[u][j][3] * v[u][j][3]);
#pragma unroll
        for (int o = 1; o < 64; o <<= 1) { s[0] += __shfl_xor(s[0], o); s[1] += __shfl_xor(s[1], o); }
#pragma unroll
        for (int u = 0; u < 2; ++u) { const float r = rsqrtf(s[u] * (1.f / D) + EPS); if (lane == 0) RSTD[m0 + u] = r;
            unsigned long long* o8 = (unsigned long long*)(XB + (size_t)(m0 + u) * D) + lane;
#pragma unroll
            for (int j = 0; j < 4; ++j) { const pg8::f32x4 gg = *((const pg8::f32x4*)norm_mix + lane + 64 * j); const pg8::f32x4 y = v[u][j] * r * gg;
                o8[64 * j] = (unsigned long long)pg8::cvt_pk_bf16(y[0], y[1]) | ((unsigned long long)pg8::cvt_pk_bf16(y[2], y[3]) << 32); } }
    }
    for (size_t i = gtid; i < DRNN; i += GSZ) LAMC[i] = -8.f * log1pf(__expf(-lam[i])) * LOG2E;
    for (size_t i = gtid; i < 4096; i += GSZ) PES[i] = i < 2048 ? pe_k[i] : pe_v[i - 2048];
    for (size_t i = gtid; i < 192; i += GSZ) NORMS[i] = i < 64 ? q_norm[i] : (i < 128 ? ks_norm[i - 64] : kw_norm[i - 128]);
    {
        float* scr = ldsf + wave * (64 * 33);
        constexpr int I_WIN = (pg8::N1PAD / 32) * 16, I_W1 = 16 * 32;
        for (int it = gw; it < I_WIN + I_W1; it += NGW) {
            int r = it;
            if (r < I_WIN) { const int ch = r / 16, kb = r % 16; int c0, cv; pg8::win_src(ch, c0, cv); tr_item(w_in, DIN, D, c0, cv, nullptr, WIN_T, D, 32 * ch, 64 * kb, scr, lane); continue; } r -= I_WIN;
            { const int ch = r / 32, kb = r % 32; tr_item((ch >> 3) ? w1v : w1k, 256, 2048, (ch & 7) * 32, 32, nullptr, W1_T, 2048, 32 * ch, 64 * kb, scr, lane); }
        }
    }
    PHASE_END
    PHASE_BEGIN DECL_PTRS
    if (FAST(1)) {
        pg8::Gemm g{XB, WIN_T, M, pg8::N1PAD, D}; pg8::StaticOrder S; S.init(M, pg8::N1PAD, G, (int)blockIdx.x);
        PG8_LAS float* ctab = (PG8_LAS float*)(ldsl + 131072);
        for (int i = tid; i < 192; i += NTHREADS) ctab[i] = NORMS[i];
        for (int i = tid; i < 4096; i += NTHREADS) ctab[256 + i] = PES[i];
        __syncthreads();
        pg8::Ep1F E{URNN, UGATE, Q, KV, GN, GA, ctab, FLATK, ctab + 256};
        pg8::gemm_phase<pg8::Ep1F, pg8::StaticOrder, true, true>(ldsl, g, S, E);
#if (REPMASK >> 1) & 1
        pg8::gemm_phase<pg8::Ep1F, pg8::StaticOrder, true, true>(ldsl, g, S, E);
#endif
    } else {
        ngemm(ldsf, M, DIN, D, ALf32Scale{x, D, norm_mix}, BLf32{w_in, DIN}, Ep1{RSTD, URNN, UGATE, Q, KV, GN, GA, GB});
    }
    PHASE_END
    PHASE_BEGIN DECL_PTRS
    if (blockIdx.x >= 64) {
        float* scr = ldsf + wave * (64 * 33);
        constexpr int I_WG = 96 * 6, I_PA = 32 * 22, I_PB = 32 * 16, I_WO = 32 * 16, I_WMI = 128 * 16, I_WMO = 32 * 64;
        for (int it = ((int)blockIdx.x - 64) * 8 + wave; it < I_WG + I_PA + I_PB + I_WO + I_WMI + I_WMO; it += ((int)gridDim.x - 64) * 8) {
            int r = it;
            if (r < I_WG) { const int ch = r / 6, kb = r % 6, nb = ch / 24, rr = ch % 24, pn = rr >> 3, l0 = (rr & 7) * 32, bj = l0 >> 7, chn0 = 128 * pn + (l0 & 127);
                int cv = BW - chn0; cv = cv < 0 ? 0 : (cv > 32 ? 32 : cv);
                tr_item((bj ? gate_x_w : gate_a_w) + (size_t)nb * BW * BW, BW, BW, chn0, cv, nullptr, WG_T, XC_LD, 32 * ch, 64 * kb, scr, lane); continue; } r -= I_WG;
            if (r < I_PA) { const int ch = r / 22, kb = r % 22; tr_item(proj_a, D, DRNN, 32 * ch, 32, nullptr, PA_T, YA_LD, 32 * ch, 64 * kb, scr, lane); continue; } r -= I_PA;
            if (r < I_PB) { const int ch = r / 16, kb = r % 16; tr_item(proj_b, D, QW, 32 * ch, 32, nullptr, PB_T, QW, 32 * ch, 64 * kb, scr, lane); continue; } r -= I_PB;
            if (r < I_WO) { const int ch = r / 16, kb = r % 16; tr_item(w_out, D, D, 32 * ch, 32, nullptr, WO_T, D, 32 * ch, 64 * kb, scr, lane); continue; } r -= I_WO;
            if (r < I_WMI) { const int ch = r / 16, kb = r % 16; tr_item(w_mlp_in, DFF, D, 32 * ch, 32, norm_mlp, WMI_T, D, 32 * ch, 64 * kb, scr, lane); continue; } r -= I_WMI;
            { const int ch = r / 64, kb = r % 64; tr_item(w_mlp_out, D, DFF, 32 * ch, 32, nullptr, WMO_T, DFF, 32 * ch, 64 * kb, scr, lane); }
        }
    } else
    if (FAST(3)) {
        pg8::Gemm g{FLATK, W1_T, 16384, 512, 2048}; pg8::OrderC1 S{G, (int)blockIdx.x};
        pg8::EpGeluF E{HIDK, 256};
        pg8::gemm_phase<pg8::EpGeluF, pg8::OrderC1, true, true>(ldsl, g, S, E);
#if (REPMASK >> 3) & 1
        pg8::gemm_phase<pg8::EpGeluF, pg8::OrderC1, true, true>(ldsl, g, S, E);
#endif
    } else {
        ngemm(ldsf, 8192, 256, 2048, ALbf{FLATK, 2048}, BLf32{w1k, 256}, EpGelu{HIDK, 256});
        ngemm(ldsf, 8192, 256, 2048, ALbf{FLATV, 2048}, BLf32{w1v, 256}, EpGelu{HIDV, 256});
    }
    PHASE_END
    PHASE_BEGIN DECL_PTRS
    {
        const int vcu = (G % 8 == 0) ? ((int)blockIdx.x % 8) * (G / 8) + (int)blockIdx.x / 8 : (int)blockIdx.x;
#ifdef ATT_PROBE_MODE
#ifndef ATT_ABL
#define ATT_ABL 0
#endif
        for (int u = vcu; u < 256; u += G) {
            const int bg = u >> 2, s4 = u & 3;
            att::attn_bias_table(bg & 3, rel_bias, lds);
            att::attn_compress_l2(bg, HIDK, HIDV, w2k, w2v, kc_norm, lds);
#pragma unroll 1
            for (int i = 0; i < 8; ++i) { const int qblk = 8 * (i >> 1) + ((i & 1) ? 7 - s4 : s4);
                att::attn_unit<ATT_PROBE_MODE, ATT_ABL>(bg >> 2, bg & 3, qblk, Q, (bf16_t*)dob, KS, VS, KW, VW, GN, rel_bias, lds); }
        }
#endif
        bool nomax;
        {   float* red = (float*)(lds + 159744);
            float v = 0.f; if (tid < 64) v = fabsf(q_norm[tid]); else if (tid < 128) v = fabsf(ks_norm[tid - 64]); else if (tid < 192) v = fabsf(kw_norm[tid - 128]);
            float bb = fabsf(rel_bias[tid]);
#pragma unroll
            for (int o = 32; o; o >>= 1) { v = fmaxf(v, __shfl_xor(v, o)); bb = fmaxf(bb, __shfl_xor(bb, o)); }
            if (lane == 0) { red[wave] = v; red[8 + wave] = bb; }
            __syncthreads();
            const float bm = fmaxf(fmaxf(fmaxf(red[8], red[9]), fmaxf(red[10], red[11])), fmaxf(fmaxf(red[12], red[13]), fmaxf(red[14], red[15])));
            nomax = 11.55f * red[0] * fmaxf(red[1], red[2]) + 1.4427f * bm <= 60.f;
        }
#define ATT_UNITS(ABLV) for (int u = vcu; u < 256; u += G) {     \
            const int bg = u >> 2, s4 = u & 3; \
            att::attn_bias_table(bg & 3, rel_bias, lds); \
            att::attn_compress_l2(bg, HIDK, HIDV, w2k, w2v, kc_norm, lds); \
            _Pragma("unroll 1") for (int i = 7; i >= 0; --i) { const int qblk = 8 * (i >> 1) + ((i & 1) ? 7 - s4 : s4);     \
                att::attn_unit<7, ABLV>(bg >> 2, bg & 3, qblk, Q, Q, KS, VS, KW, VW, GN, rel_bias, lds); } }
        if (nomax) { ATT_UNITS(64) } else { ATT_UNITS(0) }
#undef ATT_UNITS
    }
    for (unsigned it = (unsigned)gtid; it < 4u * (unsigned)(M / 8) * 48u; it += (unsigned)GSZ) {
        const unsigned ch = it % 48u, nr = it / 48u, run = nr & (unsigned)(M / 8 - 1), n = nr >> 12, m0 = run * 8u, t0 = m0 & (unsigned)(T - 1), j0 = ch * 8u;
        bf16_t* dst = XC + ((size_t)n * M + m0) * XC_LD + j0;
        if (j0 >= (unsigned)BW) {
#pragma unroll
            for (int i = 0; i < 8; ++i) *(pg8::u32x4*)(dst + (size_t)i * XC_LD) = (pg8::u32x4){0u, 0u, 0u, 0u};
            continue; }
        const unsigned c = n * BW + j0;
        pg8::u32x4 rows[11];
#pragma unroll
        for (int i = 0; i < 11; ++i) rows[i] = ((int)t0 - 3 + i >= 0) ? *(const pg8::u32x4*)(URNN + (size_t)(m0 - 3 + i) * DRNN + c) : (pg8::u32x4){0u, 0u, 0u, 0u};
        pg8::f32x4 w0[4], w1[4];
#pragma unroll
        for (int kk = 0; kk < 4; ++kk) { w0[kk] = *(const pg8::f32x4*)(conv_w + kk * DRNN + c); w1[kk] = *(const pg8::f32x4*)(conv_w + kk * DRNN + c + 4); }
        const pg8::f32x4 b0 = *(const pg8::f32x4*)(conv_b + c), b1 = *(const pg8::f32x4*)(conv_b + c + 4);
#pragma unroll
        for (int i = 0; i < 8; ++i) { pg8::f32x4 a0 = b0, a1 = b1;
#pragma unroll
            for (int kk = 0; kk < 4; ++kk) { pg8::f32x4 x0, x1; pg8::unpack8(rows[i + kk], x0, x1); a0 += w0[kk] * x0; a1 += w1[kk] * x1; }
            *(pg8::u32x4*)(dst + (size_t)i * XC_LD) = pg8::pack8(a0, a1); }
    }
    PHASE_END
    PHASE_BEGIN DECL_PTRS
    if (FAST(8)) {
        int kg = XC_LD; asm volatile("" : "+s"(kg));
        pg8::Gemm g{XC, WG_T, 4 * M, 4 * 768, kg}; pg8::OrderGate S{G, (int)blockIdx.x};
        pg8::EpGateF E{gate_a_b, gate_x_b, LAMC, XC, LA, UP};
        pg8::gemm_phase<pg8::EpGateF, pg8::OrderGate, true, true>(ldsl, g, S, E);
#if (REPMASK >> 8) & 1
        pg8::gemm_phase<pg8::EpGateF, pg8::OrderGate, true, true>(ldsl, g, S, E);
#endif
    } else {
    for (int n = 0; n < 4; ++n)
        ngemm(ldsf, M, 2 * BW, BW, ALbf{XC + (size_t)n * M * XC_LD, XC_LD}, BLgate{gate_a_w + (size_t)n * BW * BW, gate_x_w + (size_t)n * BW * BW},
              EpGate{n, gate_a_b, gate_x_b, lam, XC + (size_t)n * M * XC_LD, LA, UP});
    }
    PHASE_END
    PHASE_BEGIN_R DECL_PTRS
    for (size_t it = gtid; it < (size_t)NB * 64 * 336; it += GSZ) {
        const int slot = (int)(it % 336), bk = (int)(it / 336), kc = bk & 63, b = bk >> 6, c0 = 4 * slot; const size_t m0 = (size_t)b * T + 32 * kc;
        float h[4] = {0.f, 0.f, 0.f, 0.f}, sl[4] = {0.f, 0.f, 0.f, 0.f};
#pragma unroll 1
        for (int i0 = 0; i0 < 32; i0 += 8) {
            unsigned long long lw[8], uw[8];
#pragma unroll
            for (int i = 0; i < 8; ++i) { lw[i] = *(const unsigned long long*)(LA + (m0 + i0 + i) * DRNN + c0); uw[i] = *(const unsigned long long*)(UP + (m0 + i0 + i) * DRNN + c0); }
#pragma unroll
            for (int i = 0; i < 8; ++i)
#pragma unroll
                for (int e = 0; e < 4; ++e) { const float la = bf2f((bf16_t)(lw[i] >> (16 * e))), up = bf2f((bf16_t)(uw[i] >> (16 * e))); const float av = __builtin_amdgcn_exp2f(la);
                    const float mult = (kc == 0 && i0 + i == 0) ? 1.f : __builtin_amdgcn_sqrtf(fmaxf(0.f, 1.f - av * av)); h[e] = av * h[e] + mult * up; sl[e] += la; }
        }
        *(pg8::f32x4*)(CAR + (size_t)bk * DRNN + c0) = (pg8::f32x4){sl[0], sl[1], sl[2], sl[3]};
        *(pg8::f32x4*)(CBR + (size_t)bk * DRNN + c0) = (pg8::f32x4){h[0], h[1], h[2], h[3]};
    }
    PHASE_END
    PHASE_BEGIN_R DECL_PTRS
    for (size_t it = gtid; it < (size_t)NB * 16 * 352; it += GSZ) {
        const int slot = (int)(it % 352), bs = (int)(it / 352), kg = bs & 15, b = bs >> 4, kc0 = 4 * kg, c0 = 4 * slot; const size_t m0 = (size_t)b * T + 128 * kg;
        if (slot >= 336) { for (int i = 0; i < 128; ++i) *(unsigned long long*)(YA + (m0 + i) * YA_LD + c0) = 0ull; continue; }
        unsigned long long la_[8], ua_[8], ga_[8], lb_[8], ub_[8], gb_[8];
#define SC_LOAD(L_, U_, G_, i0_) _Pragma("unroll") for (int i = 0; i < 8; ++i) { L_[i] = *(const unsigned long long*)(LA + (m0 + (i0_) + i) * DRNN + c0); U_[i] = *(const unsigned long long*)(UP + (m0 + (i0_) + i) * DRNN + c0); G_[i] = *(const unsigned long long*)(UGATE + (m0 + (i0_) + i) * DRNN + c0); }
#define SC_SCAN(L_, U_, G_, i0_) _Pragma("unroll") for (int i = 0; i < 8; ++i) { float y[4]; \
            _Pragma("unroll") for (int e = 0; e < 4; ++e) { const float la = bf2f((bf16_t)(L_[i] >> (16 * e))), up = bf2f((bf16_t)(U_[i] >> (16 * e))); const float av = __builtin_amdgcn_exp2f(la); \
                const float mult = (kg == 0 && (i0_) + i == 0) ? 1.f : __builtin_amdgcn_sqrtf(fmaxf(0.f, 1.f - av * av)); h[e] = av * h[e] + mult * up; y[e] = h[e] * bf2f((bf16_t)(G_[i] >> (16 * e))); } \
            *(unsigned long long*)(YA + (m0 + (i0_) + i) * YA_LD + c0) = (unsigned long long)att::cvtpk(y[0], y[1]) | ((unsigned long long)att::cvtpk(y[2], y[3]) << 32); }
        SC_LOAD(la_, ua_, ga_, 0)
        float h[4] = {0.f, 0.f, 0.f, 0.f};
        for (int k0 = 0; k0 < kc0; k0 += 16) {
            pg8::f32x4 sa[16], sb[16];
#pragma unroll
            for (int u = 0; u < 16; ++u) { const int k2 = k0 + u < kc0 ? k0 + u : kc0 - 1; sa[u] = *(const pg8::f32x4*)(CAR + (size_t)(b * 64 + k2) * DRNN + c0); sb[u] = *(const pg8::f32x4*)(CBR + (size_t)(b * 64 + k2) * DRNN + c0); }
#pragma unroll
            for (int u = 0; u < 16; ++u) if (k0 + u < kc0) {
#pragma unroll
                for (int e = 0; e < 4; ++e) h[e] = __builtin_amdgcn_exp2f(sa[u][e]) * h[e] + sb[u][e]; }
        }
#pragma unroll 1
        for (int r0 = 0; r0 < 128; r0 += 16) {
            SC_LOAD(lb_, ub_, gb_, r0 + 8) SC_SCAN(la_, ua_, ga_, r0)
            if (r0 + 16 < 128) { SC_LOAD(la_, ua_, ga_, r0 + 16) }
            SC_SCAN(lb_, ub_, gb_, r0 + 8)
        }
#undef SC_LOAD
#undef SC_SCAN
    }
    PHASE_END
    PHASE_BEGIN DECL_PTRS
    if (FAST(10)) {
        pg8::Gemm g{YA, PA_T, M, D, YA_LD}; pg8::StaticOrder S; S.init(M, D, G, (int)blockIdx.x);
        pg8::EpT1F E{GA, T1};
        pg8::gemm_phase<pg8::EpT1F, pg8::StaticOrder, true, true>(ldsl, g, S, E);
#if (REPMASK >> 10) & 1
        pg8::gemm_phase<pg8::EpT1F, pg8::StaticOrder, true, true>(ldsl, g, S, E);
#endif
    } else ngemm(ldsf, M, D, DRNN, ALbf{YA, YA_LD}, BLf32{proj_a, D}, EpT1{GA, T1});
    if (FAST(11)) {
        pg8::Gemm g{Q, PB_T, M, D, QW}; pg8::StaticOrder S; S.init(M, D, G, (int)blockIdx.x);
        pg8::EpMergedF E{GB, T1, MERGED};
        pg8::gemm_phase<pg8::EpMergedF, pg8::StaticOrder, true, true>(ldsl, g, S, E);
#if (REPMASK >> 11) & 1
        pg8::gemm_phase<pg8::EpMergedF, pg8::StaticOrder, true, true>(ldsl, g, S, E);
#endif
    } else ngemm(ldsf, M, D, QW, ALbf{Q, QW}, BLf32{proj_b, D}, EpMerged{GB, T1, MERGED});
    PHASE_END
    PHASE_BEGIN DECL_PTRS
    if (FAST(12)) {
        pg8::Gemm g{MERGED, WO_T, M, D, D}; pg8::StaticOrder S; S.init(M, D, G, (int)blockIdx.x);
        pg8::EpHF E{x, H, HB, SSQ};
        pg8::gemm_phase<pg8::EpHF, pg8::StaticOrder, true, true>(ldsl, g, S, E);
#if (REPMASK >> 12) & 1
        pg8::gemm_phase<pg8::EpHF, pg8::StaticOrder, true, true>(ldsl, g, S, E);
#endif
    } else ngemm(ldsf, M, D, D, ALbf{MERGED, D}, BLf32{w_out, D}, EpH{x, H, HB});
    PHASE_END
    PHASE_BEGIN DECL_PTRS
    if (FAST(14)) {
        pg8::Gemm g{HB, WMI_T, M, DFF, D}; pg8::StaticOrder S; S.init(M, DFF, G, (int)blockIdx.x);
        PG8_LAS float* rtab = (PG8_LAS float*)(ldsl + 131072);
        bool tab_ok;
        { pg8::Unit uu; int i = 0;
          for (; i < 16 && S.next(i, uu); ++i) if (tid < 256) { const float* sp = SSQ + (size_t)(uu.pm * 256 + tid) * 16;
                const pg8::f32x4 s0 = *(const pg8::f32x4*)sp, s1 = *(const pg8::f32x4*)(sp + 4), s2 = *(const pg8::f32x4*)(sp + 8), s3 = *(const pg8::f32x4*)(sp + 12); const pg8::f32x4 st = (s0 + s1) + (s2 + s3);
                rtab[i * 256 + tid] = rsqrtf(((st[0] + st[1]) + (st[2] + st[3])) * (1.f / D) + EPS); }
          tab_ok = !(i == 16 && S.next(16, uu)); }
        __syncthreads();
        pg8::EpZF E{tab_ok ? rtab : (PG8_LAS float*)nullptr, SSQ, ZACT};
        pg8::gemm_phase<pg8::EpZF, pg8::StaticOrder, true, true>(ldsl, g, S, E);
#if (REPMASK >> 14) & 1
        pg8::gemm_phase<pg8::EpZF, pg8::StaticOrder, true, true>(ldsl, g, S, E);
#endif
    } else ngemm(ldsf, M, DFF, D, ALbfScale{HB, D, norm_mlp}, BLf32{w_mlp_in, DFF}, EpZ{SSQ, ZACT});
    PHASE_END
    PHASE_BEGIN DECL_PTRS
    if (FAST(15)) {
        pg8::Gemm g{ZACT, WMO_T, M, D, DFF}; pg8::StaticOrder S; S.init(M, D, G, (int)blockIdx.x);
        pg8::EpOutF E{HB, H};
        pg8::gemm_phase<pg8::EpOutF, pg8::StaticOrder, true, true>(ldsl, g, S, E);
#if (REPMASK >> 15) & 1
        pg8::gemm_phase<pg8::EpOutF, pg8::StaticOrder, true, true>(ldsl, g, S, E);
#endif
    } else ngemm(ldsf, M, D, DFF, ALbf{ZACT, DFF}, BLf32{w_mlp_out, D}, EpOut{H});
    PHASE_END
}
constexpr int NPHASES = 11;

extern "C" void kernel_launch(void* const* d_in, const int* in_sizes, int n_in, void* d_out, int out_size, void* d_ws, size_t ws_size, hipStream_t stream) {
    static int grid = 0;
    if (grid == 0) {
        if (n_in != 27 || out_size != M * D || ws_size < WS_END) { fprintf(stderr, "kernel_launch: unexpected shapes n_in %d out %d ws %zu\n", n_in, out_size, ws_size); grid = -1; return; }
        int dev = 0, cus = 0, per_cu = 0;
        (void)hipGetDevice(&dev);
        (void)hipDeviceGetAttribute(&cus, hipDeviceAttributeMultiprocessorCount, dev);
        (void)hipFuncSetAttribute((const void*)fwd, hipFuncAttributeMaxDynamicSharedMemorySize, LDS_BYTES);
        (void)hipOccupancyMaxActiveBlocksPerMultiprocessor(&per_cu, (const void*)fwd, NTHREADS, LDS_BYTES);
        fprintf(stderr, "kernel_launch: cus %d per_cu %d ws_size %zu\n", cus, per_cu, ws_size);
        grid = cus;
    }
    if (grid < 0) return;
    if (hipMemsetAsync(d_ws, 0, 65536, stream) != hipSuccess) { fprintf(stderr, "kernel_launch: hipMemsetAsync failed\n"); return; }
    Args a{};
    for (int i = 0; i < 27; ++i) a.in[i] = (const float*)d_in[i];
    a.out = (float*)d_out; a.ws = (unsigned char*)d_ws; a.ph_lo = 0; a.ph_hi = NPHASES;
    void* args[] = {&a};
    hipError_t e = hipLaunchCooperativeKernel((const void*)fwd, dim3(grid), dim3(NTHREADS), args, LDS_BYTES, stream);
    if (e != hipSuccess) fprintf(stderr, "cooperative launch failed: %s (grid %d)\n", hipGetErrorString(e), grid);
}
```

```cpp
#include <hip/hip_runtime.h>
#include <hip/hip_cooperative_groups.h>
#include <cstdio>
#include <cstdint>
#ifndef FASTMASK
#define FASTMASK 0xFFFFFFFFu
#endif
#define FAST(p) ((FASTMASK >> (p)) & 1u)
namespace cg = cooperative_groups;

typedef unsigned short bf16_t;
constexpr int NTHREADS = 512;
constexpr int LDS_BYTES = 163840;
constexpr size_t MiB = 1u << 20;

constexpr int NB = 16, T = 2048, D = 1024, M = NB * T;
constexpr int DRNN = 1344, BW = 336, QW = 1024, KVW = 256, NH = 16, HD = 64, NG = 4;
constexpr int DIN = 7344, DFF = 4096, NC = 127, NSB = 32, CROWS = NB * NG * NC;
constexpr int C_URNN = 0, C_UGATE = 1344, C_Q = 2688, C_KV = 3712, C_GN = 5248, C_GA = 5296, C_GB = 6320;
constexpr float EPS = 1e-6f, LOG2E = 1.4426950408889634f;
constexpr int YA_LD = 1408, XC_LD = 384;

constexpr size_t WS_RSTD = 1 * MiB, WS_RSTD2 = 1 * MiB + 512 * 1024, WS_KCC = 2 * MiB, WS_VCC = 4 * MiB, WS_SEL = 6 * MiB;
constexpr size_t WS_URNN = 52 * MiB, WS_UGATE = 136 * MiB, WS_Q = 220 * MiB, WS_KV = 284 * MiB  , WS_GN = 380 * MiB, WS_GA = 384 * MiB, WS_GB = 448 * MiB, WS_END = 512 * MiB;
constexpr size_t WS_PES = 1 * MiB + 448 * 1024  , WS_NORMS = 1 * MiB + 384 * 1024, WS_LAMC = 1 * MiB + 256 * 1024, WS_SSQ = 6 * MiB + 512 * 1024  ;
constexpr size_t WS_WIN = 9 * MiB  , WS_WG = 24 * MiB  , WS_W1 = 27 * MiB  , WS_PA = 29 * MiB  , WS_PB = 32 * MiB, WS_WO = 34 * MiB, WS_WMI = 36 * MiB  , WS_WMO = 44 * MiB  ;
constexpr size_t DO_KCB = 104 * MiB  , DO_VCT = 105 * MiB  ;
constexpr size_t DO_VST = 72 * MiB, DO_VWT = 88 * MiB;
constexpr size_t DO_CAR = 112 * MiB, DO_CBR = 120 * MiB;
constexpr size_t DO_XB = 0;
constexpr size_t WS_LA = WS_URNN, WS_UP = WS_KV, WS_T1 = WS_URNN, WS_MERGED = WS_UGATE, WS_HB = WS_GA, WS_ZACT = 52 * MiB;
constexpr size_t DO_FLATK = 64 * MiB, DO_FLATV = 96 * MiB, DO_HIDK = 0, DO_HIDV = 4 * MiB, DO_XC = 0, DO_YA = 0;

__device__ __constant__ unsigned char BUCKET[128] = {0, 1, 2, 3, 4, 5, 6, 7, 8, 9, 10, 11, 12, 13, 14, 15, 16, 16, 16, 17, 17, 18, 18, 18, 19, 19, 19, 20, 20, 20, 20, 21, 21, 21, 21, 22, 22, 22, 22, 22, 23, 23, 23, 23, 23, 23, 24, 24, 24, 24, 24, 24, 25, 25, 25, 25, 25, 25, 25, 26, 26, 26, 26, 26, 26, 26, 26, 27, 27, 27, 27, 27, 27, 27, 27, 27, 27, 28, 28, 28, 28, 28, 28, 28, 28, 28, 28, 29, 29, 29, 29, 29, 29, 29, 29, 29, 29, 29, 29, 30, 30, 30, 30, 30, 30, 30, 30, 30, 30, 30, 30, 30, 30, 31, 31, 31, 31, 31, 31, 31, 31, 31, 31, 31, 31, 31, 31, 31};

__device__ __forceinline__ float bf2f(bf16_t v) { return __uint_as_float((unsigned)v << 16); }
__device__ __forceinline__ bf16_t f2bf(float f) { unsigned u = __float_as_uint(f); return (bf16_t)((u + 0x7fffu + ((u >> 16) & 1u)) >> 16); }
__device__ __forceinline__ float sigmoidf_(float x) { return 1.f / (1.f + __expf(-x)); }
__device__ __forceinline__ float gelu_tanh(float x) { const float u = 0.7978845608028654f * (x + 0.044715f * x * x * x); return 0.5f * x * (1.f + tanhf(u)); }
__device__ __forceinline__ float wave_sum(float v) {
#pragma unroll
    for (int o = 1; o < 64; o <<= 1) v += __shfl_xor(v, o);
    return v;
}

struct Args { const float* in[27]; float* out; unsigned char* ws; int ph_lo, ph_hi; };

template <class AL, class BL, class EP>
__device__ __forceinline__ void ngemm(float* lds, int Mm, int Nn, int Kk, const AL& A, const BL& Bf, const EP& E) {
    float* As = lds;
    float* Bs = lds + 16 * 132;
    const int tid = threadIdx.x, tx = tid & 31, ty = tid >> 5;
    const int tm = (Mm + 127) / 128, tn = (Nn + 127) / 128, ntiles = tm * tn;
    for (int tile = blockIdx.x; tile < ntiles; tile += gridDim.x) {
        const int m0 = (tile / tn) * 128, n0 = (tile % tn) * 128;
        float acc[8][4];
#pragma unroll
        for (int i = 0; i < 8; ++i)
#pragma unroll
            for (int j = 0; j < 4; ++j) acc[i][j] = 0.f;
        for (int k0 = 0; k0 < Kk; k0 += 16) {
            {
                const int m = m0 + (tid >> 2), kb = k0 + (tid & 3) * 4;
#pragma unroll
                for (int i = 0; i < 4; ++i) As[((tid & 3) * 4 + i) * 132 + (tid >> 2)] = (m < Mm && kb + i < Kk) ? A(m, kb + i) : 0.f;
                const int k = k0 + (tid >> 5), nb = n0 + (tid & 31) * 4;
#pragma unroll
                for (int i = 0; i < 4; ++i) Bs[(tid >> 5) * 132 + (tid & 31) * 4 + i] = (k < Kk && nb + i < Nn) ? Bf(k, nb + i) : 0.f;
            }
            __syncthreads();
#pragma unroll 2
            for (int kk = 0; kk < 16; ++kk) {
                float a[8], b[4];
#pragma unroll
                for (int i = 0; i < 8; ++i) a[i] = As[kk * 132 + ty * 8 + i];
#pragma unroll
                for (int j = 0; j < 4; ++j) b[j] = Bs[kk * 132 + tx * 4 + j];
#pragma unroll
                for (int i = 0; i < 8; ++i)
#pragma unroll
                    for (int j = 0; j < 4; ++j) acc[i][j] += a[i] * b[j];
            }
            __syncthreads();
        }
#pragma unroll
        for (int i = 0; i < 8; ++i)
#pragma unroll
            for (int j = 0; j < 4; ++j) { const int m = m0 + ty * 8 + i, n = n0 + tx * 4 + j; if (m < Mm && n < Nn) E(m, n, acc[i][j]); }
    }
}

struct ALbf { const bf16_t* p; int ld; __device__ __forceinline__ float operator()(int m, int k) const { return bf2f(p[(size_t)m * ld + k]); } };
struct ALbfScale { const bf16_t* p; int ld; const float* g; __device__ __forceinline__ float operator()(int m, int k) const { return bf2f(p[(size_t)m * ld + k]) * g[k]; } };
struct ALf32Scale { const float* p; int ld; const float* g; __device__ __forceinline__ float operator()(int m, int k) const { return p[(size_t)m * ld + k] * g[k]; } };
struct BLf32 { const float* p; int ld; __device__ __forceinline__ float operator()(int k, int n) const { return p[(size_t)k * ld + n]; } };
struct BLgate { const float* wa; const float* wx; __device__ __forceinline__ float operator()(int k, int n) const { return n < BW ? wa[k * BW + n] : wx[k * BW + n - BW]; } };

struct Ep1 {
    const float* rstd; bf16_t *urnn, *ugate, *q, *kv, *gn, *ga, *gb;
    __device__ __forceinline__ void operator()(int m, int n, float v) const {
        v *= rstd[m];
        if (n < C_UGATE) urnn[(size_t)m * DRNN + n] = f2bf(v);
        else if (n < C_Q) ugate[(size_t)m * DRNN + n - C_UGATE] = f2bf(gelu_tanh(v));
        else if (n < C_KV) q[(size_t)m * QW + n - C_Q] = f2bf(v);
        else if (n < C_GN) { const int c = n - C_KV; kv[(size_t)(c >> 8) * ((size_t)M * KVW) + (size_t)m * KVW + (c & 255)] = f2bf(v); }
        else if (n < C_GA) gn[(size_t)m * 48 + n - C_GN] = f2bf(sigmoidf_(v));
        else if (n < C_GB) ga[(size_t)m * D + n - C_GA] = f2bf(sigmoidf_(v));
        else gb[(size_t)m * D + n - C_GB] = f2bf(sigmoidf_(v));
    }
};
struct EpGelu { bf16_t* o; int ld; __device__ __forceinline__ void operator()(int m, int n, float v) const { o[(size_t)m * ld + n] = f2bf(gelu_tanh(v)); } };
struct EpGate {
    int nb; const float *ba, *bx, *lam; const bf16_t* xc; bf16_t *la, *up;
    __device__ __forceinline__ void operator()(int m, int n, float v) const {
        if (n < BW) { const int c = nb * BW + n; const float r = sigmoidf_(v + ba[c]); const float sp = log1pf(__expf(-lam[c])); la[(size_t)m * DRNN + c] = f2bf(-8.f * r * sp * LOG2E); }
        else { const int j = n - BW, c = nb * BW + j; const float i = sigmoidf_(v + bx[c]); up[(size_t)m * DRNN + c] = f2bf(i * bf2f(xc[(size_t)m * XC_LD + j])); }
    }
};
struct EpT1 { const bf16_t* g; bf16_t* o; __device__ __forceinline__ void operator()(int m, int n, float v) const { o[(size_t)m * D + n] = f2bf(bf2f(g[(size_t)m * D + n]) * v); } };
struct EpMerged { const bf16_t* g; const bf16_t* t1; bf16_t* o; __device__ __forceinline__ void operator()(int m, int n, float v) const { o[(size_t)m * D + n] = f2bf(bf2f(t1[(size_t)m * D + n]) + bf2f(g[(size_t)m * D + n]) * v); } };
struct EpH { const float* x; float* h; bf16_t* hb; __device__ __forceinline__ void operator()(int m, int n, float v) const { const float r = x[(size_t)m * D + n] + v; h[(size_t)m * D + n] = r; hb[(size_t)m * D + n] = f2bf(r); } };
struct EpZ { const float* ssq; bf16_t* z; __device__ __forceinline__ void operator()(int m, int n, float v) const { float s_ = 0.f; for (int i = 0; i < 16; ++i) s_ += ssq[(size_t)m * 16 + i]; v *= rsqrtf(s_ * (1.f / D) + EPS); v = v > 0.f ? v * v : 0.f; z[(size_t)m * DFF + n] = f2bf(v); } };
struct EpOut { float* o; __device__ __forceinline__ void operator()(int m, int n, float v) const { o[(size_t)m * D + n] += v; } };

namespace pg8 {
#define PG8_LAS __attribute__((address_space(3)))
typedef unsigned short bf16_t;
typedef short bf16x8 __attribute__((ext_vector_type(8)));
typedef float f32x4 __attribute__((ext_vector_type(4)));
typedef unsigned u32x4 __attribute__((ext_vector_type(4)));
constexpr int BM = 256, BK = 64, HALF = 128, HTB = HALF * BK * 2  , STAGE_BYTES = 8 * HTB, NXCD = 8, WGM = 4;

__host__ __device__ __forceinline__ int lds_byte(int r, int c) { const int st = (r >> 4) * 2 + (c >> 5), rr = r & 15, cc = c & 31, ob = rr * 64 + cc * 2; return st * 1024 + (ob ^ (((ob >> 9) & 1) << 5)); }
__host__ __device__ __forceinline__ void stage_rc(int b, int& R, int& C) { const int st = b / 1024, sb = b % 1024, swz = sb ^ (((sb >> 9) & 1) << 5); R = (st >> 1) * 16 + swz / 64; C = (st & 1) * 32 + (swz % 64) / 2; }
__host__ __device__ __forceinline__ int perm32(int rho) { const int n = rho >> 4, i = rho & 15; return 8 * (i >> 2) + 4 * n + (i & 3); }

struct Unit { int pm, pn, ord; };
struct Gemm { const bf16_t* A; const bf16_t* Bt; int M, N, K; };

struct StaticOrder {
    int nM, nN, nwg, G, c;
    __host__ __device__ void init(int M, int N, int G_, int c_) { nM = M / BM; nN = N / BM; nwg = nM * nN; G = G_; c = c_; }
    __host__ __device__ __forceinline__ bool next(int i, Unit& u) const {
        const long L = (long)i * G + c; if (L >= nwg) return false;
        int wgid = (int)L; { const int q = nwg / NXCD, r = nwg % NXCD, xcd = wgid % NXCD, off = wgid / NXCD; wgid = (xcd < r ? xcd * (q + 1) : r * (q + 1) + (xcd - r) * q) + off; }
        const int nig = WGM * nN, gid = wgid / nig, fm = gid * WGM, gsz = (nM - fm) < WGM ? (nM - fm) : WGM;
        u.pm = fm + ((wgid % nig) % gsz); u.pn = (wgid % nig) / gsz; u.ord = i; return true;
    }
    __device__ __forceinline__ void a_ready(const Unit&) const {}
    __device__ __forceinline__ void done(const Unit&) const {}
};

__device__ __forceinline__ unsigned cvt_pk_bf16(float lo, float hi) { unsigned r; asm volatile("v_cvt_pk_bf16_f32 %0, %1, %2" : "=v"(r) : "v"(lo), "v"(hi)); return r; }
typedef float f32x2 __attribute__((ext_vector_type(2)));
template <class Epi, class Sched, bool ALIGN_EPI = false, bool SP2 = false>
__device__ __forceinline__ void gemm_phase(PG8_LAS unsigned char* lds, const Gemm g, const Sched& S, const Epi& E) {
    const int tid = threadIdx.x, wid = __builtin_amdgcn_readfirstlane(tid >> 6), lane = tid & 63, wr = wid >> 2, wc = wid & 3, fr = lane & 15, fq = lane >> 4;
    const int K = g.K, nt = K / BK;
    unsigned voffA[2], voffB[2];
#pragma unroll
    for (int i = 0; i < 2; ++i) { int R, C; stage_rc(tid * 16 + i * 8192, R, C); const int Rb = Epi::PERM ? ((R & ~31) + perm32(R & 31)) : R;
        voffA[i] = (unsigned)(R * K + C) * 2u; voffB[i] = (unsigned)(Rb * K + C) * 2u; }
    const size_t kstep = (size_t)(BK * 2);
    const size_t hstep = (size_t)HALF * K * 2;
    const size_t tstep = 2 * hstep;
    const unsigned ldsw = (unsigned)wid * 1024u;
    const int aoff = lds_byte(wr * 64 + fr, fq * 8), boff = lds_byte(wc * 32 + fr, fq * 8);
#define PG8_SA(b, h) (((b) * 2 + (h)) * HTB)
#define PG8_SB(b, h) ((4 + (b) * 2 + (h)) * HTB)
#define PG8_STAGE(bufoff, gbase, voff) do { _Pragma("unroll") for (int _i = 0; _i < 2; ++_i) \
        __builtin_amdgcn_global_load_lds((const unsigned*)((const char*)(gbase) + (voff)[_i]), (PG8_LAS unsigned*)(lds + (bufoff) + ldsw + _i * 8192), 16, 0, 0); } while (0)
#define PG8_LDA(dst, b, h) do { _Pragma("unroll") for (int m = 0; m < 4; ++m) _Pragma("unroll") for (int k = 0; k < 2; ++k) dst[m][k] = *(const PG8_LAS bf16x8*)(lds + PG8_SA(b, h) + aoff + m * 2048 + k * 1024); } while (0)
#define PG8_LDB(dst, b, h) do { _Pragma("unroll") for (int n = 0; n < 2; ++n) _Pragma("unroll") for (int k = 0; k < 2; ++k) dst[n][k] = *(const PG8_LAS bf16x8*)(lds + PG8_SB(b, h) + boff + n * 2048 + k * 1024); } while (0)
#define PG8_MMA(ai, bj, At, Bt) do { __builtin_amdgcn_s_setprio(1); _Pragma("unroll") for (int m = 0; m < 4; ++m) _Pragma("unroll") for (int n = 0; n < 2; ++n) _Pragma("unroll") for (int k = 0; k < 2; ++k) \
        acc[ai][bj][m][n] = __builtin_amdgcn_mfma_f32_16x16x32_bf16(Bt[n][k], At[m][k], acc[ai][bj][m][n], 0, 0, 0); __builtin_amdgcn_s_setprio(0); } while (0)
#define PG8_WAIT_V(n) asm volatile("s_waitcnt vmcnt(" #n ")" ::: "memory")
#define PG8_WAIT_L(n) asm volatile("s_waitcnt lgkmcnt(" #n ")" ::: "memory")
#define PG8_BAR __builtin_amdgcn_s_barrier()
#define PG8_SCHED __builtin_amdgcn_sched_barrier(0)
    Unit cur, nxt; int ui = 0;
    if (!S.next(0, cur)) return;
    f32x4 acc[2][2][4][2];
#pragma unroll
    for (int a = 0; a < 2; ++a)
#pragma unroll
        for (int b = 0; b < 2; ++b)
#pragma unroll
            for (int m = 0; m < 4; ++m)
#pragma unroll
                for (int n = 0; n < 2; ++n) acc[a][b][m][n] = (f32x4){0.f, 0.f, 0.f, 0.f};
    bf16x8 At[4][2], B0[2][2], B1[2][2];
    const char* cA = (const char*)g.A + (size_t)cur.pm * tstep; const char* cB = (const char*)g.Bt + (size_t)cur.pn * tstep;
    S.a_ready(cur);
    if constexpr (SP2) {
        PG8_STAGE(PG8_SB(0, 0), cB, voffB); PG8_STAGE(PG8_SB(0, 1), cB + hstep, voffB); PG8_STAGE(PG8_SA(0, 0), cA, voffA); PG8_STAGE(PG8_SA(0, 1), cA + hstep, voffA);
        if (wr == 1) PG8_BAR;
        PG8_WAIT_V(2); PG8_BAR;
        PG8_STAGE(PG8_SB(1, 0), cB + kstep, voffB); PG8_STAGE(PG8_SA(1, 0), cA + kstep, voffA); PG8_STAGE(PG8_SB(1, 1), cB + hstep + kstep, voffB);
        PG8_WAIT_V(6); PG8_BAR;
    } else {
        PG8_STAGE(PG8_SB(0, 0), cB, voffB); PG8_STAGE(PG8_SA(0, 0), cA, voffA); PG8_STAGE(PG8_SB(0, 1), cB + hstep, voffB); PG8_STAGE(PG8_SA(0, 1), cA + hstep, voffA);
        if (wr == 1) PG8_BAR;
        PG8_WAIT_V(4); PG8_BAR;
        PG8_STAGE(PG8_SB(1, 0), cB + kstep, voffB); PG8_STAGE(PG8_SA(1, 0), cA + kstep, voffA); PG8_STAGE(PG8_SB(1, 1), cB + hstep + kstep, voffB);
        PG8_WAIT_V(6); PG8_BAR;
    }
    for (;;) {
        const bool has_next = S.next(ui + 1, nxt);
        const char* nA = has_next ? (const char*)g.A + (size_t)nxt.pm * tstep : cA; const char* nB = has_next ? (const char*)g.Bt + (size_t)nxt.pn * tstep : cB;
        for (int t = 0; t < nt; t += 2) {
            const bool last = (t == nt - 2);
            const char* a1 = cA + (size_t)(t + 1) * kstep;
            const char* a2 = last ? nA : cA + (size_t)(t + 2) * kstep; const char* b2 = last ? nB : cB + (size_t)(t + 2) * kstep;
            const char* a3 = a2 + kstep; const char* b3 = b2 + kstep;
            if (last && has_next) S.a_ready(nxt);
            if constexpr (SP2) {
            PG8_LDB(B0, 0, 0); PG8_LDB(B1, 0, 1); PG8_SCHED; PG8_LDA(At, 0, 0); PG8_STAGE(PG8_SA(1, 1), a1 + hstep, voffA);
            PG8_WAIT_V(8); PG8_WAIT_L(0); PG8_BAR; PG8_MMA(0, 0, At, B0); PG8_MMA(0, 1, At, B1); PG8_BAR; PG8_SCHED;
            PG8_LDA(At, 0, 1); PG8_STAGE(PG8_SB(0, 0), b2, voffB); PG8_STAGE(PG8_SB(0, 1), b2 + hstep, voffB); PG8_STAGE(PG8_SA(0, 0), a2, voffA);
            PG8_WAIT_V(8); PG8_WAIT_L(0); PG8_BAR; PG8_MMA(1, 0, At, B0); PG8_MMA(1, 1, At, B1); PG8_BAR; PG8_SCHED;
            PG8_LDB(B0, 1, 0); PG8_LDB(B1, 1, 1); PG8_SCHED; PG8_LDA(At, 1, 0); PG8_STAGE(PG8_SA(0, 1), a2 + hstep, voffA);
            PG8_WAIT_V(8); PG8_WAIT_L(0); PG8_BAR; PG8_MMA(0, 0, At, B0); PG8_MMA(0, 1, At, B1); PG8_BAR; PG8_SCHED;
            PG8_LDA(At, 1, 1); PG8_STAGE(PG8_SB(1, 0), b3, voffB); PG8_STAGE(PG8_SB(1, 1), b3 + hstep, voffB); PG8_STAGE(PG8_SA(1, 0), a3, voffA);
            PG8_WAIT_V(8); PG8_WAIT_L(0); PG8_BAR; PG8_MMA(1, 0, At, B0); PG8_MMA(1, 1, At, B1); PG8_BAR; PG8_SCHED;
            } else {
            PG8_LDB(B0, 0, 0); PG8_SCHED; PG8_LDA(At, 0, 0); PG8_STAGE(PG8_SA(1, 1), a1 + hstep, voffA);
            PG8_WAIT_L(8); PG8_BAR; PG8_WAIT_L(0); PG8_MMA(0, 0, At, B0); PG8_BAR; PG8_SCHED;
            PG8_LDB(B1, 0, 1); PG8_STAGE(PG8_SB(0, 0), b2, voffB);
            PG8_BAR; PG8_WAIT_L(0); PG8_MMA(0, 1, At, B1); PG8_BAR;
            PG8_LDA(At, 0, 1); PG8_STAGE(PG8_SA(0, 0), a2, voffA);
            PG8_BAR; PG8_WAIT_L(0); PG8_MMA(1, 0, At, B0); PG8_BAR; PG8_SCHED;
            PG8_STAGE(PG8_SB(0, 1), b2 + hstep, voffB);
            PG8_WAIT_V(6); PG8_BAR; PG8_MMA(1, 1, At, B1); PG8_BAR;
            PG8_LDB(B0, 1, 0); PG8_SCHED; PG8_LDA(At, 1, 0); PG8_STAGE(PG8_SA(0, 1), a2 + hstep, voffA);
            PG8_WAIT_L(8); PG8_BAR; PG8_WAIT_L(0); PG8_MMA(0, 0, At, B0); PG8_BAR; PG8_SCHED;
            PG8_LDB(B1, 1, 1); PG8_STAGE(PG8_SB(1, 0), b3, voffB);
            PG8_BAR; PG8_WAIT_L(0); PG8_MMA(0, 1, At, B1); PG8_BAR;
            PG8_LDA(At, 1, 1); PG8_STAGE(PG8_SA(1, 0), a3, voffA);
            PG8_BAR; PG8_WAIT_L(0); PG8_MMA(1, 0, At, B0); PG8_BAR; PG8_SCHED;
            PG8_STAGE(PG8_SB(1, 1), b3 + hstep, voffB);
            PG8_WAIT_V(6); PG8_BAR; PG8_MMA(1, 1, At, B1); PG8_BAR;
            }
        }
        if constexpr (ALIGN_EPI) { if (wr == 0) PG8_BAR; }
        if constexpr (!Epi::AFTER_DRAIN) { E(acc, cur, wr, wc, fr, fq); S.done(cur); }
        if (!has_next) break;
#pragma unroll
        for (int a = 0; a < 2; ++a)
#pragma unroll
            for (int b = 0; b < 2; ++b)
#pragma unroll
                for (int m = 0; m < 4; ++m)
#pragma unroll
                    for (int n = 0; n < 2; ++n) acc[a][b][m][n] = (f32x4){0.f, 0.f, 0.f, 0.f};
        cur = nxt; cA = nA; cB = nB; ++ui;
        if constexpr (ALIGN_EPI) { if (wr == 1) PG8_BAR; }
    }
    PG8_WAIT_V(0);
    if constexpr (!ALIGN_EPI) { if (wr == 0) PG8_BAR; }
    PG8_BAR;
    if constexpr (Epi::AFTER_DRAIN) { E.fused(acc, cur, wr, wc, fr, fq, lds, wid, lane); S.done(cur); }
#undef PG8_SA
#undef PG8_SB
#undef PG8_STAGE
#undef PG8_LDA
#undef PG8_LDB
#undef PG8_MMA
#undef PG8_WAIT_V
#undef PG8_WAIT_L
#undef PG8_BAR
#undef PG8_SCHED
}
}

namespace pg8 {
__device__ __forceinline__ float sigm(float x) { return __builtin_amdgcn_rcpf(1.f + __expf(-x)); }
__device__ __forceinline__ float gelu_t(float x) { const float u = 1.5957691216057308f * (x + 0.044715f * x * x * x); return x * __builtin_amdgcn_rcpf(1.f + __expf(-u)); }
__device__ __forceinline__ u32x4 pack8(const f32x4& a, const f32x4& b) { u32x4 w; w.x = cvt_pk_bf16(a[0], a[1]); w.y = cvt_pk_bf16(a[2], a[3]); w.z = cvt_pk_bf16(b[0], b[1]); w.w = cvt_pk_bf16(b[2], b[3]); return w; }
__device__ __forceinline__ void unpack8(const u32x4& w, f32x4& a, f32x4& b) {
    a[0] = __uint_as_float(w.x << 16); a[1] = __uint_as_float(w.x & 0xffff0000u); a[2] = __uint_as_float(w.y << 16); a[3] = __uint_as_float(w.y & 0xffff0000u);
    b[0] = __uint_as_float(w.z << 16); b[1] = __uint_as_float(w.z & 0xffff0000u); b[2] = __uint_as_float(w.w << 16); b[3] = __uint_as_float(w.w & 0xffff0000u); }

struct Ep1F {
    static constexpr bool PERM = true, AFTER_DRAIN = false;
    bf16_t *urnn, *ugate, *q, *kv, *gn, *ga; const PG8_LAS float* norms; bf16_t* flat; const PG8_LAS float* pes;
    __device__ __forceinline__ void operator()(const f32x4 (&acc)[2][2][4][2], const Unit& u, int wr, int wc, int fr, int fq) const {
        const int row0 = u.pm * BM + wr * 64 + fr, pn = u.pn;
        if (pn == 4 || pn == 5) {
            const PG8_LAS float* pe = pes + (pn - 4) * 2048; bf16_t* fl = flat + (size_t)(pn - 4) * 8192 * 2048;
#pragma unroll
            for (int ai = 0; ai < 2; ++ai)
#pragma unroll
                for (int m = 0; m < 4; ++m) { const int mt = row0 + ai * HALF + m * 16, b = mt >> 11, t = mt & (T - 1), c1 = t >> 4, l1 = t & 15; const size_t rb = (size_t)((b * 4 + wc) * NC + c1) * 2048;
#pragma unroll
                    for (int bj = 0; bj < 2; ++bj) { const int d0 = 32 * bj + 8 * fq; const f32x4 v0 = acc[ai][bj][m][0], v1 = acc[ai][bj][m][1];
                        if (c1 < NC) { const PG8_LAS float* p = pe + l1 * 64 + d0; *(u32x4*)(fl + rb + l1 * 64 + d0) = pack8(v0 + *(const PG8_LAS f32x4*)p, v1 + *(const PG8_LAS f32x4*)(p + 4)); }
                        if (c1 > 0) { const PG8_LAS float* p = pe + (l1 + 16) * 64 + d0; *(u32x4*)(fl + rb - 2048 + (l1 + 16) * 64 + d0) = pack8(v0 + *(const PG8_LAS f32x4*)p, v1 + *(const PG8_LAS f32x4*)(p + 4)); } } }
            return;
        }
        if (pn < 10) {
            const bool donorm = pn < 4 || pn == 6 || pn == 8; const PG8_LAS float* g = norms + (pn < 4 ? 0 : (pn == 6 ? 64 : 128)); const float sc = pn < 4 ? 0.125f * LOG2E : 1.f;
            bf16_t* base; int ld;
            if (pn < 4) { base = q + 256 * pn + 64 * wc + 8 * fq; ld = QW; } else { base = kv + (size_t)(pn - 4) * ((size_t)M * KVW) + 64 * wc + 8 * fq; ld = KVW; }
            f32x4 gv[2][2];
#pragma unroll
            for (int bj = 0; bj < 2; ++bj)
#pragma unroll
                for (int n = 0; n < 2; ++n) gv[bj][n] = donorm ? *(const PG8_LAS f32x4*)(g + 32 * bj + 8 * fq + 4 * n) : (f32x4){1.f, 1.f, 1.f, 1.f};
#pragma unroll
            for (int ai = 0; ai < 2; ++ai)
#pragma unroll
                for (int m = 0; m < 4; ++m) {
                    float ss = 0.f;
#pragma unroll
                    for (int bj = 0; bj < 2; ++bj)
#pragma unroll
                        for (int n = 0; n < 2; ++n) { const f32x4 v = acc[ai][bj][m][n]; ss += (v[0] * v[0] + v[1] * v[1]) + (v[2] * v[2] + v[3] * v[3]); }
                    ss += __shfl_xor(ss, 16); ss += __shfl_xor(ss, 32);
                    const float r = donorm ? rsqrtf(ss * (1.f / 64.f) + EPS) * sc : 1.f;
                    bf16_t* rowp = base + (size_t)(row0 + ai * HALF + m * 16) * ld;
#pragma unroll
                    for (int bj = 0; bj < 2; ++bj) *(u32x4*)(rowp + 32 * bj) = pack8(acc[ai][bj][m][0] * r * gv[bj][0], acc[ai][bj][m][1] * r * gv[bj][1]);
                }
        } else if (pn < 18) {
            bf16_t* base = ga + (pn < 14 ? (size_t)0 : (size_t)M * D) + 256 * ((pn - 10) & 3) + 32 * wc + 8 * fq;
#pragma unroll
            for (int ai = 0; ai < 2; ++ai)
#pragma unroll
                for (int m = 0; m < 4; ++m) { bf16_t* rowp = base + (size_t)(row0 + ai * HALF + m * 16) * D;
#pragma unroll
                    for (int bj = 0; bj < 2; ++bj) { f32x4 v0 = acc[ai][bj][m][0], v1 = acc[ai][bj][m][1];
#pragma unroll
                        for (int e = 0; e < 4; ++e) { v0[e] = sigm(v0[e]); v1[e] = sigm(v1[e]); }
                        *(u32x4*)(rowp + bj * HALF) = pack8(v0, v1); } }
        } else { seg3<0>(acc, pn, row0, wc, fq); seg3<1>(acc, pn, row0, wc, fq); }
    }
    template <int BJ> __device__ __forceinline__ void seg3(const f32x4 (&acc)[2][2][4][2], int pn, int row0, int wc, int fq) const {
        const int c = 256 * (pn - 18) + 128 * BJ + 32 * wc;
        if (c < 1344) { bf16_t* base = urnn + c + 8 * fq;
#pragma unroll
            for (int ai = 0; ai < 2; ++ai)
#pragma unroll
                for (int m = 0; m < 4; ++m) *(u32x4*)(base + (size_t)(row0 + ai * HALF + m * 16) * DRNN) = pack8(acc[ai][BJ][m][0], acc[ai][BJ][m][1]);
        } else if (c < 2688) { bf16_t* base = ugate + (c - 1344) + 8 * fq;
#pragma unroll
            for (int ai = 0; ai < 2; ++ai)
#pragma unroll
                for (int m = 0; m < 4; ++m) { f32x4 v0 = acc[ai][BJ][m][0], v1 = acc[ai][BJ][m][1];
#pragma unroll
                    for (int e = 0; e < 4; ++e) { v0[e] = gelu_t(v0[e]); v1[e] = gelu_t(v1[e]); }
                    *(u32x4*)(base + (size_t)(row0 + ai * HALF + m * 16) * DRNN) = pack8(v0, v1); }
        } else if (c + 8 * fq < 2736) { bf16_t* base = gn + (c - 2688) + 8 * fq;
#pragma unroll
            for (int ai = 0; ai < 2; ++ai)
#pragma unroll
                for (int m = 0; m < 4; ++m) { f32x4 v0 = acc[ai][BJ][m][0], v1 = acc[ai][BJ][m][1];
#pragma unroll
                    for (int e = 0; e < 4; ++e) { v0[e] = sigm(v0[e]); v1[e] = sigm(v1[e]); }
                    *(u32x4*)(base + (size_t)(row0 + ai * HALF + m * 16) * 48) = pack8(v0, v1); }
        }
    }
};
__device__ __forceinline__ void win_src(int ch, int& c0, int& cvalid) {
    const int tile = ch >> 3, l0 = (ch & 7) * 32, bj = l0 >> 7, wc = (l0 >> 5) & 3; cvalid = 32;
    if (tile < 4) c0 = C_Q + 256 * tile + 64 * wc + 32 * bj;
    else if (tile < 10) c0 = C_KV + 256 * (tile - 4) + 64 * wc + 32 * bj;
    else if (tile < 14) c0 = C_GA + 256 * (tile - 10) + l0;
    else if (tile < 18) c0 = C_GB + 256 * (tile - 14) + l0;
    else { const int c = 256 * (tile - 18) + l0; if (c < 2688) c0 = c; else if (c < 2736) { c0 = C_GN + c - 2688; cvalid = 2736 - c < 32 ? 2736 - c : 32; } else { c0 = 0; cvalid = 0; } }
}
constexpr int N1PAD = 29 * 256;

struct EpGeluF {
    static constexpr bool PERM = true, AFTER_DRAIN = false;
    bf16_t* O; int ldc;
    __device__ __forceinline__ void operator()(const f32x4 (&acc)[2][2][4][2], const Unit& u, int wr, int wc, int fr, int fq) const {
        const int row0 = u.pm * BM + wr * 64 + fr; bf16_t* base = O + wc * 32 + 8 * fq;
#pragma unroll
        for (int ai = 0; ai < 2; ++ai)
#pragma unroll
            for (int m = 0; m < 4; ++m) { bf16_t* rowp = base + (size_t)(row0 + ai * HALF + m * 16) * ldc;
#pragma unroll
                for (int bj = 0; bj < 2; ++bj) { f32x4 v0 = acc[ai][bj][m][0], v1 = acc[ai][bj][m][1];
#pragma unroll
                    for (int e = 0; e < 4; ++e) { v0[e] = gelu_t(v0[e]); v1[e] = gelu_t(v1[e]); }
                    *(u32x4*)(rowp + bj * HALF) = pack8(v0, v1); } }
    }
};
struct OrderC1 {
    int G, c;
    __device__ __forceinline__ bool next(int i, Unit& u) const { const int L = i * G + c; if (L >= 64) return false; u.pm = L; u.pn = L >> 5; u.ord = i; return true; }
    __device__ __forceinline__ void a_ready(const Unit&) const {}
    __device__ __forceinline__ void done(const Unit&) const {}
};
struct OrderGate {
    int G, c;
    __device__ __forceinline__ bool next(int i, Unit& u) const { const int L = i * G + c; if (L >= 4 * 128 * 3) return false; const int nb = L / 384, r = L % 384; u.pm = nb * 128 + r / 3; u.pn = nb * 3 + r % 3; u.ord = i; return true; }
    __device__ __forceinline__ void a_ready(const Unit&) const {}
    __device__ __forceinline__ void done(const Unit&) const {}
};
struct EpGateF {
    static constexpr bool PERM = true, AFTER_DRAIN = false;
    const float *ba, *bx, *lamc; const bf16_t* xc; bf16_t *la, *up;
    __device__ __forceinline__ void operator()(const f32x4 (&acc)[2][2][4][2], const Unit& u, int wr, int wc, int fr, int fq) const {
        const int nb = u.pn / 3, pn3 = u.pn % 3, ch0 = 128 * pn3 + 32 * wc + 8 * fq; if (ch0 >= BW) return;
        const int c0 = nb * BW + ch0, row0 = (u.pm & 127) * BM + wr * 64 + fr;
        const bf16_t* xcb = xc + (size_t)nb * ((size_t)M * XC_LD) + ch0; bf16_t* lab = la + c0; bf16_t* upb = up + c0;
        const f32x4 bav0 = *(const f32x4*)(ba + c0), bav1 = *(const f32x4*)(ba + c0 + 4), bxv0 = *(const f32x4*)(bx + c0), bxv1 = *(const f32x4*)(bx + c0 + 4), lcv0 = *(const f32x4*)(lamc + c0), lcv1 = *(const f32x4*)(lamc + c0 + 4);
        u32x4 xcv[2][4];
#pragma unroll
        for (int ai = 0; ai < 2; ++ai)
#pragma unroll
            for (int m = 0; m < 4; ++m) xcv[ai][m] = *(const u32x4*)(xcb + (unsigned)(row0 + ai * HALF + m * 16) * (unsigned)XC_LD);
#pragma unroll
        for (int ai = 0; ai < 2; ++ai)
#pragma unroll
            for (int m = 0; m < 4; ++m) { const unsigned row = (unsigned)(row0 + ai * HALF + m * 16);
                f32x4 x0, x1; unpack8(xcv[ai][m], x0, x1);
                f32x4 l0, l1, u0, u1;
#pragma unroll
                for (int e = 0; e < 4; ++e) {
                    l0[e] = sigm(acc[ai][0][m][0][e] + bav0[e]) * lcv0[e]; l1[e] = sigm(acc[ai][0][m][1][e] + bav1[e]) * lcv1[e];
                    u0[e] = sigm(acc[ai][1][m][0][e] + bxv0[e]) * x0[e];   u1[e] = sigm(acc[ai][1][m][1][e] + bxv1[e]) * x1[e]; }
                *(u32x4*)(lab + row * (unsigned)DRNN) = pack8(l0, l1); *(u32x4*)(upb + row * (unsigned)DRNN) = pack8(u0, u1);
                asm volatile("" ::: "memory"); }
    }
};
struct EpT1F {
    static constexpr bool PERM = true, AFTER_DRAIN = false;
    const bf16_t* g; bf16_t* o;
    __device__ __forceinline__ void operator()(const f32x4 (&acc)[2][2][4][2], const Unit& u, int wr, int wc, int fr, int fq) const {
        const int row0 = u.pm * BM + wr * 64 + fr, col0 = u.pn * BM + wc * 32 + 8 * fq;
        u32x4 gv[2][4][2];
#pragma unroll
        for (int ai = 0; ai < 2; ++ai)
#pragma unroll
            for (int m = 0; m < 4; ++m) { const size_t off = (size_t)(row0 + ai * HALF + m * 16) * D + col0;
#pragma unroll
                for (int bj = 0; bj < 2; ++bj) gv[ai][m][bj] = *(const u32x4*)(g + off + bj * HALF); }
#pragma unroll
        for (int ai = 0; ai < 2; ++ai)
#pragma unroll
            for (int m = 0; m < 4; ++m) { const size_t off = (size_t)(row0 + ai * HALF + m * 16) * D + col0;
#pragma unroll
                for (int bj = 0; bj < 2; ++bj) { f32x4 g0, g1; unpack8(gv[ai][m][bj], g0, g1);
                    *(u32x4*)(o + off + bj * HALF) = pack8(acc[ai][bj][m][0] * g0, acc[ai][bj][m][1] * g1); } }
    }
};
struct EpMergedF {
    static constexpr bool PERM = true, AFTER_DRAIN = false;
    const bf16_t* g; const bf16_t* t1; bf16_t* o;
    __device__ __forceinline__ void operator()(const f32x4 (&acc)[2][2][4][2], const Unit& u, int wr, int wc, int fr, int fq) const {
        const int row0 = u.pm * BM + wr * 64 + fr, col0 = u.pn * BM + wc * 32 + 8 * fq;
#pragma unroll
        for (int ai = 0; ai < 2; ++ai) {
            u32x4 gv[4][2], tv[4][2];
#pragma unroll
            for (int m = 0; m < 4; ++m) { const size_t off = (size_t)(row0 + ai * HALF + m * 16) * D + col0;
#pragma unroll
                for (int bj = 0; bj < 2; ++bj) { gv[m][bj] = *(const u32x4*)(g + off + bj * HALF); tv[m][bj] = *(const u32x4*)(t1 + off + bj * HALF); } }
#pragma unroll
            for (int m = 0; m < 4; ++m) { const size_t off = (size_t)(row0 + ai * HALF + m * 16) * D + col0;
#pragma unroll
                for (int bj = 0; bj < 2; ++bj) { f32x4 g0, g1, t0, t1v; unpack8(gv[m][bj], g0, g1); unpack8(tv[m][bj], t0, t1v);
                    *(u32x4*)(o + off + bj * HALF) = pack8(t0 + acc[ai][bj][m][0] * g0, t1v + acc[ai][bj][m][1] * g1); } }
            asm volatile("" ::: "memory");
        }
    }
};
struct EpHF {
    static constexpr bool PERM = true, AFTER_DRAIN = false;
    const float* x; float* h; bf16_t* hb; float* ssq;
    __device__ __forceinline__ void operator()(const f32x4 (&acc)[2][2][4][2], const Unit& u, int wr, int wc, int fr, int fq) const {
        const int row0 = u.pm * BM + wr * 64 + fr, col0 = u.pn * BM + wc * 32 + 8 * fq;
#pragma unroll
        for (int ai = 0; ai < 2; ++ai) {
            f32x4 xv[4][2][2];
#pragma unroll
            for (int m = 0; m < 4; ++m) { const size_t off = (size_t)(row0 + ai * HALF + m * 16) * D + col0;
#pragma unroll
                for (int bj = 0; bj < 2; ++bj) { xv[m][bj][0] = *(const f32x4*)(x + off + bj * HALF); xv[m][bj][1] = *(const f32x4*)(x + off + bj * HALF + 4); } }
#pragma unroll
            for (int m = 0; m < 4; ++m) { const size_t row = (size_t)(row0 + ai * HALF + m * 16), off = row * D + col0; float ss = 0.f;
#pragma unroll
                for (int bj = 0; bj < 2; ++bj) {
                    const f32x4 h0 = xv[m][bj][0] + acc[ai][bj][m][0], h1 = xv[m][bj][1] + acc[ai][bj][m][1];
                    *(u32x4*)(hb + off + bj * HALF) = pack8(h0, h1);
                    ss += (h0[0] * h0[0] + h0[1] * h0[1]) + (h0[2] * h0[2] + h0[3] * h0[3]) + (h1[0] * h1[0] + h1[1] * h1[1]) + (h1[2] * h1[2] + h1[3] * h1[3]); }
                ss += __shfl_xor(ss, 16); ss += __shfl_xor(ss, 32);
                if (fq == 0) ssq[row * 16 + 4 * u.pn + wc] = ss; }
            asm volatile("" ::: "memory");
        }
    }
};
struct EpZF {
    static constexpr bool PERM = true, AFTER_DRAIN = false;
    const PG8_LAS float* rtab; const float* ssq; bf16_t* z;
    __device__ __forceinline__ void operator()(const f32x4 (&acc)[2][2][4][2], const Unit& u, int wr, int wc, int fr, int fq) const {
        const int rl0 = wr * 64 + fr, row0 = u.pm * BM + rl0, col0 = u.pn * BM + wc * 32 + 8 * fq;
#pragma unroll
        for (int ai = 0; ai < 2; ++ai)
#pragma unroll
            for (int m = 0; m < 4; ++m) { const size_t row = (size_t)(row0 + ai * HALF + m * 16);
                float r;
                if (rtab) r = rtab[u.ord * 256 + rl0 + ai * HALF + m * 16];
                else { const f32x4 s0 = *(const f32x4*)(ssq + row * 16), s1 = *(const f32x4*)(ssq + row * 16 + 4), s2 = *(const f32x4*)(ssq + row * 16 + 8), s3 = *(const f32x4*)(ssq + row * 16 + 12);
                    const f32x4 st = (s0 + s1) + (s2 + s3); r = rsqrtf(((st[0] + st[1]) + (st[2] + st[3])) * (1.f / D) + EPS); }
#pragma unroll
                for (int bj = 0; bj < 2; ++bj) { f32x4 v0 = acc[ai][bj][m][0] * r, v1 = acc[ai][bj][m][1] * r;
#pragma unroll
                    for (int e = 0; e < 4; ++e) { v0[e] = v0[e] > 0.f ? v0[e] * v0[e] : 0.f; v1[e] = v1[e] > 0.f ? v1[e] * v1[e] : 0.f; }
                    *(u32x4*)(z + row * DFF + col0 + bj * HALF) = pack8(v0, v1); } }
    }
};
struct EpOutF {
    static constexpr bool PERM = true, AFTER_DRAIN = false;
    const bf16_t* hb; float* o;
    __device__ __forceinline__ void operator()(const f32x4 (&acc)[2][2][4][2], const Unit& u, int wr, int wc, int fr, int fq) const {
        const int row0 = u.pm * BM + wr * 64 + fr, col0 = u.pn * BM + wc * 32 + 8 * fq;
        u32x4 hv[2][4][2];
#pragma unroll
        for (int ai = 0; ai < 2; ++ai)
#pragma unroll
            for (int m = 0; m < 4; ++m) { const size_t off = (size_t)(row0 + ai * HALF + m * 16) * D + col0;
#pragma unroll
                for (int bj = 0; bj < 2; ++bj) hv[ai][m][bj] = *(const u32x4*)(hb + off + bj * HALF); }
#pragma unroll
        for (int ai = 0; ai < 2; ++ai)
#pragma unroll
            for (int m = 0; m < 4; ++m) { float* p = o + (size_t)(row0 + ai * HALF + m * 16) * D + col0;
#pragma unroll
                for (int bj = 0; bj < 2; ++bj) { f32x4 h0, h1; unpack8(hv[ai][m][bj], h0, h1); *(f32x4*)(p + bj * HALF) = h0 + acc[ai][bj][m][0]; *(f32x4*)(p + bj * HALF + 4) = h1 + acc[ai][bj][m][1]; } }
    }
};
}

namespace att {
using pg8::bf16x8; using pg8::f32x4; using pg8::u32x4;
typedef float f32x16 __attribute__((ext_vector_type(16)));
typedef short s16x4 __attribute__((ext_vector_type(4)));
typedef float f32x2_t __attribute__((ext_vector_type(2))); typedef __bf16 bf16x2_t __attribute__((ext_vector_type(2)));
constexpr int KROW = 144, VROW = 144, KT = 64 * KROW, VT = 64 * VROW;
__device__ __forceinline__ int vperm(int kv) { return (kv & ~12) | ((kv & 4) << 1) | ((kv & 8) >> 1); }
constexpr int L_K0 = 0, L_K1 = KT, L_V0 = 2 * KT, L_V1 = 2 * KT + VT, L_BT = 2 * KT + 2 * VT  , L_IMPG = L_BT + 4096 + 64, L_IMPL = L_IMPG + 33792, L_IMP = L_IMPL + 33792, L_SELM = L_IMP + 64 * 33 * 4, L_KC = L_SELM + 512  , VCROW = 272, L_VC = L_KC + 128 * KROW  , L_END = L_VC + 64 * VCROW;
static_assert(L_END <= 163840 - 512, "attention LDS map");
__device__ __forceinline__ int crow(int r, int hi) { return (r & 3) + 8 * (r >> 2) + 4 * hi; }
__device__ __forceinline__ float max3f(float a, float b, float c) { float r; asm("v_max3_f32 %0, %1, %2, %3" : "=v"(r) : "v"(a), "v"(b), "v"(c)); return r; }
__device__ __forceinline__ unsigned cvtpk(float lo, float hi) { f32x2_t v = {lo, hi}; bf16x2_t b = __builtin_convertvector(v, bf16x2_t); return __builtin_bit_cast(unsigned, b); }
__device__ __forceinline__ bf16x8 packp(const f32x16& p, int s) {
    u32x4 w; w.x = cvtpk(p[8 * s + 0], p[8 * s + 1]); w.y = cvtpk(p[8 * s + 2], p[8 * s + 3]); w.z = cvtpk(p[8 * s + 4], p[8 * s + 5]); w.w = cvtpk(p[8 * s + 6], p[8 * s + 7]);
    return __builtin_bit_cast(bf16x8, w); }
__device__ __forceinline__ bf16x8 kfrag(const unsigned char* kbuf, int st, int sp, int q32, int hi) { return *(const bf16x8*)(kbuf + (32 * st + q32) * KROW + (16 * sp + 8 * hi) * 2); }
__device__ __forceinline__ bf16x8 vfrag(const unsigned char* vbuf, int st, int s, int dt, int q32, int hi) { return *(const bf16x8*)(vbuf + (32 * dt + q32) * VROW + (32 * st + 16 * s + 8 * hi) * 2); }
__device__ __forceinline__ f32x16 qk_tile(const unsigned char* kbuf, int st, const bf16x8 (&qf)[4], int q32, int hi) {
    f32x16 s = {};
#pragma unroll
    for (int sp = 0; sp < 4; ++sp) s = __builtin_amdgcn_mfma_f32_32x32x16_bf16(kfrag(kbuf, st, sp, q32, hi), qf[sp], s, 0, 0, 0);
    return s; }
__device__ __forceinline__ void pv_tile(f32x16 (&o)[2], const unsigned char* vbuf, int st, const f32x16& p, int q32, int hi) {
#pragma unroll
    for (int s = 0; s < 2; ++s) { const bf16x8 pb = packp(p, s);
#pragma unroll
        for (int dt = 0; dt < 2; ++dt) o[dt] = __builtin_amdgcn_mfma_f32_32x32x16_bf16(vfrag(vbuf, st, s, dt, q32, hi), pb, o[dt], 0, 0, 0); }
}
struct Stage { u32x4 k, v; };
__device__ __forceinline__ void stage_load(Stage& s, const bf16_t* Kblk  , int ldk, const bf16_t* Vblk  , int ldv, int tid) {
    const int row = tid >> 3, ch = tid & 7;
    s.k = *(const u32x4*)(Kblk + (size_t)row * ldk + ch * 8); s.v = *(const u32x4*)(Vblk + (size_t)row * ldv + ch * 8); }
__device__ __forceinline__ void stage_store(const Stage& s, unsigned char* kbuf, unsigned char* vbuf, int tid) {
    const int row = tid >> 3, ch = tid & 7;
    *(u32x4*)(kbuf + row * KROW + ch * 16) = s.k;
    *(u32x4*)(vbuf + row * VROW + ch * 16) = s.v; }

struct SoftState { float mhat, l; f32x16 cneg; };
constexpr float ATT_THR = 8.0f;
template <int BR, int ABL>
__device__ __forceinline__ void block64(f32x16 (&o)[2], SoftState& ss, const unsigned char* kbuf, const unsigned char* vbuf, int dj, bool selbit, bool anyunsel, const bf16x8 (&qf)[4], const float* bt2,
                                        int q32, int hi, int tl) {
    f32x16 s0, s1;
    if (ABL & 64) { s0 = f32x16{}; s1 = f32x16{}; }
    else { s0 = ss.cneg; s1 = ss.cneg; }
    bf16x8 vf0[2][2], vf1[2][2];
#define ATT_BIAS(S_, KT_) do { if (dj <= 2) { const float* bt_ = bt2 + (64 * dj + tl + 64 - 4 * hi - 27) - 32 * (KT_); \
            _Pragma("unroll") for (int r = 0; r < 16; ++r) { const int cr = (r & 3) + 8 * (r >> 2); S_[r] += bt_[27 - cr]; } \
        } else if (BR == 1 && dj == 8) { const int basei = tl - 4 * hi; \
            _Pragma("unroll") for (int r = 0; r < 16; ++r) { const int cr = (r & 3) + 8 * (r >> 2); S_[r] += __int_as_float(((cr + 32 * (KT_) - basei - 1) >> 31) & 0xf149f2cau); } } } while (0)
    if (ABL & 64) {
#pragma unroll
        for (int sp = 0; sp < 4; ++sp) s0 = __builtin_amdgcn_mfma_f32_32x32x16_bf16(kfrag(kbuf, 0, sp, q32, hi), qf[sp], s0, 0, 0, 0);
        __builtin_amdgcn_sched_barrier(0);
#pragma unroll
        for (int s = 0; s < 2; ++s)
#pragma unroll
            for (int dt = 0; dt < 2; ++dt) vf0[s][dt] = vfrag(vbuf, 0, s, dt, q32, hi);
        __builtin_amdgcn_sched_barrier(0);
        ATT_BIAS(s0, 0);
#pragma unroll
        for (int sp = 0; sp < 4; ++sp) { s1 = __builtin_amdgcn_mfma_f32_32x32x16_bf16(kfrag(kbuf, 1, sp, q32, hi), qf[sp], s1, 0, 0, 0);
#pragma unroll
            for (int e = 0; e < 4; ++e) s0[4 * sp + e] = __builtin_amdgcn_exp2f(s0[4 * sp + e]);
            __builtin_amdgcn_sched_barrier(0); }
        ATT_BIAS(s1, 1);
    } else {
#pragma unroll
    for (int sp = 0; sp < 4; ++sp) { s0 = __builtin_amdgcn_mfma_f32_32x32x16_bf16(kfrag(kbuf, 0, sp, q32, hi), qf[sp], s0, 0, 0, 0); s1 = __builtin_amdgcn_mfma_f32_32x32x16_bf16(kfrag(kbuf, 1, sp, q32, hi), qf[sp], s1, 0, 0, 0); }
    __builtin_amdgcn_sched_barrier(0);
#pragma unroll
    for (int s = 0; s < 2; ++s)
#pragma unroll
        for (int dt = 0; dt < 2; ++dt) vf0[s][dt] = vfrag(vbuf, 0, s, dt, q32, hi);
    __builtin_amdgcn_sched_barrier(0);
    ATT_BIAS(s0, 0); ATT_BIAS(s1, 1);
    }
#undef ATT_BIAS
    if (!(ABL & 64)) {
    float rm = max3f(s0[0], s0[1], s1[0]), rm2 = max3f(s0[2], s0[3], s1[1]);
    rm = max3f(rm, s1[2], s1[3]);
#pragma unroll
    for (int r = 4; r < 16; r += 4) { rm = max3f(rm, s0[r], s0[r + 1]); rm2 = max3f(rm2, s0[r + 2], s0[r + 3]); rm = max3f(rm, s1[r], s1[r + 1]); rm2 = max3f(rm2, s1[r + 2], s1[r + 3]); }
    rm = max3f(rm, rm2, rm2);
    if (BR == 0) rm = selbit ? rm : -1e30f;
    if (__any(rm > ATT_THR)) {
        const float rmc = fmaxf(rm, __shfl_xor(rm, 32)), dl = fmaxf(rmc, 0.f), f = __builtin_amdgcn_exp2f(-dl);
        ss.mhat += dl; ss.l *= f;
#pragma unroll
        for (int r = 0; r < 16; ++r) { s0[r] -= dl; s1[r] -= dl; ss.cneg[r] -= dl; o[0][r] *= f; o[1][r] *= f; }
    }
    }
    float ps = 0.f, ps1 = 0.f, ps2 = 0.f, ps3 = 0.f;
#pragma unroll
    for (int r = 0; r < 16; r += 2) { if (!(ABL & 64)) { s0[r] = __builtin_amdgcn_exp2f(s0[r]); s0[r + 1] = __builtin_amdgcn_exp2f(s0[r + 1]); } ps += s0[r]; ps2 += s0[r + 1]; }
    const unsigned pm = (BR == 0 && !selbit) ? 0u : 0xffffffffu;
    bf16x8 pb0[2];
#pragma unroll
    for (int s = 0; s < 2; ++s) { pb0[s] = packp(s0, s);
        if (BR == 0 && anyunsel) { u32x4 w = __builtin_bit_cast(u32x4, pb0[s]); w.x &= pm; w.y &= pm; w.z &= pm; w.w &= pm; pb0[s] = __builtin_bit_cast(bf16x8, w); } }
    __builtin_amdgcn_sched_barrier(0);
#pragma unroll
    for (int i = 0; i < 4; ++i) { const int s = i >> 1, dt = i & 1;
        o[dt] = __builtin_amdgcn_mfma_f32_32x32x16_bf16(vf0[s][dt], pb0[s], o[dt], 0, 0, 0);
#pragma unroll
        for (int e = 0; e < 4; ++e) s1[4 * i + e] = __builtin_amdgcn_exp2f(s1[4 * i + e]);
        __builtin_amdgcn_sched_barrier(0); }
#pragma unroll
    for (int s = 0; s < 2; ++s)
#pragma unroll
        for (int dt = 0; dt < 2; ++dt) vf1[s][dt] = vfrag(vbuf, 1, s, dt, q32, hi);
#pragma unroll
    for (int r = 0; r < 16; r += 2) { ps1 += s1[r]; ps3 += s1[r + 1]; }
    ps = (ps + ps1) + (ps2 + ps3);
    if (BR == 0) ps = selbit ? ps : 0.f;
    ss.l += ps;
#pragma unroll
    for (int s = 0; s < 2; ++s) { bf16x8 pb = packp(s1, s);
        if (BR == 0 && anyunsel) { u32x4 w = __builtin_bit_cast(u32x4, pb); w.x &= pm; w.y &= pm; w.z &= pm; w.w &= pm; pb = __builtin_bit_cast(bf16x8, w); }
#pragma unroll
        for (int dt = 0; dt < 2; ++dt) o[dt] = __builtin_amdgcn_mfma_f32_32x32x16_bf16(vf1[s][dt], pb, o[dt], 0, 0, 0); }
}
__device__ __forceinline__ void stage_load_t(Stage& s, const bf16_t* Kblk, const bf16_t* Vblk, int tid) {
    s.k = *(const u32x4*)(Kblk + (size_t)(tid >> 3) * KVW + (tid & 7) * 8); s.v = *(const u32x4*)(Vblk + (size_t)(tid & 63) * KVW + (tid >> 6) * 8); }
__device__ __forceinline__ void stage_store_t(const Stage& s, unsigned char* kbuf, unsigned char* vbuf, int tid) {
    const int row = tid >> 3, ch = tid & 7;
    *(u32x4*)(kbuf + row * KROW + ch * 16) = s.k;
    unsigned short* vp = (unsigned short*)(vbuf + ((tid >> 6) * 8) * VROW + vperm(tid & 63) * 2);
    vp[0 * (VROW / 2)] = (unsigned short)s.v.x; vp[1 * (VROW / 2)] = (unsigned short)(s.v.x >> 16); vp[2 * (VROW / 2)] = (unsigned short)s.v.y; vp[3 * (VROW / 2)] = (unsigned short)(s.v.y >> 16);
    vp[4 * (VROW / 2)] = (unsigned short)s.v.z; vp[5 * (VROW / 2)] = (unsigned short)(s.v.z >> 16); vp[6 * (VROW / 2)] = (unsigned short)s.v.w; vp[7 * (VROW / 2)] = (unsigned short)(s.v.w >> 16); }
template <int BR, int ABL>
__device__ __forceinline__ void branch(float* outl  , const Stage* first  , float gate, const bf16_t* Kg  , const bf16_t* Vg  ,
                                       int qblk, unsigned unionmask, unsigned mysel, const bf16x8 (&qf)[4], const float* bt2  , float cb  ,
                                       unsigned char* lds, int tid, int q32, int hi, int tl) {
    const int jlo = BR == 0 ? 0 : (qblk - 8 < 0 ? 0 : qblk - 8);
    f32x16 o[2]; o[0] = f32x16{}; o[1] = f32x16{};
    SoftState ss; ss.mhat = 0.f; ss.l = 0.f;
#pragma unroll
    for (int r = 0; r < 16; ++r) ss.cneg[r] = cb;
#define ATT_NEXT(jv) do { --(jv); if (BR == 0) { while ((jv) >= jlo && !((unionmask >> (jv)) & 1u)) --(jv); } } while (0)
#define ATT_LOAD(sg, jv) do { const int jl_ = (jv) < jlo ? jlo : (jv); if (!(ABL & 8)) stage_load_t(sg, Kg + (size_t)jl_ * 64 * KVW, Vg + (size_t)jl_ * 64 * KVW, tid); else { sg.k = (u32x4){(unsigned)jl_, 0u, 0u, 0u}; sg.v = sg.k; } } while (0)
#define ATT_SEL(jv) (BR == 0 ? (((mysel >> (jv)) & 1u) != 0u) : true)
    int jA = qblk, jB = qblk, jC;
    Stage sA, sB;
    if (first) sA = *first; else ATT_LOAD(sA, jA);
    ATT_NEXT(jB); ATT_LOAD(sB, jB);
    stage_store_t(sA, lds + L_K0, lds + L_V0, tid);
    __syncthreads();
    for (;;) {
        jC = jB; if (jB >= jlo) ATT_NEXT(jC);
        ATT_LOAD(sA, jC);
        { const bool sel = ATT_SEL(jA); if (BR == 1 || __any(sel)) block64<BR, ABL>(o, ss, lds + L_K0, lds + L_V0, qblk - jA, sel, BR == 0 && __any(!sel), qf, bt2, q32, hi, tl); }
        if (jB < jlo) break;
        if (!(ABL & 16)) stage_store_t(sB, lds + L_K1, lds + L_V1, tid);
        if (!(ABL & 4)) __syncthreads();
        jA = jC; if (jC >= jlo) ATT_NEXT(jA);
        ATT_LOAD(sB, jA);
        { const bool sel = ATT_SEL(jB); if (BR == 1 || __any(sel)) block64<BR, ABL>(o, ss, lds + L_K1, lds + L_V1, qblk - jB, sel, BR == 0 && __any(!sel), qf, bt2, q32, hi, tl); }
        if (jC < jlo) break;
        if (!(ABL & 16)) stage_store_t(sA, lds + L_K0, lds + L_V0, tid);
        if (!(ABL & 4)) __syncthreads();
        jB = jA; jA = jC;
    }
#undef ATT_NEXT
#undef ATT_LOAD
#undef ATT_SEL
    float lrun = ss.l; lrun += __shfl_xor(lrun, 32);
    const float f = gate / lrun;
#pragma unroll
    for (int r = 0; r < 16; ++r) { outl[r * 64] += o[0][r] * f; outl[(16 + r) * 64] += o[1][r] * f; }
    __syncthreads();
}

__device__ __forceinline__ void attn_bias_table(int g, const float* rel_bias, unsigned char* lds) {
    float* bt = (float*)(lds + L_BT); const int tid = threadIdx.x;
#pragma unroll
    for (int i = 0; i < 2; ++i) { const int e = tid + 512 * i, hh = e >> 8, ix = (e & 255) - 64; const float cbh = rel_bias[31 * NH + g * 4 + hh] * LOG2E; bt[e] = ix < 0 ? -1e30f : rel_bias[BUCKET[ix > 127 ? 127 : ix] * NH + g * 4 + hh] * LOG2E - cbh; }
    if (tid < 4) bt[1024 + tid] = rel_bias[31 * NH + g * 4 + tid] * LOG2E;
    __syncthreads();
}
__device__ __forceinline__ void attn_compress_l2(int bg, const bf16_t* HIDK, const bf16_t* HIDV, const float* w2k, const float* w2v, const float* kc_norm, unsigned char* lds) {
    const int tid = threadIdx.x, lane = tid & 63, wave = tid >> 6, q32 = lane & 31, hi = lane >> 5, which = wave >> 2, c = 32 * (wave & 3) + q32; const bool okc = c < NC;
    const bf16_t* hrow = (which ? HIDV : HIDK) + (size_t)(bg * NC + (okc ? c : 0)) * 256; const float* w2 = which ? w2v : w2k;
    f32x16 acc[2]; acc[0] = f32x16{}; acc[1] = f32x16{};
    for (int s = 0; s < 16; ++s) {
        const bf16x8 bfrag = *(const bf16x8*)(hrow + 16 * s + 8 * hi);
#pragma unroll
        for (int nt = 0; nt < 2; ++nt) { const float* wp = w2 + (size_t)(16 * s + 8 * hi) * HD + 32 * nt + q32;
            u32x4 aw; aw.x = cvtpk(wp[0], wp[HD]); aw.y = cvtpk(wp[2 * HD], wp[3 * HD]); aw.z = cvtpk(wp[4 * HD], wp[5 * HD]); aw.w = cvtpk(wp[6 * HD], wp[7 * HD]);
            acc[nt] = __builtin_amdgcn_mfma_f32_32x32x16_bf16(__builtin_bit_cast(bf16x8, aw), bfrag, acc[nt], 0, 0, 0); }
    }
    if (which) {
        unsigned short* vp = (unsigned short*)(lds + L_VC) + vperm(c);
#pragma unroll
        for (int nt = 0; nt < 2; ++nt)
#pragma unroll
            for (int q = 0; q < 16; ++q) vp[(32 * nt + crow(q, hi)) * (VCROW / 2)] = okc ? (unsigned short)(cvtpk(acc[nt][q], 0.f) & 0xffffu) : (unsigned short)0;
    } else {
        float ss = 0.f;
#pragma unroll
        for (int nt = 0; nt < 2; ++nt)
#pragma unroll
            for (int q = 0; q < 16; ++q) ss += acc[nt][q] * acc[nt][q];
        ss += __shfl_xor(ss, 32); const float rn = okc ? rsqrtf(ss * (1.f / HD) + EPS) : 0.f;
#pragma unroll
        for (int nt = 0; nt < 2; ++nt)
#pragma unroll
            for (int rg = 0; rg < 4; ++rg) { const int n0 = 32 * nt + 8 * rg + 4 * hi; const f32x4 gk = *(const f32x4*)(kc_norm + n0);
                *(unsigned long long*)(lds + L_KC + c * KROW + n0 * 2) = (unsigned long long)cvtpk(acc[nt][4 * rg] * rn * gk[0], acc[nt][4 * rg + 1] * rn * gk[1]) | ((unsigned long long)cvtpk(acc[nt][4 * rg + 2] * rn * gk[2], acc[nt][4 * rg + 3] * rn * gk[3]) << 32); }
    }
    __syncthreads();
}
__device__ __forceinline__ bf16x8 vfragc(const unsigned char* vcbuf, int tile, int s, int dt, int q32, int hi) { return *(const bf16x8*)(vcbuf + (32 * dt + q32) * VCROW + (32 * tile + 16 * s + 8 * hi) * 2); }
template <int MODE, int ABL = 0>
__device__ __forceinline__ void attn_unit(int b, int g, int qblk, const bf16_t* Q, bf16_t* O, const bf16_t* KSb, const bf16_t* VSb, const bf16_t* KWb, const bf16_t* VWb,
                                          const bf16_t* GN, const float* rel_bias, unsigned char* lds) {
    int tid = threadIdx.x; asm volatile("" : "+v"(tid));
    const int lane = tid & 63, wave = tid >> 6, q32 = lane & 31, hi = lane >> 5, hr = wave >> 1, th = wave & 1, h = g * 4 + hr, tl = 32 * th + q32, t = 64 * qblk + tl, bg = b * 4 + g;
    const size_t m = (size_t)b * T + t;
    float* bt = (float*)(lds + L_BT); float* impg = (float*)(lds + L_IMPG); float* impl = (float*)(lds + L_IMPL); float* imp = (float*)(lds + L_IMP); unsigned* selm = (unsigned*)(lds + L_SELM);
    bf16x8 qf[4];
#pragma unroll
    for (int sp = 0; sp < 4; ++sp) qf[sp] = *(const bf16x8*)(Q + m * QW + h * HD + 16 * sp + 8 * hi);
    const float g0 = bf2f(GN[m * 48 + h * 3 + 0]), g1 = bf2f(GN[m * 48 + h * 3 + 1]), g2 = bf2f(GN[m * 48 + h * 3 + 2]);
    f32x16 out[2];
    {
        const float* bte = bt + hr * 256 + 64; const float cbh = bt[1024 + hr];
        const int ncv = t >= 31 ? ((t - 31) >> 4) + 1 : 0;
        f32x16 sc[4]; float mx = -1e20f;
#pragma unroll
        for (int tile = 0; tile < 4; ++tile) {
            sc[tile] = qk_tile(lds + L_KC, tile, qf, q32, hi);
            __builtin_amdgcn_sched_barrier(0);
#pragma unroll
            for (int r = 0; r < 16; ++r) { const int c = 32 * tile + crow(r, hi);
                int dist = t - 31 - 16 * c; const float pen = __int_as_float(((ncv - 1 - c) >> 31) & 0xf149f2cau);
                dist = dist < 0 ? 0 : (dist > 127 ? 127 : dist);
                const float v = (sc[tile][r] + (bte[dist] + cbh)) + pen; sc[tile][r] = v; mx = fmaxf(mx, v); }
            __builtin_amdgcn_sched_barrier(0);
        }
        mx = fmaxf(mx, __shfl_xor(mx, 32));
        float l = 0.f;
#pragma unroll
        for (int tile = 0; tile < 4; ++tile)
#pragma unroll
            for (int r = 0; r < 16; ++r) { const float p = __builtin_amdgcn_exp2f(sc[tile][r] - mx); sc[tile][r] = p; l += p; }
        l += __shfl_xor(l, 32);
        const float inv = l > 0.f ? 1.f / l : 0.f;
#pragma unroll
        for (int tile = 0; tile < 4; ++tile)
#pragma unroll
            for (int r = 0; r < 16; ++r) sc[tile][r] *= inv;
        __builtin_amdgcn_sched_barrier(0);
        if (qblk > 15)
#pragma unroll
        for (int tile = 0; tile < 4; ++tile)
#pragma unroll
            for (int rg = 0; rg < 4; ++rg) { const int j = 8 * tile + 2 * rg + hi;
                impg[(hr * 64 + tl) * 33 + j] = (sc[tile][4 * rg] + sc[tile][4 * rg + 1]) + (sc[tile][4 * rg + 2] + sc[tile][4 * rg + 3]);
                impl[(hr * 64 + tl) * 33 + j] = sc[tile][4 * rg + 3]; }
        __builtin_amdgcn_sched_barrier(0);
        f32x16 o[2]; o[0] = f32x16{}; o[1] = f32x16{};
#pragma unroll
        for (int tile = 0; tile < 4; ++tile) {
#pragma unroll
            for (int s = 0; s < 2; ++s) { const bf16x8 pb = packp(sc[tile], s);
#pragma unroll
                for (int dt = 0; dt < 2; ++dt) o[dt] = __builtin_amdgcn_mfma_f32_32x32x16_bf16(vfragc(lds + L_VC, tile, s, dt, q32, hi), pb, o[dt], 0, 0, 0); }
            __builtin_amdgcn_sched_barrier(0); }
#pragma unroll
        for (int r = 0; r < 16; ++r) { out[0][r] = o[0][r] * g0; out[1][r] = o[1][r] * g0; }
    }
    const bf16_t* Kgs = KSb + (size_t)b * T * KVW + g * HD; const bf16_t* Kgw = KWb + (size_t)b * T * KVW + g * HD;
    const bf16_t* Vgs = VSb + (size_t)b * T * KVW + g * HD; const bf16_t* Vgw = VWb + (size_t)b * T * KVW + g * HD;
    Stage sfirst; stage_load_t(sfirst, Kgs + (size_t)qblk * 64 * KVW, Vgs + (size_t)qblk * 64 * KVW, tid);
    unsigned mysel, uni;
    if (qblk > 15) {
    __syncthreads();
    {
        const int stl = tid >> 3, jq = tid & 7;
#pragma unroll
        for (int e = 0; e < 4; ++e) { const int j = 4 * jq + e; float s = 0.f;
#pragma unroll
            for (int r = 0; r < 4; ++r) { s += impg[(r * 64 + stl) * 33 + j]; if (j > 0) s += impl[(r * 64 + stl) * 33 + j - 1]; }
            imp[stl * 33 + j] = s; }
        __syncthreads();
        unsigned bits = 0u;
        {
            float iv[32];
#pragma unroll
            for (int k = 0; k < 32; ++k) iv[k] = imp[stl * 33 + k];
#pragma unroll
            for (int e = 0; e < 4; ++e) { const int j = 4 * jq + e; float vj = iv[0];
#pragma unroll
                for (int k = 1; k < 32; ++k) vj = (k == j) ? iv[k] : vj;
                int rank = 0;
#pragma unroll
                for (int k = 1; k < 30; ++k) { const bool cand = k <= qblk - 2; rank += (cand && (iv[k] > vj || (iv[k] == vj && k < j))) ? 1 : 0; }
                if (j == 0 || j == qblk - 1 || j == qblk) bits |= 1u << j; else if (j < qblk - 1 && rank < 13) bits |= 1u << j; }
        }
        bits |= __shfl_xor(bits, 1); bits |= __shfl_xor(bits, 2); bits |= __shfl_xor(bits, 4);
        if (jq == 0) selm[stl] = bits;
    }
    __syncthreads();
    mysel = selm[tl]; uni = selm[lane];
#pragma unroll
    for (int o = 1; o < 64; o <<= 1) uni |= __shfl_xor(uni, o);
    } else { mysel = uni = (1u << (qblk + 1)) - 1u; }
    float* outl = (float*)(lds + L_IMPG) + wave * 2048 + lane;
#pragma unroll
    for (int r = 0; r < 16; ++r) { outl[r * 64] = out[0][r]; outl[(16 + r) * 64] = out[1][r]; }
    if (MODE & 2) branch<0, ABL>(outl, &sfirst, g1, Kgs, Vgs, qblk, uni, mysel, qf, bt + hr * 256, bt[1024 + hr], lds, tid, q32, hi, tl);
    if (MODE & 4) branch<1, ABL>(outl, nullptr, g2, Kgw, Vgw, qblk, 0xffffffffu, 0xffffffffu, qf, bt + hr * 256, bt[1024 + hr], lds, tid, q32, hi, tl);
    bf16_t* orow = O + m * QW + h * HD;
#pragma unroll
    for (int dt = 0; dt < 2; ++dt)
#pragma unroll
        for (int rg = 0; rg < 4; ++rg)
            *(unsigned long long*)(orow + 32 * dt + 8 * rg + 4 * hi) = (unsigned long long)cvtpk(outl[(16 * dt + 4 * rg) * 64], outl[(16 * dt + 4 * rg + 1) * 64]) | ((unsigned long long)cvtpk(outl[(16 * dt + 4 * rg + 2) * 64], outl[(16 * dt + 4 * rg + 3) * 64]) << 32);
}
}

__device__ __forceinline__ void tr_item(const float* W, int ldw, int kvalid, int c0, int cvalid, const float* kscale, bf16_t* WT, int ldt, int r0, int k0, float* scr, int lane) {
#pragma unroll
    for (int i = 0; i < 32; ++i) { const int kk = 2 * i + (lane >> 5), col = lane & 31, k = k0 + kk;
        float v = 0.f; if (k < kvalid && col < cvalid) { v = W[(size_t)k * ldw + c0 + col]; if (kscale) v *= kscale[k]; }
        scr[kk * 33 + col] = v; }
    asm volatile("s_waitcnt lgkmcnt(0)" ::: "memory");
    const int c = lane & 7;
#pragma unroll
    for (int j = 0; j < 4; ++j) { const int n = (lane >> 3) + 8 * j; const float* s = scr + (8 * c) * 33 + n;
        pg8::u32x4 o; o.x = pg8::cvt_pk_bf16(s[0 * 33], s[1 * 33]); o.y = pg8::cvt_pk_bf16(s[2 * 33], s[3 * 33]); o.z = pg8::cvt_pk_bf16(s[4 * 33], s[5 * 33]); o.w = pg8::cvt_pk_bf16(s[6 * 33], s[7 * 33]);
        *(pg8::u32x4*)(WT + (size_t)(r0 + n) * ldt + k0 + 8 * c) = o; }
    asm volatile("s_waitcnt lgkmcnt(0)" ::: "memory");
}

#define LAS __attribute__((address_space(3)))
#define XB_TMO      128
#define XB_XCNT(j)  (256  + 64 * (j))
#define XB_XSUB(j)  (1280 + 64 * (j))
#define XB_XGEN(j)  (2304 + 64 * (j))
#define XB_TOP      3328
#define XB_TOPGEN   3392
#define XCD_BAR_WORDS 3456
#define XB_SPIN_CAP (1u << 18)

__device__ __forceinline__ unsigned xb_ld(unsigned* p)              { return __hip_atomic_load(p, __ATOMIC_RELAXED, __HIP_MEMORY_SCOPE_AGENT); }
__device__ __forceinline__ unsigned xb_add(unsigned* p, unsigned v) { return __hip_atomic_fetch_add(p, v, __ATOMIC_RELAXED, __HIP_MEMORY_SCOPE_AGENT); }
__device__ __forceinline__ unsigned xb_xcc_id() { return (unsigned)__builtin_amdgcn_s_getreg((3 << 11) | 20) & 0xFu; }
#define XB_SPIN(cond, bar) do { unsigned _sp = 0; while (cond) { __builtin_amdgcn_s_sleep(1); \
    if ((++_sp & 255u) == 0u) { if (xb_ld(&(bar)[XB_TMO])) break; if (_sp > XB_SPIN_CAP) { atomicAdd(&(bar)[XB_TMO], 1u); break; } } } } while (0)

struct XcdBarrier {
    unsigned* bar; unsigned x;
    volatile LAS unsigned* st;
};

__device__ __forceinline__ XcdBarrier xcd_barrier_post(unsigned* bar, volatile LAS unsigned* st) {
    XcdBarrier b; b.bar = bar; b.x = xb_xcc_id(); b.st = st;
    if (threadIdx.x == 0) (void)xb_add(&bar[XB_XCNT(b.x)], 1u);
    return b;
}
__device__ __forceinline__ void xcd_barrier_complete(unsigned* bar, unsigned x, unsigned& nloc, unsigned& nx) {
    const unsigned G = gridDim.x * gridDim.y * gridDim.z;
    unsigned sum, cnt, mine, sp = 0u;
    for (;;) {
        sum = 0u; cnt = 0u; mine = 0u;
#pragma unroll
        for (unsigned j = 0; j < 16; ++j) { const unsigned c = xb_ld(&bar[XB_XCNT(j)]); sum += c; cnt += (c > 0u) ? 1u : 0u; mine = (j == x) ? c : mine; }
        if (sum == G) break;
        __builtin_amdgcn_s_sleep(1);
        if ((++sp & 255u) == 0u) { if (xb_ld(&bar[XB_TMO])) break; if (sp > XB_SPIN_CAP) { atomicAdd(&bar[XB_TMO], 1u); break; } }
    }
    nloc = mine > 0u ? mine : 1u; nx = cnt > 0u ? cnt : 1u;
}

__device__ __forceinline__ void xcd_barrier(const XcdBarrier& b) {
    asm volatile("s_waitcnt vmcnt(0)" ::: "memory");
    __syncthreads();
    if (threadIdx.x == 0) {
        unsigned* bar = b.bar;
        __builtin_amdgcn_s_waitcnt(0);
        unsigned nloc = b.st[0], nx = b.st[1];
        if (nloc == 0u) { xcd_barrier_complete(bar, b.x, nloc, nx); b.st[0] = nloc; b.st[1] = nx; }
        const unsigned old = xb_add(&bar[XB_XSUB(b.x)], 1u);
        const unsigned gen = old / nloc;
        if (old + 1u == (gen + 1u) * nloc) {
            __builtin_amdgcn_fence(__ATOMIC_RELEASE, "agent");
            asm volatile("s_waitcnt vmcnt(0)" ::: "memory");
            const unsigned og = xb_add(&bar[XB_TOP], 1u);
            const unsigned tg = og / nx;
            if (og + 1u == (tg + 1u) * nx) xb_add(&bar[XB_TOPGEN], 1u);
            else XB_SPIN(xb_ld(&bar[XB_TOPGEN]) == tg, bar);
            __builtin_amdgcn_fence(__ATOMIC_ACQUIRE, "agent");
            xb_add(&bar[XB_XGEN(b.x)], 1u);
            asm volatile("s_waitcnt vmcnt(0)" ::: "memory");
        } else {
            XB_SPIN(xb_ld(&bar[XB_XGEN(b.x)]) == gen, bar);
            __builtin_amdgcn_fence(__ATOMIC_ACQUIRE, "agent");
            asm volatile("s_waitcnt vmcnt(0)" ::: "memory");
        }
    }
    __syncthreads();
}

#define DECL_PTRS \
    size_t zoff_ = 0; asm volatile("" : "+s"(zoff_));     \
    unsigned char* ws = a.ws + zoff_; unsigned char* dob = (unsigned char*)a.out + zoff_; \
    const float *x = a.in[0], *norm_mix = a.in[1], *w_in = a.in[2], *conv_w = a.in[3], *conv_b = a.in[4], *gate_a_w = a.in[5], *gate_a_b = a.in[6], *gate_x_w = a.in[7], *gate_x_b = a.in[8], \
                *lam = a.in[9], *pe_k = a.in[10], *w1k = a.in[11], *w2k = a.in[12], *pe_v = a.in[13], *w1v = a.in[14], *w2v = a.in[15], *q_norm = a.in[16], *kc_norm = a.in[17], *ks_norm = a.in[18], \
                *kw_norm = a.in[19], *rel_bias = a.in[20], *proj_a = a.in[21], *proj_b = a.in[22], *w_out = a.in[23], *norm_mlp = a.in[24], *w_mlp_in = a.in[25], *w_mlp_out = a.in[26]; \
    float* RSTD = (float*)(ws + WS_RSTD); float* KCC = (float*)(ws + WS_KCC); float* VCC = (float*)(ws + WS_VCC); unsigned* SEL = (unsigned*)(ws + WS_SEL); \
    bf16_t *URNN = (bf16_t*)(ws + WS_URNN), *UGATE = (bf16_t*)(ws + WS_UGATE), *Q = (bf16_t*)(ws + WS_Q), *KV = (bf16_t*)(ws + WS_KV), *GN = (bf16_t*)(ws + WS_GN), *GA = (bf16_t*)(ws + WS_GA), *GB = (bf16_t*)(ws + WS_GB); \
    bf16_t *KCr = KV, *VCr = KV + (size_t)M * KVW, *KS = KV + 2 * (size_t)M * KVW, *VS = KV + 3 * (size_t)M * KVW, *KW = KV + 4 * (size_t)M * KVW, *VW = KV + 5 * (size_t)M * KVW; \
    bf16_t *LA = (bf16_t*)(ws + WS_LA), *UP = (bf16_t*)(ws + WS_UP), *T1 = (bf16_t*)(ws + WS_T1), *MERGED = (bf16_t*)(ws + WS_MERGED), *HB = (bf16_t*)(ws + WS_HB), *ZACT = (bf16_t*)(ws + WS_ZACT); \
    bf16_t *FLATK = (bf16_t*)(dob + DO_FLATK), *FLATV = (bf16_t*)(dob + DO_FLATV), *HIDK = (bf16_t*)(dob + DO_HIDK), *HIDV = (bf16_t*)(dob + DO_HIDV), *XC = (bf16_t*)(dob + DO_XC), *YA = (bf16_t*)(dob + DO_YA); \
    float* H = (float*)dob; \
    float* LAMC = (float*)(ws + WS_LAMC); float* NORMS = (float*)(ws + WS_NORMS); float* PES = (float*)(ws + WS_PES); float* SSQ = (float*)(ws + WS_SSQ); \
    bf16_t *WIN_T = (bf16_t*)(ws + WS_WIN), *WG_T = (bf16_t*)(ws + WS_WG), *W1_T = (bf16_t*)(ws + WS_W1), *PA_T = (bf16_t*)(ws + WS_PA), *PB_T = (bf16_t*)(ws + WS_PB), *WO_T = (bf16_t*)(ws + WS_WO), *WMI_T = (bf16_t*)(ws + WS_WMI), *WMO_T = (bf16_t*)(ws + WS_WMO); \
    float *CAR = (float*)(dob + DO_CAR), *CBR = (float*)(dob + DO_CBR); \
    bf16_t* XB = (bf16_t*)(dob + DO_XB); bf16_t *KCB = (bf16_t*)(dob + DO_KCB), *VCT = (bf16_t*)(dob + DO_VCT), *VST = (bf16_t*)(dob + DO_VST), *VWT = (bf16_t*)(dob + DO_VWT); \
    (void)0;
__global__ void __launch_bounds__(NTHREADS, 2) fwd(Args a) {
    extern __shared__ __attribute__((aligned(16))) unsigned char lds[];
    float* ldsf = (float*)lds;
    const int tid = threadIdx.x, lane = tid & 63, wave = tid >> 6;
    const int gw = blockIdx.x * 8 + wave, NGW = gridDim.x * 8;
#define gtid ((size_t)blockIdx.x * NTHREADS + threadIdx.x)
#define GSZ ((size_t)gridDim.x * NTHREADS)
    unsigned char* ws0 = a.ws;
    PG8_LAS unsigned char* ldsl = (PG8_LAS unsigned char*)lds;
    const int G = gridDim.x;
    const int lo = a.ph_lo, hi = a.ph_hi;
    volatile LAS unsigned* MISC = (volatile LAS unsigned*)((LAS unsigned char*)lds + LDS_BYTES - 256);
    if (tid < 32) MISC[tid] = 0u;
    __syncthreads();
    XcdBarrier bar = xcd_barrier_post((unsigned*)(ws0 + 16384), MISC + 8);
    int ph = 0;
#ifndef PHMASK
#define PHMASK 0xFFFFFFFFu
#endif
#ifndef REPMASK
#define REPMASK 0u
#endif
#define PHASE_BEGIN if (lo <= ph && ph < hi && ((PHMASK >> ph) & 1u)) {
#define PHASE_BEGIN_R if (lo <= ph && ph < hi && ((PHMASK >> ph) & 1u)) for (int rep_ = 0; rep_ < (((REPMASK >> (16 + ph)) & 1u) ? 2 : 1); ++rep_) {
#define PHASE_END } { const bool sync_ = (lo <= ph && ph + 1 < hi); ++ph; if (sync_) xcd_barrier(bar); }

    PHASE_BEGIN_R DECL_PTRS
    for (int m0 = 2 * gw; m0 < M; m0 += 2 * NGW) {
        pg8::f32x4 v[2][4]; float s[2] = {0.f, 0.f};
#pragma unroll
        for (int u = 0; u < 2; ++u) { const pg8::f32x4* xr = (const pg8::f32x4*)(x + (size_t)(m0 + u) * D) + lane;
#pragma unroll
            for (int j = 0; j < 4; ++j) v[u][j] = xr[64 * j]; }
#pragma unroll
        for (int u = 0; u < 2; ++u)
#pragma unroll
            for (int j = 0; j < 4; ++j) s[u] += (v[u][j][0] * v[u][j][0] + v[u][j][1] * v[u][j][1]) + (v[u][j][2] * v[u][j][2] + v[u][j][3] * v[u][j][3]);
#pragma unroll
        for (int o = 1; o < 64; o <<= 1) { s[0] += __shfl_xor(s[0], o); s[1] += __shfl_xor(s[1], o); }
#pragma unroll
        for (int u = 0; u < 2; ++u) { const float r = rsqrtf(s[u] * (1.f / D) + EPS); if (lane == 0) RSTD[m0 + u] = r;
            unsigned long long* o8 = (unsigned long long*)(XB + (size_t)(m0 + u) * D) + lane;
#pragma unroll
            for (int j = 0; j < 4; ++j) { const pg8::f32x4 gg = *((const pg8::f32x4*)norm_mix + lane + 64 * j); const pg8::f32x4 y = v[u][j] * r * gg;
                o8[64 * j] = (unsigned long long)pg8::cvt_pk_bf16(y[0], y[1]) | ((unsigned long long)pg8::cvt_pk_bf16(y[2], y[3]) << 32); } }
    }
    for (size_t i = gtid; i < DRNN; i += GSZ) LAMC[i] = -8.f * log1pf(__expf(-lam[i])) * LOG2E;
    for (size_t i = gtid; i < 4096; i += GSZ) PES[i] = i < 2048 ? pe_k[i] : pe_v[i - 2048];
    for (size_t i = gtid; i < 192; i += GSZ) NORMS[i] = i < 64 ? q_norm[i] : (i < 128 ? ks_norm[i - 64] : kw_norm[i - 128]);
    {
        float* scr = ldsf + wave * (64 * 33);
        constexpr int I_WIN = (pg8::N1PAD / 32) * 16, I_W1 = 16 * 32;
        for (int it = gw; it < I_WIN + I_W1; it += NGW) {
            int r = it;
            if (r < I_WIN) { const int ch = r / 16, kb = r % 16; int c0, cv; pg8::win_src(ch, c0, cv); tr_item(w_in, DIN, D, c0, cv, nullptr, WIN_T, D, 32 * ch, 64 * kb, scr, lane); continue; } r -= I_WIN;
            { const int ch = r / 32, kb = r % 32; tr_item((ch >> 3) ? w1v : w1k, 256, 2048, (ch & 7) * 32, 32, nullptr, W1_T, 2048, 32 * ch, 64 * kb, scr, lane); }
        }
    }
    PHASE_END
    PHASE_BEGIN DECL_PTRS
    if (FAST(1)) {
        pg8::Gemm g{XB, WIN_T, M, pg8::N1PAD, D}; pg8::StaticOrder S; S.init(M, pg8::N1PAD, G, (int)blockIdx.x);
        PG8_LAS float* ctab = (PG8_LAS float*)(ldsl + 131072);
        for (int i = tid; i < 192; i += NTHREADS) ctab[i] = NORMS[i];
        for (int i = tid; i < 4096; i += NTHREADS) ctab[256 + i] = PES[i];
        __syncthreads();
        pg8::Ep1F E{URNN, UGATE, Q, KV, GN, GA, ctab, FLATK, ctab + 256};
        pg8::gemm_phase<pg8::Ep1F, pg8::StaticOrder, true, true>(ldsl, g, S, E);
#if (REPMASK >> 1) & 1
        pg8::gemm_phase<pg8::Ep1F, pg8::StaticOrder, true, true>(ldsl, g, S, E);
#endif
    } else {
        ngemm(ldsf, M, DIN, D, ALf32Scale{x, D, norm_mix}, BLf32{w_in, DIN}, Ep1{RSTD, URNN, UGATE, Q, KV, GN, GA, GB});
    }
    PHASE_END
    PHASE_BEGIN DECL_PTRS
    if (blockIdx.x >= 64) {
        float* scr = ldsf + wave * (64 * 33);
        constexpr int I_WG = 96 * 6, I_PA = 32 * 22, I_PB = 32 * 16, I_WO = 32 * 16, I_WMI = 128 * 16, I_WMO = 32 * 64;
        for (int it = ((int)blockIdx.x - 64) * 8 + wave; it < I_WG + I_PA + I_PB + I_WO + I_WMI + I_WMO; it += ((int)gridDim.x - 64) * 8) {
            int r = it;
            if (r < I_WG) { const int ch = r / 6, kb = r % 6, nb = ch / 24, rr = ch % 24, pn = rr >> 3, l0 = (rr & 7) * 32, bj = l0 >> 7, chn0 = 128 * pn + (l0 & 127);
                int cv = BW - chn0; cv = cv < 0 ? 0 : (cv > 32 ? 32 : cv);
                tr_item((bj ? gate_x_w : gate_a_w) + (size_t)nb * BW * BW, BW, BW, chn0, cv, nullptr, WG_T, XC_LD, 32 * ch, 64 * kb, scr, lane); continue; } r -= I_WG;
            if (r < I_PA) { const int ch = r / 22, kb = r % 22; tr_item(proj_a, D, DRNN, 32 * ch, 32, nullptr, PA_T, YA_LD, 32 * ch, 64 * kb, scr, lane); continue; } r -= I_PA;
            if (r < I_PB) { const int ch = r / 16, kb = r % 16; tr_item(proj_b, D, QW, 32 * ch, 32, nullptr, PB_T, QW, 32 * ch, 64 * kb, scr, lane); continue; } r -= I_PB;
            if (r < I_WO) { const int ch = r / 16, kb = r % 16; tr_item(w_out, D, D, 32 * ch, 32, nullptr, WO_T, D, 32 * ch, 64 * kb, scr, lane); continue; } r -= I_WO;
            if (r < I_WMI) { const int ch = r / 16, kb = r % 16; tr_item(w_mlp_in, DFF, D, 32 * ch, 32, norm_mlp, WMI_T, D, 32 * ch, 64 * kb, scr, lane); continue; } r -= I_WMI;
            { const int ch = r / 64, kb = r % 64; tr_item(w_mlp_out, D, DFF, 32 * ch, 32, nullptr, WMO_T, DFF, 32 * ch, 64 * kb, scr, lane); }
        }
    } else
    if (FAST(3)) {
        pg8::Gemm g{FLATK, W1_T, 16384, 512, 2048}; pg8::OrderC1 S{G, (int)blockIdx.x};
        pg8::EpGeluF E{HIDK, 256};
        pg8::gemm_phase<pg8::EpGeluF, pg8::OrderC1, true, true>(ldsl, g, S, E);
#if (REPMASK >> 3) & 1
        pg8::gemm_phase<pg8::EpGeluF, pg8::OrderC1, true, true>(ldsl, g, S, E);
#endif
    } else {
        ngemm(ldsf, 8192, 256, 2048, ALbf{FLATK, 2048}, BLf32{w1k, 256}, EpGelu{HIDK, 256});
        ngemm(ldsf, 8192, 256, 2048, ALbf{FLATV, 2048}, BLf32{w1v, 256}, EpGelu{HIDV, 256});
    }
    PHASE_END
    PHASE_BEGIN DECL_PTRS
    {
        const int vcu = (G % 8 == 0) ? ((int)blockIdx.x % 8) * (G / 8) + (int)blockIdx.x / 8 : (int)blockIdx.x;
#ifdef ATT_PROBE_MODE
#ifndef ATT_ABL
#define ATT_ABL 0
#endif
        for (int u = vcu; u < 256; u += G) {
            const int bg = u >> 2, s4 = u & 3;
            att::attn_bias_table(bg & 3, rel_bias, lds);
            att::attn_compress_l2(bg, HIDK, HIDV, w2k, w2v, kc_norm, lds);
#pragma unroll 1
            for (int i = 0; i < 8; ++i) { const int qblk = 8 * (i >> 1) + ((i & 1) ? 7 - s4 : s4);
                att::attn_unit<ATT_PROBE_MODE, ATT_ABL>(bg >> 2, bg & 3, qblk, Q, (bf16_t*)dob, KS, VS, KW, VW, GN, rel_bias, lds); }
        }
#endif
        bool nomax;
        {   float* red = (float*)(lds + 159744);
            float v = 0.f; if (tid < 64) v = fabsf(q_norm[tid]); else if (tid < 128) v = fabsf(ks_norm[tid - 64]); else if (tid < 192) v = fabsf(kw_norm[tid - 128]);
            float bb = fabsf(rel_bias[tid]);
#pragma unroll
            for (int o = 32; o; o >>= 1) { v = fmaxf(v, __shfl_xor(v, o)); bb = fmaxf(bb, __shfl_xor(bb, o)); }
            if (lane == 0) { red[wave] = v; red[8 + wave] = bb; }
            __syncthreads();
            const float bm = fmaxf(fmaxf(fmaxf(red[8], red[9]), fmaxf(red[10], red[11])), fmaxf(fmaxf(red[12], red[13]), fmaxf(red[14], red[15])));
            nomax = 11.55f * red[0] * fmaxf(red[1], red[2]) + 2.f * 1.4427f * bm <= 60.f;
        }
#define ATT_UNITS(ABLV) for (int u = vcu; u < 256; u += G) {     \
            const int bg = u >> 2, s4 = u & 3; \
            att::attn_bias_table(bg & 3, rel_bias, lds); \
            att::attn_compress_l2(bg, HIDK, HIDV, w2k, w2v, kc_norm, lds); \
            _Pragma("unroll 1") for (int i = 7; i >= 0; --i) { const int qblk = 8 * (i >> 1) + ((i & 1) ? 7 - s4 : s4);     \
                att::attn_unit<7, ABLV>(bg >> 2, bg & 3, qblk, Q, Q, KS, VS, KW, VW, GN, rel_bias, lds); } }
        if (nomax) { ATT_UNITS(64) } else { ATT_UNITS(0) }
#undef ATT_UNITS
    }
    for (unsigned it = blockIdx.x * (unsigned)NTHREADS + threadIdx.x; it < 4u * (unsigned)(M / 8) * 48u; it += gridDim.x * (unsigned)NTHREADS) {
        const unsigned ch = it % 48u, nr = it / 48u, run = nr & (unsigned)(M / 8 - 1), n = nr >> 12, m0 = run * 8u, t0 = m0 & (unsigned)(T - 1), j0 = ch * 8u;
        bf16_t* dst = XC + ((size_t)n * M + m0) * XC_LD + j0;
        if (j0 >= (unsigned)BW) {
#pragma unroll
            for (int i = 0; i < 8; ++i) *(pg8::u32x4*)(dst + (size_t)i * XC_LD) = (pg8::u32x4){0u, 0u, 0u, 0u};
            continue; }
        const unsigned c = n * BW + j0;
        pg8::u32x4 rows[11];
#pragma unroll
        for (int i = 0; i < 11; ++i) rows[i] = ((int)t0 - 3 + i >= 0) ? *(const pg8::u32x4*)(URNN + (size_t)(m0 - 3 + i) * DRNN + c) : (pg8::u32x4){0u, 0u, 0u, 0u};
        pg8::f32x4 w0[4], w1[4];
#pragma unroll
        for (int kk = 0; kk < 4; ++kk) { w0[kk] = *(const pg8::f32x4*)(conv_w + kk * DRNN + c); w1[kk] = *(const pg8::f32x4*)(conv_w + kk * DRNN + c + 4); }
        const pg8::f32x4 b0 = *(const pg8::f32x4*)(conv_b + c), b1 = *(const pg8::f32x4*)(conv_b + c + 4);
#pragma unroll
        for (int i = 0; i < 8; ++i) { pg8::f32x4 a0 = b0, a1 = b1;
#pragma unroll
            for (int kk = 0; kk < 4; ++kk) { pg8::f32x4 x0, x1; pg8::unpack8(rows[i + kk], x0, x1); a0 += w0[kk] * x0; a1 += w1[kk] * x1; }
            *(pg8::u32x4*)(dst + (size_t)i * XC_LD) = pg8::pack8(a0, a1); }
    }
    PHASE_END
    PHASE_BEGIN DECL_PTRS
    if (FAST(8)) {
        int kg = XC_LD; asm volatile("" : "+s"(kg));
        pg8::Gemm g{XC, WG_T, 4 * M, 4 * 768, kg}; pg8::OrderGate S{G, (int)blockIdx.x};
        pg8::EpGateF E{gate_a_b, gate_x_b, LAMC, XC, LA, UP};
        pg8::gemm_phase<pg8::EpGateF, pg8::OrderGate, true, true>(ldsl, g, S, E);
#if (REPMASK >> 8) & 1
        pg8::gemm_phase<pg8::EpGateF, pg8::OrderGate, true, true>(ldsl, g, S, E);
#endif
    } else {
    for (int n = 0; n < 4; ++n)
        ngemm(ldsf, M, 2 * BW, BW, ALbf{XC + (size_t)n * M * XC_LD, XC_LD}, BLgate{gate_a_w + (size_t)n * BW * BW, gate_x_w + (size_t)n * BW * BW},
              EpGate{n, gate_a_b, gate_x_b, lam, XC + (size_t)n * M * XC_LD, LA, UP});
    }
    PHASE_END
    PHASE_BEGIN_R DECL_PTRS
    for (size_t it = gtid; it < (size_t)NB * 64 * 336; it += GSZ) {
        const int slot = (int)(it % 336), bk = (int)(it / 336), kc = bk & 63, b = bk >> 6, c0 = 4 * slot; const size_t m0 = (size_t)b * T + 32 * kc;
        float h[4] = {0.f, 0.f, 0.f, 0.f}, sl[4] = {0.f, 0.f, 0.f, 0.f};
#pragma unroll 1
        for (int i0 = 0; i0 < 32; i0 += 8) {
            unsigned long long lw[8], uw[8];
#pragma unroll
            for (int i = 0; i < 8; ++i) { lw[i] = *(const unsigned long long*)(LA + (m0 + i0 + i) * DRNN + c0); uw[i] = *(const unsigned long long*)(UP + (m0 + i0 + i) * DRNN + c0); }
#pragma unroll
            for (int i = 0; i < 8; ++i)
#pragma unroll
                for (int e = 0; e < 4; ++e) { const float la = bf2f((bf16_t)(lw[i] >> (16 * e))), up = bf2f((bf16_t)(uw[i] >> (16 * e))); const float av = __builtin_amdgcn_exp2f(la);
                    const float mult = (kc == 0 && i0 + i == 0) ? 1.f : __builtin_amdgcn_sqrtf(fmaxf(0.f, 1.f - av * av)); h[e] = av * h[e] + mult * up; sl[e] += la; }
        }
        *(pg8::f32x4*)(CAR + (size_t)bk * DRNN + c0) = (pg8::f32x4){sl[0], sl[1], sl[2], sl[3]};
        *(pg8::f32x4*)(CBR + (size_t)bk * DRNN + c0) = (pg8::f32x4){h[0], h[1], h[2], h[3]};
    }
    PHASE_END
    PHASE_BEGIN_R DECL_PTRS
    for (size_t it = gtid; it < (size_t)NB * 16 * 352; it += GSZ) {
        const int slot = (int)(it % 352), bs = (int)(it / 352), kg = bs & 15, b = bs >> 4, kc0 = 4 * kg, c0 = 4 * slot; const size_t m0 = (size_t)b * T + 128 * kg;
        if (slot >= 336) { for (int i = 0; i < 128; ++i) *(unsigned long long*)(YA + (m0 + i) * YA_LD + c0) = 0ull; continue; }
        unsigned long long la_[8], ua_[8], ga_[8], lb_[8], ub_[8], gb_[8];
#define SC_LOAD(L_, U_, G_, i0_) _Pragma("unroll") for (int i = 0; i < 8; ++i) { L_[i] = *(const unsigned long long*)(LA + (m0 + (i0_) + i) * DRNN + c0); U_[i] = *(const unsigned long long*)(UP + (m0 + (i0_) + i) * DRNN + c0); G_[i] = *(const unsigned long long*)(UGATE + (m0 + (i0_) + i) * DRNN + c0); }
#define SC_SCAN(L_, U_, G_, i0_) _Pragma("unroll") for (int i = 0; i < 8; ++i) { float y[4]; \
            _Pragma("unroll") for (int e = 0; e < 4; ++e) { const float la = bf2f((bf16_t)(L_[i] >> (16 * e))), up = bf2f((bf16_t)(U_[i] >> (16 * e))); const float av = __builtin_amdgcn_exp2f(la); \
                const float mult = (kg == 0 && (i0_) + i == 0) ? 1.f : __builtin_amdgcn_sqrtf(fmaxf(0.f, 1.f - av * av)); h[e] = av * h[e] + mult * up; y[e] = h[e] * bf2f((bf16_t)(G_[i] >> (16 * e))); } \
            *(unsigned long long*)(YA + (m0 + (i0_) + i) * YA_LD + c0) = (unsigned long long)att::cvtpk(y[0], y[1]) | ((unsigned long long)att::cvtpk(y[2], y[3]) << 32); }
        SC_LOAD(la_, ua_, ga_, 0)
        float h[4] = {0.f, 0.f, 0.f, 0.f};
        for (int k0 = 0; k0 < kc0; k0 += 16) {
            pg8::f32x4 sa[16], sb[16];
#pragma unroll
            for (int u = 0; u < 16; ++u) { const int k2 = k0 + u < kc0 ? k0 + u : kc0 - 1; sa[u] = *(const pg8::f32x4*)(CAR + (size_t)(b * 64 + k2) * DRNN + c0); sb[u] = *(const pg8::f32x4*)(CBR + (size_t)(b * 64 + k2) * DRNN + c0); }
#pragma unroll
            for (int u = 0; u < 16; ++u) if (k0 + u < kc0) {
#pragma unroll
                for (int e = 0; e < 4; ++e) h[e] = __builtin_amdgcn_exp2f(sa[u][e]) * h[e] + sb[u][e]; }
        }
#pragma unroll 1
        for (int r0 = 0; r0 < 128; r0 += 16) {
            SC_LOAD(lb_, ub_, gb_, r0 + 8) SC_SCAN(la_, ua_, ga_, r0)
            if (r0 + 16 < 128) { SC_LOAD(la_, ua_, ga_, r0 + 16) }
            SC_SCAN(lb_, ub_, gb_, r0 + 8)
        }
#undef SC_LOAD
#undef SC_SCAN
    }
    PHASE_END
    PHASE_BEGIN DECL_PTRS
    if (FAST(10)) {
        pg8::Gemm g{YA, PA_T, M, D, YA_LD}; pg8::StaticOrder S; S.init(M, D, G, (int)blockIdx.x);
        pg8::EpT1F E{GA, T1};
        pg8::gemm_phase<pg8::EpT1F, pg8::StaticOrder, true, true>(ldsl, g, S, E);
#if (REPMASK >> 10) & 1
        pg8::gemm_phase<pg8::EpT1F, pg8::StaticOrder, true, true>(ldsl, g, S, E);
#endif
    } else ngemm(ldsf, M, D, DRNN, ALbf{YA, YA_LD}, BLf32{proj_a, D}, EpT1{GA, T1});
    if (FAST(11)) {
        pg8::Gemm g{Q, PB_T, M, D, QW}; pg8::StaticOrder S; S.init(M, D, G, (int)blockIdx.x);
        pg8::EpMergedF E{GB, T1, MERGED};
        pg8::gemm_phase<pg8::EpMergedF, pg8::StaticOrder, true, true>(ldsl, g, S, E);
#if (REPMASK >> 11) & 1
        pg8::gemm_phase<pg8::EpMergedF, pg8::StaticOrder, true, true>(ldsl, g, S, E);
#endif
    } else ngemm(ldsf, M, D, QW, ALbf{Q, QW}, BLf32{proj_b, D}, EpMerged{GB, T1, MERGED});
    PHASE_END
    PHASE_BEGIN DECL_PTRS
    if (FAST(12)) {
        pg8::Gemm g{MERGED, WO_T, M, D, D}; pg8::StaticOrder S; S.init(M, D, G, (int)blockIdx.x);
        pg8::EpHF E{x, H, HB, SSQ};
        pg8::gemm_phase<pg8::EpHF, pg8::StaticOrder, true, true>(ldsl, g, S, E);
#if (REPMASK >> 12) & 1
        pg8::gemm_phase<pg8::EpHF, pg8::StaticOrder, true, true>(ldsl, g, S, E);
#endif
    } else ngemm(ldsf, M, D, D, ALbf{MERGED, D}, BLf32{w_out, D}, EpH{x, H, HB});
    PHASE_END
    PHASE_BEGIN DECL_PTRS
    if (FAST(14)) {
        pg8::Gemm g{HB, WMI_T, M, DFF, D}; pg8::StaticOrder S; S.init(M, DFF, G, (int)blockIdx.x);
        PG8_LAS float* rtab = (PG8_LAS float*)(ldsl + 131072);
        bool tab_ok;
        { pg8::Unit uu; int i = 0;
          for (; i < 16 && S.next(i, uu); ++i) if (tid < 256) { const float* sp = SSQ + (size_t)(uu.pm * 256 + tid) * 16;
                const pg8::f32x4 s0 = *(const pg8::f32x4*)sp, s1 = *(const pg8::f32x4*)(sp + 4), s2 = *(const pg8::f32x4*)(sp + 8), s3 = *(const pg8::f32x4*)(sp + 12); const pg8::f32x4 st = (s0 + s1) + (s2 + s3);
                rtab[i * 256 + tid] = rsqrtf(((st[0] + st[1]) + (st[2] + st[3])) * (1.f / D) + EPS); }
          tab_ok = !(i == 16 && S.next(16, uu)); }
        __syncthreads();
        pg8::EpZF E{tab_ok ? rtab : (PG8_LAS float*)nullptr, SSQ, ZACT};
        pg8::gemm_phase<pg8::EpZF, pg8::StaticOrder, true, true>(ldsl, g, S, E);
#if (REPMASK >> 14) & 1
        pg8::gemm_phase<pg8::EpZF, pg8::StaticOrder, true, true>(ldsl, g, S, E);
#endif
    } else ngemm(ldsf, M, DFF, D, ALbfScale{HB, D, norm_mlp}, BLf32{w_mlp_in, DFF}, EpZ{SSQ, ZACT});
    PHASE_END
    PHASE_BEGIN DECL_PTRS
    if (FAST(15)) {
        pg8::Gemm g{ZACT, WMO_T, M, D, DFF}; pg8::StaticOrder S; S.init(M, D, G, (int)blockIdx.x);
        pg8::EpOutF E{HB, H};
        pg8::gemm_phase<pg8::EpOutF, pg8::StaticOrder, true, true>(ldsl, g, S, E);
#if (REPMASK >> 15) & 1
        pg8::gemm_phase<pg8::EpOutF, pg8::StaticOrder, true, true>(ldsl, g, S, E);
#endif
    } else ngemm(ldsf, M, D, DFF, ALbf{ZACT, DFF}, BLf32{w_mlp_out, D}, EpOut{H});
    PHASE_END
}
constexpr int NPHASES = 11;

extern "C" void kernel_launch(void* const* d_in, const int* in_sizes, int n_in, void* d_out, int out_size, void* d_ws, size_t ws_size, hipStream_t stream) {
    static int grid = 0;
    if (grid == 0) {
        if (n_in != 27 || out_size != M * D || ws_size < WS_END) { fprintf(stderr, "kernel_launch: unexpected shapes n_in %d out %d ws %zu\n", n_in, out_size, ws_size); grid = -1; return; }
        int dev = 0, cus = 0, per_cu = 0;
        (void)hipGetDevice(&dev);
        (void)hipDeviceGetAttribute(&cus, hipDeviceAttributeMultiprocessorCount, dev);
        (void)hipFuncSetAttribute((const void*)fwd, hipFuncAttributeMaxDynamicSharedMemorySize, LDS_BYTES);
        (void)hipOccupancyMaxActiveBlocksPerMultiprocessor(&per_cu, (const void*)fwd, NTHREADS, LDS_BYTES);
        fprintf(stderr, "kernel_launch: cus %d per_cu %d ws_size %zu\n", cus, per_cu, ws_size);
        grid = cus;
    }
    if (grid < 0) return;
    if (hipMemsetAsync(d_ws, 0, 65536, stream) != hipSuccess) { fprintf(stderr, "kernel_launch: hipMemsetAsync failed\n"); return; }
    Args a{};
    for (int i = 0; i < 27; ++i) a.in[i] = (const float*)d_in[i];
    a.out = (float*)d_out; a.ws = (unsigned char*)d_ws; a.ph_lo = 0; a.ph_hi = NPHASES;
    void* args[] = {&a};
    hipError_t e = hipLaunchCooperativeKernel((const void*)fwd, dim3(grid), dim3(NTHREADS), args, LDS_BYTES, stream);
    if (e != hipSuccess) fprintf(stderr, "cooperative launch failed: %s (grid %d)\n", hipGetErrorString(e), grid);
}
```

```cpp
#include <hip/hip_runtime.h>
#include <hip/hip_cooperative_groups.h>
#include <cstdio>
#include <cstdint>
#ifndef FASTMASK
#define FASTMASK 0xFFFFFFFFu
#endif
#define FAST(p) ((FASTMASK >> (p)) & 1u)
namespace cg = cooperative_groups;

typedef unsigned short bf16_t;
constexpr int NTHREADS = 512;
constexpr int LDS_BYTES = 163840;
constexpr size_t MiB = 1u << 20;

constexpr int NB = 16, T = 2048, D = 1024, M = NB * T;
constexpr int DRNN = 1344, BW = 336, QW = 1024, KVW = 256, NH = 16, HD = 64, NG = 4;
constexpr int DIN = 7344, DFF = 4096, NC = 127, NSB = 32, CROWS = NB * NG * NC;
constexpr int C_URNN = 0, C_UGATE = 1344, C_Q = 2688, C_KV = 3712, C_GN = 5248, C_GA = 5296, C_GB = 6320;
constexpr float EPS = 1e-6f, LOG2E = 1.4426950408889634f;
constexpr int YA_LD = 1408, XC_LD = 384;

constexpr size_t WS_RSTD = 1 * MiB, WS_RSTD2 = 1 * MiB + 512 * 1024, WS_KCC = 2 * MiB, WS_VCC = 4 * MiB, WS_SEL = 6 * MiB;
constexpr size_t WS_URNN = 52 * MiB, WS_UGATE = 136 * MiB, WS_Q = 220 * MiB, WS_KV = 284 * MiB  , WS_GN = 380 * MiB, WS_GA = 384 * MiB, WS_GB = 448 * MiB, WS_END = 512 * MiB;
constexpr size_t WS_PES = 1 * MiB + 448 * 1024  , WS_NORMS = 1 * MiB + 384 * 1024, WS_LAMC = 1 * MiB + 256 * 1024, WS_SSQ = 6 * MiB + 512 * 1024  ;
constexpr size_t WS_WIN = 9 * MiB  , WS_WG = 24 * MiB  , WS_W1 = 27 * MiB  , WS_PA = 29 * MiB  , WS_PB = 32 * MiB, WS_WO = 34 * MiB, WS_WMI = 36 * MiB  , WS_WMO = 44 * MiB  ;
constexpr size_t DO_KCB = 104 * MiB  , DO_VCT = 105 * MiB  ;
constexpr size_t DO_VST = 72 * MiB, DO_VWT = 88 * MiB;
constexpr size_t DO_CAR = 112 * MiB, DO_CBR = 120 * MiB;
constexpr size_t DO_XB = 0;
constexpr size_t WS_LA = WS_URNN, WS_UP = WS_KV, WS_T1 = WS_URNN, WS_MERGED = WS_UGATE, WS_HB = WS_GA, WS_ZACT = 52 * MiB;
constexpr size_t DO_FLATK = 64 * MiB, DO_FLATV = 96 * MiB, DO_HIDK = 0, DO_HIDV = 4 * MiB, DO_XC = 0, DO_YA = 0;

__device__ __constant__ unsigned char BUCKET[128] = {0, 1, 2, 3, 4, 5, 6, 7, 8, 9, 10, 11, 12, 13, 14, 15, 16, 16, 16, 17, 17, 18, 18, 18, 19, 19, 19, 20, 20, 20, 20, 21, 21, 21, 21, 22, 22, 22, 22, 22, 23, 23, 23, 23, 23, 23, 24, 24, 24, 24, 24, 24, 25, 25, 25, 25, 25, 25, 25, 26, 26, 26, 26, 26, 26, 26, 26, 27, 27, 27, 27, 27, 27, 27, 27, 27, 27, 28, 28, 28, 28, 28, 28, 28, 28, 28, 28, 29, 29, 29, 29, 29, 29, 29, 29, 29, 29, 29, 29, 30, 30, 30, 30, 30, 30, 30, 30, 30, 30, 30, 30, 30, 30, 31, 31, 31, 31, 31, 31, 31, 31, 31, 31, 31, 31, 31, 31, 31};

__device__ __forceinline__ float bf2f(bf16_t v) { return __uint_as_float((unsigned)v << 16); }
__device__ __forceinline__ bf16_t f2bf(float f) { unsigned u = __float_as_uint(f); return (bf16_t)((u + 0x7fffu + ((u >> 16) & 1u)) >> 16); }
__device__ __forceinline__ float sigmoidf_(float x) { return 1.f / (1.f + __expf(-x)); }
__device__ __forceinline__ float gelu_tanh(float x) { const float u = 0.7978845608028654f * (x + 0.044715f * x * x * x); return 0.5f * x * (1.f + tanhf(u)); }
__device__ __forceinline__ float wave_sum(float v) {
#pragma unroll
    for (int o = 1; o < 64; o <<= 1) v += __shfl_xor(v, o);
    return v;
}

struct Args { const float* in[27]; float* out; unsigned char* ws; int ph_lo, ph_hi; };

template <class AL, class BL, class EP>
__device__ __forceinline__ void ngemm(float* lds, int Mm, int Nn, int Kk, const AL& A, const BL& Bf, const EP& E) {
    float* As = lds;
    float* Bs = lds + 16 * 132;
    const int tid = threadIdx.x, tx = tid & 31, ty = tid >> 5;
    const int tm = (Mm + 127) / 128, tn = (Nn + 127) / 128, ntiles = tm * tn;
    for (int tile = blockIdx.x; tile < ntiles; tile += gridDim.x) {
        const int m0 = (tile / tn) * 128, n0 = (tile % tn) * 128;
        float acc[8][4];
#pragma unroll
        for (int i = 0; i < 8; ++i)
#pragma unroll
            for (int j = 0; j < 4; ++j) acc[i][j] = 0.f;
        for (int k0 = 0; k0 < Kk; k0 += 16) {
            {
                const int m = m0 + (tid >> 2), kb = k0 + (tid & 3) * 4;
#pragma unroll
                for (int i = 0; i < 4; ++i) As[((tid & 3) * 4 + i) * 132 + (tid >> 2)] = (m < Mm && kb + i < Kk) ? A(m, kb + i) : 0.f;
                const int k = k0 + (tid >> 5), nb = n0 + (tid & 31) * 4;
#pragma unroll
                for (int i = 0; i < 4; ++i) Bs[(tid >> 5) * 132 + (tid & 31) * 4 + i] = (k < Kk && nb + i < Nn) ? Bf(k, nb + i) : 0.f;
            }
            __syncthreads();
#pragma unroll 2
            for (int kk = 0; kk < 16; ++kk) {
                float a[8], b[4];
#pragma unroll
                for (int i = 0; i < 8; ++i) a[i] = As[kk * 132 + ty * 8 + i];
#pragma unroll
                for (int j = 0; j < 4; ++j) b[j] = Bs[kk * 132 + tx * 4 + j];
#pragma unroll
                for (int i = 0; i < 8; ++i)
#pragma unroll
                    for (int j = 0; j < 4; ++j) acc[i][j] += a[i] * b[j];
            }
            __syncthreads();
        }
#pragma unroll
        for (int i = 0; i < 8; ++i)
#pragma unroll
            for (int j = 0; j < 4; ++j) { const int m = m0 + ty * 8 + i, n = n0 + tx * 4 + j; if (m < Mm && n < Nn) E(m, n, acc[i][j]); }
    }
}

struct ALbf { const bf16_t* p; int ld; __device__ __forceinline__ float operator()(int m, int k) const { return bf2f(p[(size_t)m * ld + k]); } };
struct ALbfScale { const bf16_t* p; int ld; const float* g; __device__ __forceinline__ float operator()(int m, int k) const { return bf2f(p[(size_t)m * ld + k]) * g[k]; } };
struct ALf32Scale { const float* p; int ld; const float* g; __device__ __forceinline__ float operator()(int m, int k) const { return p[(size_t)m * ld + k] * g[k]; } };
struct BLf32 { const float* p; int ld; __device__ __forceinline__ float operator()(int k, int n) const { return p[(size_t)k * ld + n]; } };
struct BLgate { const float* wa; const float* wx; __device__ __forceinline__ float operator()(int k, int n) const { return n < BW ? wa[k * BW + n] : wx[k * BW + n - BW]; } };

struct Ep1 {
    const float* rstd; bf16_t *urnn, *ugate, *q, *kv, *gn, *ga, *gb;
    __device__ __forceinline__ void operator()(int m, int n, float v) const {
        v *= rstd[m];
        if (n < C_UGATE) urnn[(size_t)m * DRNN + n] = f2bf(v);
        else if (n < C_Q) ugate[(size_t)m * DRNN + n - C_UGATE] = f2bf(gelu_tanh(v));
        else if (n < C_KV) q[(size_t)m * QW + n - C_Q] = f2bf(v);
        else if (n < C_GN) { const int c = n - C_KV; kv[(size_t)(c >> 8) * ((size_t)M * KVW) + (size_t)m * KVW + (c & 255)] = f2bf(v); }
        else if (n < C_GA) gn[(size_t)m * 48 + n - C_GN] = f2bf(sigmoidf_(v));
        else if (n < C_GB) ga[(size_t)m * D + n - C_GA] = f2bf(sigmoidf_(v));
        else gb[(size_t)m * D + n - C_GB] = f2bf(sigmoidf_(v));
    }
};
struct EpGelu { bf16_t* o; int ld; __device__ __forceinline__ void operator()(int m, int n, float v) const { o[(size_t)m * ld + n] = f2bf(gelu_tanh(v)); } };
struct EpGate {
    int nb; const float *ba, *bx, *lam; const bf16_t* xc; bf16_t *la, *up;
    __device__ __forceinline__ void operator()(int m, int n, float v) const {
        if (n < BW) { const int c = nb * BW + n; const float r = sigmoidf_(v + ba[c]); const float sp = log1pf(__expf(-lam[c])); la[(size_t)m * DRNN + c] = f2bf(-8.f * r * sp * LOG2E); }
        else { const int j = n - BW, c = nb * BW + j; const float i = sigmoidf_(v + bx[c]); up[(size_t)m * DRNN + c] = f2bf(i * bf2f(xc[(size_t)m * XC_LD + j])); }
    }
};
struct EpT1 { const bf16_t* g; bf16_t* o; __device__ __forceinline__ void operator()(int m, int n, float v) const { o[(size_t)m * D + n] = f2bf(bf2f(g[(size_t)m * D + n]) * v); } };
struct EpMerged { const bf16_t* g; const bf16_t* t1; bf16_t* o; __device__ __forceinline__ void operator()(int m, int n, float v) const { o[(size_t)m * D + n] = f2bf(bf2f(t1[(size_t)m * D + n]) + bf2f(g[(size_t)m * D + n]) * v); } };
struct EpH { const float* x; float* h; bf16_t* hb; __device__ __forceinline__ void operator()(int m, int n, float v) const { const float r = x[(size_t)m * D + n] + v; h[(size_t)m * D + n] = r; hb[(size_t)m * D + n] = f2bf(r); } };
struct EpZ { const float* ssq; bf16_t* z; __device__ __forceinline__ void operator()(int m, int n, float v) const { float s_ = 0.f; for (int i = 0; i < 16; ++i) s_ += ssq[(size_t)m * 16 + i]; v *= rsqrtf(s_ * (1.f / D) + EPS); v = v > 0.f ? v * v : 0.f; z[(size_t)m * DFF + n] = f2bf(v); } };
struct EpOut { float* o; __device__ __forceinline__ void operator()(int m, int n, float v) const { o[(size_t)m * D + n] += v; } };

namespace pg8 {
#define PG8_LAS __attribute__((address_space(3)))
typedef unsigned short bf16_t;
typedef short bf16x8 __attribute__((ext_vector_type(8)));
typedef float f32x4 __attribute__((ext_vector_type(4)));
typedef unsigned u32x4 __attribute__((ext_vector_type(4)));
constexpr int BM = 256, BK = 64, HALF = 128, HTB = HALF * BK * 2  , STAGE_BYTES = 8 * HTB, NXCD = 8, WGM = 4;

__host__ __device__ __forceinline__ int lds_byte(int r, int c) { const int st = (r >> 4) * 2 + (c >> 5), rr = r & 15, cc = c & 31, ob = rr * 64 + cc * 2; return st * 1024 + (ob ^ (((ob >> 9) & 1) << 5)); }
__host__ __device__ __forceinline__ void stage_rc(int b, int& R, int& C) { const int st = b / 1024, sb = b % 1024, swz = sb ^ (((sb >> 9) & 1) << 5); R = (st >> 1) * 16 + swz / 64; C = (st & 1) * 32 + (swz % 64) / 2; }
__host__ __device__ __forceinline__ int perm32(int rho) { const int n = rho >> 4, i = rho & 15; return 8 * (i >> 2) + 4 * n + (i & 3); }

struct Unit { int pm, pn, ord; };
struct Gemm { const bf16_t* A; const bf16_t* Bt; int M, N, K; };

struct StaticOrder {
    int nM, nN, nwg, G, c;
    __host__ __device__ void init(int M, int N, int G_, int c_) { nM = M / BM; nN = N / BM; nwg = nM * nN; G = G_; c = c_; }
    __host__ __device__ __forceinline__ bool next(int i, Unit& u) const {
        const long L = (long)i * G + c; if (L >= nwg) return false;
        int wgid = (int)L; { const int q = nwg / NXCD, r = nwg % NXCD, xcd = wgid % NXCD, off = wgid / NXCD; wgid = (xcd < r ? xcd * (q + 1) : r * (q + 1) + (xcd - r) * q) + off; }
        const int nig = WGM * nN, gid = wgid / nig, fm = gid * WGM, gsz = (nM - fm) < WGM ? (nM - fm) : WGM;
        u.pm = fm + ((wgid % nig) % gsz); u.pn = (wgid % nig) / gsz; u.ord = i; return true;
    }
    __device__ __forceinline__ void a_ready(const Unit&) const {}
    __device__ __forceinline__ void done(const Unit&) const {}
};

__device__ __forceinline__ unsigned cvt_pk_bf16(float lo, float hi) { unsigned r; asm volatile("v_cvt_pk_bf16_f32 %0, %1, %2" : "=v"(r) : "v"(lo), "v"(hi)); return r; }
typedef float f32x2 __attribute__((ext_vector_type(2)));
template <class Epi, class Sched, bool ALIGN_EPI = false, bool SP2 = false>
__device__ __forceinline__ void gemm_phase(PG8_LAS unsigned char* lds, const Gemm g, const Sched& S, const Epi& E) {
    const int tid = threadIdx.x, wid = __builtin_amdgcn_readfirstlane(tid >> 6), lane = tid & 63, wr = wid >> 2, wc = wid & 3, fr = lane & 15, fq = lane >> 4;
    const int K = g.K, nt = K / BK;
    unsigned voffA[2], voffB[2];
#pragma unroll
    for (int i = 0; i < 2; ++i) { int R, C; stage_rc(tid * 16 + i * 8192, R, C); const int Rb = Epi::PERM ? ((R & ~31) + perm32(R & 31)) : R;
        voffA[i] = (unsigned)(R * K + C) * 2u; voffB[i] = (unsigned)(Rb * K + C) * 2u; }
    const size_t kstep = (size_t)(BK * 2);
    const size_t hstep = (size_t)HALF * K * 2;
    const size_t tstep = 2 * hstep;
    const unsigned ldsw = (unsigned)wid * 1024u;
    const int aoff = lds_byte(wr * 64 + fr, fq * 8), boff = lds_byte(wc * 32 + fr, fq * 8);
#define PG8_SA(b, h) (((b) * 2 + (h)) * HTB)
#define PG8_SB(b, h) ((4 + (b) * 2 + (h)) * HTB)
#define PG8_STAGE(bufoff, gbase, voff) do { _Pragma("unroll") for (int _i = 0; _i < 2; ++_i) \
        __builtin_amdgcn_global_load_lds((const unsigned*)((const char*)(gbase) + (voff)[_i]), (PG8_LAS unsigned*)(lds + (bufoff) + ldsw + _i * 8192), 16, 0, 0); } while (0)
#define PG8_LDA(dst, b, h) do { _Pragma("unroll") for (int m = 0; m < 4; ++m) _Pragma("unroll") for (int k = 0; k < 2; ++k) dst[m][k] = *(const PG8_LAS bf16x8*)(lds + PG8_SA(b, h) + aoff + m * 2048 + k * 1024); } while (0)
#define PG8_LDB(dst, b, h) do { _Pragma("unroll") for (int n = 0; n < 2; ++n) _Pragma("unroll") for (int k = 0; k < 2; ++k) dst[n][k] = *(const PG8_LAS bf16x8*)(lds + PG8_SB(b, h) + boff + n * 2048 + k * 1024); } while (0)
#define PG8_MMA(ai, bj, At, Bt) do { __builtin_amdgcn_s_setprio(1); _Pragma("unroll") for (int m = 0; m < 4; ++m) _Pragma("unroll") for (int n = 0; n < 2; ++n) _Pragma("unroll") for (int k = 0; k < 2; ++k) \
        acc[ai][bj][m][n] = __builtin_amdgcn_mfma_f32_16x16x32_bf16(Bt[n][k], At[m][k], acc[ai][bj][m][n], 0, 0, 0); __builtin_amdgcn_s_setprio(0); } while (0)
#define PG8_WAIT_V(n) asm volatile("s_waitcnt vmcnt(" #n ")" ::: "memory")
#define PG8_WAIT_L(n) asm volatile("s_waitcnt lgkmcnt(" #n ")" ::: "memory")
#define PG8_BAR __builtin_amdgcn_s_barrier()
#define PG8_SCHED __builtin_amdgcn_sched_barrier(0)
    Unit cur, nxt; int ui = 0;
    if (!S.next(0, cur)) return;
    f32x4 acc[2][2][4][2];
#pragma unroll
    for (int a = 0; a < 2; ++a)
#pragma unroll
        for (int b = 0; b < 2; ++b)
#pragma unroll
            for (int m = 0; m < 4; ++m)
#pragma unroll
                for (int n = 0; n < 2; ++n) acc[a][b][m][n] = (f32x4){0.f, 0.f, 0.f, 0.f};
    bf16x8 At[4][2], B0[2][2], B1[2][2];
    const char* cA = (const char*)g.A + (size_t)cur.pm * tstep; const char* cB = (const char*)g.Bt + (size_t)cur.pn * tstep;
    S.a_ready(cur);
    if constexpr (SP2) {
        PG8_STAGE(PG8_SB(0, 0), cB, voffB); PG8_STAGE(PG8_SB(0, 1), cB + hstep, voffB); PG8_STAGE(PG8_SA(0, 0), cA, voffA); PG8_STAGE(PG8_SA(0, 1), cA + hstep, voffA);
        if (wr == 1) PG8_BAR;
        PG8_WAIT_V(2); PG8_BAR;
        PG8_STAGE(PG8_SB(1, 0), cB + kstep, voffB); PG8_STAGE(PG8_SA(1, 0), cA + kstep, voffA); PG8_STAGE(PG8_SB(1, 1), cB + hstep + kstep, voffB);
        PG8_WAIT_V(6); PG8_BAR;
    } else {
        PG8_STAGE(PG8_SB(0, 0), cB, voffB); PG8_STAGE(PG8_SA(0, 0), cA, voffA); PG8_STAGE(PG8_SB(0, 1), cB + hstep, voffB); PG8_STAGE(PG8_SA(0, 1), cA + hstep, voffA);
        if (wr == 1) PG8_BAR;
        PG8_WAIT_V(4); PG8_BAR;
        PG8_STAGE(PG8_SB(1, 0), cB + kstep, voffB); PG8_STAGE(PG8_SA(1, 0), cA + kstep, voffA); PG8_STAGE(PG8_SB(1, 1), cB + hstep + kstep, voffB);
        PG8_WAIT_V(6); PG8_BAR;
    }
    for (;;) {
        const bool has_next = S.next(ui + 1, nxt);
        const char* nA = has_next ? (const char*)g.A + (size_t)nxt.pm * tstep : cA; const char* nB = has_next ? (const char*)g.Bt + (size_t)nxt.pn * tstep : cB;
        for (int t = 0; t < nt; t += 2) {
            const bool last = (t == nt - 2);
            const char* a1 = cA + (size_t)(t + 1) * kstep;
            const char* a2 = last ? nA : cA + (size_t)(t + 2) * kstep; const char* b2 = last ? nB : cB + (size_t)(t + 2) * kstep;
            const char* a3 = a2 + kstep; const char* b3 = b2 + kstep;
            if (last && has_next) S.a_ready(nxt);
            if constexpr (SP2) {
            PG8_LDB(B0, 0, 0); PG8_LDB(B1, 0, 1); PG8_SCHED; PG8_LDA(At, 0, 0); PG8_STAGE(PG8_SA(1, 1), a1 + hstep, voffA);
            PG8_WAIT_V(8); PG8_WAIT_L(0); PG8_BAR; PG8_MMA(0, 0, At, B0); PG8_MMA(0, 1, At, B1); PG8_BAR; PG8_SCHED;
            PG8_LDA(At, 0, 1); PG8_STAGE(PG8_SB(0, 0), b2, voffB); PG8_STAGE(PG8_SB(0, 1), b2 + hstep, voffB); PG8_STAGE(PG8_SA(0, 0), a2, voffA);
            PG8_WAIT_V(8); PG8_WAIT_L(0); PG8_BAR; PG8_MMA(1, 0, At, B0); PG8_MMA(1, 1, At, B1); PG8_BAR; PG8_SCHED;
            PG8_LDB(B0, 1, 0); PG8_LDB(B1, 1, 1); PG8_SCHED; PG8_LDA(At, 1, 0); PG8_STAGE(PG8_SA(0, 1), a2 + hstep, voffA);
            PG8_WAIT_V(8); PG8_WAIT_L(0); PG8_BAR; PG8_MMA(0, 0, At, B0); PG8_MMA(0, 1, At, B1); PG8_BAR; PG8_SCHED;
            PG8_LDA(At, 1, 1); PG8_STAGE(PG8_SB(1, 0), b3, voffB); PG8_STAGE(PG8_SB(1, 1), b3 + hstep, voffB); PG8_STAGE(PG8_SA(1, 0), a3, voffA);
            PG8_WAIT_V(8); PG8_WAIT_L(0); PG8_BAR; PG8_MMA(1, 0, At, B0); PG8_MMA(1, 1, At, B1); PG8_BAR; PG8_SCHED;
            } else {
            PG8_LDB(B0, 0, 0); PG8_SCHED; PG8_LDA(At, 0, 0); PG8_STAGE(PG8_SA(1, 1), a1 + hstep, voffA);
            PG8_WAIT_L(8); PG8_BAR; PG8_WAIT_L(0); PG8_MMA(0, 0, At, B0); PG8_BAR; PG8_SCHED;
            PG8_LDB(B1, 0, 1); PG8_STAGE(PG8_SB(0, 0), b2, voffB);
            PG8_BAR; PG8_WAIT_L(0); PG8_MMA(0, 1, At, B1); PG8_BAR;
            PG8_LDA(At, 0, 1); PG8_STAGE(PG8_SA(0, 0), a2, voffA);
            PG8_BAR; PG8_WAIT_L(0); PG8_MMA(1, 0, At, B0); PG8_BAR; PG8_SCHED;
            PG8_STAGE(PG8_SB(0, 1), b2 + hstep, voffB);
            PG8_WAIT_V(6); PG8_BAR; PG8_MMA(1, 1, At, B1); PG8_BAR;
            PG8_LDB(B0, 1, 0); PG8_SCHED; PG8_LDA(At, 1, 0); PG8_STAGE(PG8_SA(0, 1), a2 + hstep, voffA);
            PG8_WAIT_L(8); PG8_BAR; PG8_WAIT_L(0); PG8_MMA(0, 0, At, B0); PG8_BAR; PG8_SCHED;
            PG8_LDB(B1, 1, 1); PG8_STAGE(PG8_SB(1, 0), b3, voffB);
            PG8_BAR; PG8_WAIT_L(0); PG8_MMA(0, 1, At, B1); PG8_BAR;
            PG8_LDA(At, 1, 1); PG8_STAGE(PG8_SA(1, 0), a3, voffA);
            PG8_BAR; PG8_WAIT_L(0); PG8_MMA(1, 0, At, B0); PG8_BAR; PG8_SCHED;
            PG8_STAGE(PG8_SB(1, 1), b3 + hstep, voffB);
            PG8_WAIT_V(6); PG8_BAR; PG8_MMA(1, 1, At, B1); PG8_BAR;
            }
        }
        if constexpr (ALIGN_EPI) { if (wr == 0) PG8_BAR; }
        if constexpr (!Epi::AFTER_DRAIN) { E(acc, cur, wr, wc, fr, fq); S.done(cur); }
        if (!has_next) break;
#pragma unroll
        for (int a = 0; a < 2; ++a)
#pragma unroll
            for (int b = 0; b < 2; ++b)
#pragma unroll
                for (int m = 0; m < 4; ++m)
#pragma unroll
                    for (int n = 0; n < 2; ++n) acc[a][b][m][n] = (f32x4){0.f, 0.f, 0.f, 0.f};
        cur = nxt; cA = nA; cB = nB; ++ui;
        if constexpr (ALIGN_EPI) { if (wr == 1) PG8_BAR; }
    }
    PG8_WAIT_V(0);
    if constexpr (!ALIGN_EPI) { if (wr == 0) PG8_BAR; }
    PG8_BAR;
    if constexpr (Epi::AFTER_DRAIN) { E.fused(acc, cur, wr, wc, fr, fq, lds, wid, lane); S.done(cur); }
#undef PG8_SA
#undef PG8_SB
#undef PG8_STAGE
#undef PG8_LDA
#undef PG8_LDB
#undef PG8_MMA
#undef PG8_WAIT_V
#undef PG8_WAIT_L
#undef PG8_BAR
#undef PG8_SCHED
}
}

namespace pg8 {
__device__ __forceinline__ float sigm(float x) { return __builtin_amdgcn_rcpf(1.f + __expf(-x)); }
__device__ __forceinline__ float gelu_t(float x) { const float u = 1.5957691216057308f * (x + 0.044715f * x * x * x); return x * __builtin_amdgcn_rcpf(1.f + __expf(-u)); }
__device__ __forceinline__ u32x4 pack8(const f32x4& a, const f32x4& b) { u32x4 w; w.x = cvt_pk_bf16(a[0], a[1]); w.y = cvt_pk_bf16(a[2], a[3]); w.z = cvt_pk_bf16(b[0], b[1]); w.w = cvt_pk_bf16(b[2], b[3]); return w; }
__device__ __forceinline__ void unpack8(const u32x4& w, f32x4& a, f32x4& b) {
    a[0] = __uint_as_float(w.x << 16); a[1] = __uint_as_float(w.x & 0xffff0000u); a[2] = __uint_as_float(w.y << 16); a[3] = __uint_as_float(w.y & 0xffff0000u);
    b[0] = __uint_as_float(w.z << 16); b[1] = __uint_as_float(w.z & 0xffff0000u); b[2] = __uint_as_float(w.w << 16); b[3] = __uint_as_float(w.w & 0xffff0000u); }

struct Ep1F {
    static constexpr bool PERM = true, AFTER_DRAIN = false;
    bf16_t *urnn, *ugate, *q, *kv, *gn, *ga; const PG8_LAS float* norms; bf16_t* flat; const PG8_LAS float* pes;
    __device__ __forceinline__ void operator()(const f32x4 (&acc)[2][2][4][2], const Unit& u, int wr, int wc, int fr, int fq) const {
        const int row0 = u.pm * BM + wr * 64 + fr, pn = u.pn;
        if (pn == 4 || pn == 5) {
            const PG8_LAS float* pe = pes + (pn - 4) * 2048; bf16_t* fl = flat + (size_t)(pn - 4) * 8192 * 2048;
#pragma unroll
            for (int ai = 0; ai < 2; ++ai)
#pragma unroll
                for (int m = 0; m < 4; ++m) { const int mt = row0 + ai * HALF + m * 16, b = mt >> 11, t = mt & (T - 1), c1 = t >> 4, l1 = t & 15; const size_t rb = (size_t)((b * 4 + wc) * NC + c1) * 2048;
#pragma unroll
                    for (int bj = 0; bj < 2; ++bj) { const int d0 = 32 * bj + 8 * fq; const f32x4 v0 = acc[ai][bj][m][0], v1 = acc[ai][bj][m][1];
                        if (c1 < NC) { const PG8_LAS float* p = pe + l1 * 64 + d0; *(u32x4*)(fl + rb + l1 * 64 + d0) = pack8(v0 + *(const PG8_LAS f32x4*)p, v1 + *(const PG8_LAS f32x4*)(p + 4)); }
                        if (c1 > 0) { const PG8_LAS float* p = pe + (l1 + 16) * 64 + d0; *(u32x4*)(fl + rb - 2048 + (l1 + 16) * 64 + d0) = pack8(v0 + *(const PG8_LAS f32x4*)p, v1 + *(const PG8_LAS f32x4*)(p + 4)); } } }
            return;
        }
        if (pn < 10) {
            const bool donorm = pn < 4 || pn == 6 || pn == 8; const PG8_LAS float* g = norms + (pn < 4 ? 0 : (pn == 6 ? 64 : 128)); const float sc = pn < 4 ? 0.125f * LOG2E : 1.f;
            bf16_t* base; int ld;
            if (pn < 4) { base = q + 256 * pn + 64 * wc + 8 * fq; ld = QW; } else { base = kv + (size_t)(pn - 4) * ((size_t)M * KVW) + 64 * wc + 8 * fq; ld = KVW; }
            f32x4 gv[2][2];
#pragma unroll
            for (int bj = 0; bj < 2; ++bj)
#pragma unroll
                for (int n = 0; n < 2; ++n) gv[bj][n] = donorm ? *(const PG8_LAS f32x4*)(g + 32 * bj + 8 * fq + 4 * n) : (f32x4){1.f, 1.f, 1.f, 1.f};
#pragma unroll
            for (int ai = 0; ai < 2; ++ai)
#pragma unroll
                for (int m = 0; m < 4; ++m) {
                    float ss = 0.f;
#pragma unroll
                    for (int bj = 0; bj < 2; ++bj)
#pragma unroll
                        for (int n = 0; n < 2; ++n) { const f32x4 v = acc[ai][bj][m][n]; ss += (v[0] * v[0] + v[1] * v[1]) + (v[2] * v[2] + v[3] * v[3]); }
                    ss += __shfl_xor(ss, 16); ss += __shfl_xor(ss, 32);
                    const float r = donorm ? rsqrtf(ss * (1.f / 64.f) + EPS) * sc : 1.f;
                    bf16_t* rowp = base + (size_t)(row0 + ai * HALF + m * 16) * ld;
#pragma unroll
                    for (int bj = 0; bj < 2; ++bj) *(u32x4*)(rowp + 32 * bj) = pack8(acc[ai][bj][m][0] * r * gv[bj][0], acc[ai][bj][m][1] * r * gv[bj][1]);
                }
        } else if (pn < 18) {
            bf16_t* base = ga + (pn < 14 ? (size_t)0 : (size_t)M * D) + 256 * ((pn - 10) & 3) + 32 * wc + 8 * fq;
#pragma unroll
            for (int ai = 0; ai < 2; ++ai)
#pragma unroll
                for (int m = 0; m < 4; ++m) { bf16_t* rowp = base + (size_t)(row0 + ai * HALF + m * 16) * D;
#pragma unroll
                    for (int bj = 0; bj < 2; ++bj) { f32x4 v0 = acc[ai][bj][m][0], v1 = acc[ai][bj][m][1];
#pragma unroll
                        for (int e = 0; e < 4; ++e) { v0[e] = sigm(v0[e]); v1[e] = sigm(v1[e]); }
                        *(u32x4*)(rowp + bj * HALF) = pack8(v0, v1); } }
        } else { seg3<0>(acc, pn, row0, wc, fq); seg3<1>(acc, pn, row0, wc, fq); }
    }
    template <int BJ> __device__ __forceinline__ void seg3(const f32x4 (&acc)[2][2][4][2], int pn, int row0, int wc, int fq) const {
        const int c = 256 * (pn - 18) + 128 * BJ + 32 * wc;
        if (c < 1344) { bf16_t* base = urnn + c + 8 * fq;
#pragma unroll
            for (int ai = 0; ai < 2; ++ai)
#pragma unroll
                for (int m = 0; m < 4; ++m) *(u32x4*)(base + (size_t)(row0 + ai * HALF + m * 16) * DRNN) = pack8(acc[ai][BJ][m][0], acc[ai][BJ][m][1]);
        } else if (c < 2688) { bf16_t* base = ugate + (c - 1344) + 8 * fq;
#pragma unroll
            for (int ai = 0; ai < 2; ++ai)
#pragma unroll
                for (int m = 0; m < 4; ++m) { f32x4 v0 = acc[ai][BJ][m][0], v1 = acc[ai][BJ][m][1];
#pragma unroll
                    for (int e = 0; e < 4; ++e) { v0[e] = gelu_t(v0[e]); v1[e] = gelu_t(v1[e]); }
                    *(u32x4*)(base + (size_t)(row0 + ai * HALF + m * 16) * DRNN) = pack8(v0, v1); }
        } else if (c + 8 * fq < 2736) { bf16_t* base = gn + (c - 2688) + 8 * fq;
#pragma unroll
            for (int ai = 0; ai < 2; ++ai)
#pragma unroll
                for (int m = 0; m < 4; ++m) { f32x4 v0 = acc[ai][BJ][m][0], v1 = acc[ai][BJ][m][1];
#pragma unroll
                    for (int e = 0; e < 4; ++e) { v0[e] = sigm(v0[e]); v1[e] = sigm(v1[e]); }
                    *(u32x4*)(base + (size_t)(row0 + ai * HALF + m * 16) * 48) = pack8(v0, v1); }
        }
    }
};
__device__ __forceinline__ void win_src(int ch, int& c0, int& cvalid) {
    const int tile = ch >> 3, l0 = (ch & 7) * 32, bj = l0 >> 7, wc = (l0 >> 5) & 3; cvalid = 32;
    if (tile < 4) c0 = C_Q + 256 * tile + 64 * wc + 32 * bj;
    else if (tile < 10) c0 = C_KV + 256 * (tile - 4) + 64 * wc + 32 * bj;
    else if (tile < 14) c0 = C_GA + 256 * (tile - 10) + l0;
    else if (tile < 18) c0 = C_GB + 256 * (tile - 14) + l0;
    else { const int c = 256 * (tile - 18) + l0; if (c < 2688) c0 = c; else if (c < 2736) { c0 = C_GN + c - 2688; cvalid = 2736 - c < 32 ? 2736 - c : 32; } else { c0 = 0; cvalid = 0; } }
}
constexpr int N1PAD = 29 * 256;

struct EpGeluF {
    static constexpr bool PERM = true, AFTER_DRAIN = false;
    bf16_t* O; int ldc;
    __device__ __forceinline__ void operator()(const f32x4 (&acc)[2][2][4][2], const Unit& u, int wr, int wc, int fr, int fq) const {
        const int row0 = u.pm * BM + wr * 64 + fr; bf16_t* base = O + wc * 32 + 8 * fq;
#pragma unroll
        for (int ai = 0; ai < 2; ++ai)
#pragma unroll
            for (int m = 0; m < 4; ++m) { bf16_t* rowp = base + (size_t)(row0 + ai * HALF + m * 16) * ldc;
#pragma unroll
                for (int bj = 0; bj < 2; ++bj) { f32x4 v0 = acc[ai][bj][m][0], v1 = acc[ai][bj][m][1];
#pragma unroll
                    for (int e = 0; e < 4; ++e) { v0[e] = gelu_t(v0[e]); v1[e] = gelu_t(v1[e]); }
                    *(u32x4*)(rowp + bj * HALF) = pack8(v0, v1); } }
    }
};
struct OrderC1 {
    int G, c;
    __device__ __forceinline__ bool next(int i, Unit& u) const { const int L = i * G + c; if (L >= 64) return false; u.pm = L; u.pn = L >> 5; u.ord = i; return true; }
    __device__ __forceinline__ void a_ready(const Unit&) const {}
    __device__ __forceinline__ void done(const Unit&) const {}
};
struct OrderGate {
    int G, c;
    __device__ __forceinline__ bool next(int i, Unit& u) const { const int L = i * G + c; if (L >= 4 * 128 * 3) return false; const int nb = L / 384, r = L % 384; u.pm = nb * 128 + r / 3; u.pn = nb * 3 + r % 3; u.ord = i; return true; }
    __device__ __forceinline__ void a_ready(const Unit&) const {}
    __device__ __forceinline__ void done(const Unit&) const {}
};
struct EpGateF {
    static constexpr bool PERM = true, AFTER_DRAIN = false;
    const float *ba, *bx, *lamc; const bf16_t* xc; bf16_t *la, *up;
    __device__ __forceinline__ void operator()(const f32x4 (&acc)[2][2][4][2], const Unit& u, int wr, int wc, int fr, int fq) const {
        const int nb = u.pn / 3, pn3 = u.pn % 3, ch0 = 128 * pn3 + 32 * wc + 8 * fq; if (ch0 >= BW) return;
        const int c0 = nb * BW + ch0, row0 = (u.pm & 127) * BM + wr * 64 + fr;
        const bf16_t* xcb = xc + (size_t)nb * ((size_t)M * XC_LD) + ch0; bf16_t* lab = la + c0; bf16_t* upb = up + c0;
        const f32x4 bav0 = *(const f32x4*)(ba + c0), bav1 = *(const f32x4*)(ba + c0 + 4), bxv0 = *(const f32x4*)(bx + c0), bxv1 = *(const f32x4*)(bx + c0 + 4), lcv0 = *(const f32x4*)(lamc + c0), lcv1 = *(const f32x4*)(lamc + c0 + 4);
        u32x4 xcv[2][4];
#pragma unroll
        for (int ai = 0; ai < 2; ++ai)
#pragma unroll
            for (int m = 0; m < 4; ++m) xcv[ai][m] = *(const u32x4*)(xcb + (unsigned)(row0 + ai * HALF + m * 16) * (unsigned)XC_LD);
#pragma unroll
        for (int ai = 0; ai < 2; ++ai)
#pragma unroll
            for (int m = 0; m < 4; ++m) { const unsigned row = (unsigned)(row0 + ai * HALF + m * 16);
                f32x4 x0, x1; unpack8(xcv[ai][m], x0, x1);
                f32x4 l0, l1, u0, u1;
#pragma unroll
                for (int e = 0; e < 4; ++e) {
                    l0[e] = sigm(acc[ai][0][m][0][e] + bav0[e]) * lcv0[e]; l1[e] = sigm(acc[ai][0][m][1][e] + bav1[e]) * lcv1[e];
                    u0[e] = sigm(acc[ai][1][m][0][e] + bxv0[e]) * x0[e];   u1[e] = sigm(acc[ai][1][m][1][e] + bxv1[e]) * x1[e]; }
                *(u32x4*)(lab + row * (unsigned)DRNN) = pack8(l0, l1); *(u32x4*)(upb + row * (unsigned)DRNN) = pack8(u0, u1);
                asm volatile("" ::: "memory"); }
    }
};
struct EpT1F {
    static constexpr bool PERM = true, AFTER_DRAIN = false;
    const bf16_t* g; bf16_t* o;
    __device__ __forceinline__ void operator()(const f32x4 (&acc)[2][2][4][2], const Unit& u, int wr, int wc, int fr, int fq) const {
        const int row0 = u.pm * BM + wr * 64 + fr, col0 = u.pn * BM + wc * 32 + 8 * fq;
        u32x4 gv[2][4][2];
#pragma unroll
        for (int ai = 0; ai < 2; ++ai)
#pragma unroll
            for (int m = 0; m < 4; ++m) { const size_t off = (size_t)(row0 + ai * HALF + m * 16) * D + col0;
#pragma unroll
                for (int bj = 0; bj < 2; ++bj) gv[ai][m][bj] = *(const u32x4*)(g + off + bj * HALF); }
#pragma unroll
        for (int ai = 0; ai < 2; ++ai)
#pragma unroll
            for (int m = 0; m < 4; ++m) { const size_t off = (size_t)(row0 + ai * HALF + m * 16) * D + col0;
#pragma unroll
                for (int bj = 0; bj < 2; ++bj) { f32x4 g0, g1; unpack8(gv[ai][m][bj], g0, g1);
                    *(u32x4*)(o + off + bj * HALF) = pack8(acc[ai][bj][m][0] * g0, acc[ai][bj][m][1] * g1); } }
    }
};
struct EpMergedF {
    static constexpr bool PERM = true, AFTER_DRAIN = false;
    const bf16_t* g; const bf16_t* t1; bf16_t* o;
    __device__ __forceinline__ void operator()(const f32x4 (&acc)[2][2][4][2], const Unit& u, int wr, int wc, int fr, int fq) const {
        const int row0 = u.pm * BM + wr * 64 + fr, col0 = u.pn * BM + wc * 32 + 8 * fq;
#pragma unroll
        for (int ai = 0; ai < 2; ++ai) {
            u32x4 gv[4][2], tv[4][2];
#pragma unroll
            for (int m = 0; m < 4; ++m) { const size_t off = (size_t)(row0 + ai * HALF + m * 16) * D + col0;
#pragma unroll
                for (int bj = 0; bj < 2; ++bj) { gv[m][bj] = *(const u32x4*)(g + off + bj * HALF); tv[m][bj] = *(const u32x4*)(t1 + off + bj * HALF); } }
#pragma unroll
            for (int m = 0; m < 4; ++m) { const size_t off = (size_t)(row0 + ai * HALF + m * 16) * D + col0;
#pragma unroll
                for (int bj = 0; bj < 2; ++bj) { f32x4 g0, g1, t0, t1v; unpack8(gv[m][bj], g0, g1); unpack8(tv[m][bj], t0, t1v);
                    *(u32x4*)(o + off + bj * HALF) = pack8(t0 + acc[ai][bj][m][0] * g0, t1v + acc[ai][bj][m][1] * g1); } }
            asm volatile("" ::: "memory");
        }
    }
};
struct EpHF {
    static constexpr bool PERM = true, AFTER_DRAIN = false;
    const float* x; float* h; bf16_t* hb; float* ssq;
    __device__ __forceinline__ void operator()(const f32x4 (&acc)[2][2][4][2], const Unit& u, int wr, int wc, int fr, int fq) const {
        const int row0 = u.pm * BM + wr * 64 + fr, col0 = u.pn * BM + wc * 32 + 8 * fq;
#pragma unroll
        for (int ai = 0; ai < 2; ++ai) {
            f32x4 xv[4][2][2];
#pragma unroll
            for (int m = 0; m < 4; ++m) { const size_t off = (size_t)(row0 + ai * HALF + m * 16) * D + col0;
#pragma unroll
                for (int bj = 0; bj < 2; ++bj) { xv[m][bj][0] = *(const f32x4*)(x + off + bj * HALF); xv[m][bj][1] = *(const f32x4*)(x + off + bj * HALF + 4); } }
#pragma unroll
            for (int m = 0; m < 4; ++m) { const size_t row = (size_t)(row0 + ai * HALF + m * 16), off = row * D + col0; float ss = 0.f;
#pragma unroll
                for (int bj = 0; bj < 2; ++bj) {
                    const f32x4 h0 = xv[m][bj][0] + acc[ai][bj][m][0], h1 = xv[m][bj][1] + acc[ai][bj][m][1];
                    *(u32x4*)(hb + off + bj * HALF) = pack8(h0, h1);
                    ss += (h0[0] * h0[0] + h0[1] * h0[1]) + (h0[2] * h0[2] + h0[3] * h0[3]) + (h1[0] * h1[0] + h1[1] * h1[1]) + (h1[2] * h1[2] + h1[3] * h1[3]); }
                ss += __shfl_xor(ss, 16); ss += __shfl_xor(ss, 32);
                if (fq == 0) ssq[row * 16 + 4 * u.pn + wc] = ss; }
            asm volatile("" ::: "memory");
        }
    }
};
struct EpZF {
    static constexpr bool PERM = true, AFTER_DRAIN = false;
    const PG8_LAS float* rtab; const float* ssq; bf16_t* z;
    __device__ __forceinline__ void operator()(const f32x4 (&acc)[2][2][4][2], const Unit& u, int wr, int wc, int fr, int fq) const {
        const int rl0 = wr * 64 + fr, row0 = u.pm * BM + rl0, col0 = u.pn * BM + wc * 32 + 8 * fq;
#pragma unroll
        for (int ai = 0; ai < 2; ++ai)
#pragma unroll
            for (int m = 0; m < 4; ++m) { const size_t row = (size_t)(row0 + ai * HALF + m * 16);
                float r;
                if (rtab) r = rtab[u.ord * 256 + rl0 + ai * HALF + m * 16];
                else { const f32x4 s0 = *(const f32x4*)(ssq + row * 16), s1 = *(const f32x4*)(ssq + row * 16 + 4), s2 = *(const f32x4*)(ssq + row * 16 + 8), s3 = *(const f32x4*)(ssq + row * 16 + 12);
                    const f32x4 st = (s0 + s1) + (s2 + s3); r = rsqrtf(((st[0] + st[1]) + (st[2] + st[3])) * (1.f / D) + EPS); }
#pragma unroll
                for (int bj = 0; bj < 2; ++bj) { f32x4 v0 = acc[ai][bj][m][0] * r, v1 = acc[ai][bj][m][1] * r;
#pragma unroll
                    for (int e = 0; e < 4; ++e) { v0[e] = v0[e] > 0.f ? v0[e] * v0[e] : 0.f; v1[e] = v1[e] > 0.f ? v1[e] * v1[e] : 0.f; }
                    *(u32x4*)(z + row * DFF + col0 + bj * HALF) = pack8(v0, v1); } }
    }
};
struct EpOutF {
    static constexpr bool PERM = true, AFTER_DRAIN = false;
    const bf16_t* hb; float* o;
    __device__ __forceinline__ void operator()(const f32x4 (&acc)[2][2][4][2], const Unit& u, int wr, int wc, int fr, int fq) const {
        const int row0 = u.pm * BM + wr * 64 + fr, col0 = u.pn * BM + wc * 32 + 8 * fq;
        u32x4 hv[2][4][2];
#pragma unroll
        for (int ai = 0; ai < 2; ++ai)
#pragma unroll
            for (int m = 0; m < 4; ++m) { const size_t off = (size_t)(row0 + ai * HALF + m * 16) * D + col0;
#pragma unroll
                for (int bj = 0; bj < 2; ++bj) hv[ai][m][bj] = *(const u32x4*)(hb + off + bj * HALF); }
#pragma unroll
        for (int ai = 0; ai < 2; ++ai)
#pragma unroll
            for (int m = 0; m < 4; ++m) { float* p = o + (size_t)(row0 + ai * HALF + m * 16) * D + col0;
#pragma unroll
                for (int bj = 0; bj < 2; ++bj) { f32x4 h0, h1; unpack8(hv[ai][m][bj], h0, h1); *(f32x4*)(p + bj * HALF) = h0 + acc[ai][bj][m][0]; *(f32x4*)(p + bj * HALF + 4) = h1 + acc[ai][bj][m][1]; } }
    }
};
}

namespace att {
using pg8::bf16x8; using pg8::f32x4; using pg8::u32x4;
typedef float f32x16 __attribute__((ext_vector_type(16)));
typedef short s16x4 __attribute__((ext_vector_type(4)));
typedef float f32x2_t __attribute__((ext_vector_type(2))); typedef __bf16 bf16x2_t __attribute__((ext_vector_type(2)));
constexpr int KROW = 144, VROW = 144, KT = 64 * KROW, VT = 64 * VROW;
__device__ __forceinline__ int vperm(int kv) { return (kv & ~12) | ((kv & 4) << 1) | ((kv & 8) >> 1); }
constexpr int L_K0 = 0, L_K1 = KT, L_V0 = 2 * KT, L_V1 = 2 * KT + VT, L_BT = 2 * KT + 2 * VT  , L_IMPG = L_BT + 4096 + 64, L_IMPL = L_IMPG + 33792, L_IMP = L_IMPL + 33792, L_SELM = L_IMP + 64 * 33 * 4, L_KC = L_SELM + 512  , VCROW = 272, L_VC = L_KC + 128 * KROW  , L_END = L_VC + 64 * VCROW;
static_assert(L_END <= 163840 - 512, "attention LDS map");
__device__ __forceinline__ int crow(int r, int hi) { return (r & 3) + 8 * (r >> 2) + 4 * hi; }
__device__ __forceinline__ float max3f(float a, float b, float c) { float r; asm("v_max3_f32 %0, %1, %2, %3" : "=v"(r) : "v"(a), "v"(b), "v"(c)); return r; }
__device__ __forceinline__ unsigned cvtpk(float lo, float hi) { f32x2_t v = {lo, hi}; bf16x2_t b = __builtin_convertvector(v, bf16x2_t); return __builtin_bit_cast(unsigned, b); }
__device__ __forceinline__ bf16x8 packp(const f32x16& p, int s) {
    u32x4 w; w.x = cvtpk(p[8 * s + 0], p[8 * s + 1]); w.y = cvtpk(p[8 * s + 2], p[8 * s + 3]); w.z = cvtpk(p[8 * s + 4], p[8 * s + 5]); w.w = cvtpk(p[8 * s + 6], p[8 * s + 7]);
    return __builtin_bit_cast(bf16x8, w); }
__device__ __forceinline__ bf16x8 kfrag(const unsigned char* kbuf, int st, int sp, int q32, int hi) { return *(const bf16x8*)(kbuf + (32 * st + q32) * KROW + (16 * sp + 8 * hi) * 2); }
__device__ __forceinline__ bf16x8 vfrag(const unsigned char* vbuf, int st, int s, int dt, int q32, int hi) { return *(const bf16x8*)(vbuf + (32 * dt + q32) * VROW + (32 * st + 16 * s + 8 * hi) * 2); }
__device__ __forceinline__ f32x16 qk_tile(const unsigned char* kbuf, int st, const bf16x8 (&qf)[4], int q32, int hi) {
    f32x16 s = {};
#pragma unroll
    for (int sp = 0; sp < 4; ++sp) s = __builtin_amdgcn_mfma_f32_32x32x16_bf16(kfrag(kbuf, st, sp, q32, hi), qf[sp], s, 0, 0, 0);
    return s; }
__device__ __forceinline__ void pv_tile(f32x16 (&o)[2], const unsigned char* vbuf, int st, const f32x16& p, int q32, int hi) {
#pragma unroll
    for (int s = 0; s < 2; ++s) { const bf16x8 pb = packp(p, s);
#pragma unroll
        for (int dt = 0; dt < 2; ++dt) o[dt] = __builtin_amdgcn_mfma_f32_32x32x16_bf16(vfrag(vbuf, st, s, dt, q32, hi), pb, o[dt], 0, 0, 0); }
}
struct Stage { u32x4 k, v; };
__device__ __forceinline__ void stage_load(Stage& s, const bf16_t* Kblk  , int ldk, const bf16_t* Vblk  , int ldv, int tid) {
    const int row = tid >> 3, ch = tid & 7;
    s.k = *(const u32x4*)(Kblk + (size_t)row * ldk + ch * 8); s.v = *(const u32x4*)(Vblk + (size_t)row * ldv + ch * 8); }
__device__ __forceinline__ void stage_store(const Stage& s, unsigned char* kbuf, unsigned char* vbuf, int tid) {
    const int row = tid >> 3, ch = tid & 7;
    *(u32x4*)(kbuf + row * KROW + ch * 16) = s.k;
    *(u32x4*)(vbuf + row * VROW + ch * 16) = s.v; }

struct SoftState { float mhat, l; f32x16 cneg; };
constexpr float ATT_THR = 8.0f;
template <int BR, int ABL>
__device__ __forceinline__ void block64(f32x16 (&o)[2], SoftState& ss, const unsigned char* kbuf, const unsigned char* vbuf, int dj, bool selbit, bool anyunsel, const bf16x8 (&qf)[4], const float* bt2,
                                        int q32, int hi, int tl) {
    f32x16 s0, s1;
    if (ABL & 64) { s0 = f32x16{}; s1 = f32x16{}; }
    else { s0 = ss.cneg; s1 = ss.cneg; }
    bf16x8 vf0[2][2], vf1[2][2];
#define ATT_BIAS(S_, KT_) do { if (dj <= 2) { const float* bt_ = bt2 + (64 * dj + tl + 64 - 4 * hi - 27) - 32 * (KT_); \
            _Pragma("unroll") for (int r = 0; r < 16; ++r) { const int cr = (r & 3) + 8 * (r >> 2); S_[r] += bt_[27 - cr]; } \
        } else if (BR == 1 && dj == 8) { const int basei = tl - 4 * hi; \
            _Pragma("unroll") for (int r = 0; r < 16; ++r) { const int cr = (r & 3) + 8 * (r >> 2); S_[r] += __int_as_float(((cr + 32 * (KT_) - basei - 1) >> 31) & 0xf149f2cau); } } } while (0)
    if (ABL & 64) {
#pragma unroll
        for (int sp = 0; sp < 4; ++sp) s0 = __builtin_amdgcn_mfma_f32_32x32x16_bf16(kfrag(kbuf, 0, sp, q32, hi), qf[sp], s0, 0, 0, 0);
        __builtin_amdgcn_sched_barrier(0);
#pragma unroll
        for (int s = 0; s < 2; ++s)
#pragma unroll
            for (int dt = 0; dt < 2; ++dt) vf0[s][dt] = vfrag(vbuf, 0, s, dt, q32, hi);
        __builtin_amdgcn_sched_barrier(0);
        bf16x8 k1[4];
#pragma unroll
        for (int sp = 0; sp < 4; ++sp) k1[sp] = kfrag(kbuf, 1, sp, q32, hi);
        __builtin_amdgcn_sched_barrier(0);
        ATT_BIAS(s0, 0);
#pragma unroll
        for (int sp = 0; sp < 4; ++sp) { s1 = __builtin_amdgcn_mfma_f32_32x32x16_bf16(k1[sp], qf[sp], s1, 0, 0, 0);
#pragma unroll
            for (int e = 0; e < 4; ++e) s0[4 * sp + e] = __builtin_amdgcn_exp2f(s0[4 * sp + e]);
            __builtin_amdgcn_sched_barrier(0); }
        ATT_BIAS(s1, 1);
    } else {
#pragma unroll
    for (int sp = 0; sp < 4; ++sp) { s0 = __builtin_amdgcn_mfma_f32_32x32x16_bf16(kfrag(kbuf, 0, sp, q32, hi), qf[sp], s0, 0, 0, 0); s1 = __builtin_amdgcn_mfma_f32_32x32x16_bf16(kfrag(kbuf, 1, sp, q32, hi), qf[sp], s1, 0, 0, 0); }
    __builtin_amdgcn_sched_barrier(0);
#pragma unroll
    for (int s = 0; s < 2; ++s)
#pragma unroll
        for (int dt = 0; dt < 2; ++dt) vf0[s][dt] = vfrag(vbuf, 0, s, dt, q32, hi);
    __builtin_amdgcn_sched_barrier(0);
    ATT_BIAS(s0, 0); ATT_BIAS(s1, 1);
    }
#undef ATT_BIAS
    if (!(ABL & 64)) {
    float rm = max3f(s0[0], s0[1], s1[0]), rm2 = max3f(s0[2], s0[3], s1[1]);
    rm = max3f(rm, s1[2], s1[3]);
#pragma unroll
    for (int r = 4; r < 16; r += 4) { rm = max3f(rm, s0[r], s0[r + 1]); rm2 = max3f(rm2, s0[r + 2], s0[r + 3]); rm = max3f(rm, s1[r], s1[r + 1]); rm2 = max3f(rm2, s1[r + 2], s1[r + 3]); }
    rm = max3f(rm, rm2, rm2);
    if (BR == 0) rm = selbit ? rm : -1e30f;
    if (__any(rm > ATT_THR)) {
        const float rmc = fmaxf(rm, __shfl_xor(rm, 32)), dl = fmaxf(rmc, 0.f), f = __builtin_amdgcn_exp2f(-dl);
        ss.mhat += dl; ss.l *= f;
#pragma unroll
        for (int r = 0; r < 16; ++r) { s0[r] -= dl; s1[r] -= dl; ss.cneg[r] -= dl; o[0][r] *= f; o[1][r] *= f; }
    }
    }
    float ps = 0.f, ps1 = 0.f, ps2 = 0.f, ps3 = 0.f;
#pragma unroll
    for (int r = 0; r < 16; r += 2) { if (!(ABL & 64)) { s0[r] = __builtin_amdgcn_exp2f(s0[r]); s0[r + 1] = __builtin_amdgcn_exp2f(s0[r + 1]); } ps += s0[r]; ps2 += s0[r + 1]; }
    const unsigned pm = (BR == 0 && !selbit) ? 0u : 0xffffffffu;
    bf16x8 pb0[2];
#pragma unroll
    for (int s = 0; s < 2; ++s) { pb0[s] = packp(s0, s);
        if (BR == 0 && anyunsel) { u32x4 w = __builtin_bit_cast(u32x4, pb0[s]); w.x &= pm; w.y &= pm; w.z &= pm; w.w &= pm; pb0[s] = __builtin_bit_cast(bf16x8, w); } }
    __builtin_amdgcn_sched_barrier(0);
#pragma unroll
    for (int i = 0; i < 4; ++i) { const int s = i >> 1, dt = i & 1;
        o[dt] = __builtin_amdgcn_mfma_f32_32x32x16_bf16(vf0[s][dt], pb0[s], o[dt], 0, 0, 0);
#pragma unroll
        for (int e = 0; e < 4; ++e) s1[4 * i + e] = __builtin_amdgcn_exp2f(s1[4 * i + e]);
        __builtin_amdgcn_sched_barrier(0); }
#pragma unroll
    for (int s = 0; s < 2; ++s)
#pragma unroll
        for (int dt = 0; dt < 2; ++dt) vf1[s][dt] = vfrag(vbuf, 1, s, dt, q32, hi);
#pragma unroll
    for (int r = 0; r < 16; r += 2) { ps1 += s1[r]; ps3 += s1[r + 1]; }
    ps = (ps + ps1) + (ps2 + ps3);
    if (BR == 0) ps = selbit ? ps : 0.f;
    ss.l += ps;
#pragma unroll
    for (int s = 0; s < 2; ++s) { bf16x8 pb = packp(s1, s);
        if (BR == 0 && anyunsel) { u32x4 w = __builtin_bit_cast(u32x4, pb); w.x &= pm; w.y &= pm; w.z &= pm; w.w &= pm; pb = __builtin_bit_cast(bf16x8, w); }
#pragma unroll
        for (int dt = 0; dt < 2; ++dt) o[dt] = __builtin_amdgcn_mfma_f32_32x32x16_bf16(vf1[s][dt], pb, o[dt], 0, 0, 0); }
}
__device__ __forceinline__ void stage_load_t(Stage& s, const bf16_t* Kblk, const bf16_t* Vblk, int tid) {
    s.k = *(const u32x4*)(Kblk + (size_t)(tid >> 3) * KVW + (tid & 7) * 8); s.v = *(const u32x4*)(Vblk + (size_t)(tid & 63) * KVW + (tid >> 6) * 8); }
__device__ __forceinline__ void stage_store_t(const Stage& s, unsigned char* kbuf, unsigned char* vbuf, int tid) {
    const int row = tid >> 3, ch = tid & 7;
    *(u32x4*)(kbuf + row * KROW + ch * 16) = s.k;
    unsigned short* vp = (unsigned short*)(vbuf + ((tid >> 6) * 8) * VROW + vperm(tid & 63) * 2);
    vp[0 * (VROW / 2)] = (unsigned short)s.v.x; vp[1 * (VROW / 2)] = (unsigned short)(s.v.x >> 16); vp[2 * (VROW / 2)] = (unsigned short)s.v.y; vp[3 * (VROW / 2)] = (unsigned short)(s.v.y >> 16);
    vp[4 * (VROW / 2)] = (unsigned short)s.v.z; vp[5 * (VROW / 2)] = (unsigned short)(s.v.z >> 16); vp[6 * (VROW / 2)] = (unsigned short)s.v.w; vp[7 * (VROW / 2)] = (unsigned short)(s.v.w >> 16); }
template <int BR, int ABL>
__device__ __forceinline__ void branch(float* outl  , const Stage* first  , float gate, const bf16_t* Kg  , const bf16_t* Vg  ,
                                       int qblk, unsigned unionmask, unsigned mysel, const bf16x8 (&qf)[4], const float* bt2  , float cb  ,
                                       unsigned char* lds, int tid, int q32, int hi, int tl) {
    const int jlo = BR == 0 ? 0 : (qblk - 8 < 0 ? 0 : qblk - 8);
    f32x16 o[2]; o[0] = f32x16{}; o[1] = f32x16{};
    SoftState ss; ss.mhat = 0.f; ss.l = 0.f;
#pragma unroll
    for (int r = 0; r < 16; ++r) ss.cneg[r] = cb;
#define ATT_NEXT(jv) do { --(jv); if (BR == 0) { while ((jv) >= jlo && !((unionmask >> (jv)) & 1u)) --(jv); } } while (0)
#define ATT_LOAD(sg, jv) do { const int jl_ = (jv) < jlo ? jlo : (jv); if (!(ABL & 8)) stage_load_t(sg, Kg + (size_t)jl_ * 64 * KVW, Vg + (size_t)jl_ * 64 * KVW, tid); else { sg.k = (u32x4){(unsigned)jl_, 0u, 0u, 0u}; sg.v = sg.k; } } while (0)
#define ATT_SEL(jv) (BR == 0 ? (((mysel >> (jv)) & 1u) != 0u) : true)
    int jA = qblk, jB = qblk, jC;
    Stage sA, sB;
    if (first) sA = *first; else ATT_LOAD(sA, jA);
    ATT_NEXT(jB); ATT_LOAD(sB, jB);
    stage_store_t(sA, lds + L_K0, lds + L_V0, tid);
    __syncthreads();
    for (;;) {
        jC = jB; if (jB >= jlo) ATT_NEXT(jC);
        ATT_LOAD(sA, jC);
        { const bool sel = ATT_SEL(jA); if (BR == 1 || __any(sel)) block64<BR, ABL>(o, ss, lds + L_K0, lds + L_V0, qblk - jA, sel, BR == 0 && __any(!sel), qf, bt2, q32, hi, tl); }
        if (jB < jlo) break;
        if (!(ABL & 16)) stage_store_t(sB, lds + L_K1, lds + L_V1, tid);
        if (!(ABL & 4)) __syncthreads();
        jA = jC; if (jC >= jlo) ATT_NEXT(jA);
        ATT_LOAD(sB, jA);
        { const bool sel = ATT_SEL(jB); if (BR == 1 || __any(sel)) block64<BR, ABL>(o, ss, lds + L_K1, lds + L_V1, qblk - jB, sel, BR == 0 && __any(!sel), qf, bt2, q32, hi, tl); }
        if (jC < jlo) break;
        if (!(ABL & 16)) stage_store_t(sA, lds + L_K0, lds + L_V0, tid);
        if (!(ABL & 4)) __syncthreads();
        jB = jA; jA = jC;
    }
#undef ATT_NEXT
#undef ATT_LOAD
#undef ATT_SEL
    float lrun = ss.l; lrun += __shfl_xor(lrun, 32);
    const float f = gate / lrun;
#pragma unroll
    for (int r = 0; r < 16; ++r) { outl[r * 64] += o[0][r] * f; outl[(16 + r) * 64] += o[1][r] * f; }
    __syncthreads();
}

__device__ __forceinline__ void attn_bias_table(int g, const float* rel_bias, unsigned char* lds) {
    float* bt = (float*)(lds + L_BT); const int tid = threadIdx.x;
#pragma unroll
    for (int i = 0; i < 2; ++i) { const int e = tid + 512 * i, hh = e >> 8, ix = (e & 255) - 64; const float cbh = rel_bias[31 * NH + g * 4 + hh] * LOG2E; bt[e] = ix < 0 ? -1e30f : rel_bias[BUCKET[ix > 127 ? 127 : ix] * NH + g * 4 + hh] * LOG2E - cbh; }
    if (tid < 4) bt[1024 + tid] = rel_bias[31 * NH + g * 4 + tid] * LOG2E;
    __syncthreads();
}
__device__ __forceinline__ void attn_compress_l2(int bg, const bf16_t* HIDK, const bf16_t* HIDV, const float* w2k, const float* w2v, const float* kc_norm, unsigned char* lds) {
    const int tid = threadIdx.x, lane = tid & 63, wave = tid >> 6, q32 = lane & 31, hi = lane >> 5, which = wave >> 2, c = 32 * (wave & 3) + q32; const bool okc = c < NC;
    const bf16_t* hrow = (which ? HIDV : HIDK) + (size_t)(bg * NC + (okc ? c : 0)) * 256; const float* w2 = which ? w2v : w2k;
    f32x16 acc[2]; acc[0] = f32x16{}; acc[1] = f32x16{};
    for (int s = 0; s < 16; ++s) {
        const bf16x8 bfrag = *(const bf16x8*)(hrow + 16 * s + 8 * hi);
#pragma unroll
        for (int nt = 0; nt < 2; ++nt) { const float* wp = w2 + (size_t)(16 * s + 8 * hi) * HD + 32 * nt + q32;
            u32x4 aw; aw.x = cvtpk(wp[0], wp[HD]); aw.y = cvtpk(wp[2 * HD], wp[3 * HD]); aw.z = cvtpk(wp[4 * HD], wp[5 * HD]); aw.w = cvtpk(wp[6 * HD], wp[7 * HD]);
            acc[nt] = __builtin_amdgcn_mfma_f32_32x32x16_bf16(__builtin_bit_cast(bf16x8, aw), bfrag, acc[nt], 0, 0, 0); }
    }
    if (which) {
        unsigned short* vp = (unsigned short*)(lds + L_VC) + vperm(c);
#pragma unroll
        for (int nt = 0; nt < 2; ++nt)
#pragma unroll
            for (int q = 0; q < 16; ++q) vp[(32 * nt + crow(q, hi)) * (VCROW / 2)] = okc ? (unsigned short)(cvtpk(acc[nt][q], 0.f) & 0xffffu) : (unsigned short)0;
    } else {
        float ss = 0.f;
#pragma unroll
        for (int nt = 0; nt < 2; ++nt)
#pragma unroll
            for (int q = 0; q < 16; ++q) ss += acc[nt][q] * acc[nt][q];
        ss += __shfl_xor(ss, 32); const float rn = okc ? rsqrtf(ss * (1.f / HD) + EPS) : 0.f;
#pragma unroll
        for (int nt = 0; nt < 2; ++nt)
#pragma unroll
            for (int rg = 0; rg < 4; ++rg) { const int n0 = 32 * nt + 8 * rg + 4 * hi; const f32x4 gk = *(const f32x4*)(kc_norm + n0);
                *(unsigned long long*)(lds + L_KC + c * KROW + n0 * 2) = (unsigned long long)cvtpk(acc[nt][4 * rg] * rn * gk[0], acc[nt][4 * rg + 1] * rn * gk[1]) | ((unsigned long long)cvtpk(acc[nt][4 * rg + 2] * rn * gk[2], acc[nt][4 * rg + 3] * rn * gk[3]) << 32); }
    }
    __syncthreads();
}
__device__ __forceinline__ bf16x8 vfragc(const unsigned char* vcbuf, int tile, int s, int dt, int q32, int hi) { return *(const bf16x8*)(vcbuf + (32 * dt + q32) * VCROW + (32 * tile + 16 * s + 8 * hi) * 2); }
template <int MODE, int ABL = 0>
__device__ __forceinline__ void attn_unit(int b, int g, int qblk, const bf16_t* Q, bf16_t* O, const bf16_t* KSb, const bf16_t* VSb, const bf16_t* KWb, const bf16_t* VWb,
                                          const bf16_t* GN, const float* rel_bias, unsigned char* lds) {
    int tid = threadIdx.x; asm volatile("" : "+v"(tid));
    const int lane = tid & 63, wave = tid >> 6, q32 = lane & 31, hi = lane >> 5, hr = wave >> 1, th = wave & 1, h = g * 4 + hr, tl = 32 * th + q32, t = 64 * qblk + tl, bg = b * 4 + g;
    const size_t m = (size_t)b * T + t;
    float* bt = (float*)(lds + L_BT); float* impg = (float*)(lds + L_IMPG); float* impl = (float*)(lds + L_IMPL); float* imp = (float*)(lds + L_IMP); unsigned* selm = (unsigned*)(lds + L_SELM);
    bf16x8 qf[4];
#pragma unroll
    for (int sp = 0; sp < 4; ++sp) qf[sp] = *(const bf16x8*)(Q + m * QW + h * HD + 16 * sp + 8 * hi);
    const float g0 = bf2f(GN[m * 48 + h * 3 + 0]), g1 = bf2f(GN[m * 48 + h * 3 + 1]), g2 = bf2f(GN[m * 48 + h * 3 + 2]);
    f32x16 out[2];
    {
        const float* bte = bt + hr * 256 + 64; const float cbh = bt[1024 + hr];
        const int ncv = t >= 31 ? ((t - 31) >> 4) + 1 : 0;
        f32x16 sc[4]; float mx = -1e20f;
#pragma unroll
        for (int tile = 0; tile < 4; ++tile) {
            sc[tile] = qk_tile(lds + L_KC, tile, qf, q32, hi);
            __builtin_amdgcn_sched_barrier(0);
#pragma unroll
            for (int r = 0; r < 16; ++r) { const int c = 32 * tile + crow(r, hi);
                int dist = t - 31 - 16 * c; const float pen = __int_as_float(((ncv - 1 - c) >> 31) & 0xf149f2cau);
                dist = dist < 0 ? 0 : (dist > 127 ? 127 : dist);
                const float v = (sc[tile][r] + (bte[dist] + cbh)) + pen; sc[tile][r] = v; mx = fmaxf(mx, v); }
            __builtin_amdgcn_sched_barrier(0);
        }
        mx = fmaxf(mx, __shfl_xor(mx, 32));
        float l = 0.f;
#pragma unroll
        for (int tile = 0; tile < 4; ++tile)
#pragma unroll
            for (int r = 0; r < 16; ++r) { const float p = __builtin_amdgcn_exp2f(sc[tile][r] - mx); sc[tile][r] = p; l += p; }
        l += __shfl_xor(l, 32);
        const float inv = l > 0.f ? 1.f / l : 0.f;
#pragma unroll
        for (int tile = 0; tile < 4; ++tile)
#pragma unroll
            for (int r = 0; r < 16; ++r) sc[tile][r] *= inv;
        __builtin_amdgcn_sched_barrier(0);
        if (qblk > 15)
#pragma unroll
        for (int tile = 0; tile < 4; ++tile)
#pragma unroll
            for (int rg = 0; rg < 4; ++rg) { const int j = 8 * tile + 2 * rg + hi;
                impg[(hr * 64 + tl) * 33 + j] = (sc[tile][4 * rg] + sc[tile][4 * rg + 1]) + (sc[tile][4 * rg + 2] + sc[tile][4 * rg + 3]);
                impl[(hr * 64 + tl) * 33 + j] = sc[tile][4 * rg + 3]; }
        __builtin_amdgcn_sched_barrier(0);
        f32x16 o[2]; o[0] = f32x16{}; o[1] = f32x16{};
#pragma unroll
        for (int tile = 0; tile < 4; ++tile) {
#pragma unroll
            for (int s = 0; s < 2; ++s) { const bf16x8 pb = packp(sc[tile], s);
#pragma unroll
                for (int dt = 0; dt < 2; ++dt) o[dt] = __builtin_amdgcn_mfma_f32_32x32x16_bf16(vfragc(lds + L_VC, tile, s, dt, q32, hi), pb, o[dt], 0, 0, 0); }
            __builtin_amdgcn_sched_barrier(0); }
#pragma unroll
        for (int r = 0; r < 16; ++r) { out[0][r] = o[0][r] * g0; out[1][r] = o[1][r] * g0; }
    }
    const bf16_t* Kgs = KSb + (size_t)b * T * KVW + g * HD; const bf16_t* Kgw = KWb + (size_t)b * T * KVW + g * HD;
    const bf16_t* Vgs = VSb + (size_t)b * T * KVW + g * HD; const bf16_t* Vgw = VWb + (size_t)b * T * KVW + g * HD;
    Stage sfirst; stage_load_t(sfirst, Kgs + (size_t)qblk * 64 * KVW, Vgs + (size_t)qblk * 64 * KVW, tid);
    unsigned mysel, uni;
    if (qblk > 15) {
    __syncthreads();
    {
        const int stl = tid >> 3, jq = tid & 7;
#pragma unroll
        for (int e = 0; e < 4; ++e) { const int j = 4 * jq + e; float s = 0.f;
#pragma unroll
            for (int r = 0; r < 4; ++r) { s += impg[(r * 64 + stl) * 33 + j]; if (j > 0) s += impl[(r * 64 + stl) * 33 + j - 1]; }
            imp[stl * 33 + j] = s; }
        __syncthreads();
        unsigned bits = 0u;
        {
            float iv[32];
#pragma unroll
            for (int k = 0; k < 32; ++k) iv[k] = imp[stl * 33 + k];
#pragma unroll
            for (int e = 0; e < 4; ++e) { const int j = 4 * jq + e; float vj = iv[0];
#pragma unroll
                for (int k = 1; k < 32; ++k) vj = (k == j) ? iv[k] : vj;
                int rank = 0;
#pragma unroll
                for (int k = 1; k < 30; ++k) { const bool cand = k <= qblk - 2; rank += (cand && (iv[k] > vj || (iv[k] == vj && k < j))) ? 1 : 0; }
                if (j == 0 || j == qblk - 1 || j == qblk) bits |= 1u << j; else if (j < qblk - 1 && rank < 13) bits |= 1u << j; }
        }
        bits |= __shfl_xor(bits, 1); bits |= __shfl_xor(bits, 2); bits |= __shfl_xor(bits, 4);
        if (jq == 0) selm[stl] = bits;
    }
    __syncthreads();
    mysel = selm[tl]; uni = selm[lane];
#pragma unroll
    for (int o = 1; o < 64; o <<= 1) uni |= __shfl_xor(uni, o);
    } else { mysel = uni = (1u << (qblk + 1)) - 1u; }
    float* outl = (float*)(lds + L_IMPG) + wave * 2048 + lane;
#pragma unroll
    for (int r = 0; r < 16; ++r) { outl[r * 64] = out[0][r]; outl[(16 + r) * 64] = out[1][r]; }
    if (MODE & 2) branch<0, ABL>(outl, &sfirst, g1, Kgs, Vgs, qblk, uni, mysel, qf, bt + hr * 256, bt[1024 + hr], lds, tid, q32, hi, tl);
    if (MODE & 4) branch<1, ABL>(outl, nullptr, g2, Kgw, Vgw, qblk, 0xffffffffu, 0xffffffffu, qf, bt + hr * 256, bt[1024 + hr], lds, tid, q32, hi, tl);
    bf16_t* orow = O + m * QW + h * HD;
#pragma unroll
    for (int dt = 0; dt < 2; ++dt)
#pragma unroll
        for (int rg = 0; rg < 4; ++rg)
            *(unsigned long long*)(orow + 32 * dt + 8 * rg + 4 * hi) = (unsigned long long)cvtpk(outl[(16 * dt + 4 * rg) * 64], outl[(16 * dt + 4 * rg + 1) * 64]) | ((unsigned long long)cvtpk(outl[(16 * dt + 4 * rg + 2) * 64], outl[(16 * dt + 4 * rg + 3) * 64]) << 32);
}
}

__device__ __forceinline__ void tr_item(const float* W, int ldw, int kvalid, int c0, int cvalid, const float* kscale, bf16_t* WT, int ldt, int r0, int k0, float* scr, int lane) {
#pragma unroll
    for (int i = 0; i < 32; ++i) { const int kk = 2 * i + (lane >> 5), col = lane & 31, k = k0 + kk;
        float v = 0.f; if (k < kvalid && col < cvalid) { v = W[(size_t)k * ldw + c0 + col]; if (kscale) v *= kscale[k]; }
        scr[kk * 33 + col] = v; }
    asm volatile("s_waitcnt lgkmcnt(0)" ::: "memory");
    const int c = lane & 7;
#pragma unroll
    for (int j = 0; j < 4; ++j) { const int n = (lane >> 3) + 8 * j; const float* s = scr + (8 * c) * 33 + n;
        pg8::u32x4 o; o.x = pg8::cvt_pk_bf16(s[0 * 33], s[1 * 33]); o.y = pg8::cvt_pk_bf16(s[2 * 33], s[3 * 33]); o.z = pg8::cvt_pk_bf16(s[4 * 33], s[5 * 33]); o.w = pg8::cvt_pk_bf16(s[6 * 33], s[7 * 33]);
        *(pg8::u32x4*)(WT + (size_t)(r0 + n) * ldt + k0 + 8 * c) = o; }
    asm volatile("s_waitcnt lgkmcnt(0)" ::: "memory");
}

#define LAS __attribute__((address_space(3)))
#define XB_TMO      128
#define XB_XCNT(j)  (256  + 64 * (j))
#define XB_XSUB(j)  (1280 + 64 * (j))
#define XB_XGEN(j)  (2304 + 64 * (j))
#define XB_TOP      3328
#define XB_TOPGEN   3392
#define XCD_BAR_WORDS 3456
#define XB_SPIN_CAP (1u << 18)

__device__ __forceinline__ unsigned xb_ld(unsigned* p)              { return __hip_atomic_load(p, __ATOMIC_RELAXED, __HIP_MEMORY_SCOPE_AGENT); }
__device__ __forceinline__ unsigned xb_add(unsigned* p, unsigned v) { return __hip_atomic_fetch_add(p, v, __ATOMIC_RELAXED, __HIP_MEMORY_SCOPE_AGENT); }
__device__ __forceinline__ unsigned xb_xcc_id() { return (unsigned)__builtin_amdgcn_s_getreg((3 << 11) | 20) & 0xFu; }
#define XB_SPIN(cond, bar) do { unsigned _sp = 0; while (cond) { __builtin_amdgcn_s_sleep(1); \
    if ((++_sp & 255u) == 0u) { if (xb_ld(&(bar)[XB_TMO])) break; if (_sp > XB_SPIN_CAP) { atomicAdd(&(bar)[XB_TMO], 1u); break; } } } } while (0)

struct XcdBarrier {
    unsigned* bar; unsigned x;
    volatile LAS unsigned* st;
};

__device__ __forceinline__ XcdBarrier xcd_barrier_post(unsigned* bar, volatile LAS unsigned* st) {
    XcdBarrier b; b.bar = bar; b.x = xb_xcc_id(); b.st = st;
    if (threadIdx.x == 0) (void)xb_add(&bar[XB_XCNT(b.x)], 1u);
    return b;
}
__device__ __forceinline__ void xcd_barrier_complete(unsigned* bar, unsigned x, unsigned& nloc, unsigned& nx) {
    const unsigned G = gridDim.x * gridDim.y * gridDim.z;
    unsigned sum, cnt, mine, sp = 0u;
    for (;;) {
        sum = 0u; cnt = 0u; mine = 0u;
#pragma unroll
        for (unsigned j = 0; j < 16; ++j) { const unsigned c = xb_ld(&bar[XB_XCNT(j)]); sum += c; cnt += (c > 0u) ? 1u : 0u; mine = (j == x) ? c : mine; }
        if (sum == G) break;
        __builtin_amdgcn_s_sleep(1);
        if ((++sp & 255u) == 0u) { if (xb_ld(&bar[XB_TMO])) break; if (sp > XB_SPIN_CAP) { atomicAdd(&bar[XB_TMO], 1u); break; } }
    }
    nloc = mine > 0u ? mine : 1u; nx = cnt > 0u ? cnt : 1u;
}

__device__ __forceinline__ void xcd_barrier(const XcdBarrier& b) {
    asm volatile("s_waitcnt vmcnt(0)" ::: "memory");
    __syncthreads();
    if (threadIdx.x == 0) {
        unsigned* bar = b.bar;
        __builtin_amdgcn_s_waitcnt(0);
        unsigned nloc = b.st[0], nx = b.st[1];
        if (nloc == 0u) { xcd_barrier_complete(bar, b.x, nloc, nx); b.st[0] = nloc; b.st[1] = nx; }
        const unsigned old = xb_add(&bar[XB_XSUB(b.x)], 1u);
        const unsigned gen = old / nloc;
        if (old + 1u == (gen + 1u) * nloc) {
            __builtin_amdgcn_fence(__ATOMIC_RELEASE, "agent");
            asm volatile("s_waitcnt vmcnt(0)" ::: "memory");
            const unsigned og = xb_add(&bar[XB_TOP], 1u);
            const unsigned tg = og / nx;
            if (og + 1u == (tg + 1u) * nx) xb_add(&bar[XB_TOPGEN], 1u);
            else XB_SPIN(xb_ld(&bar[XB_TOPGEN]) == tg, bar);
            __builtin_amdgcn_fence(__ATOMIC_ACQUIRE, "agent");
            xb_add(&bar[XB_XGEN(b.x)], 1u);
            asm volatile("s_waitcnt vmcnt(0)" ::: "memory");
        } else {
            XB_SPIN(xb_ld(&bar[XB_XGEN(b.x)]) == gen, bar);
            __builtin_amdgcn_fence(__ATOMIC_ACQUIRE, "agent");
            asm volatile("s_waitcnt vmcnt(0)" ::: "memory");
        }
    }
    __syncthreads();
}

#define DECL_PTRS \
    size_t zoff_ = 0; asm volatile("" : "+s"(zoff_));     \
    unsigned char* ws = a.ws + zoff_; unsigned char* dob = (unsigned char*)a.out + zoff_; \
    const float *x = a.in[0], *norm_mix = a.in[1], *w_in = a.in[2], *conv_w = a.in[3], *conv_b = a.in[4], *gate_a_w = a.in[5], *gate_a_b = a.in[6], *gate_x_w = a.in[7], *gate_x_b = a.in[8], \
                *lam = a.in[9], *pe_k = a.in[10], *w1k = a.in[11], *w2k = a.in[12], *pe_v = a.in[13], *w1v = a.in[14], *w2v = a.in[15], *q_norm = a.in[16], *kc_norm = a.in[17], *ks_norm = a.in[18], \
                *kw_norm = a.in[19], *rel_bias = a.in[20], *proj_a = a.in[21], *proj_b = a.in[22], *w_out = a.in[23], *norm_mlp = a.in[24], *w_mlp_in = a.in[25], *w_mlp_out = a.in[26]; \
    float* RSTD = (float*)(ws + WS_RSTD); float* KCC = (float*)(ws + WS_KCC); float* VCC = (float*)(ws + WS_VCC); unsigned* SEL = (unsigned*)(ws + WS_SEL); \
    bf16_t *URNN = (bf16_t*)(ws + WS_URNN), *UGATE = (bf16_t*)(ws + WS_UGATE), *Q = (bf16_t*)(ws + WS_Q), *KV = (bf16_t*)(ws + WS_KV), *GN = (bf16_t*)(ws + WS_GN), *GA = (bf16_t*)(ws + WS_GA), *GB = (bf16_t*)(ws + WS_GB); \
    bf16_t *KCr = KV, *VCr = KV + (size_t)M * KVW, *KS = KV + 2 * (size_t)M * KVW, *VS = KV + 3 * (size_t)M * KVW, *KW = KV + 4 * (size_t)M * KVW, *VW = KV + 5 * (size_t)M * KVW; \
    bf16_t *LA = (bf16_t*)(ws + WS_LA), *UP = (bf16_t*)(ws + WS_UP), *T1 = (bf16_t*)(ws + WS_T1), *MERGED = (bf16_t*)(ws + WS_MERGED), *HB = (bf16_t*)(ws + WS_HB), *ZACT = (bf16_t*)(ws + WS_ZACT); \
    bf16_t *FLATK = (bf16_t*)(dob + DO_FLATK), *FLATV = (bf16_t*)(dob + DO_FLATV), *HIDK = (bf16_t*)(dob + DO_HIDK), *HIDV = (bf16_t*)(dob + DO_HIDV), *XC = (bf16_t*)(dob + DO_XC), *YA = (bf16_t*)(dob + DO_YA); \
    float* H = (float*)dob; \
    float* LAMC = (float*)(ws + WS_LAMC); float* NORMS = (float*)(ws + WS_NORMS); float* PES = (float*)(ws + WS_PES); float* SSQ = (float*)(ws + WS_SSQ); \
    bf16_t *WIN_T = (bf16_t*)(ws + WS_WIN), *WG_T = (bf16_t*)(ws + WS_WG), *W1_T = (bf16_t*)(ws + WS_W1), *PA_T = (bf16_t*)(ws + WS_PA), *PB_T = (bf16_t*)(ws + WS_PB), *WO_T = (bf16_t*)(ws + WS_WO), *WMI_T = (bf16_t*)(ws + WS_WMI), *WMO_T = (bf16_t*)(ws + WS_WMO); \
    float *CAR = (float*)(dob + DO_CAR), *CBR = (float*)(dob + DO_CBR); \
    bf16_t* XB = (bf16_t*)(dob + DO_XB); bf16_t *KCB = (bf16_t*)(dob + DO_KCB), *VCT = (bf16_t*)(dob + DO_VCT), *VST = (bf16_t*)(dob + DO_VST), *VWT = (bf16_t*)(dob + DO_VWT); \
    (void)0;
__global__ void __launch_bounds__(NTHREADS, 2) fwd(Args a) {
    extern __shared__ __attribute__((aligned(16))) unsigned char lds[];
    float* ldsf = (float*)lds;
    const int tid = threadIdx.x, lane = tid & 63, wave = tid >> 6;
    const int gw = blockIdx.x * 8 + wave, NGW = gridDim.x * 8;
#define gtid ((size_t)blockIdx.x * NTHREADS + threadIdx.x)
#define GSZ ((size_t)gridDim.x * NTHREADS)
    unsigned char* ws0 = a.ws;
    PG8_LAS unsigned char* ldsl = (PG8_LAS unsigned char*)lds;
    const int G = gridDim.x;
    const int lo = a.ph_lo, hi = a.ph_hi;
    volatile LAS unsigned* MISC = (volatile LAS unsigned*)((LAS unsigned char*)lds + LDS_BYTES - 256);
    if (tid < 32) MISC[tid] = 0u;
    __syncthreads();
    XcdBarrier bar = xcd_barrier_post((unsigned*)(ws0 + 16384), MISC + 8);
    int ph = 0;
#ifndef PHMASK
#define PHMASK 0xFFFFFFFFu
#endif
#ifndef REPMASK
#define REPMASK 0u
#endif
#define PHASE_BEGIN if (lo <= ph && ph < hi && ((PHMASK >> ph) & 1u)) {
#define PHASE_BEGIN_R if (lo <= ph && ph < hi && ((PHMASK >> ph) & 1u)) for (int rep_ = 0; rep_ < (((REPMASK >> (16 + ph)) & 1u) ? 2 : 1); ++rep_) {
#define PHASE_END } { const bool sync_ = (lo <= ph && ph + 1 < hi); ++ph; if (sync_) xcd_barrier(bar); }

    PHASE_BEGIN_R DECL_PTRS
    for (int m0 = 2 * gw; m0 < M; m0 += 2 * NGW) {
        pg8::f32x4 v[2][4]; float s[2] = {0.f, 0.f};
#pragma unroll
        for (int u = 0; u < 2; ++u) { const pg8::f32x4* xr = (const pg8::f32x4*)(x + (size_t)(m0 + u) * D) + lane;
#pragma unroll
            for (int j = 0; j < 4; ++j) v[u][j] = xr[64 * j]; }
#pragma unroll
        for (int u = 0; u < 2; ++u)
#pragma unroll
            for (int j = 0; j < 4; ++j) s[u] += (v[u][j][0] * v[u][j][0] + v[u][j][1] * v[u][j][1]) + (v[u][j][2] * v[u][j][2] + v[u][j][3] * v[u][j][3]);
#pragma unroll
        for (int o = 1; o < 64; o <<= 1) { s[0] += __shfl_xor(s[0], o); s[1] += __shfl_xor(s[1], o); }
#pragma unroll
        for (int u = 0; u < 2; ++u) { const float r = rsqrtf(s[u] * (1.f / D) + EPS); if (lane == 0) RSTD[m0 + u] = r;
            unsigned long long* o8 = (unsigned long long*)(XB + (size_t)(m0 + u) * D) + lane;
#pragma unroll
            for (int j = 0; j < 4; ++j) { const pg8::f32x4 gg = *((const pg8::f32x4*)norm_mix + lane + 64 * j); const pg8::f32x4 y = v[u][j] * r * gg;
                o8[64 * j] = (unsigned long long)pg8::cvt_pk_bf16(y[0], y[1]) | ((unsigned long long)pg8::cvt_pk_bf16(y[2], y[3]) << 32); } }
    }
    for (size_t i = gtid; i < DRNN; i += GSZ) LAMC[i] = -8.f * log1pf(__expf(-lam[i])) * LOG2E;
    for (size_t i = gtid; i < 4096; i += GSZ) PES[i] = i < 2048 ? pe_k[i] : pe_v[i - 2048];
    for (size_t i = gtid; i < 192; i += GSZ) NORMS[i] = i < 64 ? q_norm[i] : (i < 128 ? ks_norm[i - 64] : kw_norm[i - 128]);
    {
        float* scr = ldsf + wave * (64 * 33);
        constexpr int I_WIN = (pg8::N1PAD / 32) * 16, I_W1 = 16 * 32;
        for (int it = gw; it < I_WIN + I_W1; it += NGW) {
            int r = it;
            if (r < I_WIN) { const int ch = r / 16, kb = r % 16; int c0, cv; pg8::win_src(ch, c0, cv); tr_item(w_in, DIN, D, c0, cv, nullptr, WIN_T, D, 32 * ch, 64 * kb, scr, lane); continue; } r -= I_WIN;
            { const int ch = r / 32, kb = r % 32; tr_item((ch >> 3) ? w1v : w1k, 256, 2048, (ch & 7) * 32, 32, nullptr, W1_T, 2048, 32 * ch, 64 * kb, scr, lane); }
        }
    }
    PHASE_END
    PHASE_BEGIN DECL_PTRS
    if (FAST(1)) {
        pg8::Gemm g{XB, WIN_T, M, pg8::N1PAD, D}; pg8::StaticOrder S; S.init(M, pg8::N1PAD, G, (int)blockIdx.x);
        PG8_LAS float* ctab = (PG8_LAS float*)(ldsl + 131072);
        for (int i = tid; i < 192; i += NTHREADS) ctab[i] = NORMS[i];
        for (int i = tid; i < 4096; i += NTHREADS) ctab[256 + i] = PES[i];
        __syncthreads();
        pg8::Ep1F E{URNN, UGATE, Q, KV, GN, GA, ctab, FLATK, ctab + 256};
        pg8::gemm_phase<pg8::Ep1F, pg8::StaticOrder, true, true>(ldsl, g, S, E);
#if (REPMASK >> 1) & 1
        pg8::gemm_phase<pg8::Ep1F, pg8::StaticOrder, true, true>(ldsl, g, S, E);
#endif
    } else {
        ngemm(ldsf, M, DIN, D, ALf32Scale{x, D, norm_mix}, BLf32{w_in, DIN}, Ep1{RSTD, URNN, UGATE, Q, KV, GN, GA, GB});
    }
    PHASE_END
    PHASE_BEGIN DECL_PTRS
    if (blockIdx.x >= 64) {
        float* scr = ldsf + wave * (64 * 33);
        constexpr int I_WG = 96 * 6, I_PA = 32 * 22, I_PB = 32 * 16, I_WO = 32 * 16, I_WMI = 128 * 16, I_WMO = 32 * 64;
        for (int it = ((int)blockIdx.x - 64) * 8 + wave; it < I_WG + I_PA + I_PB + I_WO + I_WMI + I_WMO; it += ((int)gridDim.x - 64) * 8) {
            int r = it;
            if (r < I_WG) { const int ch = r / 6, kb = r % 6, nb = ch / 24, rr = ch % 24, pn = rr >> 3, l0 = (rr & 7) * 32, bj = l0 >> 7, chn0 = 128 * pn + (l0 & 127);
                int cv = BW - chn0; cv = cv < 0 ? 0 : (cv > 32 ? 32 : cv);
                tr_item((bj ? gate_x_w : gate_a_w) + (size_t)nb * BW * BW, BW, BW, chn0, cv, nullptr, WG_T, XC_LD, 32 * ch, 64 * kb, scr, lane); continue; } r -= I_WG;
            if (r < I_PA) { const int ch = r / 22, kb = r % 22; tr_item(proj_a, D, DRNN, 32 * ch, 32, nullptr, PA_T, YA_LD, 32 * ch, 64 * kb, scr, lane); continue; } r -= I_PA;
            if (r < I_PB) { const int ch = r / 16, kb = r % 16; tr_item(proj_b, D, QW, 32 * ch, 32, nullptr, PB_T, QW, 32 * ch, 64 * kb, scr, lane); continue; } r -= I_PB;
            if (r < I_WO) { const int ch = r / 16, kb = r % 16; tr_item(w_out, D, D, 32 * ch, 32, nullptr, WO_T, D, 32 * ch, 64 * kb, scr, lane); continue; } r -= I_WO;
            if (r < I_WMI) { const int ch = r / 16, kb = r % 16; tr_item(w_mlp_in, DFF, D, 32 * ch, 32, norm_mlp, WMI_T, D, 32 * ch, 64 * kb, scr, lane); continue; } r -= I_WMI;
            { const int ch = r / 64, kb = r % 64; tr_item(w_mlp_out, D, DFF, 32 * ch, 32, nullptr, WMO_T, DFF, 32 * ch, 64 * kb, scr, lane); }
        }
    } else
    if (FAST(3)) {
        pg8::Gemm g{FLATK, W1_T, 16384, 512, 2048}; pg8::OrderC1 S{G, (int)blockIdx.x};
        pg8::EpGeluF E{HIDK, 256};
        pg8::gemm_phase<pg8::EpGeluF, pg8::OrderC1, true, true>(ldsl, g, S, E);
#if (REPMASK >> 3) & 1
        pg8::gemm_phase<pg8::EpGeluF, pg8::OrderC1, true, true>(ldsl, g, S, E);
#endif
    } else {
        ngemm(ldsf, 8192, 256, 2048, ALbf{FLATK, 2048}, BLf32{w1k, 256}, EpGelu{HIDK, 256});
        ngemm(ldsf, 8192, 256, 2048, ALbf{FLATV, 2048}, BLf32{w1v, 256}, EpGelu{HIDV, 256});
    }
    PHASE_END
    PHASE_BEGIN DECL_PTRS
    {
        const int vcu = (G % 8 == 0) ? ((int)blockIdx.x % 8) * (G / 8) + (int)blockIdx.x / 8 : (int)blockIdx.x;
#ifdef ATT_PROBE_MODE
#ifndef ATT_ABL
#define ATT_ABL 0
#endif
        for (int u = vcu; u < 256; u += G) {
            const int bg = u >> 2, s4 = u & 3;
            att::attn_bias_table(bg & 3, rel_bias, lds);
            att::attn_compress_l2(bg, HIDK, HIDV, w2k, w2v, kc_norm, lds);
#pragma unroll 1
            for (int i = 0; i < 8; ++i) { const int qblk = 8 * (i >> 1) + ((i & 1) ? 7 - s4 : s4);
                att::attn_unit<ATT_PROBE_MODE, ATT_ABL>(bg >> 2, bg & 3, qblk, Q, (bf16_t*)dob, KS, VS, KW, VW, GN, rel_bias, lds); }
        }
#endif
        bool nomax;
        {   float* red = (float*)(lds + 159744);
            float v = 0.f; if (tid < 64) v = fabsf(q_norm[tid]); else if (tid < 128) v = fabsf(ks_norm[tid - 64]); else if (tid < 192) v = fabsf(kw_norm[tid - 128]);
            float bb = fabsf(rel_bias[tid]);
#pragma unroll
            for (int o = 32; o; o >>= 1) { v = fmaxf(v, __shfl_xor(v, o)); bb = fmaxf(bb, __shfl_xor(bb, o)); }
            if (lane == 0) { red[wave] = v; red[8 + wave] = bb; }
            __syncthreads();
            const float bm = fmaxf(fmaxf(fmaxf(red[8], red[9]), fmaxf(red[10], red[11])), fmaxf(fmaxf(red[12], red[13]), fmaxf(red[14], red[15])));
            nomax = 11.55f * red[0] * fmaxf(red[1], red[2]) + 2.f * 1.4427f * bm <= 60.f;
        }
#define ATT_UNITS(ABLV) for (int u = vcu; u < 256; u += G) {     \
            const int bg = u >> 2, s4 = u & 3; \
            att::attn_bias_table(bg & 3, rel_bias, lds); \
            att::attn_compress_l2(bg, HIDK, HIDV, w2k, w2v, kc_norm, lds); \
            _Pragma("unroll 1") for (int i = 7; i >= 0; --i) { const int qblk = 8 * (i >> 1) + ((i & 1) ? 7 - s4 : s4);     \
                att::attn_unit<7, ABLV>(bg >> 2, bg & 3, qblk, Q, Q, KS, VS, KW, VW, GN, rel_bias, lds); } }
        if (nomax) { ATT_UNITS(64) } else { ATT_UNITS(0) }
#undef ATT_UNITS
    }
    for (unsigned it = blockIdx.x * (unsigned)NTHREADS + threadIdx.x; it < 4u * (unsigned)(M / 8) * 48u; it += gridDim.x * (unsigned)NTHREADS) {
        const unsigned ch = it % 48u, nr = it / 48u, run = nr & (unsigned)(M / 8 - 1), n = nr >> 12, m0 = run * 8u, t0 = m0 & (unsigned)(T - 1), j0 = ch * 8u;
        bf16_t* dst = XC + ((size_t)n * M + m0) * XC_LD + j0;
        if (j0 >= (unsigned)BW) {
#pragma unroll
            for (int i = 0; i < 8; ++i) *(pg8::u32x4*)(dst + (size_t)i * XC_LD) = (pg8::u32x4){0u, 0u, 0u, 0u};
            continue; }
        const unsigned c = n * BW + j0;
        pg8::u32x4 rows[11];
#pragma unroll
        for (int i = 0; i < 11; ++i) rows[i] = ((int)t0 - 3 + i >= 0) ? *(const pg8::u32x4*)(URNN + (size_t)(m0 - 3 + i) * DRNN + c) : (pg8::u32x4){0u, 0u, 0u, 0u};
        pg8::f32x4 w0[4], w1[4];
#pragma unroll
        for (int kk = 0; kk < 4; ++kk) { w0[kk] = *(const pg8::f32x4*)(conv_w + kk * DRNN + c); w1[kk] = *(const pg8::f32x4*)(conv_w + kk * DRNN + c + 4); }
        const pg8::f32x4 b0 = *(const pg8::f32x4*)(conv_b + c), b1 = *(const pg8::f32x4*)(conv_b + c + 4);
#pragma unroll
        for (int i = 0; i < 8; ++i) { pg8::f32x4 a0 = b0, a1 = b1;
#pragma unroll
            for (int kk = 0; kk < 4; ++kk) { pg8::f32x4 x0, x1; pg8::unpack8(rows[i + kk], x0, x1); a0 += w0[kk] * x0; a1 += w1[kk] * x1; }
            *(pg8::u32x4*)(dst + (size_t)i * XC_LD) = pg8::pack8(a0, a1); }
    }
    PHASE_END
    PHASE_BEGIN DECL_PTRS
    if (FAST(8)) {
        int kg = XC_LD; asm volatile("" : "+s"(kg));
        pg8::Gemm g{XC, WG_T, 4 * M, 4 * 768, kg}; pg8::OrderGate S{G, (int)blockIdx.x};
        pg8::EpGateF E{gate_a_b, gate_x_b, LAMC, XC, LA, UP};
        pg8::gemm_phase<pg8::EpGateF, pg8::OrderGate, true, true>(ldsl, g, S, E);
#if (REPMASK >> 8) & 1
        pg8::gemm_phase<pg8::EpGateF, pg8::OrderGate, true, true>(ldsl, g, S, E);
#endif
    } else {
    for (int n = 0; n < 4; ++n)
        ngemm(ldsf, M, 2 * BW, BW, ALbf{XC + (size_t)n * M * XC_LD, XC_LD}, BLgate{gate_a_w + (size_t)n * BW * BW, gate_x_w + (size_t)n * BW * BW},
              EpGate{n, gate_a_b, gate_x_b, lam, XC + (size_t)n * M * XC_LD, LA, UP});
    }
    PHASE_END
    PHASE_BEGIN_R DECL_PTRS
    for (size_t it = gtid; it < (size_t)NB * 64 * 336; it += GSZ) {
        const int slot = (int)(it % 336), bk = (int)(it / 336), kc = bk & 63, b = bk >> 6, c0 = 4 * slot; const size_t m0 = (size_t)b * T + 32 * kc;
        float h[4] = {0.f, 0.f, 0.f, 0.f}, sl[4] = {0.f, 0.f, 0.f, 0.f};
#pragma unroll 1
        for (int i0 = 0; i0 < 32; i0 += 8) {
            unsigned long long lw[8], uw[8];
#pragma unroll
            for (int i = 0; i < 8; ++i) { lw[i] = *(const unsigned long long*)(LA + (m0 + i0 + i) * DRNN + c0); uw[i] = *(const unsigned long long*)(UP + (m0 + i0 + i) * DRNN + c0); }
#pragma unroll
            for (int i = 0; i < 8; ++i)
#pragma unroll
                for (int e = 0; e < 4; ++e) { const float la = bf2f((bf16_t)(lw[i] >> (16 * e))), up = bf2f((bf16_t)(uw[i] >> (16 * e))); const float av = __builtin_amdgcn_exp2f(la);
                    const float mult = (kc == 0 && i0 + i == 0) ? 1.f : __builtin_amdgcn_sqrtf(fmaxf(0.f, 1.f - av * av)); h[e] = av * h[e] + mult * up; sl[e] += la; }
        }
        *(pg8::f32x4*)(CAR + (size_t)bk * DRNN + c0) = (pg8::f32x4){sl[0], sl[1], sl[2], sl[3]};
        *(pg8::f32x4*)(CBR + (size_t)bk * DRNN + c0) = (pg8::f32x4){h[0], h[1], h[2], h[3]};
    }
    PHASE_END
    PHASE_BEGIN_R DECL_PTRS
    for (size_t it = gtid; it < (size_t)NB * 16 * 352; it += GSZ) {
        const int slot = (int)(it % 352), bs = (int)(it / 352), kg = bs & 15, b = bs >> 4, kc0 = 4 * kg, c0 = 4 * slot; const size_t m0 = (size_t)b * T + 128 * kg;
        if (slot >= 336) { for (int i = 0; i < 128; ++i) *(unsigned long long*)(YA + (m0 + i) * YA_LD + c0) = 0ull; continue; }
        unsigned long long la_[8], ua_[8], ga_[8], lb_[8], ub_[8], gb_[8];
#define SC_LOAD(L_, U_, G_, i0_) _Pragma("unroll") for (int i = 0; i < 8; ++i) { L_[i] = *(const unsigned long long*)(LA + (m0 + (i0_) + i) * DRNN + c0); U_[i] = *(const unsigned long long*)(UP + (m0 + (i0_) + i) * DRNN + c0); G_[i] = *(const unsigned long long*)(UGATE + (m0 + (i0_) + i) * DRNN + c0); }
#define SC_SCAN(L_, U_, G_, i0_) _Pragma("unroll") for (int i = 0; i < 8; ++i) { float y[4]; \
            _Pragma("unroll") for (int e = 0; e < 4; ++e) { const float la = bf2f((bf16_t)(L_[i] >> (16 * e))), up = bf2f((bf16_t)(U_[i] >> (16 * e))); const float av = __builtin_amdgcn_exp2f(la); \
                const float mult = (kg == 0 && (i0_) + i == 0) ? 1.f : __builtin_amdgcn_sqrtf(fmaxf(0.f, 1.f - av * av)); h[e] = av * h[e] + mult * up; y[e] = h[e] * bf2f((bf16_t)(G_[i] >> (16 * e))); } \
            *(unsigned long long*)(YA + (m0 + (i0_) + i) * YA_LD + c0) = (unsigned long long)att::cvtpk(y[0], y[1]) | ((unsigned long long)att::cvtpk(y[2], y[3]) << 32); }
        SC_LOAD(la_, ua_, ga_, 0)
        float h[4] = {0.f, 0.f, 0.f, 0.f};
        for (int k0 = 0; k0 < kc0; k0 += 16) {
            pg8::f32x4 sa[16], sb[16];
#pragma unroll
            for (int u = 0; u < 16; ++u) { const int k2 = k0 + u < kc0 ? k0 + u : kc0 - 1; sa[u] = *(const pg8::f32x4*)(CAR + (size_t)(b * 64 + k2) * DRNN + c0); sb[u] = *(const pg8::f32x4*)(CBR + (size_t)(b * 64 + k2) * DRNN + c0); }
#pragma unroll
            for (int u = 0; u < 16; ++u) if (k0 + u < kc0) {
#pragma unroll
                for (int e = 0; e < 4; ++e) h[e] = __builtin_amdgcn_exp2f(sa[u][e]) * h[e] + sb[u][e]; }
        }
#pragma unroll 1
        for (int r0 = 0; r0 < 128; r0 += 16) {
            SC_LOAD(lb_, ub_, gb_, r0 + 8) SC_SCAN(la_, ua_, ga_, r0)
            if (r0 + 16 < 128) { SC_LOAD(la_, ua_, ga_, r0 + 16) }
            SC_SCAN(lb_, ub_, gb_, r0 + 8)
        }
#undef SC_LOAD
#undef SC_SCAN
    }
    PHASE_END
    PHASE_BEGIN DECL_PTRS
    if (FAST(10)) {
        pg8::Gemm g{YA, PA_T, M, D, YA_LD}; pg8::StaticOrder S; S.init(M, D, G, (int)blockIdx.x);
        pg8::EpT1F E{GA, T1};
        pg8::gemm_phase<pg8::EpT1F, pg8::StaticOrder, true, true>(ldsl, g, S, E);
#if (REPMASK >> 10) & 1
        pg8::gemm_phase<pg8::EpT1F, pg8::StaticOrder, true, true>(ldsl, g, S, E);
#endif
    } else ngemm(ldsf, M, D, DRNN, ALbf{YA, YA_LD}, BLf32{proj_a, D}, EpT1{GA, T1});
    if (FAST(11)) {
        pg8::Gemm g{Q, PB_T, M, D, QW}; pg8::StaticOrder S; S.init(M, D, G, (int)blockIdx.x);
        pg8::EpMergedF E{GB, T1, MERGED};
        pg8::gemm_phase<pg8::EpMergedF, pg8::StaticOrder, true, true>(ldsl, g, S, E);
#if (REPMASK >> 11) & 1
        pg8::gemm_phase<pg8::EpMergedF, pg8::StaticOrder, true, true>(ldsl, g, S, E);
#endif
    } else ngemm(ldsf, M, D, QW, ALbf{Q, QW}, BLf32{proj_b, D}, EpMerged{GB, T1, MERGED});
    PHASE_END
    PHASE_BEGIN DECL_PTRS
    if (FAST(12)) {
        pg8::Gemm g{MERGED, WO_T, M, D, D}; pg8::StaticOrder S; S.init(M, D, G, (int)blockIdx.x);
        pg8::EpHF E{x, H, HB, SSQ};
        pg8::gemm_phase<pg8::EpHF, pg8::StaticOrder, true, true>(ldsl, g, S, E);
#if (REPMASK >> 12) & 1
        pg8::gemm_phase<pg8::EpHF, pg8::StaticOrder, true, true>(ldsl, g, S, E);
#endif
    } else ngemm(ldsf, M, D, D, ALbf{MERGED, D}, BLf32{w_out, D}, EpH{x, H, HB});
    PHASE_END
    PHASE_BEGIN DECL_PTRS
    if (FAST(14)) {
        pg8::Gemm g{HB, WMI_T, M, DFF, D}; pg8::StaticOrder S; S.init(M, DFF, G, (int)blockIdx.x);
        PG8_LAS float* rtab = (PG8_LAS float*)(ldsl + 131072);
        bool tab_ok;
        { pg8::Unit uu; int i = 0;
          for (; i < 16 && S.next(i, uu); ++i) if (tid < 256) { const float* sp = SSQ + (size_t)(uu.pm * 256 + tid) * 16;
                const pg8::f32x4 s0 = *(const pg8::f32x4*)sp, s1 = *(const pg8::f32x4*)(sp + 4), s2 = *(const pg8::f32x4*)(sp + 8), s3 = *(const pg8::f32x4*)(sp + 12); const pg8::f32x4 st = (s0 + s1) + (s2 + s3);
                rtab[i * 256 + tid] = rsqrtf(((st[0] + st[1]) + (st[2] + st[3])) * (1.f / D) + EPS); }
          tab_ok = !(i == 16 && S.next(16, uu)); }
        __syncthreads();
        pg8::EpZF E{tab_ok ? rtab : (PG8_LAS float*)nullptr, SSQ, ZACT};
        pg8::gemm_phase<pg8::EpZF, pg8::StaticOrder, true, true>(ldsl, g, S, E);
#if (REPMASK >> 14) & 1
        pg8::gemm_phase<pg8::EpZF, pg8::StaticOrder, true, true>(ldsl, g, S, E);
#endif
    } else ngemm(ldsf, M, DFF, D, ALbfScale{HB, D, norm_mlp}, BLf32{w_mlp_in, DFF}, EpZ{SSQ, ZACT});
    PHASE_END
    PHASE_BEGIN DECL_PTRS
    if (FAST(15)) {
        pg8::Gemm g{ZACT, WMO_T, M, D, DFF}; pg8::StaticOrder S; S.init(M, D, G, (int)blockIdx.x);
        pg8::EpOutF E{HB, H};
        pg8::gemm_phase<pg8::EpOutF, pg8::StaticOrder, true, true>(ldsl, g, S, E);
#if (REPMASK >> 15) & 1
        pg8::gemm_phase<pg8::EpOutF, pg8::StaticOrder, true, true>(ldsl, g, S, E);
#endif
    } else ngemm(ldsf, M, D, DFF, ALbf{ZACT, DFF}, BLf32{w_mlp_out, D}, EpOut{H});
    PHASE_END
}
constexpr int NPHASES = 11;

extern "C" void kernel_launch(void* const* d_in, const int* in_sizes, int n_in, void* d_out, int out_size, void* d_ws, size_t ws_size, hipStream_t stream) {
    static int grid = 0;
    if (grid == 0) {
        if (n_in != 27 || out_size != M * D || ws_size < WS_END) { fprintf(stderr, "kernel_launch: unexpected shapes n_in %d out %d ws %zu\n", n_in, out_size, ws_size); grid = -1; return; }
        int dev = 0, cus = 0, per_cu = 0;
        (void)hipGetDevice(&dev);
        (void)hipDeviceGetAttribute(&cus, hipDeviceAttributeMultiprocessorCount, dev);
        (void)hipFuncSetAttribute((const void*)fwd, hipFuncAttributeMaxDynamicSharedMemorySize, LDS_BYTES);
        (void)hipOccupancyMaxActiveBlocksPerMultiprocessor(&per_cu, (const void*)fwd, NTHREADS, LDS_BYTES);
        fprintf(stderr, "kernel_launch: cus %d per_cu %d ws_size %zu\n", cus, per_cu, ws_size);
        grid = cus;
    }
    if (grid < 0) return;
    if (hipMemsetAsync(d_ws, 0, 65536, stream) != hipSuccess) { fprintf(stderr, "kernel_launch: hipMemsetAsync failed\n"); return; }
    Args a{};
    for (int i = 0; i < 27; ++i) a.in[i] = (const float*)d_in[i];
    a.out = (float*)d_out; a.ws = (unsigned char*)d_ws; a.ph_lo = 0; a.ph_hi = NPHASES;
    void* args[] = {&a};
    hipError_t e = hipLaunchCooperativeKernel((const void*)fwd, dim3(grid), dim3(NTHREADS), args, LDS_BYTES, stream);
    if (e != hipSuccess) fprintf(stderr, "cooperative launch failed: %s (grid %d)\n", hipGetErrorString(e), grid);
}
```

```cpp
#include <hip/hip_runtime.h>
#include <hip/hip_cooperative_groups.h>
#include <cstdio>
#include <cstdint>
#ifndef FASTMASK
#define FASTMASK 0xFFFFFFFFu
#endif
#define FAST(p) ((FASTMASK >> (p)) & 1u)
namespace cg = cooperative_groups;

typedef unsigned short bf16_t;
constexpr int NTHREADS = 512;
constexpr int LDS_BYTES = 163840;
constexpr size_t MiB = 1u << 20;

constexpr int NB = 16, T = 2048, D = 1024, M = NB * T;
constexpr int DRNN = 1344, BW = 336, QW = 1024, KVW = 256, NH = 16, HD = 64, NG = 4;
constexpr int DIN = 7344, DFF = 4096, NC = 127, NSB = 32, CROWS = NB * NG * NC;
constexpr int C_URNN = 0, C_UGATE = 1344, C_Q = 2688, C_KV = 3712, C_GN = 5248, C_GA = 5296, C_GB = 6320;
constexpr float EPS = 1e-6f, LOG2E = 1.4426950408889634f;
constexpr int YA_LD = 1408, XC_LD = 384;

constexpr size_t WS_RSTD = 1 * MiB, WS_RSTD2 = 1 * MiB + 512 * 1024, WS_KCC = 2 * MiB, WS_VCC = 4 * MiB, WS_SEL = 6 * MiB;
constexpr size_t WS_URNN = 52 * MiB, WS_UGATE = 136 * MiB, WS_Q = 220 * MiB, WS_KV = 284 * MiB  , WS_GN = 380 * MiB, WS_GA = 384 * MiB, WS_GB = 448 * MiB, WS_END = 512 * MiB;
constexpr size_t WS_PES = 1 * MiB + 448 * 1024  , WS_NORMS = 1 * MiB + 384 * 1024, WS_LAMC = 1 * MiB + 256 * 1024, WS_SSQ = 6 * MiB + 512 * 1024  ;
constexpr size_t WS_WIN = 9 * MiB  , WS_WG = 24 * MiB  , WS_W1 = 27 * MiB  , WS_PA = 29 * MiB  , WS_PB = 32 * MiB, WS_WO = 34 * MiB, WS_WMI = 36 * MiB  , WS_WMO = 44 * MiB  ;
constexpr size_t DO_KCB = 104 * MiB  , DO_VCT = 105 * MiB  ;
constexpr size_t DO_VST = 72 * MiB, DO_VWT = 88 * MiB;
constexpr size_t DO_CAR = 112 * MiB, DO_CBR = 120 * MiB;
constexpr size_t DO_XB = 0;
constexpr size_t WS_LA = WS_URNN, WS_UP = WS_KV, WS_T1 = WS_URNN, WS_MERGED = WS_UGATE, WS_HB = WS_GA, WS_ZACT = 52 * MiB;
constexpr size_t DO_FLATK = 64 * MiB, DO_FLATV = 96 * MiB, DO_HIDK = 0, DO_HIDV = 4 * MiB, DO_XC = 0, DO_YA = 0;

__device__ __constant__ unsigned char BUCKET[128] = {0, 1, 2, 3, 4, 5, 6, 7, 8, 9, 10, 11, 12, 13, 14, 15, 16, 16, 16, 17, 17, 18, 18, 18, 19, 19, 19, 20, 20, 20, 20, 21, 21, 21, 21, 22, 22, 22, 22, 22, 23, 23, 23, 23, 23, 23, 24, 24, 24, 24, 24, 24, 25, 25, 25, 25, 25, 25, 25, 26, 26, 26, 26, 26, 26, 26, 26, 27, 27, 27, 27, 27, 27, 27, 27, 27, 27, 28, 28, 28, 28, 28, 28, 28, 28, 28, 28, 29, 29, 29, 29, 29, 29, 29, 29, 29, 29, 29, 29, 30, 30, 30, 30, 30, 30, 30, 30, 30, 30, 30, 30, 30, 30, 31, 31, 31, 31, 31, 31, 31, 31, 31, 31, 31, 31, 31, 31, 31};

__device__ __forceinline__ float bf2f(bf16_t v) { return __uint_as_float((unsigned)v << 16); }
__device__ __forceinline__ bf16_t f2bf(float f) { unsigned u = __float_as_uint(f); return (bf16_t)((u + 0x7fffu + ((u >> 16) & 1u)) >> 16); }
__device__ __forceinline__ float sigmoidf_(float x) { return 1.f / (1.f + __expf(-x)); }
__device__ __forceinline__ float gelu_tanh(float x) { const float u = 0.7978845608028654f * (x + 0.044715f * x * x * x); return 0.5f * x * (1.f + tanhf(u)); }
__device__ __forceinline__ float wave_sum(float v) {
#pragma unroll
    for (int o = 1; o < 64; o <<= 1) v += __shfl_xor(v, o);
    return v;
}

struct Args { const float* in[27]; float* out; unsigned char* ws; int ph_lo, ph_hi; };

template <class AL, class BL, class EP>
__device__ __forceinline__ void ngemm(float* lds, int Mm, int Nn, int Kk, const AL& A, const BL& Bf, const EP& E) {
    float* As = lds;
    float* Bs = lds + 16 * 132;
    const int tid = threadIdx.x, tx = tid & 31, ty = tid >> 5;
    const int tm = (Mm + 127) / 128, tn = (Nn + 127) / 128, ntiles = tm * tn;
    for (int tile = blockIdx.x; tile < ntiles; tile += gridDim.x) {
        const int m0 = (tile / tn) * 128, n0 = (tile % tn) * 128;
        float acc[8][4];
#pragma unroll
        for (int i = 0; i < 8; ++i)
#pragma unroll
            for (int j = 0; j < 4; ++j) acc[i][j] = 0.f;
        for (int k0 = 0; k0 < Kk; k0 += 16) {
            {
                const int m = m0 + (tid >> 2), kb = k0 + (tid & 3) * 4;
#pragma unroll
                for (int i = 0; i < 4; ++i) As[((tid & 3) * 4 + i) * 132 + (tid >> 2)] = (m < Mm && kb + i < Kk) ? A(m, kb + i) : 0.f;
                const int k = k0 + (tid >> 5), nb = n0 + (tid & 31) * 4;
#pragma unroll
                for (int i = 0; i < 4; ++i) Bs[(tid >> 5) * 132 + (tid & 31) * 4 + i] = (k < Kk && nb + i < Nn) ? Bf(k, nb + i) : 0.f;
            }
            __syncthreads();
#pragma unroll 2
            for (int kk = 0; kk < 16; ++kk) {
                float a[8], b[4];
#pragma unroll
                for (int i = 0; i < 8; ++i) a[i] = As[kk * 132 + ty * 8 + i];
#pragma unroll
                for (int j = 0; j < 4; ++j) b[j] = Bs[kk * 132 + tx * 4 + j];
#pragma unroll
                for (int i = 0; i < 8; ++i)
#pragma unroll
                    for (int j = 0; j < 4; ++j) acc[i][j] += a[i] * b[j];
            }
            __syncthreads();
        }
#pragma unroll
        for (int i = 0; i < 8; ++i)
#pragma unroll
            for (int j = 0; j < 4; ++j) { const int m = m0 + ty * 8 + i, n = n0 + tx * 4 + j; if (m < Mm && n < Nn) E(m, n, acc[i][j]); }
    }
}

struct ALbf { const bf16_t* p; int ld; __device__ __forceinline__ float operator()(int m, int k) const { return bf2f(p[(size_t)m * ld + k]); } };
struct ALbfScale { const bf16_t* p; int ld; const float* g; __device__ __forceinline__ float operator()(int m, int k) const { return bf2f(p[(size_t)m * ld + k]) * g[k]; } };
struct ALf32Scale { const float* p; int ld; const float* g; __device__ __forceinline__ float operator()(int m, int k) const { return p[(size_t)m * ld + k] * g[k]; } };
struct BLf32 { const float* p; int ld; __device__ __forceinline__ float operator()(int k, int n) const { return p[(size_t)k * ld + n]; } };
struct BLgate { const float* wa; const float* wx; __device__ __forceinline__ float operator()(int k, int n) const { return n < BW ? wa[k * BW + n] : wx[k * BW + n - BW]; } };

struct Ep1 {
    const float* rstd; bf16_t *urnn, *ugate, *q, *kv, *gn, *ga, *gb;
    __device__ __forceinline__ void operator()(int m, int n, float v) const {
        v *= rstd[m];
        if (n < C_UGATE) urnn[(size_t)m * DRNN + n] = f2bf(v);
        else if (n < C_Q) ugate[(size_t)m * DRNN + n - C_UGATE] = f2bf(gelu_tanh(v));
        else if (n < C_KV) q[(size_t)m * QW + n - C_Q] = f2bf(v);
        else if (n < C_GN) { const int c = n - C_KV; kv[(size_t)(c >> 8) * ((size_t)M * KVW) + (size_t)m * KVW + (c & 255)] = f2bf(v); }
        else if (n < C_GA) gn[(size_t)m * 48 + n - C_GN] = f2bf(sigmoidf_(v));
        else if (n < C_GB) ga[(size_t)m * D + n - C_GA] = f2bf(sigmoidf_(v));
        else gb[(size_t)m * D + n - C_GB] = f2bf(sigmoidf_(v));
    }
};
struct EpGelu { bf16_t* o; int ld; __device__ __forceinline__ void operator()(int m, int n, float v) const { o[(size_t)m * ld + n] = f2bf(gelu_tanh(v)); } };
struct EpGate {
    int nb; const float *ba, *bx, *lam; const bf16_t* xc; bf16_t *la, *up;
    __device__ __forceinline__ void operator()(int m, int n, float v) const {
        if (n < BW) { const int c = nb * BW + n; const float r = sigmoidf_(v + ba[c]); const float sp = log1pf(__expf(-lam[c])); la[(size_t)m * DRNN + c] = f2bf(-8.f * r * sp * LOG2E); }
        else { const int j = n - BW, c = nb * BW + j; const float i = sigmoidf_(v + bx[c]); up[(size_t)m * DRNN + c] = f2bf(i * bf2f(xc[(size_t)m * XC_LD + j])); }
    }
};
struct EpT1 { const bf16_t* g; bf16_t* o; __device__ __forceinline__ void operator()(int m, int n, float v) const { o[(size_t)m * D + n] = f2bf(bf2f(g[(size_t)m * D + n]) * v); } };
struct EpMerged { const bf16_t* g; const bf16_t* t1; bf16_t* o; __device__ __forceinline__ void operator()(int m, int n, float v) const { o[(size_t)m * D + n] = f2bf(bf2f(t1[(size_t)m * D + n]) + bf2f(g[(size_t)m * D + n]) * v); } };
struct EpH { const float* x; float* h; bf16_t* hb; __device__ __forceinline__ void operator()(int m, int n, float v) const { const float r = x[(size_t)m * D + n] + v; h[(size_t)m * D + n] = r; hb[(size_t)m * D + n] = f2bf(r); } };
struct EpZ { const float* ssq; bf16_t* z; __device__ __forceinline__ void operator()(int m, int n, float v) const { float s_ = 0.f; for (int i = 0; i < 16; ++i) s_ += ssq[(size_t)m * 16 + i]; v *= rsqrtf(s_ * (1.f / D) + EPS); v = v > 0.f ? v * v : 0.f; z[(size_t)m * DFF + n] = f2bf(v); } };
struct EpOut { float* o; __device__ __forceinline__ void operator()(int m, int n, float v) const { o[(size_t)m * D + n] += v; } };

namespace pg8 {
#define PG8_LAS __attribute__((address_space(3)))
typedef unsigned short bf16_t;
typedef short bf16x8 __attribute__((ext_vector_type(8)));
typedef float f32x4 __attribute__((ext_vector_type(4)));
typedef unsigned u32x4 __attribute__((ext_vector_type(4)));
constexpr int BM = 256, BK = 64, HALF = 128, HTB = HALF * BK * 2  , STAGE_BYTES = 8 * HTB, NXCD = 8, WGM = 4;

__host__ __device__ __forceinline__ int lds_byte(int r, int c) { const int st = (r >> 4) * 2 + (c >> 5), rr = r & 15, cc = c & 31, ob = rr * 64 + cc * 2; return st * 1024 + (ob ^ (((ob >> 9) & 1) << 5)); }
__host__ __device__ __forceinline__ void stage_rc(int b, int& R, int& C) { const int st = b / 1024, sb = b % 1024, swz = sb ^ (((sb >> 9) & 1) << 5); R = (st >> 1) * 16 + swz / 64; C = (st & 1) * 32 + (swz % 64) / 2; }
__host__ __device__ __forceinline__ int perm32(int rho) { const int n = rho >> 4, i = rho & 15; return 8 * (i >> 2) + 4 * n + (i & 3); }

struct Unit { int pm, pn, ord; };
struct Gemm { const bf16_t* A; const bf16_t* Bt; int M, N, K; };

struct StaticOrder {
    int nM, nN, nwg, G, c;
    __host__ __device__ void init(int M, int N, int G_, int c_) { nM = M / BM; nN = N / BM; nwg = nM * nN; G = G_; c = c_; }
    __host__ __device__ __forceinline__ bool next(int i, Unit& u) const {
        const long L = (long)i * G + c; if (L >= nwg) return false;
        int wgid = (int)L; { const int q = nwg / NXCD, r = nwg % NXCD, xcd = wgid % NXCD, off = wgid / NXCD; wgid = (xcd < r ? xcd * (q + 1) : r * (q + 1) + (xcd - r) * q) + off; }
        const int nig = WGM * nN, gid = wgid / nig, fm = gid * WGM, gsz = (nM - fm) < WGM ? (nM - fm) : WGM;
        u.pm = fm + ((wgid % nig) % gsz); u.pn = (wgid % nig) / gsz; u.ord = i; return true;
    }
    __device__ __forceinline__ void a_ready(const Unit&) const {}
    __device__ __forceinline__ void done(const Unit&) const {}
};

__device__ __forceinline__ unsigned cvt_pk_bf16(float lo, float hi) { unsigned r; asm volatile("v_cvt_pk_bf16_f32 %0, %1, %2" : "=v"(r) : "v"(lo), "v"(hi)); return r; }
typedef float f32x2 __attribute__((ext_vector_type(2)));
template <class Epi, class Sched, bool ALIGN_EPI = false, bool SP2 = false>
__device__ __forceinline__ void gemm_phase(PG8_LAS unsigned char* lds, const Gemm g, const Sched& S, const Epi& E) {
    const int tid = threadIdx.x, wid = __builtin_amdgcn_readfirstlane(tid >> 6), lane = tid & 63, wr = wid >> 2, wc = wid & 3, fr = lane & 15, fq = lane >> 4;
    const int K = g.K, nt = K / BK;
    unsigned voffA[2], voffB[2];
#pragma unroll
    for (int i = 0; i < 2; ++i) { int R, C; stage_rc(tid * 16 + i * 8192, R, C); const int Rb = Epi::PERM ? ((R & ~31) + perm32(R & 31)) : R;
        voffA[i] = (unsigned)(R * K + C) * 2u; voffB[i] = (unsigned)(Rb * K + C) * 2u; }
    const size_t kstep = (size_t)(BK * 2);
    const size_t hstep = (size_t)HALF * K * 2;
    const size_t tstep = 2 * hstep;
    const unsigned ldsw = (unsigned)wid * 1024u;
    const int aoff = lds_byte(wr * 64 + fr, fq * 8), boff = lds_byte(wc * 32 + fr, fq * 8);
#define PG8_SA(b, h) (((b) * 2 + (h)) * HTB)
#define PG8_SB(b, h) ((4 + (b) * 2 + (h)) * HTB)
#define PG8_STAGE(bufoff, gbase, voff) do { _Pragma("unroll") for (int _i = 0; _i < 2; ++_i) \
        __builtin_amdgcn_global_load_lds((const unsigned*)((const char*)(gbase) + (voff)[_i]), (PG8_LAS unsigned*)(lds + (bufoff) + ldsw + _i * 8192), 16, 0, 0); } while (0)
#define PG8_LDA(dst, b, h) do { _Pragma("unroll") for (int m = 0; m < 4; ++m) _Pragma("unroll") for (int k = 0; k < 2; ++k) dst[m][k] = *(const PG8_LAS bf16x8*)(lds + PG8_SA(b, h) + aoff + m * 2048 + k * 1024); } while (0)
#define PG8_LDB(dst, b, h) do { _Pragma("unroll") for (int n = 0; n < 2; ++n) _Pragma("unroll") for (int k = 0; k < 2; ++k) dst[n][k] = *(const PG8_LAS bf16x8*)(lds + PG8_SB(b, h) + boff + n * 2048 + k * 1024); } while (0)
#define PG8_MMA(ai, bj, At, Bt) do { __builtin_amdgcn_s_setprio(1); _Pragma("unroll") for (int m = 0; m < 4; ++m) _Pragma("unroll") for (int n = 0; n < 2; ++n) _Pragma("unroll") for (int k = 0; k < 2; ++k) \
        acc[ai][bj][m][n] = __builtin_amdgcn_mfma_f32_16x16x32_bf16(Bt[n][k], At[m][k], acc[ai][bj][m][n], 0, 0, 0); __builtin_amdgcn_s_setprio(0); } while (0)
#define PG8_WAIT_V(n) asm volatile("s_waitcnt vmcnt(" #n ")" ::: "memory")
#define PG8_WAIT_L(n) asm volatile("s_waitcnt lgkmcnt(" #n ")" ::: "memory")
#define PG8_BAR __builtin_amdgcn_s_barrier()
#define PG8_SCHED __builtin_amdgcn_sched_barrier(0)
    Unit cur, nxt; int ui = 0;
    if (!S.next(0, cur)) return;
    f32x4 acc[2][2][4][2];
#pragma unroll
    for (int a = 0; a < 2; ++a)
#pragma unroll
        for (int b = 0; b < 2; ++b)
#pragma unroll
            for (int m = 0; m < 4; ++m)
#pragma unroll
                for (int n = 0; n < 2; ++n) acc[a][b][m][n] = (f32x4){0.f, 0.f, 0.f, 0.f};
    bf16x8 At[4][2], B0[2][2], B1[2][2];
    const char* cA = (const char*)g.A + (size_t)cur.pm * tstep; const char* cB = (const char*)g.Bt + (size_t)cur.pn * tstep;
    S.a_ready(cur);
    if constexpr (SP2) {
        PG8_STAGE(PG8_SB(0, 0), cB, voffB); PG8_STAGE(PG8_SB(0, 1), cB + hstep, voffB); PG8_STAGE(PG8_SA(0, 0), cA, voffA); PG8_STAGE(PG8_SA(0, 1), cA + hstep, voffA);
        if (wr == 1) PG8_BAR;
        PG8_WAIT_V(2); PG8_BAR;
        PG8_STAGE(PG8_SB(1, 0), cB + kstep, voffB); PG8_STAGE(PG8_SA(1, 0), cA + kstep, voffA); PG8_STAGE(PG8_SB(1, 1), cB + hstep + kstep, voffB);
        PG8_WAIT_V(6); PG8_BAR;
    } else {
        PG8_STAGE(PG8_SB(0, 0), cB, voffB); PG8_STAGE(PG8_SA(0, 0), cA, voffA); PG8_STAGE(PG8_SB(0, 1), cB + hstep, voffB); PG8_STAGE(PG8_SA(0, 1), cA + hstep, voffA);
        if (wr == 1) PG8_BAR;
        PG8_WAIT_V(4); PG8_BAR;
        PG8_STAGE(PG8_SB(1, 0), cB + kstep, voffB); PG8_STAGE(PG8_SA(1, 0), cA + kstep, voffA); PG8_STAGE(PG8_SB(1, 1), cB + hstep + kstep, voffB);
        PG8_WAIT_V(6); PG8_BAR;
    }
    for (;;) {
        const bool has_next = S.next(ui + 1, nxt);
        const char* nA = has_next ? (const char*)g.A + (size_t)nxt.pm * tstep : cA; const char* nB = has_next ? (const char*)g.Bt + (size_t)nxt.pn * tstep : cB;
        for (int t = 0; t < nt; t += 2) {
            const bool last = (t == nt - 2);
            const char* a1 = cA + (size_t)(t + 1) * kstep;
            const char* a2 = last ? nA : cA + (size_t)(t + 2) * kstep; const char* b2 = last ? nB : cB + (size_t)(t + 2) * kstep;
            const char* a3 = a2 + kstep; const char* b3 = b2 + kstep;
            if (last && has_next) S.a_ready(nxt);
            if constexpr (SP2) {
            PG8_LDB(B0, 0, 0); PG8_LDB(B1, 0, 1); PG8_SCHED; PG8_LDA(At, 0, 0); PG8_STAGE(PG8_SA(1, 1), a1 + hstep, voffA);
            PG8_WAIT_V(8); PG8_WAIT_L(0); PG8_BAR; PG8_MMA(0, 0, At, B0); PG8_MMA(0, 1, At, B1); PG8_BAR; PG8_SCHED;
            PG8_LDA(At, 0, 1); PG8_STAGE(PG8_SB(0, 0), b2, voffB); PG8_STAGE(PG8_SB(0, 1), b2 + hstep, voffB); PG8_STAGE(PG8_SA(0, 0), a2, voffA);
            PG8_WAIT_V(8); PG8_WAIT_L(0); PG8_BAR; PG8_MMA(1, 0, At, B0); PG8_MMA(1, 1, At, B1); PG8_BAR; PG8_SCHED;
            PG8_LDB(B0, 1, 0); PG8_LDB(B1, 1, 1); PG8_SCHED; PG8_LDA(At, 1, 0); PG8_STAGE(PG8_SA(0, 1), a2 + hstep, voffA);
            PG8_WAIT_V(8); PG8_WAIT_L(0); PG8_BAR; PG8_MMA(0, 0, At, B0); PG8_MMA(0, 1, At, B1); PG8_BAR; PG8_SCHED;
            PG8_LDA(At, 1, 1); PG8_STAGE(PG8_SB(1, 0), b3, voffB); PG8_STAGE(PG8_SB(1, 1), b3 + hstep, voffB); PG8_STAGE(PG8_SA(1, 0), a3, voffA);
            PG8_WAIT_V(8); PG8_WAIT_L(0); PG8_BAR; PG8_MMA(1, 0, At, B0); PG8_MMA(1, 1, At, B1); PG8_BAR; PG8_SCHED;
            } else {
            PG8_LDB(B0, 0, 0); PG8_SCHED; PG8_LDA(At, 0, 0); PG8_STAGE(PG8_SA(1, 1), a1 + hstep, voffA);
            PG8_WAIT_L(8); PG8_BAR; PG8_WAIT_L(0); PG8_MMA(0, 0, At, B0); PG8_BAR; PG8_SCHED;
            PG8_LDB(B1, 0, 1); PG8_STAGE(PG8_SB(0, 0), b2, voffB);
            PG8_BAR; PG8_WAIT_L(0); PG8_MMA(0, 1, At, B1); PG8_BAR;
            PG8_LDA(At, 0, 1); PG8_STAGE(PG8_SA(0, 0), a2, voffA);
            PG8_BAR; PG8_WAIT_L(0); PG8_MMA(1, 0, At, B0); PG8_BAR; PG8_SCHED;
            PG8_STAGE(PG8_SB(0, 1), b2 + hstep, voffB);
            PG8_WAIT_V(6); PG8_BAR; PG8_MMA(1, 1, At, B1); PG8_BAR;
            PG8_LDB(B0, 1, 0); PG8_SCHED; PG8_LDA(At, 1, 0); PG8_STAGE(PG8_SA(0, 1), a2 + hstep, voffA);
            PG8_WAIT_L(8); PG8_BAR; PG8_WAIT_L(0); PG8_MMA(0, 0, At, B0); PG8_BAR; PG8_SCHED;
            PG8_LDB(B1, 1, 1); PG8_STAGE(PG8_SB(1, 0), b3, voffB);
            PG8_BAR; PG8_WAIT_L(0); PG8_MMA(0, 1, At, B1); PG8_BAR;
            PG8_LDA(At, 1, 1); PG8_STAGE(PG8_SA(1, 0), a3, voffA);
            PG8_BAR; PG8_WAIT_L(0); PG8_MMA(1, 0, At, B0); PG8_BAR; PG8_SCHED;
            PG8_STAGE(PG8_SB(1, 1), b3 + hstep, voffB);
            PG8_WAIT_V(6); PG8_BAR; PG8_MMA(1, 1, At, B1); PG8_BAR;
            }
        }
        if constexpr (ALIGN_EPI) { if (wr == 0) PG8_BAR; }
        if constexpr (!Epi::AFTER_DRAIN) { E(acc, cur, wr, wc, fr, fq); S.done(cur); }
        if (!has_next) break;
#pragma unroll
        for (int a = 0; a < 2; ++a)
#pragma unroll
            for (int b = 0; b < 2; ++b)
#pragma unroll
                for (int m = 0; m < 4; ++m)
#pragma unroll
                    for (int n = 0; n < 2; ++n) acc[a][b][m][n] = (f32x4){0.f, 0.f, 0.f, 0.f};
        cur = nxt; cA = nA; cB = nB; ++ui;
        if constexpr (ALIGN_EPI) { if (wr == 1) PG8_BAR; }
    }
    PG8_WAIT_V(0);
    if constexpr (!ALIGN_EPI) { if (wr == 0) PG8_BAR; }
    PG8_BAR;
    if constexpr (Epi::AFTER_DRAIN) { E.fused(acc, cur, wr, wc, fr, fq, lds, wid, lane); S.done(cur); }
#undef PG8_SA
#undef PG8_SB
#undef PG8_STAGE
#undef PG8_LDA
#undef PG8_LDB
#undef PG8_MMA
#undef PG8_WAIT_V
#undef PG8_WAIT_L
#undef PG8_BAR
#undef PG8_SCHED
}
}

namespace pg8 {
__device__ __forceinline__ float sigm(float x) { return __builtin_amdgcn_rcpf(1.f + __expf(-x)); }
__device__ __forceinline__ float gelu_t(float x) { const float u = 1.5957691216057308f * (x + 0.044715f * x * x * x); return x * __builtin_amdgcn_rcpf(1.f + __expf(-u)); }
__device__ __forceinline__ u32x4 pack8(const f32x4& a, const f32x4& b) { u32x4 w; w.x = cvt_pk_bf16(a[0], a[1]); w.y = cvt_pk_bf16(a[2], a[3]); w.z = cvt_pk_bf16(b[0], b[1]); w.w = cvt_pk_bf16(b[2], b[3]); return w; }
__device__ __forceinline__ void unpack8(const u32x4& w, f32x4& a, f32x4& b) {
    a[0] = __uint_as_float(w.x << 16); a[1] = __uint_as_float(w.x & 0xffff0000u); a[2] = __uint_as_float(w.y << 16); a[3] = __uint_as_float(w.y & 0xffff0000u);
    b[0] = __uint_as_float(w.z << 16); b[1] = __uint_as_float(w.z & 0xffff0000u); b[2] = __uint_as_float(w.w << 16); b[3] = __uint_as_float(w.w & 0xffff0000u); }

struct Ep1F {
    static constexpr bool PERM = true, AFTER_DRAIN = false;
    bf16_t *urnn, *ugate, *q, *kv, *gn, *ga; const PG8_LAS float* norms; bf16_t* flat; const PG8_LAS float* pes;
    __device__ __forceinline__ void operator()(const f32x4 (&acc)[2][2][4][2], const Unit& u, int wr, int wc, int fr, int fq) const {
        const int row0 = u.pm * BM + wr * 64 + fr, pn = u.pn;
        if (pn == 4 || pn == 5) {
            const PG8_LAS float* pe = pes + (pn - 4) * 2048; bf16_t* fl = flat + (size_t)(pn - 4) * 8192 * 2048;
#pragma unroll
            for (int ai = 0; ai < 2; ++ai)
#pragma unroll
                for (int m = 0; m < 4; ++m) { const int mt = row0 + ai * HALF + m * 16, b = mt >> 11, t = mt & (T - 1), c1 = t >> 4, l1 = t & 15; const size_t rb = (size_t)((b * 4 + wc) * NC + c1) * 2048;
#pragma unroll
                    for (int bj = 0; bj < 2; ++bj) { const int d0 = 32 * bj + 8 * fq; const f32x4 v0 = acc[ai][bj][m][0], v1 = acc[ai][bj][m][1];
                        if (c1 < NC) { const PG8_LAS float* p = pe + l1 * 64 + d0; *(u32x4*)(fl + rb + l1 * 64 + d0) = pack8(v0 + *(const PG8_LAS f32x4*)p, v1 + *(const PG8_LAS f32x4*)(p + 4)); }
                        if (c1 > 0) { const PG8_LAS float* p = pe + (l1 + 16) * 64 + d0; *(u32x4*)(fl + rb - 2048 + (l1 + 16) * 64 + d0) = pack8(v0 + *(const PG8_LAS f32x4*)p, v1 + *(const PG8_LAS f32x4*)(p + 4)); } } }
            return;
        }
        if (pn < 10) {
            const bool donorm = pn < 4 || pn == 6 || pn == 8; const PG8_LAS float* g = norms + (pn < 4 ? 0 : (pn == 6 ? 64 : 128)); const float sc = pn < 4 ? 0.125f * LOG2E : 1.f;
            bf16_t* base; int ld;
            if (pn < 4) { base = q + 256 * pn + 64 * wc + 8 * fq; ld = QW; } else { base = kv + (size_t)(pn - 4) * ((size_t)M * KVW) + 64 * wc + 8 * fq; ld = KVW; }
            f32x4 gv[2][2];
#pragma unroll
            for (int bj = 0; bj < 2; ++bj)
#pragma unroll
                for (int n = 0; n < 2; ++n) gv[bj][n] = donorm ? *(const PG8_LAS f32x4*)(g + 32 * bj + 8 * fq + 4 * n) : (f32x4){1.f, 1.f, 1.f, 1.f};
#pragma unroll
            for (int ai = 0; ai < 2; ++ai)
#pragma unroll
                for (int m = 0; m < 4; ++m) {
                    float ss = 0.f;
#pragma unroll
                    for (int bj = 0; bj < 2; ++bj)
#pragma unroll
                        for (int n = 0; n < 2; ++n) { const f32x4 v = acc[ai][bj][m][n]; ss += (v[0] * v[0] + v[1] * v[1]) + (v[2] * v[2] + v[3] * v[3]); }
                    ss += __shfl_xor(ss, 16); ss += __shfl_xor(ss, 32);
                    const float r = donorm ? rsqrtf(ss * (1.f / 64.f) + EPS) * sc : 1.f;
                    bf16_t* rowp = base + (size_t)(row0 + ai * HALF + m * 16) * ld;
#pragma unroll
                    for (int bj = 0; bj < 2; ++bj) *(u32x4*)(rowp + 32 * bj) = pack8(acc[ai][bj][m][0] * r * gv[bj][0], acc[ai][bj][m][1] * r * gv[bj][1]);
                }
        } else if (pn < 18) {
            bf16_t* base = ga + (pn < 14 ? (size_t)0 : (size_t)M * D) + 256 * ((pn - 10) & 3) + 32 * wc + 8 * fq;
#pragma unroll
            for (int ai = 0; ai < 2; ++ai)
#pragma unroll
                for (int m = 0; m < 4; ++m) { bf16_t* rowp = base + (size_t)(row0 + ai * HALF + m * 16) * D;
#pragma unroll
                    for (int bj = 0; bj < 2; ++bj) { f32x4 v0 = acc[ai][bj][m][0], v1 = acc[ai][bj][m][1];
#pragma unroll
                        for (int e = 0; e < 4; ++e) { v0[e] = sigm(v0[e]); v1[e] = sigm(v1[e]); }
                        *(u32x4*)(rowp + bj * HALF) = pack8(v0, v1); } }
        } else { seg3<0>(acc, pn, row0, wc, fq); seg3<1>(acc, pn, row0, wc, fq); }
    }
    template <int BJ> __device__ __forceinline__ void seg3(const f32x4 (&acc)[2][2][4][2], int pn, int row0, int wc, int fq) const {
        const int c = 256 * (pn - 18) + 128 * BJ + 32 * wc;
        if (c < 1344) { bf16_t* base = urnn + c + 8 * fq;
#pragma unroll
            for (int ai = 0; ai < 2; ++ai)
#pragma unroll
                for (int m = 0; m < 4; ++m) *(u32x4*)(base + (size_t)(row0 + ai * HALF + m * 16) * DRNN) = pack8(acc[ai][BJ][m][0], acc[ai][BJ][m][1]);
        } else if (c < 2688) { bf16_t* base = ugate + (c - 1344) + 8 * fq;
#pragma unroll
            for (int ai = 0; ai < 2; ++ai)
#pragma unroll
                for (int m = 0; m < 4; ++m) { f32x4 v0 = acc[ai][BJ][m][0], v1 = acc[ai][BJ][m][1];
#pragma unroll
                    for (int e = 0; e < 4; ++e) { v0[e] = gelu_t(v0[e]); v1[e] = gelu_t(v1[e]); }
                    *(u32x4*)(base + (size_t)(row0 + ai * HALF + m * 16) * DRNN) = pack8(v0, v1); }
        } else if (c + 8 * fq < 2736) { bf16_t* base = gn + (c - 2688) + 8 * fq;
#pragma unroll
            for (int ai = 0; ai < 2; ++ai)
#pragma unroll
                for (int m = 0; m < 4; ++m) { f32x4 v0 = acc[ai][BJ][m][0], v1 = acc[ai][BJ][m][1];
#pragma unroll
                    for (int e = 0; e < 4; ++e) { v0[e] = sigm(v0[e]); v1[e] = sigm(v1[e]); }
                    *(u32x4*)(base + (size_t)(row0 + ai * HALF + m * 16) * 48) = pack8(v0, v1); }
        }
    }
};
__device__ __forceinline__ void win_src(int ch, int& c0, int& cvalid) {
    const int tile = ch >> 3, l0 = (ch & 7) * 32, bj = l0 >> 7, wc = (l0 >> 5) & 3; cvalid = 32;
    if (tile < 4) c0 = C_Q + 256 * tile + 64 * wc + 32 * bj;
    else if (tile < 10) c0 = C_KV + 256 * (tile - 4) + 64 * wc + 32 * bj;
    else if (tile < 14) c0 = C_GA + 256 * (tile - 10) + l0;
    else if (tile < 18) c0 = C_GB + 256 * (tile - 14) + l0;
    else { const int c = 256 * (tile - 18) + l0; if (c < 2688) c0 = c; else if (c < 2736) { c0 = C_GN + c - 2688; cvalid = 2736 - c < 32 ? 2736 - c : 32; } else { c0 = 0; cvalid = 0; } }
}
constexpr int N1PAD = 29 * 256;

struct EpGeluF {
    static constexpr bool PERM = true, AFTER_DRAIN = false;
    bf16_t* O; int ldc;
    __device__ __forceinline__ void operator()(const f32x4 (&acc)[2][2][4][2], const Unit& u, int wr, int wc, int fr, int fq) const {
        const int row0 = u.pm * BM + wr * 64 + fr; bf16_t* base = O + wc * 32 + 8 * fq;
#pragma unroll
        for (int ai = 0; ai < 2; ++ai)
#pragma unroll
            for (int m = 0; m < 4; ++m) { bf16_t* rowp = base + (size_t)(row0 + ai * HALF + m * 16) * ldc;
#pragma unroll
                for (int bj = 0; bj < 2; ++bj) { f32x4 v0 = acc[ai][bj][m][0], v1 = acc[ai][bj][m][1];
#pragma unroll
                    for (int e = 0; e < 4; ++e) { v0[e] = gelu_t(v0[e]); v1[e] = gelu_t(v1[e]); }
                    *(u32x4*)(rowp + bj * HALF) = pack8(v0, v1); } }
    }
};
struct OrderC1 {
    int G, c;
    __device__ __forceinline__ bool next(int i, Unit& u) const { const int L = i * G + c; if (L >= 64) return false; u.pm = L; u.pn = L >> 5; u.ord = i; return true; }
    __device__ __forceinline__ void a_ready(const Unit&) const {}
    __device__ __forceinline__ void done(const Unit&) const {}
};
struct OrderGate {
    int G, c;
    __device__ __forceinline__ bool next(int i, Unit& u) const { const int L = i * G + c; if (L >= 4 * 128 * 3) return false; const int nb = L / 384, r = L % 384; u.pm = nb * 128 + r / 3; u.pn = nb * 3 + r % 3; u.ord = i; return true; }
    __device__ __forceinline__ void a_ready(const Unit&) const {}
    __device__ __forceinline__ void done(const Unit&) const {}
};
struct EpGateF {
    static constexpr bool PERM = true, AFTER_DRAIN = false;
    const float *ba, *bx, *lamc; const bf16_t* xc; bf16_t *la, *up;
    __device__ __forceinline__ void operator()(const f32x4 (&acc)[2][2][4][2], const Unit& u, int wr, int wc, int fr, int fq) const {
        const int nb = u.pn / 3, pn3 = u.pn % 3, ch0 = 128 * pn3 + 32 * wc + 8 * fq; if (ch0 >= BW) return;
        const int c0 = nb * BW + ch0, row0 = (u.pm & 127) * BM + wr * 64 + fr;
        const bf16_t* xcb = xc + (size_t)nb * ((size_t)M * XC_LD) + ch0; bf16_t* lab = la + c0; bf16_t* upb = up + c0;
        const f32x4 bav0 = *(const f32x4*)(ba + c0), bav1 = *(const f32x4*)(ba + c0 + 4), bxv0 = *(const f32x4*)(bx + c0), bxv1 = *(const f32x4*)(bx + c0 + 4), lcv0 = *(const f32x4*)(lamc + c0), lcv1 = *(const f32x4*)(lamc + c0 + 4);
        u32x4 xcv[2][4];
#pragma unroll
        for (int ai = 0; ai < 2; ++ai)
#pragma unroll
            for (int m = 0; m < 4; ++m) xcv[ai][m] = *(const u32x4*)(xcb + (unsigned)(row0 + ai * HALF + m * 16) * (unsigned)XC_LD);
#pragma unroll
        for (int ai = 0; ai < 2; ++ai)
#pragma unroll
            for (int m = 0; m < 4; ++m) { const unsigned row = (unsigned)(row0 + ai * HALF + m * 16);
                f32x4 x0, x1; unpack8(xcv[ai][m], x0, x1);
                f32x4 l0, l1, u0, u1;
#pragma unroll
                for (int e = 0; e < 4; ++e) {
                    l0[e] = sigm(acc[ai][0][m][0][e] + bav0[e]) * lcv0[e]; l1[e] = sigm(acc[ai][0][m][1][e] + bav1[e]) * lcv1[e];
                    u0[e] = sigm(acc[ai][1][m][0][e] + bxv0[e]) * x0[e];   u1[e] = sigm(acc[ai][1][m][1][e] + bxv1[e]) * x1[e]; }
                *(u32x4*)(lab + row * (unsigned)DRNN) = pack8(l0, l1); *(u32x4*)(upb + row * (unsigned)DRNN) = pack8(u0, u1);
                asm volatile("" ::: "memory"); }
    }
};
struct EpT1F {
    static constexpr bool PERM = true, AFTER_DRAIN = false;
    const bf16_t* g; bf16_t* o;
    __device__ __forceinline__ void operator()(const f32x4 (&acc)[2][2][4][2], const Unit& u, int wr, int wc, int fr, int fq) const {
        const int row0 = u.pm * BM + wr * 64 + fr, col0 = u.pn * BM + wc * 32 + 8 * fq;
        u32x4 gv[2][4][2];
#pragma unroll
        for (int ai = 0; ai < 2; ++ai)
#pragma unroll
            for (int m = 0; m < 4; ++m) { const size_t off = (size_t)(row0 + ai * HALF + m * 16) * D + col0;
#pragma unroll
                for (int bj = 0; bj < 2; ++bj) gv[ai][m][bj] = *(const u32x4*)(g + off + bj * HALF); }
#pragma unroll
        for (int ai = 0; ai < 2; ++ai)
#pragma unroll
            for (int m = 0; m < 4; ++m) { const size_t off = (size_t)(row0 + ai * HALF + m * 16) * D + col0;
#pragma unroll
                for (int bj = 0; bj < 2; ++bj) { f32x4 g0, g1; unpack8(gv[ai][m][bj], g0, g1);
                    *(u32x4*)(o + off + bj * HALF) = pack8(acc[ai][bj][m][0] * g0, acc[ai][bj][m][1] * g1); } }
    }
};
struct EpMergedF {
    static constexpr bool PERM = true, AFTER_DRAIN = false;
    const bf16_t* g; const bf16_t* t1; bf16_t* o;
    __device__ __forceinline__ void operator()(const f32x4 (&acc)[2][2][4][2], const Unit& u, int wr, int wc, int fr, int fq) const {
        const int row0 = u.pm * BM + wr * 64 + fr, col0 = u.pn * BM + wc * 32 + 8 * fq;
#pragma unroll
        for (int ai = 0; ai < 2; ++ai) {
            u32x4 gv[4][2], tv[4][2];
#pragma unroll
            for (int m = 0; m < 4; ++m) { const size_t off = (size_t)(row0 + ai * HALF + m * 16) * D + col0;
#pragma unroll
                for (int bj = 0; bj < 2; ++bj) { gv[m][bj] = *(const u32x4*)(g + off + bj * HALF); tv[m][bj] = *(const u32x4*)(t1 + off + bj * HALF); } }
#pragma unroll
            for (int m = 0; m < 4; ++m) { const size_t off = (size_t)(row0 + ai * HALF + m * 16) * D + col0;
#pragma unroll
                for (int bj = 0; bj < 2; ++bj) { f32x4 g0, g1, t0, t1v; unpack8(gv[m][bj], g0, g1); unpack8(tv[m][bj], t0, t1v);
                    *(u32x4*)(o + off + bj * HALF) = pack8(t0 + acc[ai][bj][m][0] * g0, t1v + acc[ai][bj][m][1] * g1); } }
            asm volatile("" ::: "memory");
        }
    }
};
struct EpHF {
    static constexpr bool PERM = true, AFTER_DRAIN = false;
    const float* x; float* h; bf16_t* hb; float* ssq;
    __device__ __forceinline__ void operator()(const f32x4 (&acc)[2][2][4][2], const Unit& u, int wr, int wc, int fr, int fq) const {
        const int row0 = u.pm * BM + wr * 64 + fr, col0 = u.pn * BM + wc * 32 + 8 * fq;
#pragma unroll
        for (int ai = 0; ai < 2; ++ai) {
            f32x4 xv[4][2][2];
#pragma unroll
            for (int m = 0; m < 4; ++m) { const size_t off = (size_t)(row0 + ai * HALF + m * 16) * D + col0;
#pragma unroll
                for (int bj = 0; bj < 2; ++bj) { xv[m][bj][0] = *(const f32x4*)(x + off + bj * HALF); xv[m][bj][1] = *(const f32x4*)(x + off + bj * HALF + 4); } }
#pragma unroll
            for (int m = 0; m < 4; ++m) { const size_t row = (size_t)(row0 + ai * HALF + m * 16), off = row * D + col0; float ss = 0.f;
#pragma unroll
                for (int bj = 0; bj < 2; ++bj) {
                    const f32x4 h0 = xv[m][bj][0] + acc[ai][bj][m][0], h1 = xv[m][bj][1] + acc[ai][bj][m][1];
                    *(u32x4*)(hb + off + bj * HALF) = pack8(h0, h1);
                    ss += (h0[0] * h0[0] + h0[1] * h0[1]) + (h0[2] * h0[2] + h0[3] * h0[3]) + (h1[0] * h1[0] + h1[1] * h1[1]) + (h1[2] * h1[2] + h1[3] * h1[3]); }
                ss += __shfl_xor(ss, 16); ss += __shfl_xor(ss, 32);
                if (fq == 0) ssq[row * 16 + 4 * u.pn + wc] = ss; }
            asm volatile("" ::: "memory");
        }
    }
};
struct EpZF {
    static constexpr bool PERM = true, AFTER_DRAIN = false;
    const PG8_LAS float* rtab; const float* ssq; bf16_t* z;
    __device__ __forceinline__ void operator()(const f32x4 (&acc)[2][2][4][2], const Unit& u, int wr, int wc, int fr, int fq) const {
        const int rl0 = wr * 64 + fr, row0 = u.pm * BM + rl0, col0 = u.pn * BM + wc * 32 + 8 * fq;
#pragma unroll
        for (int ai = 0; ai < 2; ++ai)
#pragma unroll
            for (int m = 0; m < 4; ++m) { const size_t row = (size_t)(row0 + ai * HALF + m * 16);
                float r;
                if (rtab) r = rtab[u.ord * 256 + rl0 + ai * HALF + m * 16];
                else { const f32x4 s0 = *(const f32x4*)(ssq + row * 16), s1 = *(const f32x4*)(ssq + row * 16 + 4), s2 = *(const f32x4*)(ssq + row * 16 + 8), s3 = *(const f32x4*)(ssq + row * 16 + 12);
                    const f32x4 st = (s0 + s1) + (s2 + s3); r = rsqrtf(((st[0] + st[1]) + (st[2] + st[3])) * (1.f / D) + EPS); }
#pragma unroll
                for (int bj = 0; bj < 2; ++bj) { f32x4 v0 = acc[ai][bj][m][0] * r, v1 = acc[ai][bj][m][1] * r;
#pragma unroll
                    for (int e = 0; e < 4; ++e) { v0[e] = v0[e] > 0.f ? v0[e] * v0[e] : 0.f; v1[e] = v1[e] > 0.f ? v1[e] * v1[e] : 0.f; }
                    *(u32x4*)(z + row * DFF + col0 + bj * HALF) = pack8(v0, v1); } }
    }
};
struct EpOutF {
    static constexpr bool PERM = true, AFTER_DRAIN = false;
    const bf16_t* hb; float* o;
    __device__ __forceinline__ void operator()(const f32x4 (&acc)[2][2][4][2], const Unit& u, int wr, int wc, int fr, int fq) const {
        const int row0 = u.pm * BM + wr * 64 + fr, col0 = u.pn * BM + wc * 32 + 8 * fq;
        u32x4 hv[2][4][2];
#pragma unroll
        for (int ai = 0; ai < 2; ++ai)
#pragma unroll
            for (int m = 0; m < 4; ++m) { const size_t off = (size_t)(row0 + ai * HALF + m * 16) * D + col0;
#pragma unroll
                for (int bj = 0; bj < 2; ++bj) hv[ai][m][bj] = *(const u32x4*)(hb + off + bj * HALF); }
#pragma unroll
        for (int ai = 0; ai < 2; ++ai)
#pragma unroll
            for (int m = 0; m < 4; ++m) { float* p = o + (size_t)(row0 + ai * HALF + m * 16) * D + col0;
#pragma unroll
                for (int bj = 0; bj < 2; ++bj) { f32x4 h0, h1; unpack8(hv[ai][m][bj], h0, h1); *(f32x4*)(p + bj * HALF) = h0 + acc[ai][bj][m][0]; *(f32x4*)(p + bj * HALF + 4) = h1 + acc[ai][bj][m][1]; } }
    }
};
}

namespace att {
using pg8::bf16x8; using pg8::f32x4; using pg8::u32x4;
typedef float f32x16 __attribute__((ext_vector_type(16)));
typedef short s16x4 __attribute__((ext_vector_type(4)));
typedef float f32x2_t __attribute__((ext_vector_type(2))); typedef __bf16 bf16x2_t __attribute__((ext_vector_type(2)));
constexpr int KROW = 144, VROW = 144, KT = 64 * KROW, VT = 64 * VROW;
__device__ __forceinline__ int vperm(int kv) { return (kv & ~12) | ((kv & 4) << 1) | ((kv & 8) >> 1); }
constexpr int L_K0 = 0, L_K1 = KT, L_V0 = 2 * KT, L_V1 = 2 * KT + VT, L_BT = 2 * KT + 2 * VT  , L_IMPG = L_BT + 4096 + 64, L_IMPL = L_IMPG + 33792, L_IMP = L_IMPL + 33792, L_SELM = L_IMP + 64 * 33 * 4, L_KC = L_SELM + 512  , VCROW = 272, L_VC = L_KC + 128 * KROW  , L_END = L_VC + 64 * VCROW;
static_assert(L_END <= 163840 - 512, "attention LDS map");
__device__ __forceinline__ int crow(int r, int hi) { return (r & 3) + 8 * (r >> 2) + 4 * hi; }
__device__ __forceinline__ float max3f(float a, float b, float c) { float r; asm("v_max3_f32 %0, %1, %2, %3" : "=v"(r) : "v"(a), "v"(b), "v"(c)); return r; }
__device__ __forceinline__ unsigned cvtpk(float lo, float hi) { f32x2_t v = {lo, hi}; bf16x2_t b = __builtin_convertvector(v, bf16x2_t); return __builtin_bit_cast(unsigned, b); }
__device__ __forceinline__ bf16x8 packp(const f32x16& p, int s) {
    u32x4 w; w.x = cvtpk(p[8 * s + 0], p[8 * s + 1]); w.y = cvtpk(p[8 * s + 2], p[8 * s + 3]); w.z = cvtpk(p[8 * s + 4], p[8 * s + 5]); w.w = cvtpk(p[8 * s + 6], p[8 * s + 7]);
    return __builtin_bit_cast(bf16x8, w); }
__device__ __forceinline__ bf16x8 kfrag(const unsigned char* kbuf, int st, int sp, int q32, int hi) { return *(const bf16x8*)(kbuf + (32 * st + q32) * KROW + (16 * sp + 8 * hi) * 2); }
__device__ __forceinline__ bf16x8 vfrag(const unsigned char* vbuf, int st, int s, int dt, int q32, int hi) { return *(const bf16x8*)(vbuf + (32 * dt + q32) * VROW + (32 * st + 16 * s + 8 * hi) * 2); }
__device__ __forceinline__ f32x16 qk_tile(const unsigned char* kbuf, int st, const bf16x8 (&qf)[4], int q32, int hi) {
    f32x16 s = {};
#pragma unroll
    for (int sp = 0; sp < 4; ++sp) s = __builtin_amdgcn_mfma_f32_32x32x16_bf16(kfrag(kbuf, st, sp, q32, hi), qf[sp], s, 0, 0, 0);
    return s; }
__device__ __forceinline__ void pv_tile(f32x16 (&o)[2], const unsigned char* vbuf, int st, const f32x16& p, int q32, int hi) {
#pragma unroll
    for (int s = 0; s < 2; ++s) { const bf16x8 pb = packp(p, s);
#pragma unroll
        for (int dt = 0; dt < 2; ++dt) o[dt] = __builtin_amdgcn_mfma_f32_32x32x16_bf16(vfrag(vbuf, st, s, dt, q32, hi), pb, o[dt], 0, 0, 0); }
}
struct Stage { u32x4 k, v; };
__device__ __forceinline__ void stage_load(Stage& s, const bf16_t* Kblk  , int ldk, const bf16_t* Vblk  , int ldv, int tid) {
    const int row = tid >> 3, ch = tid & 7;
    s.k = *(const u32x4*)(Kblk + (size_t)row * ldk + ch * 8); s.v = *(const u32x4*)(Vblk + (size_t)row * ldv + ch * 8); }
__device__ __forceinline__ void stage_store(const Stage& s, unsigned char* kbuf, unsigned char* vbuf, int tid) {
    const int row = tid >> 3, ch = tid & 7;
    *(u32x4*)(kbuf + row * KROW + ch * 16) = s.k;
    *(u32x4*)(vbuf + row * VROW + ch * 16) = s.v; }

struct SoftState { float mhat, l; f32x16 cneg; };
constexpr float ATT_THR = 8.0f;
template <int BR, int ABL>
__device__ __forceinline__ void block64(f32x16 (&o)[2], SoftState& ss, const unsigned char* kbuf, const unsigned char* vbuf, int dj, bool selbit, bool anyunsel, const bf16x8 (&qf)[4], const float* bt2,
                                        int q32, int hi, int tl) {
    f32x16 s0, s1;
    if (ABL & 64) { s0 = f32x16{}; s1 = f32x16{}; }
    else { s0 = ss.cneg; s1 = ss.cneg; }
    bf16x8 vf0[2][2], vf1[2][2];
#define ATT_BIAS(S_, KT_) do { if (dj <= 2) { const float* bt_ = bt2 + (64 * dj + tl + 64 - 4 * hi - 27) - 32 * (KT_); \
            _Pragma("unroll") for (int r = 0; r < 16; ++r) { const int cr = (r & 3) + 8 * (r >> 2); S_[r] += bt_[27 - cr]; } \
        } else if (BR == 1 && dj == 8) { const int basei = tl - 4 * hi; \
            _Pragma("unroll") for (int r = 0; r < 16; ++r) { const int cr = (r & 3) + 8 * (r >> 2); S_[r] += __int_as_float(((cr + 32 * (KT_) - basei - 1) >> 31) & 0xf149f2cau); } } } while (0)
    if (ABL & 64) {
#pragma unroll
        for (int sp = 0; sp < 4; ++sp) s0 = __builtin_amdgcn_mfma_f32_32x32x16_bf16(kfrag(kbuf, 0, sp, q32, hi), qf[sp], s0, 0, 0, 0);
        __builtin_amdgcn_sched_barrier(0);
#pragma unroll
        for (int s = 0; s < 2; ++s)
#pragma unroll
            for (int dt = 0; dt < 2; ++dt) vf0[s][dt] = vfrag(vbuf, 0, s, dt, q32, hi);
        __builtin_amdgcn_sched_barrier(0);
        bf16x8 k1[4];
#pragma unroll
        for (int sp = 0; sp < 4; ++sp) k1[sp] = kfrag(kbuf, 1, sp, q32, hi);
        __builtin_amdgcn_sched_barrier(0);
        ATT_BIAS(s0, 0);
#pragma unroll
        for (int sp = 0; sp < 4; ++sp) { s1 = __builtin_amdgcn_mfma_f32_32x32x16_bf16(k1[sp], qf[sp], s1, 0, 0, 0);
#pragma unroll
            for (int e = 0; e < 4; ++e) s0[4 * sp + e] = __builtin_amdgcn_exp2f(s0[4 * sp + e]);
            __builtin_amdgcn_sched_barrier(0); }
        ATT_BIAS(s1, 1);
    } else {
#pragma unroll
    for (int sp = 0; sp < 4; ++sp) { s0 = __builtin_amdgcn_mfma_f32_32x32x16_bf16(kfrag(kbuf, 0, sp, q32, hi), qf[sp], s0, 0, 0, 0); s1 = __builtin_amdgcn_mfma_f32_32x32x16_bf16(kfrag(kbuf, 1, sp, q32, hi), qf[sp], s1, 0, 0, 0); }
    __builtin_amdgcn_sched_barrier(0);
#pragma unroll
    for (int s = 0; s < 2; ++s)
#pragma unroll
        for (int dt = 0; dt < 2; ++dt) vf0[s][dt] = vfrag(vbuf, 0, s, dt, q32, hi);
    __builtin_amdgcn_sched_barrier(0);
    ATT_BIAS(s0, 0); ATT_BIAS(s1, 1);
    }
#undef ATT_BIAS
    if (!(ABL & 64)) {
    float rm = max3f(s0[0], s0[1], s1[0]), rm2 = max3f(s0[2], s0[3], s1[1]);
    rm = max3f(rm, s1[2], s1[3]);
#pragma unroll
    for (int r = 4; r < 16; r += 4) { rm = max3f(rm, s0[r], s0[r + 1]); rm2 = max3f(rm2, s0[r + 2], s0[r + 3]); rm = max3f(rm, s1[r], s1[r + 1]); rm2 = max3f(rm2, s1[r + 2], s1[r + 3]); }
    rm = max3f(rm, rm2, rm2);
    if (BR == 0) rm = selbit ? rm : -1e30f;
    if (__any(rm > ATT_THR)) {
        const float rmc = fmaxf(rm, __shfl_xor(rm, 32)), dl = fmaxf(rmc, 0.f), f = __builtin_amdgcn_exp2f(-dl);
        ss.mhat += dl; ss.l *= f;
#pragma unroll
        for (int r = 0; r < 16; ++r) { s0[r] -= dl; s1[r] -= dl; ss.cneg[r] -= dl; o[0][r] *= f; o[1][r] *= f; }
    }
    }
    float ps = 0.f, ps1 = 0.f, ps2 = 0.f, ps3 = 0.f;
#pragma unroll
    for (int r = 0; r < 16; r += 2) { if (!(ABL & 64)) { s0[r] = __builtin_amdgcn_exp2f(s0[r]); s0[r + 1] = __builtin_amdgcn_exp2f(s0[r + 1]); } ps += s0[r]; ps2 += s0[r + 1]; }
    const unsigned pm = (BR == 0 && !selbit) ? 0u : 0xffffffffu;
    bf16x8 pb0[2];
#pragma unroll
    for (int s = 0; s < 2; ++s) { pb0[s] = packp(s0, s);
        if (BR == 0 && anyunsel) { u32x4 w = __builtin_bit_cast(u32x4, pb0[s]); w.x &= pm; w.y &= pm; w.z &= pm; w.w &= pm; pb0[s] = __builtin_bit_cast(bf16x8, w); } }
    __builtin_amdgcn_sched_barrier(0);
#pragma unroll
    for (int i = 0; i < 4; ++i) { const int s = i >> 1, dt = i & 1;
        o[dt] = __builtin_amdgcn_mfma_f32_32x32x16_bf16(vf0[s][dt], pb0[s], o[dt], 0, 0, 0);
#pragma unroll
        for (int e = 0; e < 4; ++e) s1[4 * i + e] = __builtin_amdgcn_exp2f(s1[4 * i + e]);
        __builtin_amdgcn_sched_barrier(0); }
#pragma unroll
    for (int s = 0; s < 2; ++s)
#pragma unroll
        for (int dt = 0; dt < 2; ++dt) vf1[s][dt] = vfrag(vbuf, 1, s, dt, q32, hi);
#pragma unroll
    for (int r = 0; r < 16; r += 2) { ps1 += s1[r]; ps3 += s1[r + 1]; }
    ps = (ps + ps1) + (ps2 + ps3);
    if (BR == 0) ps = selbit ? ps : 0.f;
    ss.l += ps;
#pragma unroll
    for (int s = 0; s < 2; ++s) { bf16x8 pb = packp(s1, s);
        if (BR == 0 && anyunsel) { u32x4 w = __builtin_bit_cast(u32x4, pb); w.x &= pm; w.y &= pm; w.z &= pm; w.w &= pm; pb = __builtin_bit_cast(bf16x8, w); }
#pragma unroll
        for (int dt = 0; dt < 2; ++dt) o[dt] = __builtin_amdgcn_mfma_f32_32x32x16_bf16(vf1[s][dt], pb, o[dt], 0, 0, 0); }
}
__device__ __forceinline__ void stage_load_t(Stage& s, const bf16_t* Kblk, const bf16_t* Vblk, int tid) {
    s.k = *(const u32x4*)(Kblk + (size_t)(tid >> 3) * KVW + (tid & 7) * 8); s.v = *(const u32x4*)(Vblk + (size_t)(tid & 63) * KVW + (tid >> 6) * 8); }
__device__ __forceinline__ void stage_store_t(const Stage& s, unsigned char* kbuf, unsigned char* vbuf, int tid) {
    const int row = tid >> 3, ch = tid & 7;
    *(u32x4*)(kbuf + row * KROW + ch * 16) = s.k;
    unsigned short* vp = (unsigned short*)(vbuf + ((tid >> 6) * 8) * VROW + vperm(tid & 63) * 2);
    vp[0 * (VROW / 2)] = (unsigned short)s.v.x; vp[1 * (VROW / 2)] = (unsigned short)(s.v.x >> 16); vp[2 * (VROW / 2)] = (unsigned short)s.v.y; vp[3 * (VROW / 2)] = (unsigned short)(s.v.y >> 16);
    vp[4 * (VROW / 2)] = (unsigned short)s.v.z; vp[5 * (VROW / 2)] = (unsigned short)(s.v.z >> 16); vp[6 * (VROW / 2)] = (unsigned short)s.v.w; vp[7 * (VROW / 2)] = (unsigned short)(s.v.w >> 16); }
template <int BR, int ABL>
__device__ __forceinline__ void branch(float* outl  , const Stage* first  , float gate, const bf16_t* Kg  , const bf16_t* Vg  ,
                                       int qblk, unsigned unionmask, unsigned mysel, const bf16x8 (&qf)[4], const float* bt2  , float cb  ,
                                       unsigned char* lds, int tid, int q32, int hi, int tl) {
    const int jlo = BR == 0 ? 0 : (qblk - 8 < 0 ? 0 : qblk - 8);
    f32x16 o[2]; o[0] = f32x16{}; o[1] = f32x16{};
    SoftState ss; ss.mhat = 0.f; ss.l = 0.f;
#pragma unroll
    for (int r = 0; r < 16; ++r) ss.cneg[r] = cb;
#define ATT_NEXT(jv) do { --(jv); if (BR == 0) { while ((jv) >= jlo && !((unionmask >> (jv)) & 1u)) --(jv); } } while (0)
#define ATT_LOAD(sg, jv) do { const int jl_ = (jv) < jlo ? jlo : (jv); if (!(ABL & 8)) stage_load_t(sg, Kg + (size_t)jl_ * 64 * KVW, Vg + (size_t)jl_ * 64 * KVW, tid); else { sg.k = (u32x4){(unsigned)jl_, 0u, 0u, 0u}; sg.v = sg.k; } } while (0)
#define ATT_SEL(jv) (BR == 0 ? (((mysel >> (jv)) & 1u) != 0u) : true)
    int jA = qblk, jB = qblk, jC;
    Stage sA, sB;
    if (first) sA = *first; else ATT_LOAD(sA, jA);
    ATT_NEXT(jB); ATT_LOAD(sB, jB);
    stage_store_t(sA, lds + L_K0, lds + L_V0, tid);
    __syncthreads();
    for (;;) {
        jC = jB; if (jB >= jlo) ATT_NEXT(jC);
        ATT_LOAD(sA, jC);
        { const bool sel = ATT_SEL(jA); if (BR == 1 || __any(sel)) block64<BR, ABL>(o, ss, lds + L_K0, lds + L_V0, qblk - jA, sel, BR == 0 && __any(!sel), qf, bt2, q32, hi, tl); }
        if (jB < jlo) break;
        if (!(ABL & 16)) stage_store_t(sB, lds + L_K1, lds + L_V1, tid);
        if (!(ABL & 4)) __syncthreads();
        jA = jC; if (jC >= jlo) ATT_NEXT(jA);
        ATT_LOAD(sB, jA);
        { const bool sel = ATT_SEL(jB); if (BR == 1 || __any(sel)) block64<BR, ABL>(o, ss, lds + L_K1, lds + L_V1, qblk - jB, sel, BR == 0 && __any(!sel), qf, bt2, q32, hi, tl); }
        if (jC < jlo) break;
        if (!(ABL & 16)) stage_store_t(sA, lds + L_K0, lds + L_V0, tid);
        if (!(ABL & 4)) __syncthreads();
        jB = jA; jA = jC;
    }
#undef ATT_NEXT
#undef ATT_LOAD
#undef ATT_SEL
    float lrun = ss.l; lrun += __shfl_xor(lrun, 32);
    const float f = gate / lrun;
#pragma unroll
    for (int r = 0; r < 16; ++r) { outl[r * 64] += o[0][r] * f; outl[(16 + r) * 64] += o[1][r] * f; }
    __syncthreads();
}

__device__ __forceinline__ void attn_bias_table(int g, const float* rel_bias, unsigned char* lds) {
    float* bt = (float*)(lds + L_BT); const int tid = threadIdx.x;
#pragma unroll
    for (int i = 0; i < 2; ++i) { const int e = tid + 512 * i, hh = e >> 8, ix = (e & 255) - 64; const float cbh = rel_bias[31 * NH + g * 4 + hh] * LOG2E; bt[e] = ix < 0 ? -1e30f : rel_bias[BUCKET[ix > 127 ? 127 : ix] * NH + g * 4 + hh] * LOG2E - cbh; }
    if (tid < 4) bt[1024 + tid] = rel_bias[31 * NH + g * 4 + tid] * LOG2E;
    __syncthreads();
}
__device__ __forceinline__ void attn_compress_l2(int bg, const bf16_t* HIDK, const bf16_t* HIDV, const float* w2k, const float* w2v, const float* kc_norm, unsigned char* lds) {
    const int tid = threadIdx.x, lane = tid & 63, wave = tid >> 6, q32 = lane & 31, hi = lane >> 5, which = wave >> 2, c = 32 * (wave & 3) + q32; const bool okc = c < NC;
    const bf16_t* hrow = (which ? HIDV : HIDK) + (size_t)(bg * NC + (okc ? c : 0)) * 256; const float* w2 = which ? w2v : w2k;
    f32x16 acc[2]; acc[0] = f32x16{}; acc[1] = f32x16{};
    for (int s = 0; s < 16; ++s) {
        const bf16x8 bfrag = *(const bf16x8*)(hrow + 16 * s + 8 * hi);
#pragma unroll
        for (int nt = 0; nt < 2; ++nt) { const float* wp = w2 + (size_t)(16 * s + 8 * hi) * HD + 32 * nt + q32;
            u32x4 aw; aw.x = cvtpk(wp[0], wp[HD]); aw.y = cvtpk(wp[2 * HD], wp[3 * HD]); aw.z = cvtpk(wp[4 * HD], wp[5 * HD]); aw.w = cvtpk(wp[6 * HD], wp[7 * HD]);
            acc[nt] = __builtin_amdgcn_mfma_f32_32x32x16_bf16(__builtin_bit_cast(bf16x8, aw), bfrag, acc[nt], 0, 0, 0); }
    }
    if (which) {
        unsigned short* vp = (unsigned short*)(lds + L_VC) + vperm(c);
#pragma unroll
        for (int nt = 0; nt < 2; ++nt)
#pragma unroll
            for (int q = 0; q < 16; ++q) vp[(32 * nt + crow(q, hi)) * (VCROW / 2)] = okc ? (unsigned short)(cvtpk(acc[nt][q], 0.f) & 0xffffu) : (unsigned short)0;
    } else {
        float ss = 0.f;
#pragma unroll
        for (int nt = 0; nt < 2; ++nt)
#pragma unroll
            for (int q = 0; q < 16; ++q) ss += acc[nt][q] * acc[nt][q];
        ss += __shfl_xor(ss, 32); const float rn = okc ? rsqrtf(ss * (1.f / HD) + EPS) : 0.f;
#pragma unroll
        for (int nt = 0; nt < 2; ++nt)
#pragma unroll
            for (int rg = 0; rg < 4; ++rg) { const int n0 = 32 * nt + 8 * rg + 4 * hi; const f32x4 gk = *(const f32x4*)(kc_norm + n0);
                *(unsigned long long*)(lds + L_KC + c * KROW + n0 * 2) = (unsigned long long)cvtpk(acc[nt][4 * rg] * rn * gk[0], acc[nt][4 * rg + 1] * rn * gk[1]) | ((unsigned long long)cvtpk(acc[nt][4 * rg + 2] * rn * gk[2], acc[nt][4 * rg + 3] * rn * gk[3]) << 32); }
    }
    __syncthreads();
}
__device__ __forceinline__ bf16x8 vfragc(const unsigned char* vcbuf, int tile, int s, int dt, int q32, int hi) { return *(const bf16x8*)(vcbuf + (32 * dt + q32) * VCROW + (32 * tile + 16 * s + 8 * hi) * 2); }
template <int MODE, int ABL = 0>
__device__ __forceinline__ void attn_unit(int b, int g, int qblk, const bf16_t* Q, bf16_t* O, const bf16_t* KSb, const bf16_t* VSb, const bf16_t* KWb, const bf16_t* VWb,
                                          const bf16_t* GN, const float* rel_bias, unsigned char* lds) {
    int tid = threadIdx.x; asm volatile("" : "+v"(tid));
    const int lane = tid & 63, wave = tid >> 6, q32 = lane & 31, hi = lane >> 5, hr = wave >> 1, th = wave & 1, h = g * 4 + hr, tl = 32 * th + q32, t = 64 * qblk + tl, bg = b * 4 + g;
    const size_t m = (size_t)b * T + t;
    float* bt = (float*)(lds + L_BT); float* impg = (float*)(lds + L_IMPG); float* impl = (float*)(lds + L_IMPL); float* imp = (float*)(lds + L_IMP); unsigned* selm = (unsigned*)(lds + L_SELM);
    bf16x8 qf[4];
#pragma unroll
    for (int sp = 0; sp < 4; ++sp) qf[sp] = *(const bf16x8*)(Q + m * QW + h * HD + 16 * sp + 8 * hi);
    const float g0 = bf2f(GN[m * 48 + h * 3 + 0]), g1 = bf2f(GN[m * 48 + h * 3 + 1]), g2 = bf2f(GN[m * 48 + h * 3 + 2]);
    f32x16 out[2];
    {
        const float* bte = bt + hr * 256 + 64; const float cbh = bt[1024 + hr];
        const int ncv = t >= 31 ? ((t - 31) >> 4) + 1 : 0;
        const int ncvw = 4 * qblk + 2 * __builtin_amdgcn_readfirstlane(th) + 1;
        f32x16 sc[4]; float mx = -1e20f;
#pragma unroll
        for (int tile = 0; tile < 4; ++tile) {
            if (32 * tile >= ncvw) { sc[tile] = f32x16{}; continue; }
            sc[tile] = qk_tile(lds + L_KC, tile, qf, q32, hi);
            __builtin_amdgcn_sched_barrier(0);
#pragma unroll
            for (int r = 0; r < 16; ++r) { const int c = 32 * tile + crow(r, hi);
                int dist = t - 31 - 16 * c; const float pen = __int_as_float(((ncv - 1 - c) >> 31) & 0xf149f2cau);
                dist = dist < 0 ? 0 : (dist > 127 ? 127 : dist);
                const float v = (sc[tile][r] + (bte[dist] + cbh)) + pen; sc[tile][r] = v; mx = fmaxf(mx, v); }
            __builtin_amdgcn_sched_barrier(0);
        }
        mx = fmaxf(mx, __shfl_xor(mx, 32));
        float l = 0.f;
#pragma unroll
        for (int tile = 0; tile < 4; ++tile) { if (32 * tile >= ncvw) continue;
#pragma unroll
            for (int r = 0; r < 16; ++r) { const float p = __builtin_amdgcn_exp2f(sc[tile][r] - mx); sc[tile][r] = p; l += p; } }
        l += __shfl_xor(l, 32);
        const float inv = l > 0.f ? 1.f / l : 0.f;
#pragma unroll
        for (int tile = 0; tile < 4; ++tile) { if (32 * tile >= ncvw) continue;
#pragma unroll
            for (int r = 0; r < 16; ++r) sc[tile][r] *= inv; }
        __builtin_amdgcn_sched_barrier(0);
        if (qblk > 15)
#pragma unroll
        for (int tile = 0; tile < 4; ++tile)
#pragma unroll
            for (int rg = 0; rg < 4; ++rg) { const int j = 8 * tile + 2 * rg + hi;
                impg[(hr * 64 + tl) * 33 + j] = (sc[tile][4 * rg] + sc[tile][4 * rg + 1]) + (sc[tile][4 * rg + 2] + sc[tile][4 * rg + 3]);
                impl[(hr * 64 + tl) * 33 + j] = sc[tile][4 * rg + 3]; }
        __builtin_amdgcn_sched_barrier(0);
        f32x16 o[2]; o[0] = f32x16{}; o[1] = f32x16{};
#pragma unroll
        for (int tile = 0; tile < 4; ++tile) { if (32 * tile >= ncvw) continue;
#pragma unroll
            for (int s = 0; s < 2; ++s) { const bf16x8 pb = packp(sc[tile], s);
#pragma unroll
                for (int dt = 0; dt < 2; ++dt) o[dt] = __builtin_amdgcn_mfma_f32_32x32x16_bf16(vfragc(lds + L_VC, tile, s, dt, q32, hi), pb, o[dt], 0, 0, 0); }
            __builtin_amdgcn_sched_barrier(0); }
#pragma unroll
        for (int r = 0; r < 16; ++r) { out[0][r] = o[0][r] * g0; out[1][r] = o[1][r] * g0; }
    }
    const bf16_t* Kgs = KSb + (size_t)b * T * KVW + g * HD; const bf16_t* Kgw = KWb + (size_t)b * T * KVW + g * HD;
    const bf16_t* Vgs = VSb + (size_t)b * T * KVW + g * HD; const bf16_t* Vgw = VWb + (size_t)b * T * KVW + g * HD;
    Stage sfirst; stage_load_t(sfirst, Kgs + (size_t)qblk * 64 * KVW, Vgs + (size_t)qblk * 64 * KVW, tid);
    unsigned mysel, uni;
    if (qblk > 15) {
    __syncthreads();
    {
        const int stl = tid >> 3, jq = tid & 7;
#pragma unroll
        for (int e = 0; e < 4; ++e) { const int j = 4 * jq + e; float s = 0.f;
#pragma unroll
            for (int r = 0; r < 4; ++r) { s += impg[(r * 64 + stl) * 33 + j]; if (j > 0) s += impl[(r * 64 + stl) * 33 + j - 1]; }
            imp[stl * 33 + j] = s; }
        __syncthreads();
        unsigned bits = 0u;
        {
            float iv[32];
#pragma unroll
            for (int k = 0; k < 32; ++k) iv[k] = imp[stl * 33 + k];
#pragma unroll
            for (int e = 0; e < 4; ++e) { const int j = 4 * jq + e; float vj = iv[0];
#pragma unroll
                for (int k = 1; k < 32; ++k) vj = (k == j) ? iv[k] : vj;
                int rank = 0;
#pragma unroll
                for (int k = 1; k < 30; ++k) { const bool cand = k <= qblk - 2; rank += (cand && (iv[k] > vj || (iv[k] == vj && k < j))) ? 1 : 0; }
                if (j == 0 || j == qblk - 1 || j == qblk) bits |= 1u << j; else if (j < qblk - 1 && rank < 13) bits |= 1u << j; }
        }
        bits |= __shfl_xor(bits, 1); bits |= __shfl_xor(bits, 2); bits |= __shfl_xor(bits, 4);
        if (jq == 0) selm[stl] = bits;
    }
    __syncthreads();
    mysel = selm[tl]; uni = selm[lane];
#pragma unroll
    for (int o = 1; o < 64; o <<= 1) uni |= __shfl_xor(uni, o);
    } else { mysel = uni = (1u << (qblk + 1)) - 1u; }
    float* outl = (float*)(lds + L_IMPG) + wave * 2048 + lane;
#pragma unroll
    for (int r = 0; r < 16; ++r) { outl[r * 64] = out[0][r]; outl[(16 + r) * 64] = out[1][r]; }
    if (MODE & 2) branch<0, ABL>(outl, &sfirst, g1, Kgs, Vgs, qblk, uni, mysel, qf, bt + hr * 256, bt[1024 + hr], lds, tid, q32, hi, tl);
    if (MODE & 4) branch<1, ABL>(outl, nullptr, g2, Kgw, Vgw, qblk, 0xffffffffu, 0xffffffffu, qf, bt + hr * 256, bt[1024 + hr], lds, tid, q32, hi, tl);
    bf16_t* orow = O + m * QW + h * HD;
#pragma unroll
    for (int dt = 0; dt < 2; ++dt)
#pragma unroll
        for (int rg = 0; rg < 4; ++rg)
            *(unsigned long long*)(orow + 32 * dt + 8 * rg + 4 * hi) = (unsigned long long)cvtpk(outl[(16 * dt + 4 * rg) * 64], outl[(16 * dt + 4 * rg + 1) * 64]) | ((unsigned long long)cvtpk(outl[(16 * dt + 4 * rg + 2) * 64], outl[(16 * dt + 4 * rg + 3) * 64]) << 32);
}
}

__device__ __forceinline__ void tr_item(const float* W, int ldw, int kvalid, int c0, int cvalid, const float* kscale, bf16_t* WT, int ldt, int r0, int k0, float* scr, int lane) {
#pragma unroll
    for (int i = 0; i < 32; ++i) { const int kk = 2 * i + (lane >> 5), col = lane & 31, k = k0 + kk;
        float v = 0.f; if (k < kvalid && col < cvalid) { v = W[(size_t)k * ldw + c0 + col]; if (kscale) v *= kscale[k]; }
        scr[kk * 33 + col] = v; }
    asm volatile("s_waitcnt lgkmcnt(0)" ::: "memory");
    const int c = lane & 7;
#pragma unroll
    for (int j = 0; j < 4; ++j) { const int n = (lane >> 3) + 8 * j; const float* s = scr + (8 * c) * 33 + n;
        pg8::u32x4 o; o.x = pg8::cvt_pk_bf16(s[0 * 33], s[1 * 33]); o.y = pg8::cvt_pk_bf16(s[2 * 33], s[3 * 33]); o.z = pg8::cvt_pk_bf16(s[4 * 33], s[5 * 33]); o.w = pg8::cvt_pk_bf16(s[6 * 33], s[7 * 33]);
        *(pg8::u32x4*)(WT + (size_t)(r0 + n) * ldt + k0 + 8 * c) = o; }
    asm volatile("s_waitcnt lgkmcnt(0)" ::: "memory");
}

#define LAS __attribute__((address_space(3)))
#define XB_TMO      128
#define XB_XCNT(j)  (256  + 64 * (j))
#define XB_XSUB(j)  (1280 + 64 * (j))
#define XB_XGEN(j)  (2304 + 64 * (j))
#define XB_TOP      3328
#define XB_TOPGEN   3392
#define XCD_BAR_WORDS 3456
#define XB_SPIN_CAP (1u << 18)

__device__ __forceinline__ unsigned xb_ld(unsigned* p)              { return __hip_atomic_load(p, __ATOMIC_RELAXED, __HIP_MEMORY_SCOPE_AGENT); }
__device__ __forceinline__ unsigned xb_add(unsigned* p, unsigned v) { return __hip_atomic_fetch_add(p, v, __ATOMIC_RELAXED, __HIP_MEMORY_SCOPE_AGENT); }
__device__ __forceinline__ unsigned xb_xcc_id() { return (unsigned)__builtin_amdgcn_s_getreg((3 << 11) | 20) & 0xFu; }
#define XB_SPIN(cond, bar) do { unsigned _sp = 0; while (cond) { __builtin_amdgcn_s_sleep(1); \
    if ((++_sp & 255u) == 0u) { if (xb_ld(&(bar)[XB_TMO])) break; if (_sp > XB_SPIN_CAP) { atomicAdd(&(bar)[XB_TMO], 1u); break; } } } } while (0)

struct XcdBarrier {
    unsigned* bar; unsigned x;
    volatile LAS unsigned* st;
};

__device__ __forceinline__ XcdBarrier xcd_barrier_post(unsigned* bar, volatile LAS unsigned* st) {
    XcdBarrier b; b.bar = bar; b.x = xb_xcc_id(); b.st = st;
    if (threadIdx.x == 0) (void)xb_add(&bar[XB_XCNT(b.x)], 1u);
    return b;
}
__device__ __forceinline__ void xcd_barrier_complete(unsigned* bar, unsigned x, unsigned& nloc, unsigned& nx) {
    const unsigned G = gridDim.x * gridDim.y * gridDim.z;
    unsigned sum, cnt, mine, sp = 0u;
    for (;;) {
        sum = 0u; cnt = 0u; mine = 0u;
#pragma unroll
        for (unsigned j = 0; j < 16; ++j) { const unsigned c = xb_ld(&bar[XB_XCNT(j)]); sum += c; cnt += (c > 0u) ? 1u : 0u; mine = (j == x) ? c : mine; }
        if (sum == G) break;
        __builtin_amdgcn_s_sleep(1);
        if ((++sp & 255u) == 0u) { if (xb_ld(&bar[XB_TMO])) break; if (sp > XB_SPIN_CAP) { atomicAdd(&bar[XB_TMO], 1u); break; } }
    }
    nloc = mine > 0u ? mine : 1u; nx = cnt > 0u ? cnt : 1u;
}

__device__ __forceinline__ void xcd_barrier(const XcdBarrier& b) {
    asm volatile("s_waitcnt vmcnt(0)" ::: "memory");
    __syncthreads();
    if (threadIdx.x == 0) {
        unsigned* bar = b.bar;
        __builtin_amdgcn_s_waitcnt(0);
        unsigned nloc = b.st[0], nx = b.st[1];
        if (nloc == 0u) { xcd_barrier_complete(bar, b.x, nloc, nx); b.st[0] = nloc; b.st[1] = nx; }
        const unsigned old = xb_add(&bar[XB_XSUB(b.x)], 1u);
        const unsigned gen = old / nloc;
        if (old + 1u == (gen + 1u) * nloc) {
            __builtin_amdgcn_fence(__ATOMIC_RELEASE, "agent");
            asm volatile("s_waitcnt vmcnt(0)" ::: "memory");
            const unsigned og = xb_add(&bar[XB_TOP], 1u);
            const unsigned tg = og / nx;
            if (og + 1u == (tg + 1u) * nx) xb_add(&bar[XB_TOPGEN], 1u);
            else XB_SPIN(xb_ld(&bar[XB_TOPGEN]) == tg, bar);
            __builtin_amdgcn_fence(__ATOMIC_ACQUIRE, "agent");
            xb_add(&bar[XB_XGEN(b.x)], 1u);
            asm volatile("s_waitcnt vmcnt(0)" ::: "memory");
        } else {
            XB_SPIN(xb_ld(&bar[XB_XGEN(b.x)]) == gen, bar);
            __builtin_amdgcn_fence(__ATOMIC_ACQUIRE, "agent");
            asm volatile("s_waitcnt vmcnt(0)" ::: "memory");
        }
    }
    __syncthreads();
}

#define DECL_PTRS \
    size_t zoff_ = 0; asm volatile("" : "+s"(zoff_));     \
    unsigned char* ws = a.ws + zoff_; unsigned char* dob = (unsigned char*)a.out + zoff_; \
    const float *x = a.in[0], *norm_mix = a.in[1], *w_in = a.in[2], *conv_w = a.in[3], *conv_b = a.in[4], *gate_a_w = a.in[5], *gate_a_b = a.in[6], *gate_x_w = a.in[7], *gate_x_b = a.in[8], \
                *lam = a.in[9], *pe_k = a.in[10], *w1k = a.in[11], *w2k = a.in[12], *pe_v = a.in[13], *w1v = a.in[14], *w2v = a.in[15], *q_norm = a.in[16], *kc_norm = a.in[17], *ks_norm = a.in[18], \
                *kw_norm = a.in[19], *rel_bias = a.in[20], *proj_a = a.in[21], *proj_b = a.in[22], *w_out = a.in[23], *norm_mlp = a.in[24], *w_mlp_in = a.in[25], *w_mlp_out = a.in[26]; \
    float* RSTD = (float*)(ws + WS_RSTD); float* KCC = (float*)(ws + WS_KCC); float* VCC = (float*)(ws + WS_VCC); unsigned* SEL = (unsigned*)(ws + WS_SEL); \
    bf16_t *URNN = (bf16_t*)(ws + WS_URNN), *UGATE = (bf16_t*)(ws + WS_UGATE), *Q = (bf16_t*)(ws + WS_Q), *KV = (bf16_t*)(ws + WS_KV), *GN = (bf16_t*)(ws + WS_GN), *GA = (bf16_t*)(ws + WS_GA), *GB = (bf16_t*)(ws + WS_GB); \
    bf16_t *KCr = KV, *VCr = KV + (size_t)M * KVW, *KS = KV + 2 * (size_t)M * KVW, *VS = KV + 3 * (size_t)M * KVW, *KW = KV + 4 * (size_t)M * KVW, *VW = KV + 5 * (size_t)M * KVW; \
    bf16_t *LA = (bf16_t*)(ws + WS_LA), *UP = (bf16_t*)(ws + WS_UP), *T1 = (bf16_t*)(ws + WS_T1), *MERGED = (bf16_t*)(ws + WS_MERGED), *HB = (bf16_t*)(ws + WS_HB), *ZACT = (bf16_t*)(ws + WS_ZACT); \
    bf16_t *FLATK = (bf16_t*)(dob + DO_FLATK), *FLATV = (bf16_t*)(dob + DO_FLATV), *HIDK = (bf16_t*)(dob + DO_HIDK), *HIDV = (bf16_t*)(dob + DO_HIDV), *XC = (bf16_t*)(dob + DO_XC), *YA = (bf16_t*)(dob + DO_YA); \
    float* H = (float*)dob; \
    float* LAMC = (float*)(ws + WS_LAMC); float* NORMS = (float*)(ws + WS_NORMS); float* PES = (float*)(ws + WS_PES); float* SSQ = (float*)(ws + WS_SSQ); \
    bf16_t *WIN_T = (bf16_t*)(ws + WS_WIN), *WG_T = (bf16_t*)(ws + WS_WG), *W1_T = (bf16_t*)(ws + WS_W1), *PA_T = (bf16_t*)(ws + WS_PA), *PB_T = (bf16_t*)(ws + WS_PB), *WO_T = (bf16_t*)(ws + WS_WO), *WMI_T = (bf16_t*)(ws + WS_WMI), *WMO_T = (bf16_t*)(ws + WS_WMO); \
    float *CAR = (float*)(dob + DO_CAR), *CBR = (float*)(dob + DO_CBR); \
    bf16_t* XB = (bf16_t*)(dob + DO_XB); bf16_t *KCB = (bf16_t*)(dob + DO_KCB), *VCT = (bf16_t*)(dob + DO_VCT), *VST = (bf16_t*)(dob + DO_VST), *VWT = (bf16_t*)(dob + DO_VWT); \
    (void)0;
__global__ void __launch_bounds__(NTHREADS, 2) fwd(Args a) {
    extern __shared__ __attribute__((aligned(16))) unsigned char lds[];
    float* ldsf = (float*)lds;
    const int tid = threadIdx.x, lane = tid & 63, wave = tid >> 6;
    const int gw = blockIdx.x * 8 + wave, NGW = gridDim.x * 8;
#define gtid ((size_t)blockIdx.x * NTHREADS + threadIdx.x)
#define GSZ ((size_t)gridDim.x * NTHREADS)
    unsigned char* ws0 = a.ws;
    PG8_LAS unsigned char* ldsl = (PG8_LAS unsigned char*)lds;
    const int G = gridDim.x;
    const int lo = a.ph_lo, hi = a.ph_hi;
    volatile LAS unsigned* MISC = (volatile LAS unsigned*)((LAS unsigned char*)lds + LDS_BYTES - 256);
    if (tid < 32) MISC[tid] = 0u;
    __syncthreads();
    XcdBarrier bar = xcd_barrier_post((unsigned*)(ws0 + 16384), MISC + 8);
    int ph = 0;
#ifndef PHMASK
#define PHMASK 0xFFFFFFFFu
#endif
#ifndef REPMASK
#define REPMASK 0u
#endif
#define PHASE_BEGIN if (lo <= ph && ph < hi && ((PHMASK >> ph) & 1u)) {
#define PHASE_BEGIN_R if (lo <= ph && ph < hi && ((PHMASK >> ph) & 1u)) for (int rep_ = 0; rep_ < (((REPMASK >> (16 + ph)) & 1u) ? 2 : 1); ++rep_) {
#define PHASE_END } { const bool sync_ = (lo <= ph && ph + 1 < hi); ++ph; if (sync_) xcd_barrier(bar); }

    PHASE_BEGIN_R DECL_PTRS
    for (int m0 = 2 * gw; m0 < M; m0 += 2 * NGW) {
        pg8::f32x4 v[2][4]; float s[2] = {0.f, 0.f};
#pragma unroll
        for (int u = 0; u < 2; ++u) { const pg8::f32x4* xr = (const pg8::f32x4*)(x + (size_t)(m0 + u) * D) + lane;
#pragma unroll
            for (int j = 0; j < 4; ++j) v[u][j] = xr[64 * j]; }
#pragma unroll
        for (int u = 0; u < 2; ++u)
#pragma unroll
            for (int j = 0; j < 4; ++j) s[u] += (v[u][j][0] * v[u][j][0] + v[u][j][1] * v[u][j][1]) + (v[u][j][2] * v[u][j][2] + v[u][j][3] * v[u][j][3]);
#pragma unroll
        for (int o = 1; o < 64; o <<= 1) { s[0] += __shfl_xor(s[0], o); s[1] += __shfl_xor(s[1], o); }
#pragma unroll
        for (int u = 0; u < 2; ++u) { const float r = rsqrtf(s[u] * (1.f / D) + EPS); if (lane == 0) RSTD[m0 + u] = r;
            unsigned long long* o8 = (unsigned long long*)(XB + (size_t)(m0 + u) * D) + lane;
#pragma unroll
            for (int j = 0; j < 4; ++j) { const pg8::f32x4 gg = *((const pg8::f32x4*)norm_mix + lane + 64 * j); const pg8::f32x4 y = v[u][j] * r * gg;
                o8[64 * j] = (unsigned long long)pg8::cvt_pk_bf16(y[0], y[1]) | ((unsigned long long)pg8::cvt_pk_bf16(y[2], y[3]) << 32); } }
    }
    for (size_t i = gtid; i < DRNN; i += GSZ) LAMC[i] = -8.f * log1pf(__expf(-lam[i])) * LOG2E;
    for (size_t i = gtid; i < 4096; i += GSZ) PES[i] = i < 2048 ? pe_k[i] : pe_v[i - 2048];
    for (size_t i = gtid; i < 192; i += GSZ) NORMS[i] = i < 64 ? q_norm[i] : (i < 128 ? ks_norm[i - 64] : kw_norm[i - 128]);
    {
        float* scr = ldsf + wave * (64 * 33);
        constexpr int I_WIN = (pg8::N1PAD / 32) * 16, I_W1 = 16 * 32;
        for (int it = gw; it < I_WIN + I_W1; it += NGW) {
            int r = it;
            if (r < I_WIN) { const int ch = r / 16, kb = r % 16; int c0, cv; pg8::win_src(ch, c0, cv); tr_item(w_in, DIN, D, c0, cv, nullptr, WIN_T, D, 32 * ch, 64 * kb, scr, lane); continue; } r -= I_WIN;
            { const int ch = r / 32, kb = r % 32; tr_item((ch >> 3) ? w1v : w1k, 256, 2048, (ch & 7) * 32, 32, nullptr, W1_T, 2048, 32 * ch, 64 * kb, scr, lane); }
        }
    }
    PHASE_END
    PHASE_BEGIN DECL_PTRS
    if (FAST(1)) {
        pg8::Gemm g{XB, WIN_T, M, pg8::N1PAD, D}; pg8::StaticOrder S; S.init(M, pg8::N1PAD, G, (int)blockIdx.x);
        PG8_LAS float* ctab = (PG8_LAS float*)(ldsl + 131072);
        for (int i = tid; i < 192; i += NTHREADS) ctab[i] = NORMS[i];
        for (int i = tid; i < 4096; i += NTHREADS) ctab[256 + i] = PES[i];
        __syncthreads();
        pg8::Ep1F E{URNN, UGATE, Q, KV, GN, GA, ctab, FLATK, ctab + 256};
        pg8::gemm_phase<pg8::Ep1F, pg8::StaticOrder, true, true>(ldsl, g, S, E);
#if (REPMASK >> 1) & 1
        pg8::gemm_phase<pg8::Ep1F, pg8::StaticOrder, true, true>(ldsl, g, S, E);
#endif
    } else {
        ngemm(ldsf, M, DIN, D, ALf32Scale{x, D, norm_mix}, BLf32{w_in, DIN}, Ep1{RSTD, URNN, UGATE, Q, KV, GN, GA, GB});
    }
    PHASE_END
    PHASE_BEGIN DECL_PTRS
    if (blockIdx.x >= 64) {
        float* scr = ldsf + wave * (64 * 33);
        constexpr int I_WG = 96 * 6, I_PA = 32 * 22, I_PB = 32 * 16, I_WO = 32 * 16, I_WMI = 128 * 16, I_WMO = 32 * 64;
        for (int it = ((int)blockIdx.x - 64) * 8 + wave; it < I_WG + I_PA + I_PB + I_WO + I_WMI + I_WMO; it += ((int)gridDim.x - 64) * 8) {
            int r = it;
            if (r < I_WG) { const int ch = r / 6, kb = r % 6, nb = ch / 24, rr = ch % 24, pn = rr >> 3, l0 = (rr & 7) * 32, bj = l0 >> 7, chn0 = 128 * pn + (l0 & 127);
                int cv = BW - chn0; cv = cv < 0 ? 0 : (cv > 32 ? 32 : cv);
                tr_item((bj ? gate_x_w : gate_a_w) + (size_t)nb * BW * BW, BW, BW, chn0, cv, nullptr, WG_T, XC_LD, 32 * ch, 64 * kb, scr, lane); continue; } r -= I_WG;
            if (r < I_PA) { const int ch = r / 22, kb = r % 22; tr_item(proj_a, D, DRNN, 32 * ch, 32, nullptr, PA_T, YA_LD, 32 * ch, 64 * kb, scr, lane); continue; } r -= I_PA;
            if (r < I_PB) { const int ch = r / 16, kb = r % 16; tr_item(proj_b, D, QW, 32 * ch, 32, nullptr, PB_T, QW, 32 * ch, 64 * kb, scr, lane); continue; } r -= I_PB;
            if (r < I_WO) { const int ch = r / 16, kb = r % 16; tr_item(w_out, D, D, 32 * ch, 32, nullptr, WO_T, D, 32 * ch, 64 * kb, scr, lane); continue; } r -= I_WO;
            if (r < I_WMI) { const int ch = r / 16, kb = r % 16; tr_item(w_mlp_in, DFF, D, 32 * ch, 32, norm_mlp, WMI_T, D, 32 * ch, 64 * kb, scr, lane); continue; } r -= I_WMI;
            { const int ch = r / 64, kb = r % 64; tr_item(w_mlp_out, D, DFF, 32 * ch, 32, nullptr, WMO_T, DFF, 32 * ch, 64 * kb, scr, lane); }
        }
    } else
    if (FAST(3)) {
        pg8::Gemm g{FLATK, W1_T, 16384, 512, 2048}; pg8::OrderC1 S{G, (int)blockIdx.x};
        pg8::EpGeluF E{HIDK, 256};
        pg8::gemm_phase<pg8::EpGeluF, pg8::OrderC1, true, true>(ldsl, g, S, E);
#if (REPMASK >> 3) & 1
        pg8::gemm_phase<pg8::EpGeluF, pg8::OrderC1, true, true>(ldsl, g, S, E);
#endif
    } else {
        ngemm(ldsf, 8192, 256, 2048, ALbf{FLATK, 2048}, BLf32{w1k, 256}, EpGelu{HIDK, 256});
        ngemm(ldsf, 8192, 256, 2048, ALbf{FLATV, 2048}, BLf32{w1v, 256}, EpGelu{HIDV, 256});
    }
    PHASE_END
    PHASE_BEGIN DECL_PTRS
    {
        const int vcu = (G % 8 == 0) ? ((int)blockIdx.x % 8) * (G / 8) + (int)blockIdx.x / 8 : (int)blockIdx.x;
#ifdef ATT_PROBE_MODE
#ifndef ATT_ABL
#define ATT_ABL 0
#endif
        for (int u = vcu; u < 256; u += G) {
            const int bg = u >> 2, s4 = u & 3;
            att::attn_bias_table(bg & 3, rel_bias, lds);
            att::attn_compress_l2(bg, HIDK, HIDV, w2k, w2v, kc_norm, lds);
#pragma unroll 1
            for (int i = 0; i < 8; ++i) { const int qblk = 8 * (i >> 1) + ((i & 1) ? 7 - s4 : s4);
                att::attn_unit<ATT_PROBE_MODE, ATT_ABL>(bg >> 2, bg & 3, qblk, Q, (bf16_t*)(dob + 64 * MiB), KS, VS, KW, VW, GN, rel_bias, lds); }
        }
#endif
        bool nomax;
        {   float* red = (float*)(lds + 159744);
            float v = 0.f; if (tid < 64) v = fabsf(q_norm[tid]); else if (tid < 128) v = fabsf(ks_norm[tid - 64]); else if (tid < 192) v = fabsf(kw_norm[tid - 128]);
            float bb = fabsf(rel_bias[tid]);
#pragma unroll
            for (int o = 32; o; o >>= 1) { v = fmaxf(v, __shfl_xor(v, o)); bb = fmaxf(bb, __shfl_xor(bb, o)); }
            if (lane == 0) { red[wave] = v; red[8 + wave] = bb; }
            __syncthreads();
            const float bm = fmaxf(fmaxf(fmaxf(red[8], red[9]), fmaxf(red[10], red[11])), fmaxf(fmaxf(red[12], red[13]), fmaxf(red[14], red[15])));
            nomax = 11.55f * red[0] * fmaxf(red[1], red[2]) + 2.f * 1.4427f * bm <= 60.f;
        }
#define ATT_UNITS(ABLV) for (int u = vcu; u < 256; u += G) {     \
            const int bg = u >> 2, s4 = u & 3; \
            att::attn_bias_table(bg & 3, rel_bias, lds); \
            att::attn_compress_l2(bg, HIDK, HIDV, w2k, w2v, kc_norm, lds); \
            _Pragma("unroll 1") for (int i = 7; i >= 0; --i) { const int qblk = 8 * (i >> 1) + ((i & 1) ? 7 - s4 : s4);     \
                att::attn_unit<7, ABLV>(bg >> 2, bg & 3, qblk, Q, Q, KS, VS, KW, VW, GN, rel_bias, lds); } }
        if (nomax) { ATT_UNITS(64) } else { ATT_UNITS(0) }
#undef ATT_UNITS
    }
    for (unsigned it = blockIdx.x * (unsigned)NTHREADS + threadIdx.x; it < 4u * (unsigned)(M / 8) * 48u; it += gridDim.x * (unsigned)NTHREADS) {
        const unsigned ch = it % 48u, nr = it / 48u, run = nr & (unsigned)(M / 8 - 1), n = nr >> 12, m0 = run * 8u, t0 = m0 & (unsigned)(T - 1), j0 = ch * 8u;
        bf16_t* dst = XC + ((size_t)n * M + m0) * XC_LD + j0;
        if (j0 >= (unsigned)BW) {
#pragma unroll
            for (int i = 0; i < 8; ++i) *(pg8::u32x4*)(dst + (size_t)i * XC_LD) = (pg8::u32x4){0u, 0u, 0u, 0u};
            continue; }
        const unsigned c = n * BW + j0;
        pg8::u32x4 rows[11];
#pragma unroll
        for (int i = 0; i < 11; ++i) rows[i] = ((int)t0 - 3 + i >= 0) ? *(const pg8::u32x4*)(URNN + (size_t)(m0 - 3 + i) * DRNN + c) : (pg8::u32x4){0u, 0u, 0u, 0u};
        pg8::f32x4 w0[4], w1[4];
#pragma unroll
        for (int kk = 0; kk < 4; ++kk) { w0[kk] = *(const pg8::f32x4*)(conv_w + kk * DRNN + c); w1[kk] = *(const pg8::f32x4*)(conv_w + kk * DRNN + c + 4); }
        const pg8::f32x4 b0 = *(const pg8::f32x4*)(conv_b + c), b1 = *(const pg8::f32x4*)(conv_b + c + 4);
#pragma unroll
        for (int i = 0; i < 8; ++i) { pg8::f32x4 a0 = b0, a1 = b1;
#pragma unroll
            for (int kk = 0; kk < 4; ++kk) { pg8::f32x4 x0, x1; pg8::unpack8(rows[i + kk], x0, x1); a0 += w0[kk] * x0; a1 += w1[kk] * x1; }
            *(pg8::u32x4*)(dst + (size_t)i * XC_LD) = pg8::pack8(a0, a1); }
    }
    PHASE_END
    PHASE_BEGIN DECL_PTRS
    if (FAST(8)) {
        int kg = XC_LD; asm volatile("" : "+s"(kg));
        pg8::Gemm g{XC, WG_T, 4 * M, 4 * 768, kg}; pg8::OrderGate S{G, (int)blockIdx.x};
        pg8::EpGateF E{gate_a_b, gate_x_b, LAMC, XC, LA, UP};
        pg8::gemm_phase<pg8::EpGateF, pg8::OrderGate, true, true>(ldsl, g, S, E);
#if (REPMASK >> 8) & 1
        pg8::gemm_phase<pg8::EpGateF, pg8::OrderGate, true, true>(ldsl, g, S, E);
#endif
    } else {
    for (int n = 0; n < 4; ++n)
        ngemm(ldsf, M, 2 * BW, BW, ALbf{XC + (size_t)n * M * XC_LD, XC_LD}, BLgate{gate_a_w + (size_t)n * BW * BW, gate_x_w + (size_t)n * BW * BW},
              EpGate{n, gate_a_b, gate_x_b, lam, XC + (size_t)n * M * XC_LD, LA, UP});
    }
    PHASE_END
    PHASE_BEGIN_R DECL_PTRS
    for (size_t it = gtid; it < (size_t)NB * 64 * 336; it += GSZ) {
        const int slot = (int)(it % 336), bk = (int)(it / 336), kc = bk & 63, b = bk >> 6, c0 = 4 * slot; const size_t m0 = (size_t)b * T + 32 * kc;
        float h[4] = {0.f, 0.f, 0.f, 0.f}, sl[4] = {0.f, 0.f, 0.f, 0.f};
#pragma unroll 1
        for (int i0 = 0; i0 < 32; i0 += 8) {
            unsigned long long lw[8], uw[8];
#pragma unroll
            for (int i = 0; i < 8; ++i) { lw[i] = *(const unsigned long long*)(LA + (m0 + i0 + i) * DRNN + c0); uw[i] = *(const unsigned long long*)(UP + (m0 + i0 + i) * DRNN + c0); }
#pragma unroll
            for (int i = 0; i < 8; ++i)
#pragma unroll
                for (int e = 0; e < 4; ++e) { const float la = bf2f((bf16_t)(lw[i] >> (16 * e))), up = bf2f((bf16_t)(uw[i] >> (16 * e))); const float av = __builtin_amdgcn_exp2f(la);
                    const float mult = (kc == 0 && i0 + i == 0) ? 1.f : __builtin_amdgcn_sqrtf(fmaxf(0.f, 1.f - av * av)); h[e] = av * h[e] + mult * up; sl[e] += la; }
        }
        *(pg8::f32x4*)(CAR + (size_t)bk * DRNN + c0) = (pg8::f32x4){sl[0], sl[1], sl[2], sl[3]};
        *(pg8::f32x4*)(CBR + (size_t)bk * DRNN + c0) = (pg8::f32x4){h[0], h[1], h[2], h[3]};
    }
    PHASE_END
    PHASE_BEGIN_R DECL_PTRS
    for (size_t it = gtid; it < (size_t)NB * 16 * 352; it += GSZ) {
        const int slot = (int)(it % 352), bs = (int)(it / 352), kg = bs & 15, b = bs >> 4, kc0 = 4 * kg, c0 = 4 * slot; const size_t m0 = (size_t)b * T + 128 * kg;
        if (slot >= 336) { for (int i = 0; i < 128; ++i) *(unsigned long long*)(YA + (m0 + i) * YA_LD + c0) = 0ull; continue; }
        unsigned long long la_[8], ua_[8], ga_[8], lb_[8], ub_[8], gb_[8];
#define SC_LOAD(L_, U_, G_, i0_) _Pragma("unroll") for (int i = 0; i < 8; ++i) { L_[i] = *(const unsigned long long*)(LA + (m0 + (i0_) + i) * DRNN + c0); U_[i] = *(const unsigned long long*)(UP + (m0 + (i0_) + i) * DRNN + c0); G_[i] = *(const unsigned long long*)(UGATE + (m0 + (i0_) + i) * DRNN + c0); }
#define SC_SCAN(L_, U_, G_, i0_) _Pragma("unroll") for (int i = 0; i < 8; ++i) { float y[4]; \
            _Pragma("unroll") for (int e = 0; e < 4; ++e) { const float la = bf2f((bf16_t)(L_[i] >> (16 * e))), up = bf2f((bf16_t)(U_[i] >> (16 * e))); const float av = __builtin_amdgcn_exp2f(la); \
                const float mult = (kg == 0 && (i0_) + i == 0) ? 1.f : __builtin_amdgcn_sqrtf(fmaxf(0.f, 1.f - av * av)); h[e] = av * h[e] + mult * up; y[e] = h[e] * bf2f((bf16_t)(G_[i] >> (16 * e))); } \
            *(unsigned long long*)(YA + (m0 + (i0_) + i) * YA_LD + c0) = (unsigned long long)att::cvtpk(y[0], y[1]) | ((unsigned long long)att::cvtpk(y[2], y[3]) << 32); }
        SC_LOAD(la_, ua_, ga_, 0)
        float h[4] = {0.f, 0.f, 0.f, 0.f};
        for (int k0 = 0; k0 < kc0; k0 += 16) {
            pg8::f32x4 sa[16], sb[16];
#pragma unroll
            for (int u = 0; u < 16; ++u) { const int k2 = k0 + u < kc0 ? k0 + u : kc0 - 1; sa[u] = *(const pg8::f32x4*)(CAR + (size_t)(b * 64 + k2) * DRNN + c0); sb[u] = *(const pg8::f32x4*)(CBR + (size_t)(b * 64 + k2) * DRNN + c0); }
#pragma unroll
            for (int u = 0; u < 16; ++u) if (k0 + u < kc0) {
#pragma unroll
                for (int e = 0; e < 4; ++e) h[e] = __builtin_amdgcn_exp2f(sa[u][e]) * h[e] + sb[u][e]; }
        }
#pragma unroll 1
        for (int r0 = 0; r0 < 128; r0 += 16) {
            SC_LOAD(lb_, ub_, gb_, r0 + 8) SC_SCAN(la_, ua_, ga_, r0)
            if (r0 + 16 < 128) { SC_LOAD(la_, ua_, ga_, r0 + 16) }
            SC_SCAN(lb_, ub_, gb_, r0 + 8)
        }
#undef SC_LOAD
#undef SC_SCAN
    }
    PHASE_END
    PHASE_BEGIN DECL_PTRS
    if (FAST(10)) {
        pg8::Gemm g{YA, PA_T, M, D, YA_LD}; pg8::StaticOrder S; S.init(M, D, G, (int)blockIdx.x);
        pg8::EpT1F E{GA, T1};
        pg8::gemm_phase<pg8::EpT1F, pg8::StaticOrder, true, true>(ldsl, g, S, E);
#if (REPMASK >> 10) & 1
        pg8::gemm_phase<pg8::EpT1F, pg8::StaticOrder, true, true>(ldsl, g, S, E);
#endif
    } else ngemm(ldsf, M, D, DRNN, ALbf{YA, YA_LD}, BLf32{proj_a, D}, EpT1{GA, T1});
    if (FAST(11)) {
        pg8::Gemm g{Q, PB_T, M, D, QW}; pg8::StaticOrder S; S.init(M, D, G, (int)blockIdx.x);
        pg8::EpMergedF E{GB, T1, MERGED};
        pg8::gemm_phase<pg8::EpMergedF, pg8::StaticOrder, true, true>(ldsl, g, S, E);
#if (REPMASK >> 11) & 1
        pg8::gemm_phase<pg8::EpMergedF, pg8::StaticOrder, true, true>(ldsl, g, S, E);
#endif
    } else ngemm(ldsf, M, D, QW, ALbf{Q, QW}, BLf32{proj_b, D}, EpMerged{GB, T1, MERGED});
    PHASE_END
    PHASE_BEGIN DECL_PTRS
    if (FAST(12)) {
        pg8::Gemm g{MERGED, WO_T, M, D, D}; pg8::StaticOrder S; S.init(M, D, G, (int)blockIdx.x);
        pg8::EpHF E{x, H, HB, SSQ};
        pg8::gemm_phase<pg8::EpHF, pg8::StaticOrder, true, true>(ldsl, g, S, E);
#if (REPMASK >> 12) & 1
        pg8::gemm_phase<pg8::EpHF, pg8::StaticOrder, true, true>(ldsl, g, S, E);
#endif
    } else ngemm(ldsf, M, D, D, ALbf{MERGED, D}, BLf32{w_out, D}, EpH{x, H, HB});
    PHASE_END
    PHASE_BEGIN DECL_PTRS
    if (FAST(14)) {
        pg8::Gemm g{HB, WMI_T, M, DFF, D}; pg8::StaticOrder S; S.init(M, DFF, G, (int)blockIdx.x);
        PG8_LAS float* rtab = (PG8_LAS float*)(ldsl + 131072);
        bool tab_ok;
        { pg8::Unit uu; int i = 0;
          for (; i < 16 && S.next(i, uu); ++i) if (tid < 256) { const float* sp = SSQ + (size_t)(uu.pm * 256 + tid) * 16;
                const pg8::f32x4 s0 = *(const pg8::f32x4*)sp, s1 = *(const pg8::f32x4*)(sp + 4), s2 = *(const pg8::f32x4*)(sp + 8), s3 = *(const pg8::f32x4*)(sp + 12); const pg8::f32x4 st = (s0 + s1) + (s2 + s3);
                rtab[i * 256 + tid] = rsqrtf(((st[0] + st[1]) + (st[2] + st[3])) * (1.f / D) + EPS); }
          tab_ok = !(i == 16 && S.next(16, uu)); }
        __syncthreads();
        pg8::EpZF E{tab_ok ? rtab : (PG8_LAS float*)nullptr, SSQ, ZACT};
        pg8::gemm_phase<pg8::EpZF, pg8::StaticOrder, true, true>(ldsl, g, S, E);
#if (REPMASK >> 14) & 1
        pg8::gemm_phase<pg8::EpZF, pg8::StaticOrder, true, true>(ldsl, g, S, E);
#endif
    } else ngemm(ldsf, M, DFF, D, ALbfScale{HB, D, norm_mlp}, BLf32{w_mlp_in, DFF}, EpZ{SSQ, ZACT});
    PHASE_END
    PHASE_BEGIN DECL_PTRS
    if (FAST(15)) {
        pg8::Gemm g{ZACT, WMO_T, M, D, DFF}; pg8::StaticOrder S; S.init(M, D, G, (int)blockIdx.x);
        pg8::EpOutF E{HB, H};
        pg8::gemm_phase<pg8::EpOutF, pg8::StaticOrder, true, true>(ldsl, g, S, E);
#if (REPMASK >> 15) & 1
        pg8::gemm_phase<pg8::EpOutF, pg8::StaticOrder, true, true>(ldsl, g, S, E);
#endif
    } else ngemm(ldsf, M, D, DFF, ALbf{ZACT, DFF}, BLf32{w_mlp_out, D}, EpOut{H});
    PHASE_END
}
constexpr int NPHASES = 11;

extern "C" void kernel_launch(void* const* d_in, const int* in_sizes, int n_in, void* d_out, int out_size, void* d_ws, size_t ws_size, hipStream_t stream) {
    static int grid = 0;
    if (grid == 0) {
        if (n_in != 27 || out_size != M * D || ws_size < WS_END) { fprintf(stderr, "kernel_launch: unexpected shapes n_in %d out %d ws %zu\n", n_in, out_size, ws_size); grid = -1; return; }
        int dev = 0, cus = 0, per_cu = 0;
        (void)hipGetDevice(&dev);
        (void)hipDeviceGetAttribute(&cus, hipDeviceAttributeMultiprocessorCount, dev);
        (void)hipFuncSetAttribute((const void*)fwd, hipFuncAttributeMaxDynamicSharedMemorySize, LDS_BYTES);
        (void)hipOccupancyMaxActiveBlocksPerMultiprocessor(&per_cu, (const void*)fwd, NTHREADS, LDS_BYTES);
        fprintf(stderr, "kernel_launch: cus %d per_cu %d ws_size %zu\n", cus, per_cu, ws_size);
        grid = cus;
    }
    if (grid < 0) return;
    if (hipMemsetAsync(d_ws, 0, 65536, stream) != hipSuccess) { fprintf(stderr, "kernel_launch: hipMemsetAsync failed\n"); return; }
    Args a{};
    for (int i = 0; i < 27; ++i) a.in[i] = (const float*)d_in[i];
    a.out = (float*)d_out; a.ws = (unsigned char*)d_ws; a.ph_lo = 0; a.ph_hi = NPHASES;
    void* args[] = {&a};
    hipError_t e = hipLaunchCooperativeKernel((const void*)fwd, dim3(grid), dim3(NTHREADS), args, LDS_BYTES, stream);
    if (e != hipSuccess) fprintf(stderr, "cooperative launch failed: %s (grid %d)\n", hipGetErrorString(e), grid);
}
```

```cpp
#include <hip/hip_runtime.h>
#include <hip/hip_cooperative_groups.h>
#include <cstdio>
#include <cstdint>
#ifndef FASTMASK
#define FASTMASK 0xFFFFFFFFu
#endif
#define FAST(p) ((FASTMASK >> (p)) & 1u)
namespace cg = cooperative_groups;

typedef unsigned short bf16_t;
constexpr int NTHREADS = 512;
constexpr int LDS_BYTES = 163840;
constexpr size_t MiB = 1u << 20;

constexpr int NB = 16, T = 2048, D = 1024, M = NB * T;
constexpr int DRNN = 1344, BW = 336, QW = 1024, KVW = 256, NH = 16, HD = 64, NG = 4;
constexpr int DIN = 7344, DFF = 4096, NC = 127, NSB = 32, CROWS = NB * NG * NC;
constexpr int C_URNN = 0, C_UGATE = 1344, C_Q = 2688, C_KV = 3712, C_GN = 5248, C_GA = 5296, C_GB = 6320;
constexpr float EPS = 1e-6f, LOG2E = 1.4426950408889634f;
constexpr int YA_LD = 1408, XC_LD = 384;

constexpr size_t WS_RSTD = 1 * MiB, WS_RSTD2 = 1 * MiB + 512 * 1024, WS_KCC = 2 * MiB, WS_VCC = 4 * MiB, WS_SEL = 6 * MiB;
constexpr size_t WS_URNN = 52 * MiB, WS_UGATE = 136 * MiB, WS_Q = 220 * MiB, WS_KV = 284 * MiB  , WS_GN = 380 * MiB, WS_GA = 384 * MiB, WS_GB = 448 * MiB, WS_END = 512 * MiB;
constexpr size_t WS_PES = 1 * MiB + 448 * 1024  , WS_NORMS = 1 * MiB + 384 * 1024, WS_LAMC = 1 * MiB + 256 * 1024, WS_SSQ = 6 * MiB + 512 * 1024  ;
constexpr size_t WS_WIN = 9 * MiB  , WS_WG = 24 * MiB  , WS_W1 = 27 * MiB  , WS_PA = 29 * MiB  , WS_PB = 32 * MiB, WS_WO = 34 * MiB, WS_WMI = 36 * MiB  , WS_WMO = 44 * MiB  ;
constexpr size_t DO_KCB = 104 * MiB  , DO_VCT = 105 * MiB  ;
constexpr size_t DO_VST = 72 * MiB, DO_VWT = 88 * MiB;
constexpr size_t DO_CAR = 112 * MiB, DO_CBR = 120 * MiB;
constexpr size_t DO_XB = 0;
constexpr size_t WS_LA = WS_URNN, WS_UP = WS_KV, WS_T1 = WS_URNN, WS_MERGED = WS_UGATE, WS_HB = WS_GA, WS_ZACT = 52 * MiB;
constexpr size_t DO_FLATK = 64 * MiB, DO_FLATV = 96 * MiB, DO_HIDK = 0, DO_HIDV = 4 * MiB, DO_XC = 0, DO_YA = 0;

__device__ __constant__ unsigned char BUCKET[128] = {0, 1, 2, 3, 4, 5, 6, 7, 8, 9, 10, 11, 12, 13, 14, 15, 16, 16, 16, 17, 17, 18, 18, 18, 19, 19, 19, 20, 20, 20, 20, 21, 21, 21, 21, 22, 22, 22, 22, 22, 23, 23, 23, 23, 23, 23, 24, 24, 24, 24, 24, 24, 25, 25, 25, 25, 25, 25, 25, 26, 26, 26, 26, 26, 26, 26, 26, 27, 27, 27, 27, 27, 27, 27, 27, 27, 27, 28, 28, 28, 28, 28, 28, 28, 28, 28, 28, 29, 29, 29, 29, 29, 29, 29, 29, 29, 29, 29, 29, 30, 30, 30, 30, 30, 30, 30, 30, 30, 30, 30, 30, 30, 30, 31, 31, 31, 31, 31, 31, 31, 31, 31, 31, 31, 31, 31, 31, 31};

__device__ __forceinline__ float bf2f(bf16_t v) { return __uint_as_float((unsigned)v << 16); }
__device__ __forceinline__ bf16_t f2bf(float f) { unsigned u = __float_as_uint(f); return (bf16_t)((u + 0x7fffu + ((u >> 16) & 1u)) >> 16); }
__device__ __forceinline__ float sigmoidf_(float x) { return 1.f / (1.f + __expf(-x)); }
__device__ __forceinline__ float gelu_tanh(float x) { const float u = 0.7978845608028654f * (x + 0.044715f * x * x * x); return 0.5f * x * (1.f + tanhf(u)); }
__device__ __forceinline__ float wave_sum(float v) {
#pragma unroll
    for (int o = 1; o < 64; o <<= 1) v += __shfl_xor(v, o);
    return v;
}

struct Args { const float* in[27]; float* out; unsigned char* ws; int ph_lo, ph_hi; };

template <class AL, class BL, class EP>
__device__ __forceinline__ void ngemm(float* lds, int Mm, int Nn, int Kk, const AL& A, const BL& Bf, const EP& E) {
    float* As = lds;
    float* Bs = lds + 16 * 132;
    const int tid = threadIdx.x, tx = tid & 31, ty = tid >> 5;
    const int tm = (Mm + 127) / 128, tn = (Nn + 127) / 128, ntiles = tm * tn;
    for (int tile = blockIdx.x; tile < ntiles; tile += gridDim.x) {
        const int m0 = (tile / tn) * 128, n0 = (tile % tn) * 128;
        float acc[8][4];
#pragma unroll
        for (int i = 0; i < 8; ++i)
#pragma unroll
            for (int j = 0; j < 4; ++j) acc[i][j] = 0.f;
        for (int k0 = 0; k0 < Kk; k0 += 16) {
            {
                const int m = m0 + (tid >> 2), kb = k0 + (tid & 3) * 4;
#pragma unroll
                for (int i = 0; i < 4; ++i) As[((tid & 3) * 4 + i) * 132 + (tid >> 2)] = (m < Mm && kb + i < Kk) ? A(m, kb + i) : 0.f;
                const int k = k0 + (tid >> 5), nb = n0 + (tid & 31) * 4;
#pragma unroll
                for (int i = 0; i < 4; ++i) Bs[(tid >> 5) * 132 + (tid & 31) * 4 + i] = (k < Kk && nb + i < Nn) ? Bf(k, nb + i) : 0.f;
            }
            __syncthreads();
#pragma unroll 2
            for (int kk = 0; kk < 16; ++kk) {
                float a[8], b[4];
#pragma unroll
                for (int i = 0; i < 8; ++i) a[i] = As[kk * 132 + ty * 8 + i];
#pragma unroll
                for (int j = 0; j < 4; ++j) b[j] = Bs[kk * 132 + tx * 4 + j];
#pragma unroll
                for (int i = 0; i < 8; ++i)
#pragma unroll
                    for (int j = 0; j < 4; ++j) acc[i][j] += a[i] * b[j];
            }
            __syncthreads();
        }
#pragma unroll
        for (int i = 0; i < 8; ++i)
#pragma unroll
            for (int j = 0; j < 4; ++j) { const int m = m0 + ty * 8 + i, n = n0 + tx * 4 + j; if (m < Mm && n < Nn) E(m, n, acc[i][j]); }
    }
}

struct ALbf { const bf16_t* p; int ld; __device__ __forceinline__ float operator()(int m, int k) const { return bf2f(p[(size_t)m * ld + k]); } };
struct ALbfScale { const bf16_t* p; int ld; const float* g; __device__ __forceinline__ float operator()(int m, int k) const { return bf2f(p[(size_t)m * ld + k]) * g[k]; } };
struct ALf32Scale { const float* p; int ld; const float* g; __device__ __forceinline__ float operator()(int m, int k) const { return p[(size_t)m * ld + k] * g[k]; } };
struct BLf32 { const float* p; int ld; __device__ __forceinline__ float operator()(int k, int n) const { return p[(size_t)k * ld + n]; } };
struct BLgate { const float* wa; const float* wx; __device__ __forceinline__ float operator()(int k, int n) const { return n < BW ? wa[k * BW + n] : wx[k * BW + n - BW]; } };

struct Ep1 {
    const float* rstd; bf16_t *urnn, *ugate, *q, *kv, *gn, *ga, *gb;
    __device__ __forceinline__ void operator()(int m, int n, float v) const {
        v *= rstd[m];
        if (n < C_UGATE) urnn[(size_t)m * DRNN + n] = f2bf(v);
        else if (n < C_Q) ugate[(size_t)m * DRNN + n - C_UGATE] = f2bf(gelu_tanh(v));
        else if (n < C_KV) q[(size_t)m * QW + n - C_Q] = f2bf(v);
        else if (n < C_GN) { const int c = n - C_KV; kv[(size_t)(c >> 8) * ((size_t)M * KVW) + (size_t)m * KVW + (c & 255)] = f2bf(v); }
        else if (n < C_GA) gn[(size_t)m * 48 + n - C_GN] = f2bf(sigmoidf_(v));
        else if (n < C_GB) ga[(size_t)m * D + n - C_GA] = f2bf(sigmoidf_(v));
        else gb[(size_t)m * D + n - C_GB] = f2bf(sigmoidf_(v));
    }
};
struct EpGelu { bf16_t* o; int ld; __device__ __forceinline__ void operator()(int m, int n, float v) const { o[(size_t)m * ld + n] = f2bf(gelu_tanh(v)); } };
struct EpGate {
    int nb; const float *ba, *bx, *lam; const bf16_t* xc; bf16_t *la, *up;
    __device__ __forceinline__ void operator()(int m, int n, float v) const {
        if (n < BW) { const int c = nb * BW + n; const float r = sigmoidf_(v + ba[c]); const float sp = log1pf(__expf(-lam[c])); la[(size_t)m * DRNN + c] = f2bf(-8.f * r * sp * LOG2E); }
        else { const int j = n - BW, c = nb * BW + j; const float i = sigmoidf_(v + bx[c]); up[(size_t)m * DRNN + c] = f2bf(i * bf2f(xc[(size_t)m * XC_LD + j])); }
    }
};
struct EpT1 { const bf16_t* g; bf16_t* o; __device__ __forceinline__ void operator()(int m, int n, float v) const { o[(size_t)m * D + n] = f2bf(bf2f(g[(size_t)m * D + n]) * v); } };
struct EpMerged { const bf16_t* g; const bf16_t* t1; bf16_t* o; __device__ __forceinline__ void operator()(int m, int n, float v) const { o[(size_t)m * D + n] = f2bf(bf2f(t1[(size_t)m * D + n]) + bf2f(g[(size_t)m * D + n]) * v); } };
struct EpH { const float* x; float* h; bf16_t* hb; __device__ __forceinline__ void operator()(int m, int n, float v) const { const float r = x[(size_t)m * D + n] + v; h[(size_t)m * D + n] = r; hb[(size_t)m * D + n] = f2bf(r); } };
struct EpZ { const float* ssq; bf16_t* z; __device__ __forceinline__ void operator()(int m, int n, float v) const { float s_ = 0.f; for (int i = 0; i < 16; ++i) s_ += ssq[(size_t)m * 16 + i]; v *= rsqrtf(s_ * (1.f / D) + EPS); v = v > 0.f ? v * v : 0.f; z[(size_t)m * DFF + n] = f2bf(v); } };
struct EpOut { float* o; __device__ __forceinline__ void operator()(int m, int n, float v) const { o[(size_t)m * D + n] += v; } };

namespace pg8 {
#define PG8_LAS __attribute__((address_space(3)))
typedef unsigned short bf16_t;
typedef short bf16x8 __attribute__((ext_vector_type(8)));
typedef float f32x4 __attribute__((ext_vector_type(4)));
typedef unsigned u32x4 __attribute__((ext_vector_type(4)));
constexpr int BM = 256, BK = 64, HALF = 128, HTB = HALF * BK * 2  , STAGE_BYTES = 8 * HTB, NXCD = 8, WGM = 4;

__host__ __device__ __forceinline__ int lds_byte(int r, int c) { const int st = (r >> 4) * 2 + (c >> 5), rr = r & 15, cc = c & 31, ob = rr * 64 + cc * 2; return st * 1024 + (ob ^ (((ob >> 9) & 1) << 5)); }
__host__ __device__ __forceinline__ void stage_rc(int b, int& R, int& C) { const int st = b / 1024, sb = b % 1024, swz = sb ^ (((sb >> 9) & 1) << 5); R = (st >> 1) * 16 + swz / 64; C = (st & 1) * 32 + (swz % 64) / 2; }
__host__ __device__ __forceinline__ int perm32(int rho) { const int n = rho >> 4, i = rho & 15; return 8 * (i >> 2) + 4 * n + (i & 3); }

struct Unit { int pm, pn, ord; };
struct Gemm { const bf16_t* A; const bf16_t* Bt; int M, N, K; };

struct StaticOrder {
    int nM, nN, nwg, G, c;
    __host__ __device__ void init(int M, int N, int G_, int c_) { nM = M / BM; nN = N / BM; nwg = nM * nN; G = G_; c = c_; }
    __host__ __device__ __forceinline__ bool next(int i, Unit& u) const {
        const long L = (long)i * G + c; if (L >= nwg) return false;
        int wgid = (int)L; { const int q = nwg / NXCD, r = nwg % NXCD, xcd = wgid % NXCD, off = wgid / NXCD; wgid = (xcd < r ? xcd * (q + 1) : r * (q + 1) + (xcd - r) * q) + off; }
        const int nig = WGM * nN, gid = wgid / nig, fm = gid * WGM, gsz = (nM - fm) < WGM ? (nM - fm) : WGM;
        u.pm = fm + ((wgid % nig) % gsz); u.pn = (wgid % nig) / gsz; u.ord = i; return true;
    }
    __device__ __forceinline__ void a_ready(const Unit&) const {}
    __device__ __forceinline__ void done(const Unit&) const {}
};

__device__ __forceinline__ unsigned cvt_pk_bf16(float lo, float hi) { unsigned r; asm volatile("v_cvt_pk_bf16_f32 %0, %1, %2" : "=v"(r) : "v"(lo), "v"(hi)); return r; }
typedef float f32x2 __attribute__((ext_vector_type(2)));
template <class Epi, class Sched, bool ALIGN_EPI = false, bool SP2 = false>
__device__ __forceinline__ void gemm_phase(PG8_LAS unsigned char* lds, const Gemm g, const Sched& S, const Epi& E) {
    const int tid = threadIdx.x, wid = __builtin_amdgcn_readfirstlane(tid >> 6), lane = tid & 63, wr = wid >> 2, wc = wid & 3, fr = lane & 15, fq = lane >> 4;
    const int K = g.K, nt = K / BK;
    unsigned voffA[2], voffB[2];
#pragma unroll
    for (int i = 0; i < 2; ++i) { int R, C; stage_rc(tid * 16 + i * 8192, R, C); const int Rb = Epi::PERM ? ((R & ~31) + perm32(R & 31)) : R;
        voffA[i] = (unsigned)(R * K + C) * 2u; voffB[i] = (unsigned)(Rb * K + C) * 2u; }
    const size_t kstep = (size_t)(BK * 2);
    const size_t hstep = (size_t)HALF * K * 2;
    const size_t tstep = 2 * hstep;
    const unsigned ldsw = (unsigned)wid * 1024u;
    const int aoff = lds_byte(wr * 64 + fr, fq * 8), boff = lds_byte(wc * 32 + fr, fq * 8);
#define PG8_SA(b, h) (((b) * 2 + (h)) * HTB)
#define PG8_SB(b, h) ((4 + (b) * 2 + (h)) * HTB)
#define PG8_STAGE(bufoff, gbase, voff) do { _Pragma("unroll") for (int _i = 0; _i < 2; ++_i) \
        __builtin_amdgcn_global_load_lds((const unsigned*)((const char*)(gbase) + (voff)[_i]), (PG8_LAS unsigned*)(lds + (bufoff) + ldsw + _i * 8192), 16, 0, 0); } while (0)
#define PG8_LDA(dst, b, h) do { _Pragma("unroll") for (int m = 0; m < 4; ++m) _Pragma("unroll") for (int k = 0; k < 2; ++k) dst[m][k] = *(const PG8_LAS bf16x8*)(lds + PG8_SA(b, h) + aoff + m * 2048 + k * 1024); } while (0)
#define PG8_LDB(dst, b, h) do { _Pragma("unroll") for (int n = 0; n < 2; ++n) _Pragma("unroll") for (int k = 0; k < 2; ++k) dst[n][k] = *(const PG8_LAS bf16x8*)(lds + PG8_SB(b, h) + boff + n * 2048 + k * 1024); } while (0)
#define PG8_MMA(ai, bj, At, Bt) do { __builtin_amdgcn_s_setprio(1); _Pragma("unroll") for (int m = 0; m < 4; ++m) _Pragma("unroll") for (int n = 0; n < 2; ++n) _Pragma("unroll") for (int k = 0; k < 2; ++k) \
        acc[ai][bj][m][n] = __builtin_amdgcn_mfma_f32_16x16x32_bf16(Bt[n][k], At[m][k], acc[ai][bj][m][n], 0, 0, 0); __builtin_amdgcn_s_setprio(0); } while (0)
#define PG8_WAIT_V(n) asm volatile("s_waitcnt vmcnt(" #n ")" ::: "memory")
#define PG8_WAIT_L(n) asm volatile("s_waitcnt lgkmcnt(" #n ")" ::: "memory")
#define PG8_BAR __builtin_amdgcn_s_barrier()
#define PG8_SCHED __builtin_amdgcn_sched_barrier(0)
    Unit cur, nxt; int ui = 0;
    if (!S.next(0, cur)) return;
    f32x4 acc[2][2][4][2];
#pragma unroll
    for (int a = 0; a < 2; ++a)
#pragma unroll
        for (int b = 0; b < 2; ++b)
#pragma unroll
            for (int m = 0; m < 4; ++m)
#pragma unroll
                for (int n = 0; n < 2; ++n) acc[a][b][m][n] = (f32x4){0.f, 0.f, 0.f, 0.f};
    bf16x8 At[4][2], B0[2][2], B1[2][2];
    const char* cA = (const char*)g.A + (size_t)cur.pm * tstep; const char* cB = (const char*)g.Bt + (size_t)cur.pn * tstep;
    S.a_ready(cur);
    if constexpr (SP2) {
        PG8_STAGE(PG8_SB(0, 0), cB, voffB); PG8_STAGE(PG8_SB(0, 1), cB + hstep, voffB); PG8_STAGE(PG8_SA(0, 0), cA, voffA); PG8_STAGE(PG8_SA(0, 1), cA + hstep, voffA);
        if (wr == 1) PG8_BAR;
        PG8_WAIT_V(2); PG8_BAR;
        PG8_STAGE(PG8_SB(1, 0), cB + kstep, voffB); PG8_STAGE(PG8_SA(1, 0), cA + kstep, voffA); PG8_STAGE(PG8_SB(1, 1), cB + hstep + kstep, voffB);
        PG8_WAIT_V(6); PG8_BAR;
    } else {
        PG8_STAGE(PG8_SB(0, 0), cB, voffB); PG8_STAGE(PG8_SA(0, 0), cA, voffA); PG8_STAGE(PG8_SB(0, 1), cB + hstep, voffB); PG8_STAGE(PG8_SA(0, 1), cA + hstep, voffA);
        if (wr == 1) PG8_BAR;
        PG8_WAIT_V(4); PG8_BAR;
        PG8_STAGE(PG8_SB(1, 0), cB + kstep, voffB); PG8_STAGE(PG8_SA(1, 0), cA + kstep, voffA); PG8_STAGE(PG8_SB(1, 1), cB + hstep + kstep, voffB);
        PG8_WAIT_V(6); PG8_BAR;
    }
    for (;;) {
        const bool has_next = S.next(ui + 1, nxt);
        const char* nA = has_next ? (const char*)g.A + (size_t)nxt.pm * tstep : cA; const char* nB = has_next ? (const char*)g.Bt + (size_t)nxt.pn * tstep : cB;
        for (int t = 0; t < nt; t += 2) {
            const bool last = (t == nt - 2);
            const char* a1 = cA + (size_t)(t + 1) * kstep;
            const char* a2 = last ? nA : cA + (size_t)(t + 2) * kstep; const char* b2 = last ? nB : cB + (size_t)(t + 2) * kstep;
            const char* a3 = a2 + kstep; const char* b3 = b2 + kstep;
            if (last && has_next) S.a_ready(nxt);
            if constexpr (SP2) {
            PG8_LDB(B0, 0, 0); PG8_LDB(B1, 0, 1); PG8_SCHED; PG8_LDA(At, 0, 0); PG8_STAGE(PG8_SA(1, 1), a1 + hstep, voffA);
            PG8_WAIT_V(8); PG8_WAIT_L(0); PG8_BAR; PG8_MMA(0, 0, At, B0); PG8_MMA(0, 1, At, B1); PG8_BAR; PG8_SCHED;
            PG8_LDA(At, 0, 1); PG8_STAGE(PG8_SB(0, 0), b2, voffB); PG8_STAGE(PG8_SB(0, 1), b2 + hstep, voffB); PG8_STAGE(PG8_SA(0, 0), a2, voffA);
            PG8_WAIT_V(8); PG8_WAIT_L(0); PG8_BAR; PG8_MMA(1, 0, At, B0); PG8_MMA(1, 1, At, B1); PG8_BAR; PG8_SCHED;
            PG8_LDB(B0, 1, 0); PG8_LDB(B1, 1, 1); PG8_SCHED; PG8_LDA(At, 1, 0); PG8_STAGE(PG8_SA(0, 1), a2 + hstep, voffA);
            PG8_WAIT_V(8); PG8_WAIT_L(0); PG8_BAR; PG8_MMA(0, 0, At, B0); PG8_MMA(0, 1, At, B1); PG8_BAR; PG8_SCHED;
            PG8_LDA(At, 1, 1); PG8_STAGE(PG8_SB(1, 0), b3, voffB); PG8_STAGE(PG8_SB(1, 1), b3 + hstep, voffB); PG8_STAGE(PG8_SA(1, 0), a3, voffA);
            PG8_WAIT_V(8); PG8_WAIT_L(0); PG8_BAR; PG8_MMA(1, 0, At, B0); PG8_MMA(1, 1, At, B1); PG8_BAR; PG8_SCHED;
            } else {
            PG8_LDB(B0, 0, 0); PG8_SCHED; PG8_LDA(At, 0, 0); PG8_STAGE(PG8_SA(1, 1), a1 + hstep, voffA);
            PG8_WAIT_L(8); PG8_BAR; PG8_WAIT_L(0); PG8_MMA(0, 0, At, B0); PG8_BAR; PG8_SCHED;
            PG8_LDB(B1, 0, 1); PG8_STAGE(PG8_SB(0, 0), b2, voffB);
            PG8_BAR; PG8_WAIT_L(0); PG8_MMA(0, 1, At, B1); PG8_BAR;
            PG8_LDA(At, 0, 1); PG8_STAGE(PG8_SA(0, 0), a2, voffA);
            PG8_BAR; PG8_WAIT_L(0); PG8_MMA(1, 0, At, B0); PG8_BAR; PG8_SCHED;
            PG8_STAGE(PG8_SB(0, 1), b2 + hstep, voffB);
            PG8_WAIT_V(6); PG8_BAR; PG8_MMA(1, 1, At, B1); PG8_BAR;
            PG8_LDB(B0, 1, 0); PG8_SCHED; PG8_LDA(At, 1, 0); PG8_STAGE(PG8_SA(0, 1), a2 + hstep, voffA);
            PG8_WAIT_L(8); PG8_BAR; PG8_WAIT_L(0); PG8_MMA(0, 0, At, B0); PG8_BAR; PG8_SCHED;
            PG8_LDB(B1, 1, 1); PG8_STAGE(PG8_SB(1, 0), b3, voffB);
            PG8_BAR; PG8_WAIT_L(0); PG8_MMA(0, 1, At, B1); PG8_BAR;
            PG8_LDA(At, 1, 1); PG8_STAGE(PG8_SA(1, 0), a3, voffA);
            PG8_BAR; PG8_WAIT_L(0); PG8_MMA(1, 0, At, B0); PG8_BAR; PG8_SCHED;
            PG8_STAGE(PG8_SB(1, 1), b3 + hstep, voffB);
            PG8_WAIT_V(6); PG8_BAR; PG8_MMA(1, 1, At, B1); PG8_BAR;
            }
        }
        if constexpr (ALIGN_EPI) { if (wr == 0) PG8_BAR; }
        if constexpr (!Epi::AFTER_DRAIN) { E(acc, cur, wr, wc, fr, fq); S.done(cur); }
        if (!has_next) break;
#pragma unroll
        for (int a = 0; a < 2; ++a)
#pragma unroll
            for (int b = 0; b < 2; ++b)
#pragma unroll
                for (int m = 0; m < 4; ++m)
#pragma unroll
                    for (int n = 0; n < 2; ++n) acc[a][b][m][n] = (f32x4){0.f, 0.f, 0.f, 0.f};
        cur = nxt; cA = nA; cB = nB; ++ui;
        if constexpr (ALIGN_EPI) { if (wr == 1) PG8_BAR; }
    }
    PG8_WAIT_V(0);
    if constexpr (!ALIGN_EPI) { if (wr == 0) PG8_BAR; }
    PG8_BAR;
    if constexpr (Epi::AFTER_DRAIN) { E.fused(acc, cur, wr, wc, fr, fq, lds, wid, lane); S.done(cur); }
#undef PG8_SA
#undef PG8_SB
#undef PG8_STAGE
#undef PG8_LDA
#undef PG8_LDB
#undef PG8_MMA
#undef PG8_WAIT_V
#undef PG8_WAIT_L
#undef PG8_BAR
#undef PG8_SCHED
}
}

namespace pg8 {
__device__ __forceinline__ float sigm(float x) { return __builtin_amdgcn_rcpf(1.f + __expf(-x)); }
__device__ __forceinline__ float gelu_t(float x) { const float u = 1.5957691216057308f * (x + 0.044715f * x * x * x); return x * __builtin_amdgcn_rcpf(1.f + __expf(-u)); }
__device__ __forceinline__ u32x4 pack8(const f32x4& a, const f32x4& b) { u32x4 w; w.x = cvt_pk_bf16(a[0], a[1]); w.y = cvt_pk_bf16(a[2], a[3]); w.z = cvt_pk_bf16(b[0], b[1]); w.w = cvt_pk_bf16(b[2], b[3]); return w; }
__device__ __forceinline__ void unpack8(const u32x4& w, f32x4& a, f32x4& b) {
    a[0] = __uint_as_float(w.x << 16); a[1] = __uint_as_float(w.x & 0xffff0000u); a[2] = __uint_as_float(w.y << 16); a[3] = __uint_as_float(w.y & 0xffff0000u);
    b[0] = __uint_as_float(w.z << 16); b[1] = __uint_as_float(w.z & 0xffff0000u); b[2] = __uint_as_float(w.w << 16); b[3] = __uint_as_float(w.w & 0xffff0000u); }

struct Ep1F {
    static constexpr bool PERM = true, AFTER_DRAIN = false;
    bf16_t *urnn, *ugate, *q, *kv, *gn, *ga; const PG8_LAS float* norms; bf16_t* flat; const PG8_LAS float* pes;
    __device__ __forceinline__ void operator()(const f32x4 (&acc)[2][2][4][2], const Unit& u, int wr, int wc, int fr, int fq) const {
        const int row0 = u.pm * BM + wr * 64 + fr, pn = u.pn;
        if (pn == 4 || pn == 5) {
            const PG8_LAS float* pe = pes + (pn - 4) * 2048; bf16_t* fl = flat + (size_t)(pn - 4) * 8192 * 2048;
#pragma unroll
            for (int ai = 0; ai < 2; ++ai)
#pragma unroll
                for (int m = 0; m < 4; ++m) { const int mt = row0 + ai * HALF + m * 16, b = mt >> 11, t = mt & (T - 1), c1 = t >> 4, l1 = t & 15; const size_t rb = (size_t)((b * 4 + wc) * NC + c1) * 2048;
#pragma unroll
                    for (int bj = 0; bj < 2; ++bj) { const int d0 = 32 * bj + 8 * fq; const f32x4 v0 = acc[ai][bj][m][0], v1 = acc[ai][bj][m][1];
                        if (c1 < NC) { const PG8_LAS float* p = pe + l1 * 64 + d0; *(u32x4*)(fl + rb + l1 * 64 + d0) = pack8(v0 + *(const PG8_LAS f32x4*)p, v1 + *(const PG8_LAS f32x4*)(p + 4)); }
                        if (c1 > 0) { const PG8_LAS float* p = pe + (l1 + 16) * 64 + d0; *(u32x4*)(fl + rb - 2048 + (l1 + 16) * 64 + d0) = pack8(v0 + *(const PG8_LAS f32x4*)p, v1 + *(const PG8_LAS f32x4*)(p + 4)); } } }
            return;
        }
        if (pn < 10) {
            const bool donorm = pn < 4 || pn == 6 || pn == 8; const PG8_LAS float* g = norms + (pn < 4 ? 0 : (pn == 6 ? 64 : 128)); const float sc = pn < 4 ? 0.125f * LOG2E : 1.f;
            bf16_t* base; int ld;
            if (pn < 4) { base = q + 256 * pn + 64 * wc + 8 * fq; ld = QW; } else { base = kv + (size_t)(pn - 4) * ((size_t)M * KVW) + 64 * wc + 8 * fq; ld = KVW; }
            f32x4 gv[2][2];
#pragma unroll
            for (int bj = 0; bj < 2; ++bj)
#pragma unroll
                for (int n = 0; n < 2; ++n) gv[bj][n] = donorm ? *(const PG8_LAS f32x4*)(g + 32 * bj + 8 * fq + 4 * n) : (f32x4){1.f, 1.f, 1.f, 1.f};
#pragma unroll
            for (int ai = 0; ai < 2; ++ai)
#pragma unroll
                for (int m = 0; m < 4; ++m) {
                    float ss = 0.f;
#pragma unroll
                    for (int bj = 0; bj < 2; ++bj)
#pragma unroll
                        for (int n = 0; n < 2; ++n) { const f32x4 v = acc[ai][bj][m][n]; ss += (v[0] * v[0] + v[1] * v[1]) + (v[2] * v[2] + v[3] * v[3]); }
                    ss += __shfl_xor(ss, 16); ss += __shfl_xor(ss, 32);
                    const float r = donorm ? rsqrtf(ss * (1.f / 64.f) + EPS) * sc : 1.f;
                    bf16_t* rowp = base + (size_t)(row0 + ai * HALF + m * 16) * ld;
#pragma unroll
                    for (int bj = 0; bj < 2; ++bj) *(u32x4*)(rowp + 32 * bj) = pack8(acc[ai][bj][m][0] * r * gv[bj][0], acc[ai][bj][m][1] * r * gv[bj][1]);
                }
        } else if (pn < 18) {
            bf16_t* base = ga + (pn < 14 ? (size_t)0 : (size_t)M * D) + 256 * ((pn - 10) & 3) + 32 * wc + 8 * fq;
#pragma unroll
            for (int ai = 0; ai < 2; ++ai)
#pragma unroll
                for (int m = 0; m < 4; ++m) { bf16_t* rowp = base + (size_t)(row0 + ai * HALF + m * 16) * D;
#pragma unroll
                    for (int bj = 0; bj < 2; ++bj) { f32x4 v0 = acc[ai][bj][m][0], v1 = acc[ai][bj][m][1];
#pragma unroll
                        for (int e = 0; e < 4; ++e) { v0[e] = sigm(v0[e]); v1[e] = sigm(v1[e]); }
                        *(u32x4*)(rowp + bj * HALF) = pack8(v0, v1); } }
        } else { seg3<0>(acc, pn, row0, wc, fq); seg3<1>(acc, pn, row0, wc, fq); }
    }
    template <int BJ> __device__ __forceinline__ void seg3(const f32x4 (&acc)[2][2][4][2], int pn, int row0, int wc, int fq) const {
        const int c = 256 * (pn - 18) + 128 * BJ + 32 * wc;
        if (c < 1344) { bf16_t* base = urnn + c + 8 * fq;
#pragma unroll
            for (int ai = 0; ai < 2; ++ai)
#pragma unroll
                for (int m = 0; m < 4; ++m) *(u32x4*)(base + (size_t)(row0 + ai * HALF + m * 16) * DRNN) = pack8(acc[ai][BJ][m][0], acc[ai][BJ][m][1]);
        } else if (c < 2688) { bf16_t* base = ugate + (c - 1344) + 8 * fq;
#pragma unroll
            for (int ai = 0; ai < 2; ++ai)
#pragma unroll
                for (int m = 0; m < 4; ++m) { f32x4 v0 = acc[ai][BJ][m][0], v1 = acc[ai][BJ][m][1];
#pragma unroll
                    for (int e = 0; e < 4; ++e) { v0[e] = gelu_t(v0[e]); v1[e] = gelu_t(v1[e]); }
                    *(u32x4*)(base + (size_t)(row0 + ai * HALF + m * 16) * DRNN) = pack8(v0, v1); }
        } else if (c + 8 * fq < 2736) { bf16_t* base = gn + (c - 2688) + 8 * fq;
#pragma unroll
            for (int ai = 0; ai < 2; ++ai)
#pragma unroll
                for (int m = 0; m < 4; ++m) { f32x4 v0 = acc[ai][BJ][m][0], v1 = acc[ai][BJ][m][1];
#pragma unroll
                    for (int e = 0; e < 4; ++e) { v0[e] = sigm(v0[e]); v1[e] = sigm(v1[e]); }
                    *(u32x4*)(base + (size_t)(row0 + ai * HALF + m * 16) * 48) = pack8(v0, v1); }
        }
    }
};
__device__ __forceinline__ void win_src(int ch, int& c0, int& cvalid) {
    const int tile = ch >> 3, l0 = (ch & 7) * 32, bj = l0 >> 7, wc = (l0 >> 5) & 3; cvalid = 32;
    if (tile < 4) c0 = C_Q + 256 * tile + 64 * wc + 32 * bj;
    else if (tile < 10) c0 = C_KV + 256 * (tile - 4) + 64 * wc + 32 * bj;
    else if (tile < 14) c0 = C_GA + 256 * (tile - 10) + l0;
    else if (tile < 18) c0 = C_GB + 256 * (tile - 14) + l0;
    else { const int c = 256 * (tile - 18) + l0; if (c < 2688) c0 = c; else if (c < 2736) { c0 = C_GN + c - 2688; cvalid = 2736 - c < 32 ? 2736 - c : 32; } else { c0 = 0; cvalid = 0; } }
}
constexpr int N1PAD = 29 * 256;

struct EpGeluF {
    static constexpr bool PERM = true, AFTER_DRAIN = false;
    bf16_t* O; int ldc;
    __device__ __forceinline__ void operator()(const f32x4 (&acc)[2][2][4][2], const Unit& u, int wr, int wc, int fr, int fq) const {
        const int row0 = u.pm * BM + wr * 64 + fr; bf16_t* base = O + wc * 32 + 8 * fq;
#pragma unroll
        for (int ai = 0; ai < 2; ++ai)
#pragma unroll
            for (int m = 0; m < 4; ++m) { bf16_t* rowp = base + (size_t)(row0 + ai * HALF + m * 16) * ldc;
#pragma unroll
                for (int bj = 0; bj < 2; ++bj) { f32x4 v0 = acc[ai][bj][m][0], v1 = acc[ai][bj][m][1];
#pragma unroll
                    for (int e = 0; e < 4; ++e) { v0[e] = gelu_t(v0[e]); v1[e] = gelu_t(v1[e]); }
                    *(u32x4*)(rowp + bj * HALF) = pack8(v0, v1); } }
    }
};
struct OrderC1 {
    int G, c;
    __device__ __forceinline__ bool next(int i, Unit& u) const { const int L = i * G + c; if (L >= 64) return false; u.pm = L; u.pn = L >> 5; u.ord = i; return true; }
    __device__ __forceinline__ void a_ready(const Unit&) const {}
    __device__ __forceinline__ void done(const Unit&) const {}
};
struct OrderGate {
    int G, c;
    __device__ __forceinline__ bool next(int i, Unit& u) const { const int L = i * G + c; if (L >= 4 * 128 * 3) return false; const int nb = L / 384, r = L % 384; u.pm = nb * 128 + r / 3; u.pn = nb * 3 + r % 3; u.ord = i; return true; }
    __device__ __forceinline__ void a_ready(const Unit&) const {}
    __device__ __forceinline__ void done(const Unit&) const {}
};
struct EpGateF {
    static constexpr bool PERM = true, AFTER_DRAIN = false;
    const float *ba, *bx, *lamc; const bf16_t* xc; bf16_t *la, *up;
    __device__ __forceinline__ void operator()(const f32x4 (&acc)[2][2][4][2], const Unit& u, int wr, int wc, int fr, int fq) const {
        const int nb = u.pn / 3, pn3 = u.pn % 3, ch0 = 128 * pn3 + 32 * wc + 8 * fq; if (ch0 >= BW) return;
        const int c0 = nb * BW + ch0, row0 = (u.pm & 127) * BM + wr * 64 + fr;
        const bf16_t* xcb = xc + (size_t)nb * ((size_t)M * XC_LD) + ch0; bf16_t* lab = la + c0; bf16_t* upb = up + c0;
        const f32x4 bav0 = *(const f32x4*)(ba + c0), bav1 = *(const f32x4*)(ba + c0 + 4), bxv0 = *(const f32x4*)(bx + c0), bxv1 = *(const f32x4*)(bx + c0 + 4), lcv0 = *(const f32x4*)(lamc + c0), lcv1 = *(const f32x4*)(lamc + c0 + 4);
        u32x4 xcv[2][4];
#pragma unroll
        for (int ai = 0; ai < 2; ++ai)
#pragma unroll
            for (int m = 0; m < 4; ++m) xcv[ai][m] = *(const u32x4*)(xcb + (unsigned)(row0 + ai * HALF + m * 16) * (unsigned)XC_LD);
#pragma unroll
        for (int ai = 0; ai < 2; ++ai)
#pragma unroll
            for (int m = 0; m < 4; ++m) { const unsigned row = (unsigned)(row0 + ai * HALF + m * 16);
                f32x4 x0, x1; unpack8(xcv[ai][m], x0, x1);
                f32x4 l0, l1, u0, u1;
#pragma unroll
                for (int e = 0; e < 4; ++e) {
                    l0[e] = sigm(acc[ai][0][m][0][e] + bav0[e]) * lcv0[e]; l1[e] = sigm(acc[ai][0][m][1][e] + bav1[e]) * lcv1[e];
                    u0[e] = sigm(acc[ai][1][m][0][e] + bxv0[e]) * x0[e];   u1[e] = sigm(acc[ai][1][m][1][e] + bxv1[e]) * x1[e]; }
                *(u32x4*)(lab + row * (unsigned)DRNN) = pack8(l0, l1); *(u32x4*)(upb + row * (unsigned)DRNN) = pack8(u0, u1);
                asm volatile("" ::: "memory"); }
    }
};
struct EpT1F {
    static constexpr bool PERM = true, AFTER_DRAIN = false;
    const bf16_t* g; bf16_t* o;
    __device__ __forceinline__ void operator()(const f32x4 (&acc)[2][2][4][2], const Unit& u, int wr, int wc, int fr, int fq) const {
        const int row0 = u.pm * BM + wr * 64 + fr, col0 = u.pn * BM + wc * 32 + 8 * fq;
        u32x4 gv[2][4][2];
#pragma unroll
        for (int ai = 0; ai < 2; ++ai)
#pragma unroll
            for (int m = 0; m < 4; ++m) { const size_t off = (size_t)(row0 + ai * HALF + m * 16) * D + col0;
#pragma unroll
                for (int bj = 0; bj < 2; ++bj) gv[ai][m][bj] = *(const u32x4*)(g + off + bj * HALF); }
#pragma unroll
        for (int ai = 0; ai < 2; ++ai)
#pragma unroll
            for (int m = 0; m < 4; ++m) { const size_t off = (size_t)(row0 + ai * HALF + m * 16) * D + col0;
#pragma unroll
                for (int bj = 0; bj < 2; ++bj) { f32x4 g0, g1; unpack8(gv[ai][m][bj], g0, g1);
                    *(u32x4*)(o + off + bj * HALF) = pack8(acc[ai][bj][m][0] * g0, acc[ai][bj][m][1] * g1); } }
    }
};
struct EpMergedF {
    static constexpr bool PERM = true, AFTER_DRAIN = false;
    const bf16_t* g; const bf16_t* t1; bf16_t* o;
    __device__ __forceinline__ void operator()(const f32x4 (&acc)[2][2][4][2], const Unit& u, int wr, int wc, int fr, int fq) const {
        const int row0 = u.pm * BM + wr * 64 + fr, col0 = u.pn * BM + wc * 32 + 8 * fq;
#pragma unroll
        for (int ai = 0; ai < 2; ++ai) {
            u32x4 gv[4][2], tv[4][2];
#pragma unroll
            for (int m = 0; m < 4; ++m) { const size_t off = (size_t)(row0 + ai * HALF + m * 16) * D + col0;
#pragma unroll
                for (int bj = 0; bj < 2; ++bj) { gv[m][bj] = *(const u32x4*)(g + off + bj * HALF); tv[m][bj] = *(const u32x4*)(t1 + off + bj * HALF); } }
#pragma unroll
            for (int m = 0; m < 4; ++m) { const size_t off = (size_t)(row0 + ai * HALF + m * 16) * D + col0;
#pragma unroll
                for (int bj = 0; bj < 2; ++bj) { f32x4 g0, g1, t0, t1v; unpack8(gv[m][bj], g0, g1); unpack8(tv[m][bj], t0, t1v);
                    *(u32x4*)(o + off + bj * HALF) = pack8(t0 + acc[ai][bj][m][0] * g0, t1v + acc[ai][bj][m][1] * g1); } }
            asm volatile("" ::: "memory");
        }
    }
};
struct EpHF {
    static constexpr bool PERM = true, AFTER_DRAIN = false;
    const float* x; float* h; bf16_t* hb; float* ssq;
    __device__ __forceinline__ void operator()(const f32x4 (&acc)[2][2][4][2], const Unit& u, int wr, int wc, int fr, int fq) const {
        const int row0 = u.pm * BM + wr * 64 + fr, col0 = u.pn * BM + wc * 32 + 8 * fq;
#pragma unroll
        for (int ai = 0; ai < 2; ++ai) {
            f32x4 xv[4][2][2];
#pragma unroll
            for (int m = 0; m < 4; ++m) { const size_t off = (size_t)(row0 + ai * HALF + m * 16) * D + col0;
#pragma unroll
                for (int bj = 0; bj < 2; ++bj) { xv[m][bj][0] = *(const f32x4*)(x + off + bj * HALF); xv[m][bj][1] = *(const f32x4*)(x + off + bj * HALF + 4); } }
#pragma unroll
            for (int m = 0; m < 4; ++m) { const size_t row = (size_t)(row0 + ai * HALF + m * 16), off = row * D + col0; float ss = 0.f;
#pragma unroll
                for (int bj = 0; bj < 2; ++bj) {
                    const f32x4 h0 = xv[m][bj][0] + acc[ai][bj][m][0], h1 = xv[m][bj][1] + acc[ai][bj][m][1];
                    *(u32x4*)(hb + off + bj * HALF) = pack8(h0, h1);
                    ss += (h0[0] * h0[0] + h0[1] * h0[1]) + (h0[2] * h0[2] + h0[3] * h0[3]) + (h1[0] * h1[0] + h1[1] * h1[1]) + (h1[2] * h1[2] + h1[3] * h1[3]); }
                ss += __shfl_xor(ss, 16); ss += __shfl_xor(ss, 32);
                if (fq == 0) ssq[row * 16 + 4 * u.pn + wc] = ss; }
            asm volatile("" ::: "memory");
        }
    }
};
struct EpZF {
    static constexpr bool PERM = true, AFTER_DRAIN = false;
    const PG8_LAS float* rtab; const float* ssq; bf16_t* z;
    __device__ __forceinline__ void operator()(const f32x4 (&acc)[2][2][4][2], const Unit& u, int wr, int wc, int fr, int fq) const {
        const int rl0 = wr * 64 + fr, row0 = u.pm * BM + rl0, col0 = u.pn * BM + wc * 32 + 8 * fq;
#pragma unroll
        for (int ai = 0; ai < 2; ++ai)
#pragma unroll
            for (int m = 0; m < 4; ++m) { const size_t row = (size_t)(row0 + ai * HALF + m * 16);
                float r;
                if (rtab) r = rtab[u.ord * 256 + rl0 + ai * HALF + m * 16];
                else { const f32x4 s0 = *(const f32x4*)(ssq + row * 16), s1 = *(const f32x4*)(ssq + row * 16 + 4), s2 = *(const f32x4*)(ssq + row * 16 + 8), s3 = *(const f32x4*)(ssq + row * 16 + 12);
                    const f32x4 st = (s0 + s1) + (s2 + s3); r = rsqrtf(((st[0] + st[1]) + (st[2] + st[3])) * (1.f / D) + EPS); }
#pragma unroll
                for (int bj = 0; bj < 2; ++bj) { f32x4 v0 = acc[ai][bj][m][0] * r, v1 = acc[ai][bj][m][1] * r;
#pragma unroll
                    for (int e = 0; e < 4; ++e) { v0[e] = v0[e] > 0.f ? v0[e] * v0[e] : 0.f; v1[e] = v1[e] > 0.f ? v1[e] * v1[e] : 0.f; }
                    *(u32x4*)(z + row * DFF + col0 + bj * HALF) = pack8(v0, v1); } }
    }
};
struct EpOutF {
    static constexpr bool PERM = true, AFTER_DRAIN = false;
    const bf16_t* hb; float* o;
    __device__ __forceinline__ void operator()(const f32x4 (&acc)[2][2][4][2], const Unit& u, int wr, int wc, int fr, int fq) const {
        const int row0 = u.pm * BM + wr * 64 + fr, col0 = u.pn * BM + wc * 32 + 8 * fq;
        u32x4 hv[2][4][2];
#pragma unroll
        for (int ai = 0; ai < 2; ++ai)
#pragma unroll
            for (int m = 0; m < 4; ++m) { const size_t off = (size_t)(row0 + ai * HALF + m * 16) * D + col0;
#pragma unroll
                for (int bj = 0; bj < 2; ++bj) hv[ai][m][bj] = *(const u32x4*)(hb + off + bj * HALF); }
#pragma unroll
        for (int ai = 0; ai < 2; ++ai)
#pragma unroll
            for (int m = 0; m < 4; ++m) { float* p = o + (size_t)(row0 + ai * HALF + m * 16) * D + col0;
#pragma unroll
                for (int bj = 0; bj < 2; ++bj) { f32x4 h0, h1; unpack8(hv[ai][m][bj], h0, h1); *(f32x4*)(p + bj * HALF) = h0 + acc[ai][bj][m][0]; *(f32x4*)(p + bj * HALF + 4) = h1 + acc[ai][bj][m][1]; } }
    }
};
}

namespace att {
using pg8::bf16x8; using pg8::f32x4; using pg8::u32x4;
typedef float f32x16 __attribute__((ext_vector_type(16)));
typedef short s16x4 __attribute__((ext_vector_type(4)));
typedef float f32x2_t __attribute__((ext_vector_type(2))); typedef __bf16 bf16x2_t __attribute__((ext_vector_type(2)));
constexpr int KROW = 144, VROW = 144, KT = 64 * KROW, VT = 64 * VROW;
__device__ __forceinline__ int vperm(int kv) { return (kv & ~12) | ((kv & 4) << 1) | ((kv & 8) >> 1); }
constexpr int L_K0 = 0, L_K1 = KT, L_V0 = 2 * KT, L_V1 = 2 * KT + VT, L_BT = 2 * KT + 2 * VT  , L_IMPG = L_BT + 4096 + 64, L_IMPL = L_IMPG + 33792, L_IMP = L_IMPL + 33792, L_SELM = L_IMP + 64 * 33 * 4, L_KC = L_SELM + 512  , VCROW = 272, L_VC = L_KC + 128 * KROW  , L_END = L_VC + 64 * VCROW;
static_assert(L_END <= 163840 - 512, "attention LDS map");
__device__ __forceinline__ int crow(int r, int hi) { return (r & 3) + 8 * (r >> 2) + 4 * hi; }
__device__ __forceinline__ float max3f(float a, float b, float c) { float r; asm("v_max3_f32 %0, %1, %2, %3" : "=v"(r) : "v"(a), "v"(b), "v"(c)); return r; }
__device__ __forceinline__ unsigned cvtpk(float lo, float hi) { f32x2_t v = {lo, hi}; bf16x2_t b = __builtin_convertvector(v, bf16x2_t); return __builtin_bit_cast(unsigned, b); }
__device__ __forceinline__ bf16x8 packp(const f32x16& p, int s) {
    u32x4 w; w.x = cvtpk(p[8 * s + 0], p[8 * s + 1]); w.y = cvtpk(p[8 * s + 2], p[8 * s + 3]); w.z = cvtpk(p[8 * s + 4], p[8 * s + 5]); w.w = cvtpk(p[8 * s + 6], p[8 * s + 7]);
    return __builtin_bit_cast(bf16x8, w); }
__device__ __forceinline__ bf16x8 kfrag(const unsigned char* kbuf, int st, int sp, int q32, int hi) { return *(const bf16x8*)(kbuf + (32 * st + q32) * KROW + (16 * sp + 8 * hi) * 2); }
__device__ __forceinline__ bf16x8 vfrag(const unsigned char* vbuf, int st, int s, int dt, int q32, int hi) { return *(const bf16x8*)(vbuf + (32 * dt + q32) * VROW + (32 * st + 16 * s + 8 * hi) * 2); }
__device__ __forceinline__ f32x16 qk_tile(const unsigned char* kbuf, int st, const bf16x8 (&qf)[4], int q32, int hi) {
    f32x16 s = {};
#pragma unroll
    for (int sp = 0; sp < 4; ++sp) s = __builtin_amdgcn_mfma_f32_32x32x16_bf16(kfrag(kbuf, st, sp, q32, hi), qf[sp], s, 0, 0, 0);
    return s; }
__device__ __forceinline__ void pv_tile(f32x16 (&o)[2], const unsigned char* vbuf, int st, const f32x16& p, int q32, int hi) {
#pragma unroll
    for (int s = 0; s < 2; ++s) { const bf16x8 pb = packp(p, s);
#pragma unroll
        for (int dt = 0; dt < 2; ++dt) o[dt] = __builtin_amdgcn_mfma_f32_32x32x16_bf16(vfrag(vbuf, st, s, dt, q32, hi), pb, o[dt], 0, 0, 0); }
}
struct Stage { u32x4 k, v; };
__device__ __forceinline__ void stage_load(Stage& s, const bf16_t* Kblk  , int ldk, const bf16_t* Vblk  , int ldv, int tid) {
    const int row = tid >> 3, ch = tid & 7;
    s.k = *(const u32x4*)(Kblk + (size_t)row * ldk + ch * 8); s.v = *(const u32x4*)(Vblk + (size_t)row * ldv + ch * 8); }
__device__ __forceinline__ void stage_store(const Stage& s, unsigned char* kbuf, unsigned char* vbuf, int tid) {
    const int row = tid >> 3, ch = tid & 7;
    *(u32x4*)(kbuf + row * KROW + ch * 16) = s.k;
    *(u32x4*)(vbuf + row * VROW + ch * 16) = s.v; }

struct SoftState { float mhat, l; f32x16 cneg; };
constexpr float ATT_THR = 8.0f;
template <int BR, int ABL>
__device__ __forceinline__ void block64(f32x16 (&o)[2], SoftState& ss, const unsigned char* kbuf, const unsigned char* vbuf, int dj, bool selbit, bool anyunsel, const bf16x8 (&qf)[4], const float* bt2,
                                        int q32, int hi, int tl) {
    f32x16 s0, s1;
    if (ABL & 64) { s0 = f32x16{}; s1 = f32x16{}; }
    else { s0 = ss.cneg; s1 = ss.cneg; }
    bf16x8 vf0[2][2], vf1[2][2];
#define ATT_BIAS(S_, KT_) do { if (dj <= 2) { const float* bt_ = bt2 + (64 * dj + tl + 64 - 4 * hi - 27) - 32 * (KT_); \
            _Pragma("unroll") for (int r = 0; r < 16; ++r) { const int cr = (r & 3) + 8 * (r >> 2); S_[r] += bt_[27 - cr]; } \
        } else if (BR == 1 && dj == 8) { const int basei = tl - 4 * hi; \
            _Pragma("unroll") for (int r = 0; r < 16; ++r) { const int cr = (r & 3) + 8 * (r >> 2); S_[r] += __int_as_float(((cr + 32 * (KT_) - basei - 1) >> 31) & 0xf149f2cau); } } } while (0)
    if (ABL & 64) {
#pragma unroll
        for (int sp = 0; sp < 4; ++sp) s0 = __builtin_amdgcn_mfma_f32_32x32x16_bf16(kfrag(kbuf, 0, sp, q32, hi), qf[sp], s0, 0, 0, 0);
        __builtin_amdgcn_sched_barrier(0);
#pragma unroll
        for (int s = 0; s < 2; ++s)
#pragma unroll
            for (int dt = 0; dt < 2; ++dt) vf0[s][dt] = vfrag(vbuf, 0, s, dt, q32, hi);
        __builtin_amdgcn_sched_barrier(0);
        bf16x8 k1[4];
#pragma unroll
        for (int sp = 0; sp < 4; ++sp) k1[sp] = kfrag(kbuf, 1, sp, q32, hi);
        __builtin_amdgcn_sched_barrier(0);
        ATT_BIAS(s0, 0);
#pragma unroll
        for (int sp = 0; sp < 4; ++sp) { s1 = __builtin_amdgcn_mfma_f32_32x32x16_bf16(k1[sp], qf[sp], s1, 0, 0, 0);
#pragma unroll
            for (int e = 0; e < 4; ++e) s0[4 * sp + e] = __builtin_amdgcn_exp2f(s0[4 * sp + e]);
            __builtin_amdgcn_sched_barrier(0); }
        ATT_BIAS(s1, 1);
    } else {
#pragma unroll
    for (int sp = 0; sp < 4; ++sp) { s0 = __builtin_amdgcn_mfma_f32_32x32x16_bf16(kfrag(kbuf, 0, sp, q32, hi), qf[sp], s0, 0, 0, 0); s1 = __builtin_amdgcn_mfma_f32_32x32x16_bf16(kfrag(kbuf, 1, sp, q32, hi), qf[sp], s1, 0, 0, 0); }
    __builtin_amdgcn_sched_barrier(0);
#pragma unroll
    for (int s = 0; s < 2; ++s)
#pragma unroll
        for (int dt = 0; dt < 2; ++dt) vf0[s][dt] = vfrag(vbuf, 0, s, dt, q32, hi);
    __builtin_amdgcn_sched_barrier(0);
    ATT_BIAS(s0, 0); ATT_BIAS(s1, 1);
    }
#undef ATT_BIAS
    if (!(ABL & 64)) {
    float rm = max3f(s0[0], s0[1], s1[0]), rm2 = max3f(s0[2], s0[3], s1[1]);
    rm = max3f(rm, s1[2], s1[3]);
#pragma unroll
    for (int r = 4; r < 16; r += 4) { rm = max3f(rm, s0[r], s0[r + 1]); rm2 = max3f(rm2, s0[r + 2], s0[r + 3]); rm = max3f(rm, s1[r], s1[r + 1]); rm2 = max3f(rm2, s1[r + 2], s1[r + 3]); }
    rm = max3f(rm, rm2, rm2);
    if (BR == 0) rm = selbit ? rm : -1e30f;
    if (__any(rm > ATT_THR)) {
        const float rmc = fmaxf(rm, __shfl_xor(rm, 32)), dl = fmaxf(rmc, 0.f), f = __builtin_amdgcn_exp2f(-dl);
        ss.mhat += dl; ss.l *= f;
#pragma unroll
        for (int r = 0; r < 16; ++r) { s0[r] -= dl; s1[r] -= dl; ss.cneg[r] -= dl; o[0][r] *= f; o[1][r] *= f; }
    }
    }
    float ps = 0.f, ps1 = 0.f, ps2 = 0.f, ps3 = 0.f;
#pragma unroll
    for (int r = 0; r < 16; r += 2) { if (!(ABL & 64)) { s0[r] = __builtin_amdgcn_exp2f(s0[r]); s0[r + 1] = __builtin_amdgcn_exp2f(s0[r + 1]); } ps += s0[r]; ps2 += s0[r + 1]; }
    const unsigned pm = (BR == 0 && !selbit) ? 0u : 0xffffffffu;
    bf16x8 pb0[2];
#pragma unroll
    for (int s = 0; s < 2; ++s) { pb0[s] = packp(s0, s);
        if (BR == 0 && anyunsel) { u32x4 w = __builtin_bit_cast(u32x4, pb0[s]); w.x &= pm; w.y &= pm; w.z &= pm; w.w &= pm; pb0[s] = __builtin_bit_cast(bf16x8, w); } }
    __builtin_amdgcn_sched_barrier(0);
#pragma unroll
    for (int i = 0; i < 4; ++i) { const int s = i >> 1, dt = i & 1;
        o[dt] = __builtin_amdgcn_mfma_f32_32x32x16_bf16(vf0[s][dt], pb0[s], o[dt], 0, 0, 0);
#pragma unroll
        for (int e = 0; e < 4; ++e) s1[4 * i + e] = __builtin_amdgcn_exp2f(s1[4 * i + e]);
        __builtin_amdgcn_sched_barrier(0); }
#pragma unroll
    for (int s = 0; s < 2; ++s)
#pragma unroll
        for (int dt = 0; dt < 2; ++dt) vf1[s][dt] = vfrag(vbuf, 1, s, dt, q32, hi);
#pragma unroll
    for (int r = 0; r < 16; r += 2) { ps1 += s1[r]; ps3 += s1[r + 1]; }
    ps = (ps + ps1) + (ps2 + ps3);
    if (BR == 0) ps = selbit ? ps : 0.f;
    ss.l += ps;
#pragma unroll
    for (int s = 0; s < 2; ++s) { bf16x8 pb = packp(s1, s);
        if (BR == 0 && anyunsel) { u32x4 w = __builtin_bit_cast(u32x4, pb); w.x &= pm; w.y &= pm; w.z &= pm; w.w &= pm; pb = __builtin_bit_cast(bf16x8, w); }
#pragma unroll
        for (int dt = 0; dt < 2; ++dt) o[dt] = __builtin_amdgcn_mfma_f32_32x32x16_bf16(vf1[s][dt], pb, o[dt], 0, 0, 0); }
}
__device__ __forceinline__ void stage_load_t(Stage& s, const bf16_t* Kblk, const bf16_t* Vblk, int tid) {
    s.k = *(const u32x4*)(Kblk + (size_t)(tid >> 3) * KVW + (tid & 7) * 8); s.v = *(const u32x4*)(Vblk + (size_t)(tid & 63) * KVW + (tid >> 6) * 8); }
__device__ __forceinline__ void stage_store_t(const Stage& s, unsigned char* kbuf, unsigned char* vbuf, int tid) {
    const int row = tid >> 3, ch = tid & 7;
    *(u32x4*)(kbuf + row * KROW + ch * 16) = s.k;
    unsigned short* vp = (unsigned short*)(vbuf + ((tid >> 6) * 8) * VROW + vperm(tid & 63) * 2);
    vp[0 * (VROW / 2)] = (unsigned short)s.v.x; vp[1 * (VROW / 2)] = (unsigned short)(s.v.x >> 16); vp[2 * (VROW / 2)] = (unsigned short)s.v.y; vp[3 * (VROW / 2)] = (unsigned short)(s.v.y >> 16);
    vp[4 * (VROW / 2)] = (unsigned short)s.v.z; vp[5 * (VROW / 2)] = (unsigned short)(s.v.z >> 16); vp[6 * (VROW / 2)] = (unsigned short)s.v.w; vp[7 * (VROW / 2)] = (unsigned short)(s.v.w >> 16); }
template <int BR, int ABL>
__device__ __forceinline__ void branch(float* outl  , const Stage* first  , float gate, const bf16_t* Kg  , const bf16_t* Vg  ,
                                       int qblk, unsigned unionmask, unsigned mysel, const bf16x8 (&qf)[4], const float* bt2  , float cb  ,
                                       unsigned char* lds, int tid, int q32, int hi, int tl) {
    const int jlo = BR == 0 ? 0 : (qblk - 8 < 0 ? 0 : qblk - 8);
    f32x16 o[2]; o[0] = f32x16{}; o[1] = f32x16{};
    SoftState ss; ss.mhat = 0.f; ss.l = 0.f;
#pragma unroll
    for (int r = 0; r < 16; ++r) ss.cneg[r] = cb;
#define ATT_NEXT(jv) do { --(jv); if (BR == 0) { while ((jv) >= jlo && !((unionmask >> (jv)) & 1u)) --(jv); } } while (0)
#define ATT_LOAD(sg, jv) do { const int jl_ = (jv) < jlo ? jlo : (jv); if (!(ABL & 8)) stage_load_t(sg, Kg + (size_t)jl_ * 64 * KVW, Vg + (size_t)jl_ * 64 * KVW, tid); else { sg.k = (u32x4){(unsigned)jl_, 0u, 0u, 0u}; sg.v = sg.k; } } while (0)
#define ATT_SEL(jv) (BR == 0 ? (((mysel >> (jv)) & 1u) != 0u) : true)
    int jA = qblk, jB = qblk, jC;
    Stage sA, sB;
    if (first) sA = *first; else ATT_LOAD(sA, jA);
    ATT_NEXT(jB); ATT_LOAD(sB, jB);
    stage_store_t(sA, lds + L_K0, lds + L_V0, tid);
    __syncthreads();
    for (;;) {
        jC = jB; if (jB >= jlo) ATT_NEXT(jC);
        ATT_LOAD(sA, jC);
        { const bool sel = ATT_SEL(jA); if (BR == 1 || __any(sel)) block64<BR, ABL>(o, ss, lds + L_K0, lds + L_V0, qblk - jA, sel, BR == 0 && __any(!sel), qf, bt2, q32, hi, tl); }
        if (jB < jlo) break;
        if (!(ABL & 16)) stage_store_t(sB, lds + L_K1, lds + L_V1, tid);
        if (!(ABL & 4)) __syncthreads();
        jA = jC; if (jC >= jlo) ATT_NEXT(jA);
        ATT_LOAD(sB, jA);
        { const bool sel = ATT_SEL(jB); if (BR == 1 || __any(sel)) block64<BR, ABL>(o, ss, lds + L_K1, lds + L_V1, qblk - jB, sel, BR == 0 && __any(!sel), qf, bt2, q32, hi, tl); }
        if (jC < jlo) break;
        if (!(ABL & 16)) stage_store_t(sA, lds + L_K0, lds + L_V0, tid);
        if (!(ABL & 4)) __syncthreads();
        jB = jA; jA = jC;
    }
#undef ATT_NEXT
#undef ATT_LOAD
#undef ATT_SEL
    float lrun = ss.l; lrun += __shfl_xor(lrun, 32);
    const float f = gate / lrun;
#pragma unroll
    for (int r = 0; r < 16; ++r) { outl[r * 64] += o[0][r] * f; outl[(16 + r) * 64] += o[1][r] * f; }
    __syncthreads();
}

__device__ __forceinline__ void attn_bias_table(int g, const float* rel_bias, unsigned char* lds) {
    float* bt = (float*)(lds + L_BT); const int tid = threadIdx.x;
#pragma unroll
    for (int i = 0; i < 2; ++i) { const int e = tid + 512 * i, hh = e >> 8, ix = (e & 255) - 64; const float cbh = rel_bias[31 * NH + g * 4 + hh] * LOG2E; bt[e] = ix < 0 ? -1e30f : rel_bias[BUCKET[ix > 127 ? 127 : ix] * NH + g * 4 + hh] * LOG2E - cbh; }
    if (tid < 4) bt[1024 + tid] = rel_bias[31 * NH + g * 4 + tid] * LOG2E;
    __syncthreads();
}
__device__ __forceinline__ void attn_compress_l2(int bg, const bf16_t* HIDK, const bf16_t* HIDV, const float* w2k, const float* w2v, const float* kc_norm, unsigned char* lds) {
    const int tid = threadIdx.x, lane = tid & 63, wave = tid >> 6, q32 = lane & 31, hi = lane >> 5, which = wave >> 2, c = 32 * (wave & 3) + q32; const bool okc = c < NC;
    const bf16_t* hrow = (which ? HIDV : HIDK) + (size_t)(bg * NC + (okc ? c : 0)) * 256; const float* w2 = which ? w2v : w2k;
    f32x16 acc[2]; acc[0] = f32x16{}; acc[1] = f32x16{};
    for (int s = 0; s < 16; ++s) {
        const bf16x8 bfrag = *(const bf16x8*)(hrow + 16 * s + 8 * hi);
#pragma unroll
        for (int nt = 0; nt < 2; ++nt) { const float* wp = w2 + (size_t)(16 * s + 8 * hi) * HD + 32 * nt + q32;
            u32x4 aw; aw.x = cvtpk(wp[0], wp[HD]); aw.y = cvtpk(wp[2 * HD], wp[3 * HD]); aw.z = cvtpk(wp[4 * HD], wp[5 * HD]); aw.w = cvtpk(wp[6 * HD], wp[7 * HD]);
            acc[nt] = __builtin_amdgcn_mfma_f32_32x32x16_bf16(__builtin_bit_cast(bf16x8, aw), bfrag, acc[nt], 0, 0, 0); }
    }
    if (which) {
        unsigned short* vp = (unsigned short*)(lds + L_VC) + vperm(c);
#pragma unroll
        for (int nt = 0; nt < 2; ++nt)
#pragma unroll
            for (int q = 0; q < 16; ++q) vp[(32 * nt + crow(q, hi)) * (VCROW / 2)] = okc ? (unsigned short)(cvtpk(acc[nt][q], 0.f) & 0xffffu) : (unsigned short)0;
    } else {
        float ss = 0.f;
#pragma unroll
        for (int nt = 0; nt < 2; ++nt)
#pragma unroll
            for (int q = 0; q < 16; ++q) ss += acc[nt][q] * acc[nt][q];
        ss += __shfl_xor(ss, 32); const float rn = okc ? rsqrtf(ss * (1.f / HD) + EPS) : 0.f;
#pragma unroll
        for (int nt = 0; nt < 2; ++nt)
#pragma unroll
            for (int rg = 0; rg < 4; ++rg) { const int n0 = 32 * nt + 8 * rg + 4 * hi; const f32x4 gk = *(const f32x4*)(kc_norm + n0);
                *(unsigned long long*)(lds + L_KC + c * KROW + n0 * 2) = (unsigned long long)cvtpk(acc[nt][4 * rg] * rn * gk[0], acc[nt][4 * rg + 1] * rn * gk[1]) | ((unsigned long long)cvtpk(acc[nt][4 * rg + 2] * rn * gk[2], acc[nt][4 * rg + 3] * rn * gk[3]) << 32); }
    }
    __syncthreads();
}
__device__ __forceinline__ bf16x8 vfragc(const unsigned char* vcbuf, int tile, int s, int dt, int q32, int hi) { return *(const bf16x8*)(vcbuf + (32 * dt + q32) * VCROW + (32 * tile + 16 * s + 8 * hi) * 2); }
template <int MODE, int ABL = 0>
__device__ __forceinline__ void attn_unit(int b, int g, int qblk, const bf16_t* Q, bf16_t* O, const bf16_t* KSb, const bf16_t* VSb, const bf16_t* KWb, const bf16_t* VWb,
                                          const bf16_t* GN, const float* rel_bias, unsigned char* lds) {
    int tid = threadIdx.x; asm volatile("" : "+v"(tid));
    const int lane = tid & 63, wave = tid >> 6, q32 = lane & 31, hi = lane >> 5, hr = wave >> 1, th = wave & 1, h = g * 4 + hr, tl = 32 * th + q32, t = 64 * qblk + tl, bg = b * 4 + g;
    const size_t m = (size_t)b * T + t;
    float* bt = (float*)(lds + L_BT); float* impg = (float*)(lds + L_IMPG); float* impl = (float*)(lds + L_IMPL); float* imp = (float*)(lds + L_IMP); unsigned* selm = (unsigned*)(lds + L_SELM);
    bf16x8 qf[4];
#pragma unroll
    for (int sp = 0; sp < 4; ++sp) qf[sp] = *(const bf16x8*)(Q + m * QW + h * HD + 16 * sp + 8 * hi);
    const float g0 = bf2f(GN[m * 48 + h * 3 + 0]), g1 = bf2f(GN[m * 48 + h * 3 + 1]), g2 = bf2f(GN[m * 48 + h * 3 + 2]);
    f32x16 out[2];
    {
        const float* bte = bt + hr * 256 + 64;
        const int ncv = t >= 31 ? ((t - 31) >> 4) + 1 : 0;
        const int thu = __builtin_amdgcn_readfirstlane(th), ncvw = 4 * qblk + 2 * thu + 1;
        f32x16 sc[4]; float mx = -1e20f;
#pragma unroll
        for (int tile = 0; tile < 4; ++tile) {
            if (32 * tile >= ncvw) { sc[tile] = f32x16{}; continue; }
            sc[tile] = qk_tile(lds + L_KC, tile, qf, q32, hi);
            __builtin_amdgcn_sched_barrier(0);
            if (64 * qblk + 32 * thu - 512 * tile >= 654) {
#pragma unroll
                for (int r = 0; r < 16; ++r) mx = fmaxf(mx, sc[tile][r]);
            } else
#pragma unroll
            for (int r = 0; r < 16; ++r) { const int c = 32 * tile + crow(r, hi);
                int dist = t - 31 - 16 * c; const float pen = __int_as_float(((ncv - 1 - c) >> 31) & 0xf149f2cau);
                dist = dist < 0 ? 0 : (dist > 127 ? 127 : dist);
                const float v = (sc[tile][r] + bte[dist]) + pen; sc[tile][r] = v; mx = fmaxf(mx, v); }
            __builtin_amdgcn_sched_barrier(0);
        }
        mx = fmaxf(mx, __shfl_xor(mx, 32));
        float l = 0.f;
#pragma unroll
        for (int tile = 0; tile < 4; ++tile) { if (32 * tile >= ncvw) continue;
#pragma unroll
            for (int r = 0; r < 16; ++r) { const float p = __builtin_amdgcn_exp2f(sc[tile][r] - mx); sc[tile][r] = p; l += p; } }
        l += __shfl_xor(l, 32);
        const float inv = l > 0.f ? 1.f / l : 0.f;
#pragma unroll
        for (int tile = 0; tile < 4; ++tile) { if (32 * tile >= ncvw) continue;
#pragma unroll
            for (int r = 0; r < 16; ++r) sc[tile][r] *= inv; }
        __builtin_amdgcn_sched_barrier(0);
        if (qblk > 15)
#pragma unroll
        for (int tile = 0; tile < 4; ++tile)
#pragma unroll
            for (int rg = 0; rg < 4; ++rg) { const int j = 8 * tile + 2 * rg + hi;
                impg[(hr * 64 + tl) * 33 + j] = (sc[tile][4 * rg] + sc[tile][4 * rg + 1]) + (sc[tile][4 * rg + 2] + sc[tile][4 * rg + 3]);
                impl[(hr * 64 + tl) * 33 + j] = sc[tile][4 * rg + 3]; }
        __builtin_amdgcn_sched_barrier(0);
        f32x16 o[2]; o[0] = f32x16{}; o[1] = f32x16{};
#pragma unroll
        for (int tile = 0; tile < 4; ++tile) { if (32 * tile >= ncvw) continue;
#pragma unroll
            for (int s = 0; s < 2; ++s) { const bf16x8 pb = packp(sc[tile], s);
#pragma unroll
                for (int dt = 0; dt < 2; ++dt) o[dt] = __builtin_amdgcn_mfma_f32_32x32x16_bf16(vfragc(lds + L_VC, tile, s, dt, q32, hi), pb, o[dt], 0, 0, 0); }
            __builtin_amdgcn_sched_barrier(0); }
#pragma unroll
        for (int r = 0; r < 16; ++r) { out[0][r] = o[0][r] * g0; out[1][r] = o[1][r] * g0; }
    }
    const bf16_t* Kgs = KSb + (size_t)b * T * KVW + g * HD; const bf16_t* Kgw = KWb + (size_t)b * T * KVW + g * HD;
    const bf16_t* Vgs = VSb + (size_t)b * T * KVW + g * HD; const bf16_t* Vgw = VWb + (size_t)b * T * KVW + g * HD;
    Stage sfirst; stage_load_t(sfirst, Kgs + (size_t)qblk * 64 * KVW, Vgs + (size_t)qblk * 64 * KVW, tid);
    unsigned mysel, uni;
    if (qblk > 15) {
    __syncthreads();
    {
        const int stl = tid >> 3, jq = tid & 7;
#pragma unroll
        for (int e = 0; e < 4; ++e) { const int j = 4 * jq + e; float s = 0.f;
#pragma unroll
            for (int r = 0; r < 4; ++r) { s += impg[(r * 64 + stl) * 33 + j]; if (j > 0) s += impl[(r * 64 + stl) * 33 + j - 1]; }
            imp[stl * 33 + j] = s; }
        __syncthreads();
        unsigned bits = 0u;
        {
            float iv[32];
#pragma unroll
            for (int k = 0; k < 32; ++k) iv[k] = imp[stl * 33 + k];
#pragma unroll
            for (int e = 0; e < 4; ++e) { const int j = 4 * jq + e; float vj = iv[0];
#pragma unroll
                for (int k = 1; k < 32; ++k) vj = (k == j) ? iv[k] : vj;
                int rank = 0;
#pragma unroll
                for (int k = 1; k < 30; ++k) { const bool cand = k <= qblk - 2; rank += (cand && (iv[k] > vj || (iv[k] == vj && k < j))) ? 1 : 0; }
                if (j == 0 || j == qblk - 1 || j == qblk) bits |= 1u << j; else if (j < qblk - 1 && rank < 13) bits |= 1u << j; }
        }
        bits |= __shfl_xor(bits, 1); bits |= __shfl_xor(bits, 2); bits |= __shfl_xor(bits, 4);
        if (jq == 0) selm[stl] = bits;
    }
    __syncthreads();
    mysel = selm[tl]; uni = selm[lane];
#pragma unroll
    for (int o = 1; o < 64; o <<= 1) uni |= __shfl_xor(uni, o);
    } else { mysel = uni = (1u << (qblk + 1)) - 1u; }
    float* outl = (float*)(lds + L_IMPG) + wave * 2048 + lane;
#pragma unroll
    for (int r = 0; r < 16; ++r) { outl[r * 64] = out[0][r]; outl[(16 + r) * 64] = out[1][r]; }
    if (MODE & 2) branch<0, ABL>(outl, &sfirst, g1, Kgs, Vgs, qblk, uni, mysel, qf, bt + hr * 256, bt[1024 + hr], lds, tid, q32, hi, tl);
    if (MODE & 4) branch<1, ABL>(outl, nullptr, g2, Kgw, Vgw, qblk, 0xffffffffu, 0xffffffffu, qf, bt + hr * 256, bt[1024 + hr], lds, tid, q32, hi, tl);
    bf16_t* orow = O + m * QW + h * HD;
#pragma unroll
    for (int dt = 0; dt < 2; ++dt)
#pragma unroll
        for (int rg = 0; rg < 4; ++rg)
            *(unsigned long long*)(orow + 32 * dt + 8 * rg + 4 * hi) = (unsigned long long)cvtpk(outl[(16 * dt + 4 * rg) * 64], outl[(16 * dt + 4 * rg + 1) * 64]) | ((unsigned long long)cvtpk(outl[(16 * dt + 4 * rg + 2) * 64], outl[(16 * dt + 4 * rg + 3) * 64]) << 32);
}
}

__device__ __forceinline__ void tr_item(const float* W, int ldw, int kvalid, int c0, int cvalid, const float* kscale, bf16_t* WT, int ldt, int r0, int k0, float* scr, int lane) {
#pragma unroll
    for (int i = 0; i < 32; ++i) { const int kk = 2 * i + (lane >> 5), col = lane & 31, k = k0 + kk;
        float v = 0.f; if (k < kvalid && col < cvalid) { v = W[(size_t)k * ldw + c0 + col]; if (kscale) v *= kscale[k]; }
        scr[kk * 33 + col] = v; }
    asm volatile("s_waitcnt lgkmcnt(0)" ::: "memory");
    const int c = lane & 7;
#pragma unroll
    for (int j = 0; j < 4; ++j) { const int n = (lane >> 3) + 8 * j; const float* s = scr + (8 * c) * 33 + n;
        pg8::u32x4 o; o.x = pg8::cvt_pk_bf16(s[0 * 33], s[1 * 33]); o.y = pg8::cvt_pk_bf16(s[2 * 33], s[3 * 33]); o.z = pg8::cvt_pk_bf16(s[4 * 33], s[5 * 33]); o.w = pg8::cvt_pk_bf16(s[6 * 33], s[7 * 33]);
        *(pg8::u32x4*)(WT + (size_t)(r0 + n) * ldt + k0 + 8 * c) = o; }
    asm volatile("s_waitcnt lgkmcnt(0)" ::: "memory");
}

#define LAS __attribute__((address_space(3)))
#define XB_TMO      128
#define XB_XCNT(j)  (256  + 64 * (j))
#define XB_XSUB(j)  (1280 + 64 * (j))
#define XB_XGEN(j)  (2304 + 64 * (j))
#define XB_TOP      3328
#define XB_TOPGEN   3392
#define XCD_BAR_WORDS 3456
#define XB_SPIN_CAP (1u << 18)

__device__ __forceinline__ unsigned xb_ld(unsigned* p)              { return __hip_atomic_load(p, __ATOMIC_RELAXED, __HIP_MEMORY_SCOPE_AGENT); }
__device__ __forceinline__ unsigned xb_add(unsigned* p, unsigned v) { return __hip_atomic_fetch_add(p, v, __ATOMIC_RELAXED, __HIP_MEMORY_SCOPE_AGENT); }
__device__ __forceinline__ unsigned xb_xcc_id() { return (unsigned)__builtin_amdgcn_s_getreg((3 << 11) | 20) & 0xFu; }
#define XB_SPIN(cond, bar) do { unsigned _sp = 0; while (cond) { __builtin_amdgcn_s_sleep(1); \
    if ((++_sp & 255u) == 0u) { if (xb_ld(&(bar)[XB_TMO])) break; if (_sp > XB_SPIN_CAP) { atomicAdd(&(bar)[XB_TMO], 1u); break; } } } } while (0)

struct XcdBarrier {
    unsigned* bar; unsigned x;
    volatile LAS unsigned* st;
};

__device__ __forceinline__ XcdBarrier xcd_barrier_post(unsigned* bar, volatile LAS unsigned* st) {
    XcdBarrier b; b.bar = bar; b.x = xb_xcc_id(); b.st = st;
    if (threadIdx.x == 0) (void)xb_add(&bar[XB_XCNT(b.x)], 1u);
    return b;
}
__device__ __forceinline__ void xcd_barrier_complete(unsigned* bar, unsigned x, unsigned& nloc, unsigned& nx) {
    const unsigned G = gridDim.x * gridDim.y * gridDim.z;
    unsigned sum, cnt, mine, sp = 0u;
    for (;;) {
        sum = 0u; cnt = 0u; mine = 0u;
#pragma unroll
        for (unsigned j = 0; j < 16; ++j) { const unsigned c = xb_ld(&bar[XB_XCNT(j)]); sum += c; cnt += (c > 0u) ? 1u : 0u; mine = (j == x) ? c : mine; }
        if (sum == G) break;
        __builtin_amdgcn_s_sleep(1);
        if ((++sp & 255u) == 0u) { if (xb_ld(&bar[XB_TMO])) break; if (sp > XB_SPIN_CAP) { atomicAdd(&bar[XB_TMO], 1u); break; } }
    }
    nloc = mine > 0u ? mine : 1u; nx = cnt > 0u ? cnt : 1u;
}

__device__ __forceinline__ void xcd_barrier(const XcdBarrier& b) {
    asm volatile("s_waitcnt vmcnt(0)" ::: "memory");
    __syncthreads();
    if (threadIdx.x == 0) {
        unsigned* bar = b.bar;
        __builtin_amdgcn_s_waitcnt(0);
        unsigned nloc = b.st[0], nx = b.st[1];
        if (nloc == 0u) { xcd_barrier_complete(bar, b.x, nloc, nx); b.st[0] = nloc; b.st[1] = nx; }
        const unsigned old = xb_add(&bar[XB_XSUB(b.x)], 1u);
        const unsigned gen = old / nloc;
        if (old + 1u == (gen + 1u) * nloc) {
            __builtin_amdgcn_fence(__ATOMIC_RELEASE, "agent");
            asm volatile("s_waitcnt vmcnt(0)" ::: "memory");
            const unsigned og = xb_add(&bar[XB_TOP], 1u);
            const unsigned tg = og / nx;
            if (og + 1u == (tg + 1u) * nx) xb_add(&bar[XB_TOPGEN], 1u);
            else XB_SPIN(xb_ld(&bar[XB_TOPGEN]) == tg, bar);
            __builtin_amdgcn_fence(__ATOMIC_ACQUIRE, "agent");
            xb_add(&bar[XB_XGEN(b.x)], 1u);
            asm volatile("s_waitcnt vmcnt(0)" ::: "memory");
        } else {
            XB_SPIN(xb_ld(&bar[XB_XGEN(b.x)]) == gen, bar);
            __builtin_amdgcn_fence(__ATOMIC_ACQUIRE, "agent");
            asm volatile("s_waitcnt vmcnt(0)" ::: "memory");
        }
    }
    __syncthreads();
}

#define DECL_PTRS \
    size_t zoff_ = 0; asm volatile("" : "+s"(zoff_));     \
    unsigned char* ws = a.ws + zoff_; unsigned char* dob = (unsigned char*)a.out + zoff_; \
    const float *x = a.in[0], *norm_mix = a.in[1], *w_in = a.in[2], *conv_w = a.in[3], *conv_b = a.in[4], *gate_a_w = a.in[5], *gate_a_b = a.in[6], *gate_x_w = a.in[7], *gate_x_b = a.in[8], \
                *lam = a.in[9], *pe_k = a.in[10], *w1k = a.in[11], *w2k = a.in[12], *pe_v = a.in[13], *w1v = a.in[14], *w2v = a.in[15], *q_norm = a.in[16], *kc_norm = a.in[17], *ks_norm = a.in[18], \
                *kw_norm = a.in[19], *rel_bias = a.in[20], *proj_a = a.in[21], *proj_b = a.in[22], *w_out = a.in[23], *norm_mlp = a.in[24], *w_mlp_in = a.in[25], *w_mlp_out = a.in[26]; \
    float* RSTD = (float*)(ws + WS_RSTD); float* KCC = (float*)(ws + WS_KCC); float* VCC = (float*)(ws + WS_VCC); unsigned* SEL = (unsigned*)(ws + WS_SEL); \
    bf16_t *URNN = (bf16_t*)(ws + WS_URNN), *UGATE = (bf16_t*)(ws + WS_UGATE), *Q = (bf16_t*)(ws + WS_Q), *KV = (bf16_t*)(ws + WS_KV), *GN = (bf16_t*)(ws + WS_GN), *GA = (bf16_t*)(ws + WS_GA), *GB = (bf16_t*)(ws + WS_GB); \
    bf16_t *KCr = KV, *VCr = KV + (size_t)M * KVW, *KS = KV + 2 * (size_t)M * KVW, *VS = KV + 3 * (size_t)M * KVW, *KW = KV + 4 * (size_t)M * KVW, *VW = KV + 5 * (size_t)M * KVW; \
    bf16_t *LA = (bf16_t*)(ws + WS_LA), *UP = (bf16_t*)(ws + WS_UP), *T1 = (bf16_t*)(ws + WS_T1), *MERGED = (bf16_t*)(ws + WS_MERGED), *HB = (bf16_t*)(ws + WS_HB), *ZACT = (bf16_t*)(ws + WS_ZACT); \
    bf16_t *FLATK = (bf16_t*)(dob + DO_FLATK), *FLATV = (bf16_t*)(dob + DO_FLATV), *HIDK = (bf16_t*)(dob + DO_HIDK), *HIDV = (bf16_t*)(dob + DO_HIDV), *XC = (bf16_t*)(dob + DO_XC), *YA = (bf16_t*)(dob + DO_YA); \
    float* H = (float*)dob; \
    float* LAMC = (float*)(ws + WS_LAMC); float* NORMS = (float*)(ws + WS_NORMS); float* PES = (float*)(ws + WS_PES); float* SSQ = (float*)(ws + WS_SSQ); \
    bf16_t *WIN_T = (bf16_t*)(ws + WS_WIN), *WG_T = (bf16_t*)(ws + WS_WG), *W1_T = (bf16_t*)(ws + WS_W1), *PA_T = (bf16_t*)(ws + WS_PA), *PB_T = (bf16_t*)(ws + WS_PB), *WO_T = (bf16_t*)(ws + WS_WO), *WMI_T = (bf16_t*)(ws + WS_WMI), *WMO_T = (bf16_t*)(ws + WS_WMO); \
    float *CAR = (float*)(dob + DO_CAR), *CBR = (float*)(dob + DO_CBR); \
    bf16_t* XB = (bf16_t*)(dob + DO_XB); bf16_t *KCB = (bf16_t*)(dob + DO_KCB), *VCT = (bf16_t*)(dob + DO_VCT), *VST = (bf16_t*)(dob + DO_VST), *VWT = (bf16_t*)(dob + DO_VWT); \
    (void)0;
__global__ void __launch_bounds__(NTHREADS, 2) fwd(Args a) {
    extern __shared__ __attribute__((aligned(16))) unsigned char lds[];
    float* ldsf = (float*)lds;
    const int tid = threadIdx.x, lane = tid & 63, wave = tid >> 6;
    const int gw = blockIdx.x * 8 + wave, NGW = gridDim.x * 8;
#define gtid ((size_t)blockIdx.x * NTHREADS + threadIdx.x)
#define GSZ ((size_t)gridDim.x * NTHREADS)
    unsigned char* ws0 = a.ws;
    PG8_LAS unsigned char* ldsl = (PG8_LAS unsigned char*)lds;
    const int G = gridDim.x;
    const int lo = a.ph_lo, hi = a.ph_hi;
    volatile LAS unsigned* MISC = (volatile LAS unsigned*)((LAS unsigned char*)lds + LDS_BYTES - 256);
    if (tid < 32) MISC[tid] = 0u;
    __syncthreads();
    XcdBarrier bar = xcd_barrier_post((unsigned*)(ws0 + 16384), MISC + 8);
    int ph = 0;
#ifndef PHMASK
#define PHMASK 0xFFFFFFFFu
#endif
#ifndef REPMASK
#define REPMASK 0u
#endif
#define PHASE_BEGIN if (lo <= ph && ph < hi && ((PHMASK >> ph) & 1u)) {
#define PHASE_BEGIN_R if (lo <= ph && ph < hi && ((PHMASK >> ph) & 1u)) for (int rep_ = 0; rep_ < (((REPMASK >> (16 + ph)) & 1u) ? 2 : 1); ++rep_) {
#define PHASE_END } { const bool sync_ = (lo <= ph && ph + 1 < hi); ++ph; if (sync_) xcd_barrier(bar); }

    PHASE_BEGIN_R DECL_PTRS
    for (int m0 = 2 * gw; m0 < M; m0 += 2 * NGW) {
        pg8::f32x4 v[2][4]; float s[2] = {0.f, 0.f};
#pragma unroll
        for (int u = 0; u < 2; ++u) { const pg8::f32x4* xr = (const pg8::f32x4*)(x + (size_t)(m0 + u) * D) + lane;
#pragma unroll
            for (int j = 0; j < 4; ++j) v[u][j] = xr[64 * j]; }
#pragma unroll
        for (int u = 0; u < 2; ++u)
#pragma unroll
            for (int j = 0; j < 4; ++j) s[u] += (v[u][j][0] * v[u][j][0] + v[u][j][1] * v[u][j][1]) + (v[u][j][2] * v[u][j][2] + v[u][j][3] * v[u][j][3]);
#pragma unroll
        for (int o = 1; o < 64; o <<= 1) { s[0] += __shfl_xor(s[0], o); s[1] += __shfl_xor(s[1], o); }
#pragma unroll
        for (int u = 0; u < 2; ++u) { const float r = rsqrtf(s[u] * (1.f / D) + EPS); if (lane == 0) RSTD[m0 + u] = r;
            unsigned long long* o8 = (unsigned long long*)(XB + (size_t)(m0 + u) * D) + lane;
#pragma unroll
            for (int j = 0; j < 4; ++j) { const pg8::f32x4 gg = *((const pg8::f32x4*)norm_mix + lane + 64 * j); const pg8::f32x4 y = v[u][j] * r * gg;
                o8[64 * j] = (unsigned long long)pg8::cvt_pk_bf16(y[0], y[1]) | ((unsigned long long)pg8::cvt_pk_bf16(y[2], y[3]) << 32); } }
    }
    for (size_t i = gtid; i < DRNN; i += GSZ) LAMC[i] = -8.f * log1pf(__expf(-lam[i])) * LOG2E;
    for (size_t i = gtid; i < 4096; i += GSZ) PES[i] = i < 2048 ? pe_k[i] : pe_v[i - 2048];
    for (size_t i = gtid; i < 192; i += GSZ) NORMS[i] = i < 64 ? q_norm[i] : (i < 128 ? ks_norm[i - 64] : kw_norm[i - 128]);
    {
        float* scr = ldsf + wave * (64 * 33);
        constexpr int I_WIN = (pg8::N1PAD / 32) * 16, I_W1 = 16 * 32;
        for (int it = gw; it < I_WIN + I_W1; it += NGW) {
            int r = it;
            if (r < I_WIN) { const int ch = r / 16, kb = r % 16; int c0, cv; pg8::win_src(ch, c0, cv); tr_item(w_in, DIN, D, c0, cv, nullptr, WIN_T, D, 32 * ch, 64 * kb, scr, lane); continue; } r -= I_WIN;
            { const int ch = r / 32, kb = r % 32; tr_item((ch >> 3) ? w1v : w1k, 256, 2048, (ch & 7) * 32, 32, nullptr, W1_T, 2048, 32 * ch, 64 * kb, scr, lane); }
        }
    }
    PHASE_END
    PHASE_BEGIN DECL_PTRS
    if (FAST(1)) {
        pg8::Gemm g{XB, WIN_T, M, pg8::N1PAD, D}; pg8::StaticOrder S; S.init(M, pg8::N1PAD, G, (int)blockIdx.x);
        PG8_LAS float* ctab = (PG8_LAS float*)(ldsl + 131072);
        for (int i = tid; i < 192; i += NTHREADS) ctab[i] = NORMS[i];
        for (int i = tid; i < 4096; i += NTHREADS) ctab[256 + i] = PES[i];
        __syncthreads();
        pg8::Ep1F E{URNN, UGATE, Q, KV, GN, GA, ctab, FLATK, ctab + 256};
        pg8::gemm_phase<pg8::Ep1F, pg8::StaticOrder, true, true>(ldsl, g, S, E);
#if (REPMASK >> 1) & 1
        pg8::gemm_phase<pg8::Ep1F, pg8::StaticOrder, true, true>(ldsl, g, S, E);
#endif
    } else {
        ngemm(ldsf, M, DIN, D, ALf32Scale{x, D, norm_mix}, BLf32{w_in, DIN}, Ep1{RSTD, URNN, UGATE, Q, KV, GN, GA, GB});
    }
    PHASE_END
    PHASE_BEGIN DECL_PTRS
    if (blockIdx.x >= 64) {
        float* scr = ldsf + wave * (64 * 33);
        constexpr int I_WG = 96 * 6, I_PA = 32 * 22, I_PB = 32 * 16, I_WO = 32 * 16, I_WMI = 128 * 16, I_WMO = 32 * 64;
        for (int it = ((int)blockIdx.x - 64) * 8 + wave; it < I_WG + I_PA + I_PB + I_WO + I_WMI + I_WMO; it += ((int)gridDim.x - 64) * 8) {
            int r = it;
            if (r < I_WG) { const int ch = r / 6, kb = r % 6, nb = ch / 24, rr = ch % 24, pn = rr >> 3, l0 = (rr & 7) * 32, bj = l0 >> 7, chn0 = 128 * pn + (l0 & 127);
                int cv = BW - chn0; cv = cv < 0 ? 0 : (cv > 32 ? 32 : cv);
                tr_item((bj ? gate_x_w : gate_a_w) + (size_t)nb * BW * BW, BW, BW, chn0, cv, nullptr, WG_T, XC_LD, 32 * ch, 64 * kb, scr, lane); continue; } r -= I_WG;
            if (r < I_PA) { const int ch = r / 22, kb = r % 22; tr_item(proj_a, D, DRNN, 32 * ch, 32, nullptr, PA_T, YA_LD, 32 * ch, 64 * kb, scr, lane); continue; } r -= I_PA;
            if (r < I_PB) { const int ch = r / 16, kb = r % 16; tr_item(proj_b, D, QW, 32 * ch, 32, nullptr, PB_T, QW, 32 * ch, 64 * kb, scr, lane); continue; } r -= I_PB;
            if (r < I_WO) { const int ch = r / 16, kb = r % 16; tr_item(w_out, D, D, 32 * ch, 32, nullptr, WO_T, D, 32 * ch, 64 * kb, scr, lane); continue; } r -= I_WO;
            if (r < I_WMI) { const int ch = r / 16, kb = r % 16; tr_item(w_mlp_in, DFF, D, 32 * ch, 32, norm_mlp, WMI_T, D, 32 * ch, 64 * kb, scr, lane); continue; } r -= I_WMI;
            { const int ch = r / 64, kb = r % 64; tr_item(w_mlp_out, D, DFF, 32 * ch, 32, nullptr, WMO_T, DFF, 32 * ch, 64 * kb, scr, lane); }
        }
    } else
    if (FAST(3)) {
        pg8::Gemm g{FLATK, W1_T, 16384, 512, 2048}; pg8::OrderC1 S{G, (int)blockIdx.x};
        pg8::EpGeluF E{HIDK, 256};
        pg8::gemm_phase<pg8::EpGeluF, pg8::OrderC1, true, true>(ldsl, g, S, E);
#if (REPMASK >> 3) & 1
        pg8::gemm_phase<pg8::EpGeluF, pg8::OrderC1, true, true>(ldsl, g, S, E);
#endif
    } else {
        ngemm(ldsf, 8192, 256, 2048, ALbf{FLATK, 2048}, BLf32{w1k, 256}, EpGelu{HIDK, 256});
        ngemm(ldsf, 8192, 256, 2048, ALbf{FLATV, 2048}, BLf32{w1v, 256}, EpGelu{HIDV, 256});
    }
    PHASE_END
    PHASE_BEGIN DECL_PTRS
    {
        const int vcu = (G % 8 == 0) ? ((int)blockIdx.x % 8) * (G / 8) + (int)blockIdx.x / 8 : (int)blockIdx.x;
#ifdef ATT_PROBE_MODE
#ifndef ATT_ABL
#define ATT_ABL 0
#endif
        for (int u = vcu; u < 256; u += G) {
            const int bg = u >> 2, s4 = u & 3;
            att::attn_bias_table(bg & 3, rel_bias, lds);
            att::attn_compress_l2(bg, HIDK, HIDV, w2k, w2v, kc_norm, lds);
#pragma unroll 1
            for (int i = 0; i < 8; ++i) { const int qblk = 8 * (i >> 1) + ((i & 1) ? 7 - s4 : s4);
                att::attn_unit<ATT_PROBE_MODE, ATT_ABL>(bg >> 2, bg & 3, qblk, Q, (bf16_t*)(dob + 64 * MiB), KS, VS, KW, VW, GN, rel_bias, lds); }
        }
#endif
        bool nomax;
        {   float* red = (float*)(lds + 159744);
            float v = 0.f; if (tid < 64) v = fabsf(q_norm[tid]); else if (tid < 128) v = fabsf(ks_norm[tid - 64]); else if (tid < 192) v = fabsf(kw_norm[tid - 128]);
            float bb = fabsf(rel_bias[tid]);
#pragma unroll
            for (int o = 32; o; o >>= 1) { v = fmaxf(v, __shfl_xor(v, o)); bb = fmaxf(bb, __shfl_xor(bb, o)); }
            if (lane == 0) { red[wave] = v; red[8 + wave] = bb; }
            __syncthreads();
            const float bm = fmaxf(fmaxf(fmaxf(red[8], red[9]), fmaxf(red[10], red[11])), fmaxf(fmaxf(red[12], red[13]), fmaxf(red[14], red[15])));
            nomax = 11.55f * red[0] * fmaxf(red[1], red[2]) + 2.f * 1.4427f * bm <= 60.f;
        }
#define ATT_UNITS(ABLV) for (int u = vcu; u < 256; u += G) {     \
            const int bg = u >> 2, s4 = u & 3; \
            att::attn_bias_table(bg & 3, rel_bias, lds); \
            att::attn_compress_l2(bg, HIDK, HIDV, w2k, w2v, kc_norm, lds); \
            _Pragma("unroll 1") for (int i = 7; i >= 0; --i) { const int qblk = 8 * (i >> 1) + ((i & 1) ? 7 - s4 : s4);     \
                att::attn_unit<7, ABLV>(bg >> 2, bg & 3, qblk, Q, Q, KS, VS, KW, VW, GN, rel_bias, lds); } }
        if (nomax) { ATT_UNITS(64) } else { ATT_UNITS(0) }
#undef ATT_UNITS
    }
    for (unsigned it = blockIdx.x * (unsigned)NTHREADS + threadIdx.x; it < 4u * (unsigned)(M / 8) * 48u; it += gridDim.x * (unsigned)NTHREADS) {
        const unsigned ch = it % 48u, nr = it / 48u, run = nr & (unsigned)(M / 8 - 1), n = nr >> 12, m0 = run * 8u, t0 = m0 & (unsigned)(T - 1), j0 = ch * 8u;
        bf16_t* dst = XC + ((size_t)n * M + m0) * XC_LD + j0;
        if (j0 >= (unsigned)BW) {
#pragma unroll
            for (int i = 0; i < 8; ++i) *(pg8::u32x4*)(dst + (size_t)i * XC_LD) = (pg8::u32x4){0u, 0u, 0u, 0u};
            continue; }
        const unsigned c = n * BW + j0;
        pg8::u32x4 rows[11];
#pragma unroll
        for (int i = 0; i < 11; ++i) rows[i] = ((int)t0 - 3 + i >= 0) ? *(const pg8::u32x4*)(URNN + (size_t)(m0 - 3 + i) * DRNN + c) : (pg8::u32x4){0u, 0u, 0u, 0u};
        pg8::f32x4 w0[4], w1[4];
#pragma unroll
        for (int kk = 0; kk < 4; ++kk) { w0[kk] = *(const pg8::f32x4*)(conv_w + kk * DRNN + c); w1[kk] = *(const pg8::f32x4*)(conv_w + kk * DRNN + c + 4); }
        const pg8::f32x4 b0 = *(const pg8::f32x4*)(conv_b + c), b1 = *(const pg8::f32x4*)(conv_b + c + 4);
#pragma unroll
        for (int i = 0; i < 8; ++i) { pg8::f32x4 a0 = b0, a1 = b1;
#pragma unroll
            for (int kk = 0; kk < 4; ++kk) { pg8::f32x4 x0, x1; pg8::unpack8(rows[i + kk], x0, x1); a0 += w0[kk] * x0; a1 += w1[kk] * x1; }
            *(pg8::u32x4*)(dst + (size_t)i * XC_LD) = pg8::pack8(a0, a1); }
    }
    PHASE_END
    PHASE_BEGIN DECL_PTRS
    if (FAST(8)) {
        int kg = XC_LD; asm volatile("" : "+s"(kg));
        pg8::Gemm g{XC, WG_T, 4 * M, 4 * 768, kg}; pg8::OrderGate S{G, (int)blockIdx.x};
        pg8::EpGateF E{gate_a_b, gate_x_b, LAMC, XC, LA, UP};
        pg8::gemm_phase<pg8::EpGateF, pg8::OrderGate, true, true>(ldsl, g, S, E);
#if (REPMASK >> 8) & 1
        pg8::gemm_phase<pg8::EpGateF, pg8::OrderGate, true, true>(ldsl, g, S, E);
#endif
    } else {
    for (int n = 0; n < 4; ++n)
        ngemm(ldsf, M, 2 * BW, BW, ALbf{XC + (size_t)n * M * XC_LD, XC_LD}, BLgate{gate_a_w + (size_t)n * BW * BW, gate_x_w + (size_t)n * BW * BW},
              EpGate{n, gate_a_b, gate_x_b, lam, XC + (size_t)n * M * XC_LD, LA, UP});
    }
    PHASE_END
    PHASE_BEGIN_R DECL_PTRS
    for (size_t it = gtid; it < (size_t)NB * 64 * 336; it += GSZ) {
        const int slot = (int)(it % 336), bk = (int)(it / 336), kc = bk & 63, b = bk >> 6, c0 = 4 * slot; const size_t m0 = (size_t)b * T + 32 * kc;
        float h[4] = {0.f, 0.f, 0.f, 0.f}, sl[4] = {0.f, 0.f, 0.f, 0.f};
#pragma unroll 1
        for (int i0 = 0; i0 < 32; i0 += 8) {
            unsigned long long lw[8], uw[8];
#pragma unroll
            for (int i = 0; i < 8; ++i) { lw[i] = *(const unsigned long long*)(LA + (m0 + i0 + i) * DRNN + c0); uw[i] = *(const unsigned long long*)(UP + (m0 + i0 + i) * DRNN + c0); }
#pragma unroll
            for (int i = 0; i < 8; ++i)
#pragma unroll
                for (int e = 0; e < 4; ++e) { const float la = bf2f((bf16_t)(lw[i] >> (16 * e))), up = bf2f((bf16_t)(uw[i] >> (16 * e))); const float av = __builtin_amdgcn_exp2f(la);
                    const float mult = (kc == 0 && i0 + i == 0) ? 1.f : __builtin_amdgcn_sqrtf(fmaxf(0.f, 1.f - av * av)); h[e] = av * h[e] + mult * up; sl[e] += la; }
        }
        *(pg8::f32x4*)(CAR + (size_t)bk * DRNN + c0) = (pg8::f32x4){sl[0], sl[1], sl[2], sl[3]};
        *(pg8::f32x4*)(CBR + (size_t)bk * DRNN + c0) = (pg8::f32x4){h[0], h[1], h[2], h[3]};
    }
    PHASE_END
    PHASE_BEGIN_R DECL_PTRS
    for (size_t it = gtid; it < (size_t)NB * 16 * 352; it += GSZ) {
        const int slot = (int)(it % 352), bs = (int)(it / 352), kg = bs & 15, b = bs >> 4, kc0 = 4 * kg, c0 = 4 * slot; const size_t m0 = (size_t)b * T + 128 * kg;
        if (slot >= 336) { for (int i = 0; i < 128; ++i) *(unsigned long long*)(YA + (m0 + i) * YA_LD + c0) = 0ull; continue; }
        unsigned long long la_[8], ua_[8], ga_[8], lb_[8], ub_[8], gb_[8];
#define SC_LOAD(L_, U_, G_, i0_) _Pragma("unroll") for (int i = 0; i < 8; ++i) { L_[i] = *(const unsigned long long*)(LA + (m0 + (i0_) + i) * DRNN + c0); U_[i] = *(const unsigned long long*)(UP + (m0 + (i0_) + i) * DRNN + c0); G_[i] = *(const unsigned long long*)(UGATE + (m0 + (i0_) + i) * DRNN + c0); }
#define SC_SCAN(L_, U_, G_, i0_) _Pragma("unroll") for (int i = 0; i < 8; ++i) { float y[4]; \
            _Pragma("unroll") for (int e = 0; e < 4; ++e) { const float la = bf2f((bf16_t)(L_[i] >> (16 * e))), up = bf2f((bf16_t)(U_[i] >> (16 * e))); const float av = __builtin_amdgcn_exp2f(la); \
                const float mult = (kg == 0 && (i0_) + i == 0) ? 1.f : __builtin_amdgcn_sqrtf(fmaxf(0.f, 1.f - av * av)); h[e] = av * h[e] + mult * up; y[e] = h[e] * bf2f((bf16_t)(G_[i] >> (16 * e))); } \
            *(unsigned long long*)(YA + (m0 + (i0_) + i) * YA_LD + c0) = (unsigned long long)att::cvtpk(y[0], y[1]) | ((unsigned long long)att::cvtpk(y[2], y[3]) << 32); }
        SC_LOAD(la_, ua_, ga_, 0)
        float h[4] = {0.f, 0.f, 0.f, 0.f};
        for (int k0 = 0; k0 < kc0; k0 += 16) {
            pg8::f32x4 sa[16], sb[16];
#pragma unroll
            for (int u = 0; u < 16; ++u) { const int k2 = k0 + u < kc0 ? k0 + u : kc0 - 1; sa[u] = *(const pg8::f32x4*)(CAR + (size_t)(b * 64 + k2) * DRNN + c0); sb[u] = *(const pg8::f32x4*)(CBR + (size_t)(b * 64 + k2) * DRNN + c0); }
#pragma unroll
            for (int u = 0; u < 16; ++u) if (k0 + u < kc0) {
#pragma unroll
                for (int e = 0; e < 4; ++e) h[e] = __builtin_amdgcn_exp2f(sa[u][e]) * h[e] + sb[u][e]; }
        }
#pragma unroll 1
        for (int r0 = 0; r0 < 128; r0 += 16) {
            SC_LOAD(lb_, ub_, gb_, r0 + 8) SC_SCAN(la_, ua_, ga_, r0)
            if (r0 + 16 < 128) { SC_LOAD(la_, ua_, ga_, r0 + 16) }
            SC_SCAN(lb_, ub_, gb_, r0 + 8)
        }
#undef SC_LOAD
#undef SC_SCAN
    }
    PHASE_END
    PHASE_BEGIN DECL_PTRS
    if (FAST(10)) {
        pg8::Gemm g{YA, PA_T, M, D, YA_LD}; pg8::StaticOrder S; S.init(M, D, G, (int)blockIdx.x);
        pg8::EpT1F E{GA, T1};
        pg8::gemm_phase<pg8::EpT1F, pg8::StaticOrder, true, true>(ldsl, g, S, E);
#if (REPMASK >> 10) & 1
        pg8::gemm_phase<pg8::EpT1F, pg8::StaticOrder, true, true>(ldsl, g, S, E);
#endif
    } else ngemm(ldsf, M, D, DRNN, ALbf{YA, YA_LD}, BLf32{proj_a, D}, EpT1{GA, T1});
    if (FAST(11)) {
        pg8::Gemm g{Q, PB_T, M, D, QW}; pg8::StaticOrder S; S.init(M, D, G, (int)blockIdx.x);
        pg8::EpMergedF E{GB, T1, MERGED};
        pg8::gemm_phase<pg8::EpMergedF, pg8::StaticOrder, true, true>(ldsl, g, S, E);
#if (REPMASK >> 11) & 1
        pg8::gemm_phase<pg8::EpMergedF, pg8::StaticOrder, true, true>(ldsl, g, S, E);
#endif
    } else ngemm(ldsf, M, D, QW, ALbf{Q, QW}, BLf32{proj_b, D}, EpMerged{GB, T1, MERGED});
    PHASE_END
    PHASE_BEGIN DECL_PTRS
    if (FAST(12)) {
        pg8::Gemm g{MERGED, WO_T, M, D, D}; pg8::StaticOrder S; S.init(M, D, G, (int)blockIdx.x);
        pg8::EpHF E{x, H, HB, SSQ};
        pg8::gemm_phase<pg8::EpHF, pg8::StaticOrder, true, true>(ldsl, g, S, E);
#if (REPMASK >> 12) & 1
        pg8::gemm_phase<pg8::EpHF, pg8::StaticOrder, true, true>(ldsl, g, S, E);
#endif
    } else ngemm(ldsf, M, D, D, ALbf{MERGED, D}, BLf32{w_out, D}, EpH{x, H, HB});
    PHASE_END
    PHASE_BEGIN DECL_PTRS
    if (FAST(14)) {
        pg8::Gemm g{HB, WMI_T, M, DFF, D}; pg8::StaticOrder S; S.init(M, DFF, G, (int)blockIdx.x);
        PG8_LAS float* rtab = (PG8_LAS float*)(ldsl + 131072);
        bool tab_ok;
        { pg8::Unit uu; int i = 0;
          for (; i < 16 && S.next(i, uu); ++i) if (tid < 256) { const float* sp = SSQ + (size_t)(uu.pm * 256 + tid) * 16;
                const pg8::f32x4 s0 = *(const pg8::f32x4*)sp, s1 = *(const pg8::f32x4*)(sp + 4), s2 = *(const pg8::f32x4*)(sp + 8), s3 = *(const pg8::f32x4*)(sp + 12); const pg8::f32x4 st = (s0 + s1) + (s2 + s3);
                rtab[i * 256 + tid] = rsqrtf(((st[0] + st[1]) + (st[2] + st[3])) * (1.f / D) + EPS); }
          tab_ok = !(i == 16 && S.next(16, uu)); }
        __syncthreads();
        pg8::EpZF E{tab_ok ? rtab : (PG8_LAS float*)nullptr, SSQ, ZACT};
        pg8::gemm_phase<pg8::EpZF, pg8::StaticOrder, true, true>(ldsl, g, S, E);
#if (REPMASK >> 14) & 1
        pg8::gemm_phase<pg8::EpZF, pg8::StaticOrder, true, true>(ldsl, g, S, E);
#endif
    } else ngemm(ldsf, M, DFF, D, ALbfScale{HB, D, norm_mlp}, BLf32{w_mlp_in, DFF}, EpZ{SSQ, ZACT});
    PHASE_END
    PHASE_BEGIN DECL_PTRS
    if (FAST(15)) {
        pg8::Gemm g{ZACT, WMO_T, M, D, DFF}; pg8::StaticOrder S; S.init(M, D, G, (int)blockIdx.x);
        pg8::EpOutF E{HB, H};
        pg8::gemm_phase<pg8::EpOutF, pg8::StaticOrder, true, true>(ldsl, g, S, E);
#if (REPMASK >> 15) & 1
        pg8::gemm_phase<pg8::EpOutF, pg8::StaticOrder, true, true>(ldsl, g, S, E);
#endif
    } else ngemm(ldsf, M, D, DFF, ALbf{ZACT, DFF}, BLf32{w_mlp_out, D}, EpOut{H});
    PHASE_END
}
constexpr int NPHASES = 11;

extern "C" void kernel_launch(void* const* d_in, const int* in_sizes, int n_in, void* d_out, int out_size, void* d_ws, size_t ws_size, hipStream_t stream) {
    static int grid = 0;
    if (grid == 0) {
        if (n_in != 27 || out_size != M * D || ws_size < WS_END) { fprintf(stderr, "kernel_launch: unexpected shapes n_in %d out %d ws %zu\n", n_in, out_size, ws_size); grid = -1; return; }
        int dev = 0, cus = 0, per_cu = 0;
        (void)hipGetDevice(&dev);
        (void)hipDeviceGetAttribute(&cus, hipDeviceAttributeMultiprocessorCount, dev);
        (void)hipFuncSetAttribute((const void*)fwd, hipFuncAttributeMaxDynamicSharedMemorySize, LDS_BYTES);
        (void)hipOccupancyMaxActiveBlocksPerMultiprocessor(&per_cu, (const void*)fwd, NTHREADS, LDS_BYTES);
        fprintf(stderr, "kernel_launch: cus %d per_cu %d ws_size %zu\n", cus, per_cu, ws_size);
        grid = cus;
    }
    if (grid < 0) return;
    if (hipMemsetAsync(d_ws, 0, 65536, stream) != hipSuccess) { fprintf(stderr, "kernel_launch: hipMemsetAsync failed\n"); return; }
    Args a{};
    for (int i = 0; i < 27; ++i) a.in[i] = (const float*)d_in[i];
    a.out = (float*)d_out; a.ws = (unsigned char*)d_ws; a.ph_lo = 0; a.ph_hi = NPHASES;
    void* args[] = {&a};
    hipError_t e = hipLaunchCooperativeKernel((const void*)fwd, dim3(grid), dim3(NTHREADS), args, LDS_BYTES, stream);
    if (e != hipSuccess) fprintf(stderr, "cooperative launch failed: %s (grid %d)\n", hipGetErrorString(e), grid);
}
```
